# Optimizing an MI355X kernel written in HIP

```python
import math
import jax, jax.numpy as jnp
from jax import lax
import numpy as np

D_MODEL = 2048
BATCH = 8
SEQ = 2048
DEPTH = 1

D_MIX = D_MODEL
CONV_WIDTH = 4
LRU_WIDTH = D_MIX // 2
LRU_HEADS = 16
LRU_HEAD_DIM = LRU_WIDTH // LRU_HEADS
LRU_C = 8.0
SSD_WIDTH = D_MIX - LRU_WIDTH
SSD_HEAD_DIM = 64
SSD_HEADS = SSD_WIDTH // SSD_HEAD_DIM
SSD_GROUPS = 2
SSD_STATE = 128
SSD_CHUNK = 128
SSD_CONV_DIM = SSD_WIDTH + 2 * SSD_GROUPS * SSD_STATE
IN_SPLITS = (LRU_WIDTH, LRU_WIDTH, SSD_WIDTH, SSD_CONV_DIM, SSD_HEADS)
IN_PROJ_DIM = sum(IN_SPLITS)
PEER_HEADS = 8
PEER_N_KEYS = 128
PEER_N_EXPERTS = PEER_N_KEYS * PEER_N_KEYS
PEER_QUERY_DIM = 256
PEER_HALF = PEER_QUERY_DIM // 2
PEER_TOPK = 16
PEER_TOKEN_BLOCK = 128
EPS = 1e-6

kernel_name = "hybrid_rglru_ssd_peer"


def rmsnorm(x, w):
    xf = x.astype(jnp.float32)
    y = xf * lax.rsqrt(jnp.mean(xf * xf, axis=-1, keepdims=True) + EPS)
    return (y * w.astype(jnp.float32)).astype(x.dtype)


def causal_depthwise_conv(x, w, b):
    c = x.shape[-1]
    y = lax.conv_general_dilated(
        x, w[:, None, :].astype(x.dtype), window_strides=(1,),
        padding=[(CONV_WIDTH - 1, 0)], dimension_numbers=('NWC', 'WIO', 'NWC'),
        feature_group_count=c)
    return y + b.astype(x.dtype)


def rglru(xb, wa, ba, wx, bx, lam):
    bsz, s, w = xb.shape
    xh = xb.reshape(bsz, s, LRU_HEADS, LRU_HEAD_DIM)
    r = jax.nn.sigmoid((jnp.einsum('bshi,hij->bshj', xh, wa).reshape(bsz, s, w) + ba).astype(jnp.float32))
    i = jax.nn.sigmoid((jnp.einsum('bshi,hij->bshj', xh, wx).reshape(bsz, s, w) + bx).astype(jnp.float32))
    log_a = -LRU_C * r * jax.nn.softplus(-lam.astype(jnp.float32))
    a = jnp.exp(log_a)
    b = jnp.sqrt(-jnp.expm1(2.0 * log_a)) * (i * xb.astype(jnp.float32))

    def step(h, ab):
        a_t, b_t = ab
        h = a_t * h + b_t
        return h, h

    _, hs = lax.scan(step, jnp.zeros((bsz, w), jnp.float32),
                     (a.transpose(1, 0, 2), b.transpose(1, 0, 2)))
    return hs.transpose(1, 0, 2).astype(xb.dtype)


def segsum(x):
    t = x.shape[-1]
    xx = jnp.broadcast_to(x[..., None], x.shape + (t,))
    xx = jnp.where(jnp.tril(jnp.ones((t, t), bool), -1), xx, 0.0)
    ss = jnp.cumsum(xx, axis=-2)
    return jnp.where(jnp.tril(jnp.ones((t, t), bool), 0), ss, -jnp.inf)


def ssd_chunked(x, dt, a, bm, cm):
    bsz, s, h, p = x.shape
    nc = s // SSD_CHUNK
    rep = h // SSD_GROUPS
    bh = jnp.repeat(bm, rep, axis=2).reshape(bsz, nc, SSD_CHUNK, h, SSD_STATE)
    ch = jnp.repeat(cm, rep, axis=2).reshape(bsz, nc, SSD_CHUNK, h, SSD_STATE)
    xc = (x * dt[..., None]).reshape(bsz, nc, SSD_CHUNK, h, p)
    adt = (a * dt).reshape(bsz, nc, SSD_CHUNK, h).transpose(0, 3, 1, 2)
    a_cs = jnp.cumsum(adt, axis=-1)
    lmat = jnp.exp(segsum(adt))
    scores = jnp.einsum('bclhn,bcshn->bhcls', ch, bh) * lmat
    y_diag = jnp.einsum('bhcls,bcshp->bclhp', scores, xc)
    decay_states = jnp.exp(a_cs[..., -1:] - a_cs)
    states = jnp.einsum('bclhn,bhcl,bclhp->bchpn', bh, decay_states, xc)
    states = jnp.concatenate([jnp.zeros_like(states[:, :1]), states], axis=1)
    chunk_decay = jnp.exp(segsum(jnp.pad(a_cs[..., -1], ((0, 0), (0, 0), (1, 0)))))
    states = jnp.einsum('bhzc,bchpn->bzhpn', chunk_decay, states)[:, :-1]
    y_off = jnp.einsum('bclhn,bchpn,bhcl->bclhp', ch, states, jnp.exp(a_cs))
    return (y_diag + y_off).reshape(bsz, s, h, p)


def peer(h, wq, sub_keys, u, v):
    bsz, s, d = h.shape
    q = (h @ wq).astype(jnp.float32).reshape(bsz, s, PEER_HEADS, 2, PEER_HALF)
    sc = jnp.einsum('bshkd,hknd->bshkn', q, sub_keys.astype(jnp.float32))
    s1, i1 = lax.top_k(sc[..., 0, :], PEER_TOPK)
    s2, i2 = lax.top_k(sc[..., 1, :], PEER_TOPK)
    cand_s = (s1[..., :, None] + s2[..., None, :]).reshape(bsz, s, PEER_HEADS, PEER_TOPK * PEER_TOPK)
    cand_i = (i1[..., :, None] * PEER_N_KEYS + i2[..., None, :]).reshape(bsz, s, PEER_HEADS, PEER_TOPK * PEER_TOPK)
    top_s, top_pos = lax.top_k(cand_s, PEER_TOPK)
    idx = jnp.take_along_axis(cand_i, top_pos, axis=-1)
    g = jax.nn.softmax(top_s, axis=-1)
    n_blocks = (bsz * s) // PEER_TOKEN_BLOCK
    hb = h.reshape(n_blocks, PEER_TOKEN_BLOCK, d)
    ib = idx.reshape(n_blocks, PEER_TOKEN_BLOCK, PEER_HEADS * PEER_TOPK)
    gb = g.astype(h.dtype).reshape(n_blocks, PEER_TOKEN_BLOCK, PEER_HEADS * PEER_TOPK)

    def block(args):
        hx, ix, gx = args
        u_sel = jnp.take(u, ix, axis=0)
        act = jax.nn.gelu(jnp.einsum('tkd,td->tk', u_sel, hx))
        v_sel = jnp.take(v, ix, axis=0)
        return jnp.einsum('tk,tkd->td', gx * act, v_sel)

    out = lax.map(block, (hb, ib, gb))
    return out.reshape(bsz, s, d)


def setup_inputs(seed: int = 0) -> dict:
    key = jax.random.key(seed)
    ks = jax.random.split(key, 32)
    f32 = jnp.float32

    def nrm(k, shape, scale):
        return jax.random.normal(k, shape, f32) * scale

    def gain(k, shape):
        return 1.0 + 0.02 * jax.random.normal(k, shape, f32)

    a8 = jax.random.uniform(ks[10], (DEPTH, LRU_WIDTH), f32, 0.9, 0.999)
    sig = a8 ** (1.0 / LRU_C)
    lru_lambda = jnp.log(sig) - jnp.log1p(-sig)
    dt0 = jnp.exp(jax.random.uniform(ks[13], (DEPTH, SSD_HEADS), f32, math.log(1e-3), math.log(1e-1)))
    ssd_dt_bias = dt0 + jnp.log(-jnp.expm1(-dt0))
    ssd_a_log = jnp.log(jax.random.uniform(ks[14], (DEPTH, SSD_HEADS), f32, 1.0, 16.0))
    return {
        'x': nrm(ks[0], (BATCH, SEQ, D_MODEL), 1.0),
        'norm_mix_w': gain(ks[1], (DEPTH, D_MODEL)),
        'w_in': nrm(ks[2], (DEPTH, D_MODEL, IN_PROJ_DIM), D_MODEL ** -0.5),
        'lru_conv_w': nrm(ks[3], (DEPTH, CONV_WIDTH, LRU_WIDTH), CONV_WIDTH ** -0.5),
        'lru_conv_b': nrm(ks[4], (DEPTH, LRU_WIDTH), 0.02),
        'lru_wa': nrm(ks[5], (DEPTH, LRU_HEADS, LRU_HEAD_DIM, LRU_HEAD_DIM), LRU_HEAD_DIM ** -0.5),
        'lru_ba': nrm(ks[6], (DEPTH, LRU_WIDTH), 0.02),
        'lru_wx': nrm(ks[7], (DEPTH, LRU_HEADS, LRU_HEAD_DIM, LRU_HEAD_DIM), LRU_HEAD_DIM ** -0.5),
        'lru_bx': nrm(ks[8], (DEPTH, LRU_WIDTH), 0.02),
        'lru_lambda': lru_lambda,
        'ssd_conv_w': nrm(ks[11], (DEPTH, CONV_WIDTH, SSD_CONV_DIM), CONV_WIDTH ** -0.5),
        'ssd_conv_b': nrm(ks[12], (DEPTH, SSD_CONV_DIM), 0.02),
        'ssd_dt_bias': ssd_dt_bias,
        'ssd_a_log': ssd_a_log,
        'ssd_d': gain(ks[15], (DEPTH, SSD_HEADS)),
        'ssd_norm_w': gain(ks[16], (DEPTH, SSD_WIDTH)),
        'w_out': nrm(ks[17], (DEPTH, D_MIX, D_MODEL), D_MIX ** -0.5),
        'norm_ffn_w': gain(ks[18], (DEPTH, D_MODEL)),
        'peer_wq': nrm(ks[19], (DEPTH, D_MODEL, PEER_HEADS * PEER_QUERY_DIM), D_MODEL ** -0.5),
        'peer_sub_keys': nrm(ks[20], (DEPTH, PEER_HEADS, 2, PEER_N_KEYS, PEER_HALF), PEER_HALF ** -0.5),
        'peer_u': nrm(ks[21], (DEPTH, PEER_N_EXPERTS, D_MODEL), D_MODEL ** -0.5),
        'peer_v': nrm(ks[22], (DEPTH, PEER_N_EXPERTS, D_MODEL), 0.1),
        'norm_final_w': gain(ks[23], (D_MODEL,)),
    }


def reference(x, norm_mix_w, w_in, lru_conv_w, lru_conv_b, lru_wa, lru_ba, lru_wx, lru_bx,
              lru_lambda, ssd_conv_w, ssd_conv_b, ssd_dt_bias, ssd_a_log, ssd_d, ssd_norm_w,
              w_out, norm_ffn_w, peer_wq, peer_sub_keys, peer_u, peer_v, norm_final_w):
    bsz, s, _ = x.shape
    split_at = [int(v) for v in np.cumsum(IN_SPLITS)[:-1]]
    for l in range(DEPTH):
        h = rmsnorm(x, norm_mix_w[l])
        proj = h @ w_in[l]
        lru_x, lru_gate, ssd_z, ssd_xbc, ssd_dt = jnp.split(proj, split_at, axis=-1)
        xl = causal_depthwise_conv(lru_x, lru_conv_w[l], lru_conv_b[l])
        y_lru = rglru(xl, lru_wa[l], lru_ba[l], lru_wx[l], lru_bx[l], lru_lambda[l]) * jax.nn.gelu(lru_gate)
        xbc = jax.nn.silu(causal_depthwise_conv(ssd_xbc, ssd_conv_w[l], ssd_conv_b[l]))
        xs, bm, cm = jnp.split(xbc, [SSD_WIDTH, SSD_WIDTH + SSD_GROUPS * SSD_STATE], axis=-1)
        xs_h = xs.astype(jnp.float32).reshape(bsz, s, SSD_HEADS, SSD_HEAD_DIM)
        dt = jax.nn.softplus(ssd_dt.astype(jnp.float32) + ssd_dt_bias[l].astype(jnp.float32))
        a = -jnp.exp(ssd_a_log[l].astype(jnp.float32))
        y = ssd_chunked(xs_h, dt, a,
                        bm.astype(jnp.float32).reshape(bsz, s, SSD_GROUPS, SSD_STATE),
                        cm.astype(jnp.float32).reshape(bsz, s, SSD_GROUPS, SSD_STATE))
        y = y + ssd_d[l].astype(jnp.float32)[:, None] * xs_h
        y = y.reshape(bsz, s, SSD_WIDTH).astype(x.dtype)
        y_ssd = rmsnorm(y * jax.nn.silu(ssd_z), ssd_norm_w[l])
        x = x + jnp.concatenate([y_lru, y_ssd], axis=-1) @ w_out[l]
        h = rmsnorm(x, norm_ffn_w[l])
        x = x + peer(h, peer_wq[l], peer_sub_keys[l], peer_u[l], peer_v[l])
    return rmsnorm(x, norm_final_w)
```

```cpp
#include <hip/hip_runtime.h>
#include <hip/hip_cooperative_groups.h>
#include <cstdio>
namespace cg = cooperative_groups;

#define ABL_NOPEER 1
#ifndef SINGLE_LAUNCH
#define SINGLE_LAUNCH 1
#endif

typedef unsigned short bf16_t;
typedef short bf16x8 __attribute__((ext_vector_type(8)));
typedef float f32x4 __attribute__((ext_vector_type(4)));
typedef unsigned u32x4 __attribute__((ext_vector_type(4)));
typedef unsigned u32x2 __attribute__((ext_vector_type(2)));
typedef __bf16 bf2_t __attribute__((ext_vector_type(2)));

#define T_TOK 16384
#define DM 2048
#define LDP 4736
#define NTHR 256
#define SMEM_BYTES 73728
#define EPSV 1e-6f
#define MIB ((size_t)1 << 20)

#define OFF_XB (0 * MIB)
#define OFF_PROJ (64 * MIB)
#define OFF_X1B (64 * MIB)
#define OFF_Q (128 * MIB)
#define OFF_IDX (192 * MIB)
#define OFF_G (200 * MIB)
#define OFF_HLOC (212 * MIB)
#define OFF_CUMA (276 * MIB)
#define OFF_YPART (340 * MIB)
#define OFF_ST (372 * MIB)
#define OFF_WINT (436 * MIB)
#define OFF_WOUTT (455 * MIB)
#define OFF_WQT (463 * MIB)
#define OFF_WAT (471 * MIB)
#define OFF_WXT (471 * MIB + 131072)
#define OFF_KEYSB (471 * MIB + 262144)
#define OFF_RS1 (472 * MIB)
#define OFF_ACS (472 * MIB + 65536)
#define OFF_LCARRY (OFF_ACS + MIB)
#define OFF_SSQ (OFF_LCARRY + 524288)
#define OFF_SSQ2 (OFF_SSQ + MIB)

struct Params {
  const float *x, *norm_mix_w, *w_in, *lru_conv_w, *lru_conv_b, *lru_wa, *lru_ba, *lru_wx, *lru_bx, *lru_lambda;
  const float *ssd_conv_w, *ssd_conv_b, *ssd_dt_bias, *ssd_a_log, *ssd_d, *ssd_norm_w, *w_out, *norm_ffn_w, *peer_wq;
  const float *peer_sub_keys, *peer_u, *peer_v, *norm_final_w;
  float* out;
  unsigned char* ws;
  int phase_lo, phase_hi, coop, pad0;
};

__device__ __forceinline__ unsigned pk2(float lo, float hi) {
  unsigned r;
  asm("v_cvt_pk_bf16_f32 %0, %1, %2" : "=v"(r) : "v"(lo), "v"(hi));
  return r;
}
__device__ __forceinline__ float bf2f(bf16_t v) { return __uint_as_float(((unsigned)v) << 16); }
__device__ __forceinline__ float bflo(unsigned u) { return __uint_as_float(u << 16); }
__device__ __forceinline__ float bfhi(unsigned u) { return __uint_as_float(u & 0xffff0000u); }
__device__ __forceinline__ float wave_sum(float v) {
#pragma unroll
  for (int o = 32; o > 0; o >>= 1) v += __shfl_xor(v, o);
  return v;
}
__device__ __forceinline__ float sigmoid_(float x) { return 1.f / (1.f + __expf(-x)); }
__device__ __forceinline__ float silu_(float x) { return x * sigmoid_(x); }
__device__ __forceinline__ float gelu_(float x) {
  float u = 0.7978845608028654f * (x + 0.044715f * x * x * x);
  return x * sigmoid_(2.f * u);
}
__device__ __forceinline__ float softplus_(float x) { return fmaxf(x, 0.f) + log1pf(__expf(-fabsf(x))); }
__device__ __forceinline__ f32x4 mfma16(bf16x8 a, bf16x8 b, f32x4 c) {
  return __builtin_amdgcn_mfma_f32_16x16x32_bf16(a, b, c, 0, 0, 0);
}
__device__ __forceinline__ bf16x8 as_frag(u32x4 v) { return __builtin_bit_cast(bf16x8, v); }
__device__ __forceinline__ int sw256(int row, int chunk) { return row * 256 + ((chunk ^ (row & 15)) << 4); }
__device__ __forceinline__ int sw128(int row, int chunk) { return row * 128 + ((chunk ^ ((row >> 1) & 7)) << 4); }

__device__ __forceinline__ float rs_from_ssq2(const float* ssq2, int row) {
  const f32x4* pp = (const f32x4*)(ssq2 + (size_t)row * 32);
  float s = 0.f;
#pragma unroll
  for (int i = 0; i < 8; ++i) { f32x4 v = pp[i]; s += v[0] + v[1] + v[2] + v[3]; }
  return rsqrtf(s * (1.f / 2048.f) + EPSV);
}
__device__ __forceinline__ float rs_from_ssq(const float* ssq, int row) {
  const f32x4* pp = (const f32x4*)(ssq + (size_t)row * 16);
  float s = 0.f;
#pragma unroll
  for (int i = 0; i < 4; ++i) { f32x4 v = pp[i]; s += v[0] + v[1] + v[2] + v[3]; }
  return rsqrtf(s * (1.f / 1024.f) + EPSV);
}

__device__ void transpose_tile(const float* __restrict__ src, int ld_src, int r0, int c0, int c_valid,
                               bf16_t* __restrict__ dst, int ld_dst, const float* __restrict__ scale, int scale_from,
                               float* tile) {
  const int tid = threadIdx.x;
  {
    const int j = tid & 63, i0 = tid >> 6;
#pragma unroll 4
    for (int ii = 0; ii < 16; ++ii) {
      const int i = i0 + 4 * ii;
      float v = 0.f;
      if (c0 + j < c_valid) {
        v = src[(size_t)(r0 + i) * ld_src + c0 + j];
        if (scale != nullptr && (r0 + i) >= scale_from) v *= scale[r0 + i - scale_from];
      }
      tile[i * 65 + j] = v;
    }
  }
  __syncthreads();
  {
    const int i = tid & 63, j0 = tid >> 6;
#pragma unroll 4
    for (int jj = 0; jj < 16; ++jj) {
      const int j = j0 + 4 * jj;
      dst[(size_t)(c0 + j) * ld_dst + r0 + i] = (bf16_t)(pk2(tile[i * 65 + j], 0.f) & 0xffffu);
    }
  }
  __syncthreads();
}

__device__ void phase_prep(const Params& p, unsigned char* smem) {
  const int tid = threadIdx.x, lane = tid & 63, wid = tid >> 6;
  unsigned char* ws = p.ws;
  bf16_t* xb = (bf16_t*)(ws + OFF_XB);
  float* rs1 = (float*)(ws + OFF_RS1);
  for (int t = blockIdx.x * 4 + wid; t < T_TOK; t += gridDim.x * 4) {
    const float* xr = p.x + (size_t)t * DM;
    bf16_t* xo = xb + (size_t)t * DM;
    float ss = 0.f;
#pragma unroll
    for (int c = 0; c < 8; ++c) {
      f32x4 v = *(const f32x4*)(xr + c * 256 + lane * 4);
      ss += v[0] * v[0] + v[1] * v[1] + v[2] * v[2] + v[3] * v[3];
      u32x2 o = {pk2(v[0], v[1]), pk2(v[2], v[3])};
      *(u32x2*)(xo + c * 256 + lane * 4) = o;
    }
    ss = wave_sum(ss);
    if (lane == 0) rs1[t] = rsqrtf(ss * (1.f / 2048.f) + EPSV);
  }
  float* tile = (float*)smem;
  const int NT_WIN = 32 * 74, NT_SQ = 32 * 32;
  const int total = NT_WIN + 2 * NT_SQ + 32;
  for (int u = blockIdx.x; u < total; u += gridDim.x) {
    if (u < NT_WIN) {
      const int ri = u & 31, cj = u >> 5;
      transpose_tile(p.w_in, 4624, ri * 64, cj * 64, 4624, (bf16_t*)(ws + OFF_WINT), 2048, p.norm_mix_w, 0, tile);
    } else if (u < NT_WIN + NT_SQ) {
      const int v = u - NT_WIN, ri = v & 31, cj = v >> 5;
      transpose_tile(p.w_out, 2048, ri * 64, cj * 64, 2048, (bf16_t*)(ws + OFF_WOUTT), 2048, p.ssd_norm_w, 1024, tile);
    } else if (u < NT_WIN + 2 * NT_SQ) {
      const int v = u - NT_WIN - NT_SQ, ri = v & 31, cj = v >> 5;
      transpose_tile(p.peer_wq, 2048, ri * 64, cj * 64, 2048, (bf16_t*)(ws + OFF_WQT), 2048, p.norm_ffn_w, 0, tile);
    } else {
      const int v = u - NT_WIN - 2 * NT_SQ;
      const int h = v & 15;
      const float* src = (v < 16 ? p.lru_wa : p.lru_wx) + (size_t)h * 4096;
      bf16_t* dst = (bf16_t*)(ws + (v < 16 ? OFF_WAT : OFF_WXT)) + (size_t)h * 4096;
      transpose_tile(src, 64, 0, 0, 64, dst, 64, nullptr, 0, tile);
    }
  }
  {
    bf16_t* kb = (bf16_t*)(ws + OFF_KEYSB);
    for (int i = blockIdx.x * NTHR + tid; i < 65536; i += gridDim.x * NTHR) {
      f32x4 v = *(const f32x4*)(p.peer_sub_keys + (size_t)i * 4);
      u32x2 o = {pk2(v[0], v[1]), pk2(v[2], v[3])};
      *(u32x2*)(kb + (size_t)i * 4) = o;
    }
  }
}

template <int MODE>
__device__ void gemm_tile(const Params& p, unsigned char* smem, const bf16_t* __restrict__ A,
                          const bf16_t* __restrict__ Bt, int mt, int nt) {
  const int tid = threadIdx.x, lane = tid & 63, wid = tid >> 6, wr = wid >> 1, wc = wid & 1;
  const int l15 = lane & 15, q4 = lane >> 4;
  const int m0 = mt * 128, n0 = nt * 128;
  unsigned char* ws = p.ws;
  f32x4 acc[4][4];
#pragma unroll
  for (int i = 0; i < 4; ++i)
#pragma unroll
    for (int j = 0; j < 4; ++j) acc[i][j] = (f32x4){0.f, 0.f, 0.f, 0.f};
  const int srow = tid >> 3, skc = tid & 7;
  const bf16_t* Ag = A + (size_t)(m0 + srow) * 2048 + skc * 8;
  const bf16_t* Bg = Bt + (size_t)(n0 + srow) * 2048 + skc * 8;
  const int soff = srow * 128 + ((skc ^ ((srow >> 1) & 7)) << 4);
  u32x4 ra[4], rb[4];
  constexpr int NK = 32;
#define KIDX(kt) ((MODE == 2) ? (((kt) + 16) & 31) : (kt))
  {
    const int kk = KIDX(0);
#pragma unroll
    for (int i = 0; i < 4; ++i) {
      ra[i] = *(const u32x4*)(Ag + (size_t)i * 32 * 2048 + kk * 64);
      rb[i] = *(const u32x4*)(Bg + (size_t)i * 32 * 2048 + kk * 64);
    }
#pragma unroll
    for (int i = 0; i < 4; ++i) {
      *(u32x4*)(smem + soff + i * 4096) = ra[i];
      *(u32x4*)(smem + 16384 + soff + i * 4096) = rb[i];
    }
  }
  __syncthreads();
  for (int kt = 0; kt < NK; ++kt) {
    const int buf = kt & 1;
    if (kt + 1 < NK) {
      const int kk = KIDX(kt + 1);
#pragma unroll
      for (int i = 0; i < 4; ++i) {
        ra[i] = *(const u32x4*)(Ag + (size_t)i * 32 * 2048 + kk * 64);
        rb[i] = *(const u32x4*)(Bg + (size_t)i * 32 * 2048 + kk * 64);
      }
    }
    const unsigned char* As = smem + buf * 32768;
    const unsigned char* Bs = As + 16384;
#pragma unroll
    for (int ks = 0; ks < 2; ++ks) {
      bf16x8 af[4], bfr[4];
      const int chunk = ks * 4 + q4;
#pragma unroll
      for (int mi = 0; mi < 4; ++mi) af[mi] = *(const bf16x8*)(As + sw128(wr * 64 + mi * 16 + l15, chunk));
#pragma unroll
      for (int ni = 0; ni < 4; ++ni) bfr[ni] = *(const bf16x8*)(Bs + sw128(wc * 64 + ni * 16 + l15, chunk));
#pragma unroll
      for (int mi = 0; mi < 4; ++mi)
#pragma unroll
        for (int ni = 0; ni < 4; ++ni) acc[mi][ni] = mfma16(bfr[ni], af[mi], acc[mi][ni]);
    }
    if (MODE == 2 && kt == 15) {
      const float* ssq = (const float*)(ws + OFF_SSQ);
#pragma unroll
      for (int mi = 0; mi < 4; ++mi) {
        const float s = rs_from_ssq(ssq, m0 + wr * 64 + mi * 16 + l15);
#pragma unroll
        for (int ni = 0; ni < 4; ++ni) acc[mi][ni] *= s;
      }
    }
    if (kt + 1 < NK) {
      unsigned char* dsta = smem + (buf ^ 1) * 32768 + soff;
#pragma unroll
      for (int i = 0; i < 4; ++i) {
        *(u32x4*)(dsta + i * 4096) = ra[i];
        *(u32x4*)(dsta + 16384 + i * 4096) = rb[i];
      }
    }
    __syncthreads();
  }
#undef KIDX
  if (MODE == 1) {
    const float* rs1 = (const float*)(ws + OFF_RS1);
    bf16_t* proj = (bf16_t*)(ws + OFF_PROJ);
#pragma unroll
    for (int mi = 0; mi < 4; ++mi) {
      const int row = m0 + wr * 64 + mi * 16 + l15;
      const float s = rs1[row];
#pragma unroll
      for (int ni = 0; ni < 4; ++ni) {
        const int col = n0 + wc * 64 + ni * 16 + q4 * 4;
        f32x4 v = acc[mi][ni] * s;
        u32x2 o = {pk2(v[0], v[1]), pk2(v[2], v[3])};
        *(u32x2*)(proj + (size_t)row * LDP + col) = o;
      }
    }
  } else if (MODE == 2) {
    bf16_t* x1b = (bf16_t*)(ws + OFF_X1B);
    float* ssq2 = (float*)(ws + OFF_SSQ2);
#pragma unroll
    for (int mi = 0; mi < 4; ++mi) {
      const int row = m0 + wr * 64 + mi * 16 + l15;
      float ss = 0.f;
#pragma unroll
      for (int ni = 0; ni < 4; ++ni) {
        const int col = n0 + wc * 64 + ni * 16 + q4 * 4;
        f32x4 xr = *(const f32x4*)(p.x + (size_t)row * DM + col);
        f32x4 v = acc[mi][ni] + xr;
        *(f32x4*)(p.out + (size_t)row * DM + col) = v;
        u32x2 o = {pk2(v[0], v[1]), pk2(v[2], v[3])};
        *(u32x2*)(x1b + (size_t)row * DM + col) = o;
        ss += v[0] * v[0] + v[1] * v[1] + v[2] * v[2] + v[3] * v[3];
      }
      ss += __shfl_xor(ss, 16);
      ss += __shfl_xor(ss, 32);
      if (q4 == 0) ssq2[(size_t)row * 32 + nt * 2 + wc] = ss;
    }
  } else {
    const float* ssq2 = (const float*)(ws + OFF_SSQ2);
    bf16_t* qo = (bf16_t*)(ws + OFF_Q);
#pragma unroll
    for (int mi = 0; mi < 4; ++mi) {
      const int row = m0 + wr * 64 + mi * 16 + l15;
      const float s = rs_from_ssq2(ssq2, row);
#pragma unroll
      for (int ni = 0; ni < 4; ++ni) {
        const int col = n0 + wc * 64 + ni * 16 + q4 * 4;
        f32x4 v = acc[mi][ni] * s;
        u32x2 o = {pk2(v[0], v[1]), pk2(v[2], v[3])};
        *(u32x2*)(qo + (size_t)row * DM + col) = o;
      }
    }
  }
}

__device__ __forceinline__ void conv8(const bf16_t* __restrict__ proj, int t, int tt_in_seq, int col,
                                      const float* __restrict__ cw, int ld_w, const float* __restrict__ cb, int ch,
                                      float* o) {
  f32x4 b0 = *(const f32x4*)(cb + ch), b1 = *(const f32x4*)(cb + ch + 4);
  o[0] = b0[0]; o[1] = b0[1]; o[2] = b0[2]; o[3] = b0[3];
  o[4] = b1[0]; o[5] = b1[1]; o[6] = b1[2]; o[7] = b1[3];
#pragma unroll
  for (int k = 0; k < 4; ++k) {
    if (tt_in_seq - 3 + k >= 0) {
      u32x4 v = *(const u32x4*)(proj + (size_t)(t - 3 + k) * LDP + col);
      f32x4 w0 = *(const f32x4*)(cw + k * ld_w + ch), w1 = *(const f32x4*)(cw + k * ld_w + ch + 4);
      o[0] += w0[0] * bflo(v[0]); o[1] += w0[1] * bfhi(v[0]);
      o[2] += w0[2] * bflo(v[1]); o[3] += w0[3] * bfhi(v[1]);
      o[4] += w1[0] * bflo(v[2]); o[5] += w1[1] * bfhi(v[2]);
      o[6] += w1[2] * bflo(v[3]); o[7] += w1[3] * bfhi(v[3]);
    }
  }
}
__device__ __forceinline__ void conv4(const bf16_t* __restrict__ proj, int t, int tt_in_seq, int col,
                                      const float* __restrict__ cw, int ld_w, const float* __restrict__ cb, int ch,
                                      float* o) {
  f32x4 b0 = *(const f32x4*)(cb + ch);
  o[0] = b0[0]; o[1] = b0[1]; o[2] = b0[2]; o[3] = b0[3];
#pragma unroll
  for (int k = 0; k < 4; ++k) {
    if (tt_in_seq - 3 + k >= 0) {
      u32x2 v = *(const u32x2*)(proj + (size_t)(t - 3 + k) * LDP + col);
      f32x4 w0 = *(const f32x4*)(cw + k * ld_w + ch);
      o[0] += w0[0] * bflo(v[0]); o[1] += w0[1] * bfhi(v[0]);
      o[2] += w0[2] * bflo(v[1]); o[3] += w0[3] * bfhi(v[1]);
    }
  }
}
__device__ __forceinline__ bf16x8 cfrag(const Params& p, const bf16_t* proj, int t, int tseq, int g, int n8) {
  float o[8];
  const int ch = 1280 + g * 128 + n8;
  conv8(proj, t, tseq, 3072 + ch, p.ssd_conv_w, 1536, p.ssd_conv_b, ch, o);
#pragma unroll
  for (int i = 0; i < 8; ++i) o[i] = silu_(o[i]);
  u32x4 r = {pk2(o[0], o[1]), pk2(o[2], o[3]), pk2(o[4], o[5]), pk2(o[6], o[7])};
  return as_frag(r);
}

__device__ void lru_local_unit(const Params& p, unsigned char* smem, int unit) {
  const int tid = threadIdx.x, lane = tid & 63, wid = tid >> 6, l15 = lane & 15, q4 = lane >> 4;
  const int hh = unit & 15, c = (unit >> 4) & 15, b = unit >> 8;
  const int t0 = b * 2048 + c * 128, ch0 = hh * 64;
  unsigned char* ws = p.ws;
  const bf16_t* proj = (const bf16_t*)(ws + OFF_PROJ);
  float* R1 = (float*)smem;
  float* R2 = (float*)(smem + 33536);
  float* R3 = (float*)(smem + 33536 + 32768);
#pragma unroll 2
  for (int e = tid; e < 131 * 64; e += NTHR) {
    const int r = e >> 6, j = e & 63, tt = r - 3;
    float v = 0.f;
    if (c * 128 + tt >= 0) v = bf2f(proj[(size_t)(t0 + tt) * LDP + ch0 + j]);
    R1[e] = v;
  }
  __syncthreads();
  {
    const int j = tid & 63;
    const float cb = p.lru_conv_b[ch0 + j];
    const float w0 = p.lru_conv_w[0 * 1024 + ch0 + j], w1 = p.lru_conv_w[1 * 1024 + ch0 + j],
                w2 = p.lru_conv_w[2 * 1024 + ch0 + j], w3 = p.lru_conv_w[3 * 1024 + ch0 + j];
#pragma unroll 4
    for (int tt = tid >> 6; tt < 128; tt += 4) {
      R2[tt * 64 + j] = cb + w0 * R1[tt * 64 + j] + w1 * R1[(tt + 1) * 64 + j] + w2 * R1[(tt + 2) * 64 + j] +
                        w3 * R1[(tt + 3) * 64 + j];
    }
  }
  __syncthreads();
  {
    const bf16_t* waT = (const bf16_t*)(ws + OFF_WAT) + (size_t)hh * 4096;
    const bf16_t* wxT = (const bf16_t*)(ws + OFF_WXT) + (size_t)hh * 4096;
    f32x4 aa[2][4], ax[2][4];
#pragma unroll
    for (int i = 0; i < 2; ++i)
#pragma unroll
      for (int j = 0; j < 4; ++j) { aa[i][j] = (f32x4){0, 0, 0, 0}; ax[i][j] = (f32x4){0, 0, 0, 0}; }
#pragma unroll
    for (int ks = 0; ks < 2; ++ks) {
      bf16x8 af[2];
#pragma unroll
      for (int mi = 0; mi < 2; ++mi) {
        const float* src = R2 + (wid * 32 + mi * 16 + l15) * 64 + ks * 32 + q4 * 8;
        f32x4 v0 = *(const f32x4*)src, v1 = *(const f32x4*)(src + 4);
        u32x4 r = {pk2(v0[0], v0[1]), pk2(v0[2], v0[3]), pk2(v1[0], v1[1]), pk2(v1[2], v1[3])};
        af[mi] = as_frag(r);
      }
#pragma unroll
      for (int ni = 0; ni < 4; ++ni) {
        const size_t wo = (size_t)(ni * 16 + l15) * 64 + ks * 32 + q4 * 8;
        bf16x8 ba = as_frag(*(const u32x4*)(waT + wo));
        bf16x8 bx = as_frag(*(const u32x4*)(wxT + wo));
#pragma unroll
        for (int mi = 0; mi < 2; ++mi) {
          aa[mi][ni] = mfma16(af[mi], ba, aa[mi][ni]);
          ax[mi][ni] = mfma16(af[mi], bx, ax[mi][ni]);
        }
      }
    }
#pragma unroll
    for (int ni = 0; ni < 4; ++ni) {
      const int j = ni * 16 + l15;
      const float ba = p.lru_ba[ch0 + j], bx = p.lru_bx[ch0 + j];
      const float lam = p.lru_lambda[ch0 + j];
      const float spl = -8.f * log1pf(__expf(-lam));
#pragma unroll
      for (int mi = 0; mi < 2; ++mi)
#pragma unroll
        for (int r = 0; r < 4; ++r) {
          const int tt = wid * 32 + mi * 16 + q4 * 4 + r;
          const float rg = sigmoid_(aa[mi][ni][r] + ba);
          const float ig = sigmoid_(ax[mi][ni][r] + bx);
          const float log_a = spl * rg;
          const float av = __expf(log_a);
          const float xl = R2[tt * 64 + j];
          const float bv = sqrtf(fmaxf(-expm1f(2.f * log_a), 0.f)) * (ig * xl);
          R1[tt * 64 + j] = av;
          R2[tt * 64 + j] = bv;
        }
    }
  }
  __syncthreads();
  {
    const int j = tid & 63, seg = tid >> 6;
    float h = 0.f, Ac = 1.f;
#pragma unroll 4
    for (int s = 0; s < 32; ++s) {
      const int tt = seg * 32 + s;
      const float a = R1[tt * 64 + j], bb = R2[tt * 64 + j];
      h = a * h + bb;
      Ac *= a;
      R2[tt * 64 + j] = h;
      R1[tt * 64 + j] = Ac;
    }
    R3[seg * 64 + j] = h;
    R3[256 + seg * 64 + j] = Ac;
    __syncthreads();
    float cin = 0.f, Ain = 1.f;
    for (int s2 = 0; s2 < seg; ++s2) {
      cin = R3[256 + s2 * 64 + j] * cin + R3[s2 * 64 + j];
      Ain *= R3[256 + s2 * 64 + j];
    }
    float* hloc = (float*)(ws + OFF_HLOC);
    float* cumA = (float*)(ws + OFF_CUMA);
#pragma unroll 4
    for (int s = 0; s < 32; ++s) {
      const int tt = seg * 32 + s;
      const float hl = R2[tt * 64 + j] + R1[tt * 64 + j] * cin;
      const float Al = R1[tt * 64 + j] * Ain;
      hloc[(size_t)(t0 + tt) * 1024 + ch0 + j] = hl;
      cumA[(size_t)(t0 + tt) * 1024 + ch0 + j] = Al;
    }
  }
  __syncthreads();
}

__device__ void ssd_local_unit(const Params& p, unsigned char* smem, int unit) {
  const int tid = threadIdx.x, lane = tid & 63, wid = tid >> 6, l15 = lane & 15, q4 = lane >> 4;
  const int hh = unit & 15, c = (unit >> 4) & 15, b = unit >> 8, g = hh >> 3;
  const int t0 = b * 2048 + c * 128, ts0 = c * 128;
  unsigned char* ws = p.ws;
  const bf16_t* proj = (const bf16_t*)(ws + OFF_PROJ);
  unsigned char* Bm = smem;
  unsigned char* XT = smem + 32768;
  unsigned char* Pw = smem + 49152 + wid * 4096;
  float* dts = (float*)(smem + 65536);
  float* acs = dts + 128;
  float* adt = acs + 128;
  if (tid < 128) {
    const float raw = bf2f(proj[(size_t)(t0 + tid) * LDP + 4608 + hh]);
    const float dtv = softplus_(raw + p.ssd_dt_bias[hh]);
    dts[tid] = dtv;
    adt[tid] = -__expf(p.ssd_a_log[hh]) * dtv;
  }
  __syncthreads();
  if (tid < 128) {
    float s = 0.f;
    for (int k = 0; k <= tid; ++k) s += adt[k];
    acs[tid] = s;
    ((float*)(ws + OFF_ACS))[(size_t)(t0 + tid) * 16 + hh] = s;
  }
  {
    const int chunk = tid & 15;
    const int ch = 1024 + g * 128 + chunk * 8;
#pragma unroll 1
    for (int i = 0; i < 8; ++i) {
      const int tt = (tid >> 4) + 16 * i;
      float o[8];
      conv8(proj, t0 + tt, ts0 + tt, 3072 + ch, p.ssd_conv_w, 1536, p.ssd_conv_b, ch, o);
#pragma unroll
      for (int e = 0; e < 8; ++e) o[e] = silu_(o[e]);
      u32x4 r = {pk2(o[0], o[1]), pk2(o[2], o[3]), pk2(o[4], o[5]), pk2(o[6], o[7])};
      *(u32x4*)(Bm + sw256(tt, chunk)) = r;
    }
  }
  __syncthreads();
  {
    const int pp = tid & 63;
    const int ch = hh * 64 + pp;
    const float cb = p.ssd_conv_b[ch];
    const float w0 = p.ssd_conv_w[ch], w1 = p.ssd_conv_w[1536 + ch], w2 = p.ssd_conv_w[2 * 1536 + ch],
                w3 = p.ssd_conv_w[3 * 1536 + ch];
#pragma unroll 1
    for (int i = 0; i < 4; ++i) {
      const int chunk = (tid >> 6) * 4 + i;
      const int tt0 = chunk * 8;
      float xv[11];
#pragma unroll
      for (int k = 0; k < 11; ++k) {
        const int tt = tt0 - 3 + k;
        xv[k] = (ts0 + tt >= 0) ? bf2f(proj[(size_t)(t0 + tt) * LDP + 3072 + ch]) : 0.f;
      }
      float o[8];
#pragma unroll
      for (int e = 0; e < 8; ++e) {
        const float cv = cb + w0 * xv[e] + w1 * xv[e + 1] + w2 * xv[e + 2] + w3 * xv[e + 3];
        o[e] = silu_(cv) * dts[tt0 + e];
      }
      u32x4 r = {pk2(o[0], o[1]), pk2(o[2], o[3]), pk2(o[4], o[5]), pk2(o[6], o[7])};
      *(u32x4*)(XT + sw256(pp, chunk)) = r;
    }
  }
  __syncthreads();
  bf16_t* ypart = (bf16_t*)(ws + OFF_YPART);
  const float Dh = p.ssd_d[hh];
#pragma unroll 1
  for (int mt = 0; mt < 2; ++mt) {
    const int M = wid * 2 + mt;
    const int lrow = M * 16 + l15;
    bf16x8 cf[4];
#pragma unroll
    for (int ks = 0; ks < 4; ++ks) cf[ks] = cfrag(p, proj, t0 + lrow, ts0 + lrow, g, ks * 32 + q4 * 8);
    const float acl = acs[lrow];
    const int ntmax = M | 1;
#pragma unroll 1
    for (int nt = 0; nt <= ntmax; ++nt) {
      f32x4 a4 = (f32x4){0, 0, 0, 0};
      if (nt <= M) {
#pragma unroll
        for (int ks = 0; ks < 4; ++ks) {
          bf16x8 bfr = *(const bf16x8*)(Bm + sw256(nt * 16 + l15, ks * 4 + q4));
          a4 = mfma16(bfr, cf[ks], a4);
        }
      }
      float pv[4];
#pragma unroll
      for (int r = 0; r < 4; ++r) {
        const int s = nt * 16 + q4 * 4 + r;
        pv[r] = (s <= lrow) ? a4[r] * __expf(acl - acs[s]) : 0.f;
      }
      u32x2 o = {pk2(pv[0], pv[1]), pk2(pv[2], pv[3])};
      const int chunk = nt * 2 + (q4 >> 1);
      *(u32x2*)(Pw + sw256(l15, chunk) + (q4 & 1) * 8) = o;
    }
    f32x4 ya[4];
#pragma unroll
    for (int pt = 0; pt < 4; ++pt) ya[pt] = (f32x4){0, 0, 0, 0};
    const int ksmax = M >> 1;
#pragma unroll 1
    for (int ks = 0; ks <= ksmax; ++ks) {
      bf16x8 pf = *(const bf16x8*)(Pw + sw256(l15, ks * 4 + q4));
#pragma unroll
      for (int pt = 0; pt < 4; ++pt) {
        bf16x8 xf = *(const bf16x8*)(XT + sw256(pt * 16 + l15, ks * 4 + q4));
        ya[pt] = mfma16(xf, pf, ya[pt]);
      }
    }
#pragma unroll
    for (int pt = 0; pt < 4; ++pt) {
      const int pc = pt * 16 + q4 * 4;
      const int ch = hh * 64 + pc;
      float xo[4];
      conv4(proj, t0 + lrow, ts0 + lrow, 3072 + ch, p.ssd_conv_w, 1536, p.ssd_conv_b, ch, xo);
      float y0 = ya[pt][0] + Dh * silu_(xo[0]), y1 = ya[pt][1] + Dh * silu_(xo[1]);
      float y2 = ya[pt][2] + Dh * silu_(xo[2]), y3 = ya[pt][3] + Dh * silu_(xo[3]);
      u32x2 o = {pk2(y0, y1), pk2(y2, y3)};
      *(u32x2*)(ypart + (size_t)(t0 + lrow) * 1024 + ch) = o;
    }
  }
  {
    f32x4 sa[2][4];
#pragma unroll
    for (int i = 0; i < 2; ++i)
#pragma unroll
      for (int j = 0; j < 4; ++j) sa[i][j] = (f32x4){0, 0, 0, 0};
    const float aend = acs[127];
#pragma unroll 1
    for (int ks = 0; ks < 4; ++ks) {
      float dec[8];
#pragma unroll
      for (int e = 0; e < 8; ++e) dec[e] = __expf(aend - acs[ks * 32 + q4 * 8 + e]);
      bf16x8 bd[2];
#pragma unroll
      for (int ni = 0; ni < 2; ++ni) {
        const int n = wid * 32 + ni * 16 + l15;
        float v[8];
#pragma unroll
        for (int e = 0; e < 8; ++e) {
          const int l = ks * 32 + q4 * 8 + e;
          const bf16_t raw = *(const bf16_t*)(Bm + sw256(l, n >> 3) + (n & 7) * 2);
          v[e] = bf2f(raw) * dec[e];
        }
        u32x4 r = {pk2(v[0], v[1]), pk2(v[2], v[3]), pk2(v[4], v[5]), pk2(v[6], v[7])};
        bd[ni] = as_frag(r);
      }
#pragma unroll
      for (int pt = 0; pt < 4; ++pt) {
        bf16x8 xf = *(const bf16x8*)(XT + sw256(pt * 16 + l15, ks * 4 + q4));
#pragma unroll
        for (int ni = 0; ni < 2; ++ni) sa[ni][pt] = mfma16(bd[ni], xf, sa[ni][pt]);
      }
    }
    float* St = (float*)(ws + OFF_ST) + (size_t)((b * 16 + c) * 16 + hh) * 8192;
#pragma unroll
    for (int ni = 0; ni < 2; ++ni)
#pragma unroll
      for (int pt = 0; pt < 4; ++pt) {
        const int pr = pt * 16 + l15, n = wid * 32 + ni * 16 + q4 * 4;
        *(f32x4*)(St + pr * 128 + n) = sa[ni][pt];
      }
  }
  __syncthreads();
}

__device__ void phase_carry(const Params& p) {
  unsigned char* ws = p.ws;
  const int gt = blockIdx.x * NTHR + threadIdx.x, ng = gridDim.x * NTHR;
  const float* hloc = (const float*)(ws + OFF_HLOC);
  const float* cumA = (const float*)(ws + OFF_CUMA);
  float* lcarry = (float*)(ws + OFF_LCARRY);
  for (int i = gt; i < 8192; i += ng) {
    const int b = i >> 10, ch = i & 1023;
    float carry = 0.f;
    for (int c = 0; c < 16; ++c) {
      lcarry[(size_t)(b * 16 + c) * 1024 + ch] = carry;
      const size_t tl = (size_t)(b * 2048 + c * 128 + 127) * 1024 + ch;
      carry = cumA[tl] * carry + hloc[tl];
    }
  }
  const float* acsG = (const float*)(ws + OFF_ACS);
  float* St = (float*)(ws + OFF_ST);
  for (int i = gt; i < 128 * 2048; i += ng) {
    const int bh = i >> 11, e4 = i & 2047, b = bh >> 4, hh = bh & 15;
    f32x4 s = (f32x4){0, 0, 0, 0};
    for (int c = 0; c < 16; ++c) {
      const float Ad = __expf(acsG[(size_t)(b * 2048 + c * 128 + 127) * 16 + hh]);
      f32x4* ptr = (f32x4*)(St + (size_t)((b * 16 + c) * 16 + hh) * 8192 + e4 * 4);
      f32x4 tmp = *ptr;
      *ptr = s;
      s = s * Ad + tmp;
    }
  }
}

__device__ void ssd_final_unit(const Params& p, int unit) {
  const int tid = threadIdx.x, lane = tid & 63, wid = tid >> 6, l15 = lane & 15, q4 = lane >> 4;
  const int hh = unit & 15, c = (unit >> 4) & 15, b = unit >> 8, g = hh >> 3;
  const int t0 = b * 2048 + c * 128, ts0 = c * 128;
  unsigned char* ws = p.ws;
  const bf16_t* proj = (const bf16_t*)(ws + OFF_PROJ);
  const float* Sin = (const float*)(ws + OFF_ST) + (size_t)((b * 16 + c) * 16 + hh) * 8192;
  const bf16_t* ypart = (const bf16_t*)(ws + OFF_YPART);
  const float* acsG = (const float*)(ws + OFF_ACS);
  bf16_t* A2 = (bf16_t*)(ws + OFF_XB);
  float* ssq = (float*)(ws + OFF_SSQ);
#pragma unroll 1
  for (int mt = 0; mt < 2; ++mt) {
    const int lrow = (wid * 2 + mt) * 16 + l15;
    f32x4 ya[4];
#pragma unroll
    for (int pt = 0; pt < 4; ++pt) ya[pt] = (f32x4){0, 0, 0, 0};
    if (c > 0) {
#pragma unroll 1
      for (int ks = 0; ks < 4; ++ks) {
        bf16x8 cf = cfrag(p, proj, t0 + lrow, ts0 + lrow, g, ks * 32 + q4 * 8);
#pragma unroll
        for (int pt = 0; pt < 4; ++pt) {
          const float* sp = Sin + (pt * 16 + l15) * 128 + ks * 32 + q4 * 8;
          f32x4 v0 = *(const f32x4*)sp, v1 = *(const f32x4*)(sp + 4);
          u32x4 r = {pk2(v0[0], v0[1]), pk2(v0[2], v0[3]), pk2(v1[0], v1[1]), pk2(v1[2], v1[3])};
          ya[pt] = mfma16(as_frag(r), cf, ya[pt]);
        }
      }
    }
    const size_t t = (size_t)(t0 + lrow);
    const float ea = __expf(acsG[t * 16 + hh]);
    float ss = 0.f;
#pragma unroll
    for (int pt = 0; pt < 4; ++pt) {
      const int ch = hh * 64 + pt * 16 + q4 * 4;
      u32x2 yp = *(const u32x2*)(ypart + t * 1024 + ch);
      u32x2 zz = *(const u32x2*)(proj + t * LDP + 2048 + ch);
      float y[4] = {bflo(yp[0]) + ea * ya[pt][0], bfhi(yp[0]) + ea * ya[pt][1], bflo(yp[1]) + ea * ya[pt][2],
                    bfhi(yp[1]) + ea * ya[pt][3]};
      float z[4] = {bflo(zz[0]), bfhi(zz[0]), bflo(zz[1]), bfhi(zz[1])};
#pragma unroll
      for (int r = 0; r < 4; ++r) { y[r] = y[r] * silu_(z[r]); ss += y[r] * y[r]; }
      u32x2 o = {pk2(y[0], y[1]), pk2(y[2], y[3])};
      *(u32x2*)(A2 + t * DM + 1024 + ch) = o;
    }
    ss += __shfl_xor(ss, 16);
    ss += __shfl_xor(ss, 32);
    if (q4 == 0) ssq[t * 16 + hh] = ss;
  }
}

__device__ void phase_mix_final(const Params& p) {
  unsigned char* ws = p.ws;
  const bf16_t* proj = (const bf16_t*)(ws + OFF_PROJ);
  const f32x4* hloc = (const f32x4*)(ws + OFF_HLOC);
  const f32x4* cumA = (const f32x4*)(ws + OFF_CUMA);
  const float* lcarry = (const float*)(ws + OFF_LCARRY);
  bf16_t* A2 = (bf16_t*)(ws + OFF_XB);
  for (int u = blockIdx.x; u < 2048; u += gridDim.x) ssd_final_unit(p, u);
  for (int i = blockIdx.x * NTHR + threadIdx.x; i < T_TOK * 256; i += gridDim.x * NTHR) {
    const int t = i >> 8, ch = (i & 255) * 4;
    f32x4 h = hloc[i], ca = cumA[i];
    f32x4 cr = *(const f32x4*)(lcarry + (size_t)(t >> 7) * 1024 + ch);
    u32x2 gg = *(const u32x2*)(proj + (size_t)t * LDP + 1024 + ch);
    float y0 = (h[0] + ca[0] * cr[0]) * gelu_(bflo(gg[0]));
    float y1 = (h[1] + ca[1] * cr[1]) * gelu_(bfhi(gg[0]));
    float y2 = (h[2] + ca[2] * cr[2]) * gelu_(bflo(gg[1]));
    float y3 = (h[3] + ca[3] * cr[3]) * gelu_(bfhi(gg[1]));
    u32x2 o = {pk2(y0, y1), pk2(y2, y3)};
    *(u32x2*)(A2 + (size_t)t * DM + ch) = o;
  }
}

__device__ void convert_uv(const Params& p) {
  unsigned char* ws = p.ws;
  bf16_t* ub = (bf16_t*)(ws + OFF_XB);
  bf16_t* vb = (bf16_t*)(ws + OFF_HLOC);
  const int n8 = 16384 * 2048 / 8;
  for (int i = blockIdx.x * NTHR + threadIdx.x; i < n8; i += gridDim.x * NTHR) {
    const int d = (i & 255) * 8;
    f32x4 a0 = *(const f32x4*)(p.peer_u + (size_t)i * 8), a1 = *(const f32x4*)(p.peer_u + (size_t)i * 8 + 4);
    f32x4 w0 = *(const f32x4*)(p.norm_ffn_w + d), w1 = *(const f32x4*)(p.norm_ffn_w + d + 4);
    a0 *= w0; a1 *= w1;
    u32x4 o = {pk2(a0[0], a0[1]), pk2(a0[2], a0[3]), pk2(a1[0], a1[1]), pk2(a1[2], a1[3])};
    *(u32x4*)(ub + (size_t)i * 8) = o;
    f32x4 b0 = *(const f32x4*)(p.peer_v + (size_t)i * 8), b1 = *(const f32x4*)(p.peer_v + (size_t)i * 8 + 4);
    u32x4 o2 = {pk2(b0[0], b0[1]), pk2(b0[2], b0[3]), pk2(b1[0], b1[1]), pk2(b1[2], b1[3])};
    *(u32x4*)(vb + (size_t)i * 8) = o2;
  }
}

__device__ const unsigned char cand_tab[64] = {
    0x00, 0x01, 0x02, 0x03, 0x04, 0x05, 0x06, 0x07, 0x08, 0x09, 0x0a, 0x0b, 0x0c, 0x0d, 0x0e, 0x0f,
    0x10, 0x11, 0x12, 0x13, 0x14, 0x15, 0x16, 0x17,
    0x20, 0x21, 0x22, 0x23, 0x24,
    0x30, 0x31, 0x32, 0x33,
    0x40, 0x41, 0x42,
    0x50, 0x51, 0x60, 0x61, 0x70, 0x71,
    0x80, 0x90, 0xa0, 0xb0, 0xc0, 0xd0, 0xe0, 0xf0,
    0xff, 0xff, 0xff, 0xff, 0xff, 0xff, 0xff, 0xff, 0xff, 0xff, 0xff, 0xff, 0xff, 0xff};

__device__ __forceinline__ unsigned ord_key(float f) {
  unsigned u = __float_as_uint(f);
  return u ^ ((u >> 31) ? 0xffffffffu : 0x80000000u);
}
__device__ __forceinline__ float ord_dec(unsigned k) {
  unsigned u = (k >> 31) ? (k ^ 0x80000000u) : ~k;
  return __uint_as_float(u);
}

__device__ void topk_unit(const Params& p, unsigned char* smem, int unit) {
  const int tid = threadIdx.x, lane = tid & 63, wid = tid >> 6, l15 = lane & 15, q4 = lane >> 4;
  const int h = unit & 7, tile = unit >> 3;
  const int tok0 = tile * 64 + wid * 16;
  unsigned char* ws = p.ws;
  const bf16_t* qg = (const bf16_t*)(ws + OFF_Q);
  const bf16_t* kb = (const bf16_t*)(ws + OFF_KEYSB);
  unsigned* S = (unsigned*)(smem + wid * 16640);
  float* tops = (float*)(smem + 4 * 16640 + wid * 256);
  int* topi = (int*)(tops + 32);
#pragma unroll
  for (int k = 0; k < 2; ++k) {
    f32x4 sc[8];
#pragma unroll
    for (int i = 0; i < 8; ++i) sc[i] = (f32x4){0, 0, 0, 0};
#pragma unroll
    for (int ks = 0; ks < 4; ++ks) {
      bf16x8 qf = as_frag(*(const u32x4*)(qg + (size_t)(tok0 + l15) * DM + h * 256 + k * 128 + ks * 32 + q4 * 8));
#pragma unroll
      for (int nt = 0; nt < 8; ++nt) {
        bf16x8 kf = as_frag(*(const u32x4*)(kb + (size_t)((h * 2 + k) * 128 + nt * 16 + l15) * 128 + ks * 32 + q4 * 8));
        sc[nt] = mfma16(kf, qf, sc[nt]);
      }
    }
#pragma unroll
    for (int nt = 0; nt < 8; ++nt) {
      const int n = nt * 16 + q4 * 4;
      u32x4 kk;
#pragma unroll
      for (int r = 0; r < 4; ++r) kk[r] = (ord_key(sc[nt][r]) & ~127u) | (unsigned)(127 - (n + r));
      *(u32x4*)(S + l15 * 260 + k * 128 + n) = kk;
    }
  }
  const unsigned ct = cand_tab[lane];
  const int ca = ct >> 4, cbb = ct & 15;
  int* idxo = (int*)(ws + OFF_IDX);
  float* go = (float*)(ws + OFF_G);
  for (int tk = 0; tk < 16; ++tk) {
    const unsigned* row = S + tk * 260;
    const unsigned k0 = row[lane], k1 = row[lane + 64], k2 = row[128 + lane], k3 = row[192 + lane];
    int r0 = 0, r1 = 0, r2 = 0, r3 = 0;
#pragma unroll 8
    for (int j = 0; j < 32; ++j) {
      u32x4 a = *(const u32x4*)(row + j * 4);
      u32x4 bq = *(const u32x4*)(row + 128 + j * 4);
#pragma unroll
      for (int e = 0; e < 4; ++e) {
        r0 += (a[e] > k0) ? 1 : 0;
        r1 += (a[e] > k1) ? 1 : 0;
        r2 += (bq[e] > k2) ? 1 : 0;
        r3 += (bq[e] > k3) ? 1 : 0;
      }
    }
    if (r0 < 16) { tops[r0] = ord_dec(k0 & ~127u); topi[r0] = lane; }
    if (r1 < 16) { tops[r1] = ord_dec(k1 & ~127u); topi[r1] = lane + 64; }
    if (r2 < 16) { tops[16 + r2] = ord_dec(k2 & ~127u); topi[16 + r2] = lane; }
    if (r3 < 16) { tops[16 + r3] = ord_dec(k3 & ~127u); topi[16 + r3] = lane + 64; }
    float cs = 0.f;
    unsigned ck = 0u;
    if (lane < 50) {
      cs = tops[ca] + tops[16 + cbb];
      ck = (ord_key(cs) & ~255u) | (unsigned)(255 - (ca * 16 + cbb));
    }
    int rk = 0;
#pragma unroll
    for (int j = 0; j < 50; ++j) {
      const unsigned oj = (unsigned)__builtin_amdgcn_readlane((int)ck, j);
      rk += (oj > ck) ? 1 : 0;
    }
    const float mx = tops[0] + tops[16];
    const bool sel = (lane < 50) && (rk < 16);
    const float ev = sel ? __expf(cs - mx) : 0.f;
    const float sum = wave_sum(ev);
    if (sel) {
      const size_t o = (size_t)(tok0 + tk) * 128 + h * 16 + rk;
      idxo[o] = topi[ca] * 128 + topi[16 + cbb];
      go[o] = ev / sum;
    }
  }
  __syncthreads();
}

__device__ __forceinline__ float dot8(u32x4 a, u32x4 b, float acc) {
#pragma unroll
  for (int i = 0; i < 4; ++i) {
    acc += bflo(a[i]) * bflo(b[i]);
    acc += bfhi(a[i]) * bfhi(b[i]);
  }
  return acc;
}

__device__ void phase_gather(const Params& p) {
  const int tid = threadIdx.x, lane = tid & 63, wid = tid >> 6;
  unsigned char* ws = p.ws;
  const bf16_t* x1b = (const bf16_t*)(ws + OFF_X1B);
  const bf16_t* ub = (const bf16_t*)(ws + OFF_XB);
  const bf16_t* vb = (const bf16_t*)(ws + OFF_HLOC);
  const int* idxg = (const int*)(ws + OFF_IDX);
  const float* gg = (const float*)(ws + OFF_G);
  const float* ssq2 = (const float*)(ws + OFF_SSQ2);
  for (int t = blockIdx.x * 4 + wid; t < T_TOK; t += gridDim.x * 4) {
    const int id0 = idxg[(size_t)t * 128 + lane], id1 = idxg[(size_t)t * 128 + 64 + lane];
    const float g0 = gg[(size_t)t * 128 + lane], g1 = gg[(size_t)t * 128 + 64 + lane];
    u32x4 hr[4];
#pragma unroll
    for (int c = 0; c < 4; ++c) hr[c] = *(const u32x4*)(x1b + (size_t)t * DM + c * 512 + lane * 8);
    float sq = (lane < 32) ? ssq2[(size_t)t * 32 + lane] : 0.f;
    sq = wave_sum(sq);
    const float rs2 = rsqrtf(sq * (1.f / 2048.f) + EPSV);
    float w0 = 0.f, w1 = 0.f;
#pragma unroll 1
    for (int half = 0; half < 2; ++half) {
      const int idv = half ? id1 : id0;
      float wv = 0.f;
#pragma unroll 1
      for (int j0 = 0; j0 < 64; j0 += 4) {
        u32x4 r[4][4];
#pragma unroll
        for (int k = 0; k < 4; ++k) {
          const int e = __builtin_amdgcn_readlane(idv, j0 + k);
          const bf16_t* rp = ub + (size_t)e * DM + lane * 8;
#pragma unroll
          for (int c = 0; c < 4; ++c) r[k][c] = *(const u32x4*)(rp + c * 512);
        }
#pragma unroll
        for (int k = 0; k < 4; ++k) {
          float d = 0.f;
#pragma unroll
          for (int c = 0; c < 4; ++c) d = dot8(r[k][c], hr[c], d);
          d = wave_sum(d);
          const float a = gelu_(d * rs2);
          if (lane == j0 + k) wv = a;
        }
      }
      if (half) w1 = wv * g1; else w0 = wv * g0;
    }
    float acc[32];
#pragma unroll
    for (int i = 0; i < 32; ++i) acc[i] = 0.f;
#pragma unroll 1
    for (int half = 0; half < 2; ++half) {
      const int idv = half ? id1 : id0;
      const float wvv = half ? w1 : w0;
#pragma unroll 1
      for (int j0 = 0; j0 < 64; j0 += 4) {
        u32x4 r[4][4];
        float wk[4];
#pragma unroll
        for (int k = 0; k < 4; ++k) {
          const int e = __builtin_amdgcn_readlane(idv, j0 + k);
          wk[k] = __builtin_bit_cast(float, __builtin_amdgcn_readlane(__builtin_bit_cast(int, wvv), j0 + k));
          const bf16_t* rp = vb + (size_t)e * DM + lane * 8;
#pragma unroll
          for (int c = 0; c < 4; ++c) r[k][c] = *(const u32x4*)(rp + c * 512);
        }
#pragma unroll
        for (int k = 0; k < 4; ++k)
#pragma unroll
          for (int c = 0; c < 4; ++c)
#pragma unroll
            for (int i = 0; i < 4; ++i) {
              acc[c * 8 + i * 2] += wk[k] * bflo(r[k][c][i]);
              acc[c * 8 + i * 2 + 1] += wk[k] * bfhi(r[k][c][i]);
            }
      }
    }
#ifdef ABL_NOPEER
#pragma unroll
    for (int i = 0; i < 32; ++i) acc[i] *= 1.0f;
#endif
    float ss = 0.f;
    float* orow = p.out + (size_t)t * DM;
#pragma unroll
    for (int c = 0; c < 4; ++c) {
      f32x4 a0 = *(const f32x4*)(orow + c * 512 + lane * 8), a1 = *(const f32x4*)(orow + c * 512 + lane * 8 + 4);
#pragma unroll
      for (int i = 0; i < 4; ++i) {
        acc[c * 8 + i] += a0[i];
        acc[c * 8 + 4 + i] += a1[i];
      }
    }
#pragma unroll
    for (int i = 0; i < 32; ++i) ss += acc[i] * acc[i];
    ss = wave_sum(ss);
    const float rs3 = rsqrtf(ss * (1.f / 2048.f) + EPSV);
#pragma unroll
    for (int c = 0; c < 4; ++c) {
      const int d = c * 512 + lane * 8;
      f32x4 w0v = *(const f32x4*)(p.norm_final_w + d), w1v = *(const f32x4*)(p.norm_final_w + d + 4);
      f32x4 o0 = {acc[c * 8 + 0] * rs3 * w0v[0], acc[c * 8 + 1] * rs3 * w0v[1], acc[c * 8 + 2] * rs3 * w0v[2],
                  acc[c * 8 + 3] * rs3 * w0v[3]};
      f32x4 o1 = {acc[c * 8 + 4] * rs3 * w1v[0], acc[c * 8 + 5] * rs3 * w1v[1], acc[c * 8 + 6] * rs3 * w1v[2],
                  acc[c * 8 + 7] * rs3 * w1v[3]};
      *(f32x4*)(orow + d) = o0;
      *(f32x4*)(orow + d + 4) = o1;
    }
  }
}

__global__ void __launch_bounds__(NTHR, 2) fwd_kernel(Params p) {
  __shared__ __attribute__((aligned(16))) unsigned char smem[SMEM_BYTES];
  cg::grid_group grid = cg::this_grid();
  unsigned char* ws = p.ws;
#define PHASE_ON(n) (p.phase_lo <= (n) && (n) <= p.phase_hi)
#define PHASE_SYNC(n) if (p.coop && PHASE_ON(n) && (n) < p.phase_hi) grid.sync();
  if (PHASE_ON(0)) phase_prep(p, smem);
  PHASE_SYNC(0)
  if (PHASE_ON(1)) {
    for (int u = blockIdx.x; u < 128 * 37; u += gridDim.x)
      gemm_tile<1>(p, smem, (const bf16_t*)(ws + OFF_XB), (const bf16_t*)(ws + OFF_WINT), u & 127, u >> 7);
  }
  PHASE_SYNC(1)
  if (PHASE_ON(2)) {
    for (int u = blockIdx.x; u < 2048; u += gridDim.x) ssd_local_unit(p, smem, u);
    for (int u = blockIdx.x; u < 2048; u += gridDim.x) lru_local_unit(p, smem, u);
  }
  PHASE_SYNC(2)
  if (PHASE_ON(3)) phase_carry(p);
  PHASE_SYNC(3)
  if (PHASE_ON(4)) phase_mix_final(p);
  PHASE_SYNC(4)
  if (PHASE_ON(5)) {
    for (int u = blockIdx.x; u < 128 * 16; u += gridDim.x)
      gemm_tile<2>(p, smem, (const bf16_t*)(ws + OFF_XB), (const bf16_t*)(ws + OFF_WOUTT), u & 127, u >> 7);
  }
  PHASE_SYNC(5)
  if (PHASE_ON(6)) {
    for (int u = blockIdx.x; u < 128 * 16; u += gridDim.x)
      gemm_tile<3>(p, smem, (const bf16_t*)(ws + OFF_X1B), (const bf16_t*)(ws + OFF_WQT), u & 127, u >> 7);
    convert_uv(p);
  }
  PHASE_SYNC(6)
  if (PHASE_ON(7)) {
    for (int u = blockIdx.x; u < 2048; u += gridDim.x) topk_unit(p, smem, u);
  }
  PHASE_SYNC(7)
  if (PHASE_ON(8)) phase_gather(p);
}

extern "C" void kernel_launch(void* const* d_in, const int* in_sizes, int n_in, void* d_out, int out_size,
                              void* d_ws, size_t ws_size, hipStream_t stream) {
  Params p{};
  const float** fp = (const float**)&p;
  for (int i = 0; i < 23; ++i) fp[i] = (const float*)d_in[i];
  p.out = (float*)d_out;
  p.ws = (unsigned char*)d_ws;
  static int grid_blocks = 0;
  if (!grid_blocks) {
    int dev = 0, cus = 0, per_cu = 0;
    hipGetDevice(&dev);
    hipDeviceGetAttribute(&cus, hipDeviceAttributeMultiprocessorCount, dev);
    hipOccupancyMaxActiveBlocksPerMultiprocessor(&per_cu, fwd_kernel, NTHR, 0);
    if (per_cu < 1) per_cu = 1;
    if (per_cu > 2) per_cu = 2;
    grid_blocks = cus * per_cu;
  }
#if SINGLE_LAUNCH
  p.phase_lo = 0; p.phase_hi = 8; p.coop = 1;
  void* args[] = {&p};
  hipError_t e = hipLaunchCooperativeKernel((void*)fwd_kernel, dim3(grid_blocks), dim3(NTHR), args, 0, stream);
  if (e != hipSuccess) fprintf(stderr, "cooperative launch failed: %s (grid %d)\n", hipGetErrorString(e), grid_blocks);
#else
  for (int ph = 0; ph <= 8; ++ph) {
    p.phase_lo = ph; p.phase_hi = ph; p.coop = 0;
    hipLaunchKernelGGL(fwd_kernel, dim3(grid_blocks), dim3(NTHR), 0, stream, p);
  }
#endif
}
```

```cpp
#include <hip/hip_runtime.h>
#include <hip/hip_cooperative_groups.h>
#include <cstdio>
namespace cg = cooperative_groups;

#ifndef SINGLE_LAUNCH
#define SINGLE_LAUNCH 1
#endif

typedef unsigned short bf16_t;
typedef short bf16x8 __attribute__((ext_vector_type(8)));
typedef float f32x4 __attribute__((ext_vector_type(4)));
typedef unsigned u32x4 __attribute__((ext_vector_type(4)));
typedef unsigned u32x2 __attribute__((ext_vector_type(2)));
typedef __bf16 bf2_t __attribute__((ext_vector_type(2)));

#define T_TOK 16384
#define DM 2048
#define LDP 4736
#define NTHR 256
#define SMEM_BYTES 73728
#define EPSV 1e-6f
#define MIB ((size_t)1 << 20)

#define OFF_XB (0 * MIB)
#define OFF_PROJ (64 * MIB)
#define OFF_X1B (64 * MIB)
#define OFF_Q (128 * MIB)
#define OFF_IDX (192 * MIB)
#define OFF_G (200 * MIB)
#define OFF_HLOC (212 * MIB)
#define OFF_CUMA (276 * MIB)
#define OFF_YPART (340 * MIB)
#define OFF_ST (372 * MIB)
#define OFF_WINT (436 * MIB)
#define OFF_WOUTT (455 * MIB)
#define OFF_WQT (463 * MIB)
#define OFF_WAT (471 * MIB)
#define OFF_WXT (471 * MIB + 131072)
#define OFF_KEYSB (471 * MIB + 262144)
#define OFF_RS1 (472 * MIB)
#define OFF_ACS (472 * MIB + 65536)
#define OFF_LCARRY (OFF_ACS + MIB)
#define OFF_SSQ (OFF_LCARRY + 524288)
#define OFF_SSQ2 (OFF_SSQ + MIB)
#define OFF_SCALES (OFF_SSQ2 + 2 * MIB)

struct Params {
  const float *x, *norm_mix_w, *w_in, *lru_conv_w, *lru_conv_b, *lru_wa, *lru_ba, *lru_wx, *lru_bx, *lru_lambda;
  const float *ssd_conv_w, *ssd_conv_b, *ssd_dt_bias, *ssd_a_log, *ssd_d, *ssd_norm_w, *w_out, *norm_ffn_w, *peer_wq;
  const float *peer_sub_keys, *peer_u, *peer_v, *norm_final_w;
  float* out;
  unsigned char* ws;
  int phase_lo, phase_hi, coop, pad0;
};

__device__ __forceinline__ unsigned pk2(float lo, float hi) {
  unsigned r;
  asm("v_cvt_pk_bf16_f32 %0, %1, %2" : "=v"(r) : "v"(lo), "v"(hi));
  return r;
}
__device__ __forceinline__ float bf2f(bf16_t v) { return __uint_as_float(((unsigned)v) << 16); }
__device__ __forceinline__ float bflo(unsigned u) { return __uint_as_float(u << 16); }
__device__ __forceinline__ float bfhi(unsigned u) { return __uint_as_float(u & 0xffff0000u); }
__device__ __forceinline__ float wave_sum(float v) {
#pragma unroll
  for (int o = 32; o > 0; o >>= 1) v += __shfl_xor(v, o);
  return v;
}
__device__ __forceinline__ float sigmoid_(float x) { return 1.f / (1.f + __expf(-x)); }
__device__ __forceinline__ float silu_(float x) { return x * sigmoid_(x); }
__device__ __forceinline__ float gelu_(float x) {
  float u = 0.7978845608028654f * (x + 0.044715f * x * x * x);
  return x * sigmoid_(2.f * u);
}
__device__ __forceinline__ float softplus_(float x) { return fmaxf(x, 0.f) + log1pf(__expf(-fabsf(x))); }
__device__ __forceinline__ f32x4 mfma16(bf16x8 a, bf16x8 b, f32x4 c) {
  return __builtin_amdgcn_mfma_f32_16x16x32_bf16(a, b, c, 0, 0, 0);
}
__device__ __forceinline__ bf16x8 as_frag(u32x4 v) { return __builtin_bit_cast(bf16x8, v); }
__device__ __forceinline__ int sw256(int row, int chunk) { return row * 256 + ((chunk ^ (row & 15)) << 4); }
__device__ __forceinline__ int sw128(int row, int chunk) { return row * 128 + ((chunk ^ ((row >> 1) & 7)) << 4); }

__device__ __forceinline__ float rs_from_ssq2(const float* ssq2, int row) {
  const f32x4* pp = (const f32x4*)(ssq2 + (size_t)row * 32);
  float s = 0.f;
#pragma unroll
  for (int i = 0; i < 8; ++i) { f32x4 v = pp[i]; s += v[0] + v[1] + v[2] + v[3]; }
  return rsqrtf(s * (1.f / 2048.f) + EPSV);
}
__device__ __forceinline__ float rs_from_ssq(const float* ssq, int row) {
  const f32x4* pp = (const f32x4*)(ssq + (size_t)row * 16);
  float s = 0.f;
#pragma unroll
  for (int i = 0; i < 4; ++i) { f32x4 v = pp[i]; s += v[0] + v[1] + v[2] + v[3]; }
  return rsqrtf(s * (1.f / 1024.f) + EPSV);
}

__device__ void transpose_tile(const float* __restrict__ src, int ld_src, int r0, int c0, int c_valid,
                               bf16_t* __restrict__ dst, int ld_dst, const float* __restrict__ scale, int scale_from,
                               float* tile) {
  const int tid = threadIdx.x;
  {
    const int j = tid & 63, i0 = tid >> 6;
#pragma unroll 4
    for (int ii = 0; ii < 16; ++ii) {
      const int i = i0 + 4 * ii;
      float v = 0.f;
      if (c0 + j < c_valid) {
        v = src[(size_t)(r0 + i) * ld_src + c0 + j];
        if (scale != nullptr && (r0 + i) >= scale_from) v *= scale[r0 + i - scale_from];
      }
      tile[i * 65 + j] = v;
    }
  }
  __syncthreads();
  {
    const int i = tid & 63, j0 = tid >> 6;
#pragma unroll 4
    for (int jj = 0; jj < 16; ++jj) {
      const int j = j0 + 4 * jj;
      dst[(size_t)(c0 + j) * ld_dst + r0 + i] = (bf16_t)(pk2(tile[i * 65 + j], 0.f) & 0xffffu);
    }
  }
  __syncthreads();
}

__device__ void phase_prep(const Params& p, unsigned char* smem) {
  const int tid = threadIdx.x, lane = tid & 63, wid = tid >> 6;
  unsigned char* ws = p.ws;
  bf16_t* xb = (bf16_t*)(ws + OFF_XB);
  float* rs1 = (float*)(ws + OFF_RS1);
  for (int t = blockIdx.x * 4 + wid; t < T_TOK; t += gridDim.x * 4) {
    const float* xr = p.x + (size_t)t * DM;
    bf16_t* xo = xb + (size_t)t * DM;
    float ss = 0.f;
#pragma unroll
    for (int c = 0; c < 8; ++c) {
      f32x4 v = *(const f32x4*)(xr + c * 256 + lane * 4);
      ss += v[0] * v[0] + v[1] * v[1] + v[2] * v[2] + v[3] * v[3];
      u32x2 o = {pk2(v[0], v[1]), pk2(v[2], v[3])};
      *(u32x2*)(xo + c * 256 + lane * 4) = o;
    }
    ss = wave_sum(ss);
    if (lane == 0) rs1[t] = rsqrtf(ss * (1.f / 2048.f) + EPSV);
  }
  float* tile = (float*)smem;
  const int NT_WIN = 32 * 74, NT_SQ = 32 * 32;
  const int total = NT_WIN + 2 * NT_SQ + 32;
  for (int u = blockIdx.x; u < total; u += gridDim.x) {
    if (u < NT_WIN) {
      const int ri = u & 31, cj = u >> 5;
      transpose_tile(p.w_in, 4624, ri * 64, cj * 64, 4624, (bf16_t*)(ws + OFF_WINT), 2048, p.norm_mix_w, 0, tile);
    } else if (u < NT_WIN + NT_SQ) {
      const int v = u - NT_WIN, ri = v & 31, cj = v >> 5;
      transpose_tile(p.w_out, 2048, ri * 64, cj * 64, 2048, (bf16_t*)(ws + OFF_WOUTT), 2048, p.ssd_norm_w, 1024, tile);
    } else if (u < NT_WIN + 2 * NT_SQ) {
      const int v = u - NT_WIN - NT_SQ, ri = v & 31, cj = v >> 5;
      transpose_tile(p.peer_wq, 2048, ri * 64, cj * 64, 2048, (bf16_t*)(ws + OFF_WQT), 2048, p.norm_ffn_w, 0, tile);
    } else {
      const int v = u - NT_WIN - 2 * NT_SQ;
      const int h = v & 15;
      const float* src = (v < 16 ? p.lru_wa : p.lru_wx) + (size_t)h * 4096;
      bf16_t* dst = (bf16_t*)(ws + (v < 16 ? OFF_WAT : OFF_WXT)) + (size_t)h * 4096;
      transpose_tile(src, 64, 0, 0, 64, dst, 64, nullptr, 0, tile);
    }
  }
  {
    bf16_t* kb = (bf16_t*)(ws + OFF_KEYSB);
    for (int i = blockIdx.x * NTHR + tid; i < 65536; i += gridDim.x * NTHR) {
      f32x4 v = *(const f32x4*)(p.peer_sub_keys + (size_t)i * 4);
      u32x2 o = {pk2(v[0], v[1]), pk2(v[2], v[3])};
      *(u32x2*)(kb + (size_t)i * 4) = o;
    }
  }
}

template <int MODE>
__device__ void gemm_tile(const Params& p, unsigned char* smem, const bf16_t* __restrict__ A,
                          const bf16_t* __restrict__ Bt, int mt, int nt) {
  const int tid = threadIdx.x, lane = tid & 63, wid = tid >> 6, wr = wid >> 1, wc = wid & 1;
  const int l15 = lane & 15, q4 = lane >> 4;
  const int m0 = mt * 128, n0 = nt * 128;
  unsigned char* ws = p.ws;
  f32x4 acc[4][4];
#pragma unroll
  for (int i = 0; i < 4; ++i)
#pragma unroll
    for (int j = 0; j < 4; ++j) acc[i][j] = (f32x4){0.f, 0.f, 0.f, 0.f};
  const int srow = tid >> 3, skc = tid & 7;
  const bf16_t* Ag = A + (size_t)(m0 + srow) * 2048 + skc * 8;
  const bf16_t* Bg = Bt + (size_t)(n0 + srow) * 2048 + skc * 8;
  const int soff = srow * 128 + ((skc ^ ((srow >> 1) & 7)) << 4);
  u32x4 ra[4], rb[4];
  constexpr int NK = 32;
#define KIDX(kt) ((MODE == 2) ? (((kt) + 16) & 31) : (kt))
  {
    const int kk = KIDX(0);
#pragma unroll
    for (int i = 0; i < 4; ++i) {
      ra[i] = *(const u32x4*)(Ag + (size_t)i * 32 * 2048 + kk * 64);
      rb[i] = *(const u32x4*)(Bg + (size_t)i * 32 * 2048 + kk * 64);
    }
#pragma unroll
    for (int i = 0; i < 4; ++i) {
      *(u32x4*)(smem + soff + i * 4096) = ra[i];
      *(u32x4*)(smem + 16384 + soff + i * 4096) = rb[i];
    }
  }
  __syncthreads();
  for (int kt = 0; kt < NK; ++kt) {
    const int buf = kt & 1;
    if (kt + 1 < NK) {
      const int kk = KIDX(kt + 1);
#pragma unroll
      for (int i = 0; i < 4; ++i) {
        ra[i] = *(const u32x4*)(Ag + (size_t)i * 32 * 2048 + kk * 64);
        rb[i] = *(const u32x4*)(Bg + (size_t)i * 32 * 2048 + kk * 64);
      }
    }
    const unsigned char* As = smem + buf * 32768;
    const unsigned char* Bs = As + 16384;
#pragma unroll
    for (int ks = 0; ks < 2; ++ks) {
      bf16x8 af[4], bfr[4];
      const int chunk = ks * 4 + q4;
#pragma unroll
      for (int mi = 0; mi < 4; ++mi) af[mi] = *(const bf16x8*)(As + sw128(wr * 64 + mi * 16 + l15, chunk));
#pragma unroll
      for (int ni = 0; ni < 4; ++ni) bfr[ni] = *(const bf16x8*)(Bs + sw128(wc * 64 + ni * 16 + l15, chunk));
#pragma unroll
      for (int mi = 0; mi < 4; ++mi)
#pragma unroll
        for (int ni = 0; ni < 4; ++ni) acc[mi][ni] = mfma16(bfr[ni], af[mi], acc[mi][ni]);
    }
    if (MODE == 2 && kt == 15) {
      const float* ssq = (const float*)(ws + OFF_SSQ);
#pragma unroll
      for (int mi = 0; mi < 4; ++mi) {
        const float s = rs_from_ssq(ssq, m0 + wr * 64 + mi * 16 + l15);
#pragma unroll
        for (int ni = 0; ni < 4; ++ni) acc[mi][ni] *= s;
      }
    }
    if (kt + 1 < NK) {
      unsigned char* dsta = smem + (buf ^ 1) * 32768 + soff;
#pragma unroll
      for (int i = 0; i < 4; ++i) {
        *(u32x4*)(dsta + i * 4096) = ra[i];
        *(u32x4*)(dsta + 16384 + i * 4096) = rb[i];
      }
    }
    __syncthreads();
  }
#undef KIDX
  if (MODE == 1) {
    const float* rs1 = (const float*)(ws + OFF_RS1);
    bf16_t* proj = (bf16_t*)(ws + OFF_PROJ);
#pragma unroll
    for (int mi = 0; mi < 4; ++mi) {
      const int row = m0 + wr * 64 + mi * 16 + l15;
      const float s = rs1[row];
#pragma unroll
      for (int ni = 0; ni < 4; ++ni) {
        const int col = n0 + wc * 64 + ni * 16 + q4 * 4;
        f32x4 v = acc[mi][ni] * s;
        u32x2 o = {pk2(v[0], v[1]), pk2(v[2], v[3])};
        *(u32x2*)(proj + (size_t)row * LDP + col) = o;
      }
    }
  } else if (MODE == 2) {
    bf16_t* x1b = (bf16_t*)(ws + OFF_X1B);
    float* ssq2 = (float*)(ws + OFF_SSQ2);
#pragma unroll
    for (int mi = 0; mi < 4; ++mi) {
      const int row = m0 + wr * 64 + mi * 16 + l15;
      float ss = 0.f;
#pragma unroll
      for (int ni = 0; ni < 4; ++ni) {
        const int col = n0 + wc * 64 + ni * 16 + q4 * 4;
        f32x4 xr = *(const f32x4*)(p.x + (size_t)row * DM + col);
        f32x4 v = acc[mi][ni] + xr;
        *(f32x4*)(p.out + (size_t)row * DM + col) = v;
        u32x2 o = {pk2(v[0], v[1]), pk2(v[2], v[3])};
        *(u32x2*)(x1b + (size_t)row * DM + col) = o;
        ss += v[0] * v[0] + v[1] * v[1] + v[2] * v[2] + v[3] * v[3];
      }
      ss += __shfl_xor(ss, 16);
      ss += __shfl_xor(ss, 32);
      if (q4 == 0) ssq2[(size_t)row * 32 + nt * 2 + wc] = ss;
    }
  } else {
    const float* ssq2 = (const float*)(ws + OFF_SSQ2);
    bf16_t* qo = (bf16_t*)(ws + OFF_Q);
#pragma unroll
    for (int mi = 0; mi < 4; ++mi) {
      const int row = m0 + wr * 64 + mi * 16 + l15;
      const float s = rs_from_ssq2(ssq2, row);
#pragma unroll
      for (int ni = 0; ni < 4; ++ni) {
        const int col = n0 + wc * 64 + ni * 16 + q4 * 4;
        f32x4 v = acc[mi][ni] * s;
        u32x2 o = {pk2(v[0], v[1]), pk2(v[2], v[3])};
        *(u32x2*)(qo + (size_t)row * DM + col) = o;
      }
    }
  }
}

__device__ __forceinline__ void conv8(const bf16_t* __restrict__ proj, int t, int tt_in_seq, int col,
                                      const float* __restrict__ cw, int ld_w, const float* __restrict__ cb, int ch,
                                      float* o) {
  f32x4 b0 = *(const f32x4*)(cb + ch), b1 = *(const f32x4*)(cb + ch + 4);
  o[0] = b0[0]; o[1] = b0[1]; o[2] = b0[2]; o[3] = b0[3];
  o[4] = b1[0]; o[5] = b1[1]; o[6] = b1[2]; o[7] = b1[3];
#pragma unroll
  for (int k = 0; k < 4; ++k) {
    if (tt_in_seq - 3 + k >= 0) {
      u32x4 v = *(const u32x4*)(proj + (size_t)(t - 3 + k) * LDP + col);
      f32x4 w0 = *(const f32x4*)(cw + k * ld_w + ch), w1 = *(const f32x4*)(cw + k * ld_w + ch + 4);
      o[0] += w0[0] * bflo(v[0]); o[1] += w0[1] * bfhi(v[0]);
      o[2] += w0[2] * bflo(v[1]); o[3] += w0[3] * bfhi(v[1]);
      o[4] += w1[0] * bflo(v[2]); o[5] += w1[1] * bfhi(v[2]);
      o[6] += w1[2] * bflo(v[3]); o[7] += w1[3] * bfhi(v[3]);
    }
  }
}
__device__ __forceinline__ void conv4(const bf16_t* __restrict__ proj, int t, int tt_in_seq, int col,
                                      const float* __restrict__ cw, int ld_w, const float* __restrict__ cb, int ch,
                                      float* o) {
  f32x4 b0 = *(const f32x4*)(cb + ch);
  o[0] = b0[0]; o[1] = b0[1]; o[2] = b0[2]; o[3] = b0[3];
#pragma unroll
  for (int k = 0; k < 4; ++k) {
    if (tt_in_seq - 3 + k >= 0) {
      u32x2 v = *(const u32x2*)(proj + (size_t)(t - 3 + k) * LDP + col);
      f32x4 w0 = *(const f32x4*)(cw + k * ld_w + ch);
      o[0] += w0[0] * bflo(v[0]); o[1] += w0[1] * bfhi(v[0]);
      o[2] += w0[2] * bflo(v[1]); o[3] += w0[3] * bfhi(v[1]);
    }
  }
}
__device__ __forceinline__ bf16x8 cfrag(const Params& p, const bf16_t* proj, int t, int tseq, int g, int n8) {
  float o[8];
  const int ch = 1280 + g * 128 + n8;
  conv8(proj, t, tseq, 3072 + ch, p.ssd_conv_w, 1536, p.ssd_conv_b, ch, o);
#pragma unroll
  for (int i = 0; i < 8; ++i) o[i] = silu_(o[i]);
  u32x4 r = {pk2(o[0], o[1]), pk2(o[2], o[3]), pk2(o[4], o[5]), pk2(o[6], o[7])};
  return as_frag(r);
}

__device__ void lru_local_unit(const Params& p, unsigned char* smem, int unit) {
  const int tid = threadIdx.x, lane = tid & 63, wid = tid >> 6, l15 = lane & 15, q4 = lane >> 4;
  const int hh = unit & 15, c = (unit >> 4) & 15, b = unit >> 8;
  const int t0 = b * 2048 + c * 128, ch0 = hh * 64;
  unsigned char* ws = p.ws;
  const bf16_t* proj = (const bf16_t*)(ws + OFF_PROJ);
  float* R1 = (float*)smem;
  float* R2 = (float*)(smem + 33536);
  float* R3 = (float*)(smem + 33536 + 32768);
#pragma unroll 2
  for (int e = tid; e < 131 * 64; e += NTHR) {
    const int r = e >> 6, j = e & 63, tt = r - 3;
    float v = 0.f;
    if (c * 128 + tt >= 0) v = bf2f(proj[(size_t)(t0 + tt) * LDP + ch0 + j]);
    R1[e] = v;
  }
  __syncthreads();
  {
    const int j = tid & 63;
    const float cb = p.lru_conv_b[ch0 + j];
    const float w0 = p.lru_conv_w[0 * 1024 + ch0 + j], w1 = p.lru_conv_w[1 * 1024 + ch0 + j],
                w2 = p.lru_conv_w[2 * 1024 + ch0 + j], w3 = p.lru_conv_w[3 * 1024 + ch0 + j];
#pragma unroll 4
    for (int tt = tid >> 6; tt < 128; tt += 4) {
      R2[tt * 64 + j] = cb + w0 * R1[tt * 64 + j] + w1 * R1[(tt + 1) * 64 + j] + w2 * R1[(tt + 2) * 64 + j] +
                        w3 * R1[(tt + 3) * 64 + j];
    }
  }
  __syncthreads();
  {
    const bf16_t* waT = (const bf16_t*)(ws + OFF_WAT) + (size_t)hh * 4096;
    const bf16_t* wxT = (const bf16_t*)(ws + OFF_WXT) + (size_t)hh * 4096;
    f32x4 aa[2][4], ax[2][4];
#pragma unroll
    for (int i = 0; i < 2; ++i)
#pragma unroll
      for (int j = 0; j < 4; ++j) { aa[i][j] = (f32x4){0, 0, 0, 0}; ax[i][j] = (f32x4){0, 0, 0, 0}; }
#pragma unroll
    for (int ks = 0; ks < 2; ++ks) {
      bf16x8 af[2];
#pragma unroll
      for (int mi = 0; mi < 2; ++mi) {
        const float* src = R2 + (wid * 32 + mi * 16 + l15) * 64 + ks * 32 + q4 * 8;
        f32x4 v0 = *(const f32x4*)src, v1 = *(const f32x4*)(src + 4);
        u32x4 r = {pk2(v0[0], v0[1]), pk2(v0[2], v0[3]), pk2(v1[0], v1[1]), pk2(v1[2], v1[3])};
        af[mi] = as_frag(r);
      }
#pragma unroll
      for (int ni = 0; ni < 4; ++ni) {
        const size_t wo = (size_t)(ni * 16 + l15) * 64 + ks * 32 + q4 * 8;
        bf16x8 ba = as_frag(*(const u32x4*)(waT + wo));
        bf16x8 bx = as_frag(*(const u32x4*)(wxT + wo));
#pragma unroll
        for (int mi = 0; mi < 2; ++mi) {
          aa[mi][ni] = mfma16(af[mi], ba, aa[mi][ni]);
          ax[mi][ni] = mfma16(af[mi], bx, ax[mi][ni]);
        }
      }
    }
#pragma unroll
    for (int ni = 0; ni < 4; ++ni) {
      const int j = ni * 16 + l15;
      const float ba = p.lru_ba[ch0 + j], bx = p.lru_bx[ch0 + j];
      const float lam = p.lru_lambda[ch0 + j];
      const float spl = -8.f * log1pf(__expf(-lam));
#pragma unroll
      for (int mi = 0; mi < 2; ++mi)
#pragma unroll
        for (int r = 0; r < 4; ++r) {
          const int tt = wid * 32 + mi * 16 + q4 * 4 + r;
          const float rg = sigmoid_(aa[mi][ni][r] + ba);
          const float ig = sigmoid_(ax[mi][ni][r] + bx);
          const float log_a = spl * rg;
          const float av = __expf(log_a);
          const float xl = R2[tt * 64 + j];
          const float bv = sqrtf(fmaxf(-expm1f(2.f * log_a), 0.f)) * (ig * xl);
          R1[tt * 64 + j] = av;
          R2[tt * 64 + j] = bv;
        }
    }
  }
  __syncthreads();
  {
    const int j = tid & 63, seg = tid >> 6;
    float h = 0.f, Ac = 1.f;
#pragma unroll 4
    for (int s = 0; s < 32; ++s) {
      const int tt = seg * 32 + s;
      const float a = R1[tt * 64 + j], bb = R2[tt * 64 + j];
      h = a * h + bb;
      Ac *= a;
      R2[tt * 64 + j] = h;
      R1[tt * 64 + j] = Ac;
    }
    R3[seg * 64 + j] = h;
    R3[256 + seg * 64 + j] = Ac;
    __syncthreads();
    float cin = 0.f, Ain = 1.f;
    for (int s2 = 0; s2 < seg; ++s2) {
      cin = R3[256 + s2 * 64 + j] * cin + R3[s2 * 64 + j];
      Ain *= R3[256 + s2 * 64 + j];
    }
    float* hloc = (float*)(ws + OFF_HLOC);
    float* cumA = (float*)(ws + OFF_CUMA);
#pragma unroll 4
    for (int s = 0; s < 32; ++s) {
      const int tt = seg * 32 + s;
      const float hl = R2[tt * 64 + j] + R1[tt * 64 + j] * cin;
      const float Al = R1[tt * 64 + j] * Ain;
      hloc[(size_t)(t0 + tt) * 1024 + ch0 + j] = hl;
      cumA[(size_t)(t0 + tt) * 1024 + ch0 + j] = Al;
    }
  }
  __syncthreads();
}

__device__ void ssd_local_unit(const Params& p, unsigned char* smem, int unit) {
  const int tid = threadIdx.x, lane = tid & 63, wid = tid >> 6, l15 = lane & 15, q4 = lane >> 4;
  const int hh = unit & 15, c = (unit >> 4) & 15, b = unit >> 8, g = hh >> 3;
  const int t0 = b * 2048 + c * 128, ts0 = c * 128;
  unsigned char* ws = p.ws;
  const bf16_t* proj = (const bf16_t*)(ws + OFF_PROJ);
  unsigned char* Bm = smem;
  unsigned char* XT = smem + 32768;
  unsigned char* Pw = smem + 49152 + wid * 4096;
  float* dts = (float*)(smem + 65536);
  float* acs = dts + 128;
  float* adt = acs + 128;
  if (tid < 128) {
    const float raw = bf2f(proj[(size_t)(t0 + tid) * LDP + 4608 + hh]);
    const float dtv = softplus_(raw + p.ssd_dt_bias[hh]);
    dts[tid] = dtv;
    adt[tid] = -__expf(p.ssd_a_log[hh]) * dtv;
  }
  __syncthreads();
  if (tid < 128) {
    float s = 0.f;
    for (int k = 0; k <= tid; ++k) s += adt[k];
    acs[tid] = s;
    ((float*)(ws + OFF_ACS))[(size_t)(t0 + tid) * 16 + hh] = s;
  }
  {
    const int chunk = tid & 15;
    const int ch = 1024 + g * 128 + chunk * 8;
#pragma unroll 1
    for (int i = 0; i < 8; ++i) {
      const int tt = (tid >> 4) + 16 * i;
      float o[8];
      conv8(proj, t0 + tt, ts0 + tt, 3072 + ch, p.ssd_conv_w, 1536, p.ssd_conv_b, ch, o);
#pragma unroll
      for (int e = 0; e < 8; ++e) o[e] = silu_(o[e]);
      u32x4 r = {pk2(o[0], o[1]), pk2(o[2], o[3]), pk2(o[4], o[5]), pk2(o[6], o[7])};
      *(u32x4*)(Bm + sw256(tt, chunk)) = r;
    }
  }
  __syncthreads();
  {
    const int pp = tid & 63;
    const int ch = hh * 64 + pp;
    const float cb = p.ssd_conv_b[ch];
    const float w0 = p.ssd_conv_w[ch], w1 = p.ssd_conv_w[1536 + ch], w2 = p.ssd_conv_w[2 * 1536 + ch],
                w3 = p.ssd_conv_w[3 * 1536 + ch];
#pragma unroll 1
    for (int i = 0; i < 4; ++i) {
      const int chunk = (tid >> 6) * 4 + i;
      const int tt0 = chunk * 8;
      float xv[11];
#pragma unroll
      for (int k = 0; k < 11; ++k) {
        const int tt = tt0 - 3 + k;
        xv[k] = (ts0 + tt >= 0) ? bf2f(proj[(size_t)(t0 + tt) * LDP + 3072 + ch]) : 0.f;
      }
      float o[8];
#pragma unroll
      for (int e = 0; e < 8; ++e) {
        const float cv = cb + w0 * xv[e] + w1 * xv[e + 1] + w2 * xv[e + 2] + w3 * xv[e + 3];
        o[e] = silu_(cv) * dts[tt0 + e];
      }
      u32x4 r = {pk2(o[0], o[1]), pk2(o[2], o[3]), pk2(o[4], o[5]), pk2(o[6], o[7])};
      *(u32x4*)(XT + sw256(pp, chunk)) = r;
    }
  }
  __syncthreads();
  bf16_t* ypart = (bf16_t*)(ws + OFF_YPART);
  const float Dh = p.ssd_d[hh];
#pragma unroll 1
  for (int mt = 0; mt < 2; ++mt) {
    const int M = wid * 2 + mt;
    const int lrow = M * 16 + l15;
    bf16x8 cf[4];
#pragma unroll
    for (int ks = 0; ks < 4; ++ks) cf[ks] = cfrag(p, proj, t0 + lrow, ts0 + lrow, g, ks * 32 + q4 * 8);
    const float acl = acs[lrow];
    const int ntmax = M | 1;
#pragma unroll 1
    for (int nt = 0; nt <= ntmax; ++nt) {
      f32x4 a4 = (f32x4){0, 0, 0, 0};
      if (nt <= M) {
#pragma unroll
        for (int ks = 0; ks < 4; ++ks) {
          bf16x8 bfr = *(const bf16x8*)(Bm + sw256(nt * 16 + l15, ks * 4 + q4));
          a4 = mfma16(bfr, cf[ks], a4);
        }
      }
      float pv[4];
#pragma unroll
      for (int r = 0; r < 4; ++r) {
        const int s = nt * 16 + q4 * 4 + r;
        pv[r] = (s <= lrow) ? a4[r] * __expf(acl - acs[s]) : 0.f;
      }
      u32x2 o = {pk2(pv[0], pv[1]), pk2(pv[2], pv[3])};
      const int chunk = nt * 2 + (q4 >> 1);
      *(u32x2*)(Pw + sw256(l15, chunk) + (q4 & 1) * 8) = o;
    }
    f32x4 ya[4];
#pragma unroll
    for (int pt = 0; pt < 4; ++pt) ya[pt] = (f32x4){0, 0, 0, 0};
    const int ksmax = M >> 1;
#pragma unroll 1
    for (int ks = 0; ks <= ksmax; ++ks) {
      bf16x8 pf = *(const bf16x8*)(Pw + sw256(l15, ks * 4 + q4));
#pragma unroll
      for (int pt = 0; pt < 4; ++pt) {
        bf16x8 xf = *(const bf16x8*)(XT + sw256(pt * 16 + l15, ks * 4 + q4));
        ya[pt] = mfma16(xf, pf, ya[pt]);
      }
    }
#pragma unroll
    for (int pt = 0; pt < 4; ++pt) {
      const int pc = pt * 16 + q4 * 4;
      const int ch = hh * 64 + pc;
      float xo[4];
      conv4(proj, t0 + lrow, ts0 + lrow, 3072 + ch, p.ssd_conv_w, 1536, p.ssd_conv_b, ch, xo);
      float y0 = ya[pt][0] + Dh * silu_(xo[0]), y1 = ya[pt][1] + Dh * silu_(xo[1]);
      float y2 = ya[pt][2] + Dh * silu_(xo[2]), y3 = ya[pt][3] + Dh * silu_(xo[3]);
      u32x2 o = {pk2(y0, y1), pk2(y2, y3)};
      *(u32x2*)(ypart + (size_t)(t0 + lrow) * 1024 + ch) = o;
    }
  }
  {
    f32x4 sa[2][4];
#pragma unroll
    for (int i = 0; i < 2; ++i)
#pragma unroll
      for (int j = 0; j < 4; ++j) sa[i][j] = (f32x4){0, 0, 0, 0};
    const float aend = acs[127];
#pragma unroll 1
    for (int ks = 0; ks < 4; ++ks) {
      float dec[8];
#pragma unroll
      for (int e = 0; e < 8; ++e) dec[e] = __expf(aend - acs[ks * 32 + q4 * 8 + e]);
      bf16x8 bd[2];
#pragma unroll
      for (int ni = 0; ni < 2; ++ni) {
        const int n = wid * 32 + ni * 16 + l15;
        float v[8];
#pragma unroll
        for (int e = 0; e < 8; ++e) {
          const int l = ks * 32 + q4 * 8 + e;
          const bf16_t raw = *(const bf16_t*)(Bm + sw256(l, n >> 3) + (n & 7) * 2);
          v[e] = bf2f(raw) * dec[e];
        }
        u32x4 r = {pk2(v[0], v[1]), pk2(v[2], v[3]), pk2(v[4], v[5]), pk2(v[6], v[7])};
        bd[ni] = as_frag(r);
      }
#pragma unroll
      for (int pt = 0; pt < 4; ++pt) {
        bf16x8 xf = *(const bf16x8*)(XT + sw256(pt * 16 + l15, ks * 4 + q4));
#pragma unroll
        for (int ni = 0; ni < 2; ++ni) sa[ni][pt] = mfma16(bd[ni], xf, sa[ni][pt]);
      }
    }
    float* St = (float*)(ws + OFF_ST) + (size_t)((b * 16 + c) * 16 + hh) * 8192;
#pragma unroll
    for (int ni = 0; ni < 2; ++ni)
#pragma unroll
      for (int pt = 0; pt < 4; ++pt) {
        const int pr = pt * 16 + l15, n = wid * 32 + ni * 16 + q4 * 4;
        *(f32x4*)(St + pr * 128 + n) = sa[ni][pt];
      }
  }
  __syncthreads();
}

__device__ void phase_carry(const Params& p) {
  unsigned char* ws = p.ws;
  const int gt = blockIdx.x * NTHR + threadIdx.x, ng = gridDim.x * NTHR;
  const float* hloc = (const float*)(ws + OFF_HLOC);
  const float* cumA = (const float*)(ws + OFF_CUMA);
  float* lcarry = (float*)(ws + OFF_LCARRY);
  for (int i = gt; i < 8192; i += ng) {
    const int b = i >> 10, ch = i & 1023;
    float carry = 0.f;
    for (int c = 0; c < 16; ++c) {
      lcarry[(size_t)(b * 16 + c) * 1024 + ch] = carry;
      const size_t tl = (size_t)(b * 2048 + c * 128 + 127) * 1024 + ch;
      carry = cumA[tl] * carry + hloc[tl];
    }
  }
  const float* acsG = (const float*)(ws + OFF_ACS);
  float* St = (float*)(ws + OFF_ST);
  for (int i = gt; i < 128 * 2048; i += ng) {
    const int bh = i >> 11, e4 = i & 2047, b = bh >> 4, hh = bh & 15;
    f32x4 s = (f32x4){0, 0, 0, 0};
    for (int c = 0; c < 16; ++c) {
      const float Ad = __expf(acsG[(size_t)(b * 2048 + c * 128 + 127) * 16 + hh]);
      f32x4* ptr = (f32x4*)(St + (size_t)((b * 16 + c) * 16 + hh) * 8192 + e4 * 4);
      f32x4 tmp = *ptr;
      *ptr = s;
      s = s * Ad + tmp;
    }
  }
}

__device__ void ssd_final_unit(const Params& p, int unit) {
  const int tid = threadIdx.x, lane = tid & 63, wid = tid >> 6, l15 = lane & 15, q4 = lane >> 4;
  const int hh = unit & 15, c = (unit >> 4) & 15, b = unit >> 8, g = hh >> 3;
  const int t0 = b * 2048 + c * 128, ts0 = c * 128;
  unsigned char* ws = p.ws;
  const bf16_t* proj = (const bf16_t*)(ws + OFF_PROJ);
  const float* Sin = (const float*)(ws + OFF_ST) + (size_t)((b * 16 + c) * 16 + hh) * 8192;
  const bf16_t* ypart = (const bf16_t*)(ws + OFF_YPART);
  const float* acsG = (const float*)(ws + OFF_ACS);
  bf16_t* A2 = (bf16_t*)(ws + OFF_XB);
  float* ssq = (float*)(ws + OFF_SSQ);
#pragma unroll 1
  for (int mt = 0; mt < 2; ++mt) {
    const int lrow = (wid * 2 + mt) * 16 + l15;
    f32x4 ya[4];
#pragma unroll
    for (int pt = 0; pt < 4; ++pt) ya[pt] = (f32x4){0, 0, 0, 0};
    if (c > 0) {
#pragma unroll 1
      for (int ks = 0; ks < 4; ++ks) {
        bf16x8 cf = cfrag(p, proj, t0 + lrow, ts0 + lrow, g, ks * 32 + q4 * 8);
#pragma unroll
        for (int pt = 0; pt < 4; ++pt) {
          const float* sp = Sin + (pt * 16 + l15) * 128 + ks * 32 + q4 * 8;
          f32x4 v0 = *(const f32x4*)sp, v1 = *(const f32x4*)(sp + 4);
          u32x4 r = {pk2(v0[0], v0[1]), pk2(v0[2], v0[3]), pk2(v1[0], v1[1]), pk2(v1[2], v1[3])};
          ya[pt] = mfma16(as_frag(r), cf, ya[pt]);
        }
      }
    }
    const size_t t = (size_t)(t0 + lrow);
    const float ea = __expf(acsG[t * 16 + hh]);
    float ss = 0.f;
#pragma unroll
    for (int pt = 0; pt < 4; ++pt) {
      const int ch = hh * 64 + pt * 16 + q4 * 4;
      u32x2 yp = *(const u32x2*)(ypart + t * 1024 + ch);
      u32x2 zz = *(const u32x2*)(proj + t * LDP + 2048 + ch);
      float y[4] = {bflo(yp[0]) + ea * ya[pt][0], bfhi(yp[0]) + ea * ya[pt][1], bflo(yp[1]) + ea * ya[pt][2],
                    bfhi(yp[1]) + ea * ya[pt][3]};
      float z[4] = {bflo(zz[0]), bfhi(zz[0]), bflo(zz[1]), bfhi(zz[1])};
#pragma unroll
      for (int r = 0; r < 4; ++r) { y[r] = y[r] * silu_(z[r]); ss += y[r] * y[r]; }
      u32x2 o = {pk2(y[0], y[1]), pk2(y[2], y[3])};
      *(u32x2*)(A2 + t * DM + 1024 + ch) = o;
    }
    ss += __shfl_xor(ss, 16);
    ss += __shfl_xor(ss, 32);
    if (q4 == 0) ssq[t * 16 + hh] = ss;
  }
}

__device__ void phase_mix_final(const Params& p) {
  unsigned char* ws = p.ws;
  const bf16_t* proj = (const bf16_t*)(ws + OFF_PROJ);
  const f32x4* hloc = (const f32x4*)(ws + OFF_HLOC);
  const f32x4* cumA = (const f32x4*)(ws + OFF_CUMA);
  const float* lcarry = (const float*)(ws + OFF_LCARRY);
  bf16_t* A2 = (bf16_t*)(ws + OFF_XB);
  for (int u = blockIdx.x; u < 2048; u += gridDim.x) ssd_final_unit(p, u);
  for (int i = blockIdx.x * NTHR + threadIdx.x; i < T_TOK * 256; i += gridDim.x * NTHR) {
    const int t = i >> 8, ch = (i & 255) * 4;
    f32x4 h = hloc[i], ca = cumA[i];
    f32x4 cr = *(const f32x4*)(lcarry + (size_t)(t >> 7) * 1024 + ch);
    u32x2 gg = *(const u32x2*)(proj + (size_t)t * LDP + 1024 + ch);
    float y0 = (h[0] + ca[0] * cr[0]) * gelu_(bflo(gg[0]));
    float y1 = (h[1] + ca[1] * cr[1]) * gelu_(bfhi(gg[0]));
    float y2 = (h[2] + ca[2] * cr[2]) * gelu_(bflo(gg[1]));
    float y3 = (h[3] + ca[3] * cr[3]) * gelu_(bfhi(gg[1]));
    u32x2 o = {pk2(y0, y1), pk2(y2, y3)};
    *(u32x2*)(A2 + (size_t)t * DM + ch) = o;
  }
}

__device__ void convert_uv(const Params& p) {
  unsigned char* ws = p.ws;
  const int lane = threadIdx.x & 63, wid = threadIdx.x >> 6;
  unsigned char* tb = ws + OFF_XB;
  float* scales = (float*)(ws + OFF_SCALES);
  for (int row = blockIdx.x * 4 + wid; row < 32768; row += gridDim.x * 4) {
    const bool isv = row >= 16384;
    const int e = row & 16383;
    const float* src = (isv ? p.peer_v : p.peer_u) + (size_t)e * DM;
    float vals[32];
    float amax = 0.f;
#pragma unroll
    for (int c = 0; c < 2; ++c)
#pragma unroll
      for (int q = 0; q < 4; ++q) {
        const int d = c * 1024 + lane * 16 + q * 4;
        f32x4 t = *(const f32x4*)(src + d);
        if (!isv) t *= *(const f32x4*)(p.norm_ffn_w + d);
#pragma unroll
        for (int k = 0; k < 4; ++k) {
          vals[c * 16 + q * 4 + k] = t[k];
          amax = fmaxf(amax, fabsf(t[k]));
        }
      }
#pragma unroll
    for (int o = 32; o > 0; o >>= 1) amax = fmaxf(amax, __shfl_xor(amax, o));
    const float inv = amax > 0.f ? 127.f / amax : 0.f;
#pragma unroll
    for (int c = 0; c < 2; ++c) {
      u32x4 o;
#pragma unroll
      for (int q = 0; q < 4; ++q) {
        unsigned w = 0;
#pragma unroll
        for (int k = 0; k < 4; ++k) {
          const int bi = __float2int_rn(vals[c * 16 + q * 4 + k] * inv) + 128;
          w |= ((unsigned)bi & 0xffu) << (8 * k);
        }
        o[q] = w;
      }
      *(u32x4*)(tb + (size_t)row * DM + c * 1024 + lane * 16) = o;
    }
    if (lane == 0) scales[row] = amax * (1.f / 127.f);
  }
}

__device__ const unsigned char cand_tab[64] = {
    0x00, 0x01, 0x02, 0x03, 0x04, 0x05, 0x06, 0x07, 0x08, 0x09, 0x0a, 0x0b, 0x0c, 0x0d, 0x0e, 0x0f,
    0x10, 0x11, 0x12, 0x13, 0x14, 0x15, 0x16, 0x17,
    0x20, 0x21, 0x22, 0x23, 0x24,
    0x30, 0x31, 0x32, 0x33,
    0x40, 0x41, 0x42,
    0x50, 0x51, 0x60, 0x61, 0x70, 0x71,
    0x80, 0x90, 0xa0, 0xb0, 0xc0, 0xd0, 0xe0, 0xf0,
    0xff, 0xff, 0xff, 0xff, 0xff, 0xff, 0xff, 0xff, 0xff, 0xff, 0xff, 0xff, 0xff, 0xff};

__device__ __forceinline__ unsigned ord_key(float f) {
  unsigned u = __float_as_uint(f);
  return u ^ ((u >> 31) ? 0xffffffffu : 0x80000000u);
}
__device__ __forceinline__ float ord_dec(unsigned k) {
  unsigned u = (k >> 31) ? (k ^ 0x80000000u) : ~k;
  return __uint_as_float(u);
}

__device__ void topk_unit(const Params& p, unsigned char* smem, int unit) {
  const int tid = threadIdx.x, lane = tid & 63, wid = tid >> 6, l15 = lane & 15, q4 = lane >> 4;
  const int h = unit & 7, tile = unit >> 3;
  const int tok0 = tile * 64 + wid * 16;
  unsigned char* ws = p.ws;
  const bf16_t* qg = (const bf16_t*)(ws + OFF_Q);
  const bf16_t* kb = (const bf16_t*)(ws + OFF_KEYSB);
  unsigned* S = (unsigned*)(smem + wid * 16640);
  float* tops = (float*)(smem + 4 * 16640 + wid * 256);
  int* topi = (int*)(tops + 32);
#pragma unroll
  for (int k = 0; k < 2; ++k) {
    f32x4 sc[8];
#pragma unroll
    for (int i = 0; i < 8; ++i) sc[i] = (f32x4){0, 0, 0, 0};
#pragma unroll
    for (int ks = 0; ks < 4; ++ks) {
      bf16x8 qf = as_frag(*(const u32x4*)(qg + (size_t)(tok0 + l15) * DM + h * 256 + k * 128 + ks * 32 + q4 * 8));
#pragma unroll
      for (int nt = 0; nt < 8; ++nt) {
        bf16x8 kf = as_frag(*(const u32x4*)(kb + (size_t)((h * 2 + k) * 128 + nt * 16 + l15) * 128 + ks * 32 + q4 * 8));
        sc[nt] = mfma16(kf, qf, sc[nt]);
      }
    }
#pragma unroll
    for (int nt = 0; nt < 8; ++nt) {
      const int n = nt * 16 + q4 * 4;
      u32x4 kk;
#pragma unroll
      for (int r = 0; r < 4; ++r) kk[r] = (ord_key(sc[nt][r]) & ~127u) | (unsigned)(127 - (n + r));
      *(u32x4*)(S + l15 * 260 + k * 128 + n) = kk;
    }
  }
  const unsigned ct = cand_tab[lane];
  const int ca = ct >> 4, cbb = ct & 15;
  int* idxo = (int*)(ws + OFF_IDX);
  float* go = (float*)(ws + OFF_G);
  for (int tk = 0; tk < 16; ++tk) {
    const unsigned* row = S + tk * 260;
    const unsigned k0 = row[lane], k1 = row[lane + 64], k2 = row[128 + lane], k3 = row[192 + lane];
    int r0 = 0, r1 = 0, r2 = 0, r3 = 0;
#pragma unroll 8
    for (int j = 0; j < 32; ++j) {
      u32x4 a = *(const u32x4*)(row + j * 4);
      u32x4 bq = *(const u32x4*)(row + 128 + j * 4);
#pragma unroll
      for (int e = 0; e < 4; ++e) {
        r0 += (a[e] > k0) ? 1 : 0;
        r1 += (a[e] > k1) ? 1 : 0;
        r2 += (bq[e] > k2) ? 1 : 0;
        r3 += (bq[e] > k3) ? 1 : 0;
      }
    }
    if (r0 < 16) { tops[r0] = ord_dec(k0 & ~127u); topi[r0] = lane; }
    if (r1 < 16) { tops[r1] = ord_dec(k1 & ~127u); topi[r1] = lane + 64; }
    if (r2 < 16) { tops[16 + r2] = ord_dec(k2 & ~127u); topi[16 + r2] = lane; }
    if (r3 < 16) { tops[16 + r3] = ord_dec(k3 & ~127u); topi[16 + r3] = lane + 64; }
    float cs = 0.f;
    unsigned ck = 0u;
    if (lane < 50) {
      cs = tops[ca] + tops[16 + cbb];
      ck = (ord_key(cs) & ~255u) | (unsigned)(255 - (ca * 16 + cbb));
    }
    int rk = 0;
#pragma unroll
    for (int j = 0; j < 50; ++j) {
      const unsigned oj = (unsigned)__builtin_amdgcn_readlane((int)ck, j);
      rk += (oj > ck) ? 1 : 0;
    }
    const float mx = tops[0] + tops[16];
    const bool sel = (lane < 50) && (rk < 16);
    const float ev = sel ? __expf(cs - mx) : 0.f;
    const float sum = wave_sum(ev);
    if (sel) {
      const size_t o = (size_t)(tok0 + tk) * 128 + h * 16 + rk;
      idxo[o] = topi[ca] * 128 + topi[16 + cbb];
      go[o] = ev / sum;
    }
  }
  __syncthreads();
}

__device__ __forceinline__ float ub0(unsigned w) { return (float)(w & 0xffu); }
__device__ __forceinline__ float ub1(unsigned w) { return (float)((w >> 8) & 0xffu); }
__device__ __forceinline__ float ub2(unsigned w) { return (float)((w >> 16) & 0xffu); }
__device__ __forceinline__ float ub3(unsigned w) { return (float)(w >> 24); }

#define GROWS 8
__device__ void phase_gather(const Params& p) {
  const int tid = threadIdx.x, lane = tid & 63, wid = tid >> 6;
  unsigned char* ws = p.ws;
  const unsigned char* ub = ws + OFF_XB;
  const unsigned char* vb = ws + OFF_XB + 32 * MIB;
  const float* scales = (const float*)(ws + OFF_SCALES);
  const int* idxg = (const int*)(ws + OFF_IDX);
  const float* gg = (const float*)(ws + OFF_G);
  const float* ssq2 = (const float*)(ws + OFF_SSQ2);
  for (int t = blockIdx.x * 4 + wid; t < T_TOK; t += gridDim.x * 4) {
    const int id0 = idxg[(size_t)t * 128 + lane], id1 = idxg[(size_t)t * 128 + 64 + lane];
    const float g0 = gg[(size_t)t * 128 + lane], g1 = gg[(size_t)t * 128 + 64 + lane];
    const float su0 = scales[id0], su1 = scales[id1], sv0 = scales[16384 + id0], sv1 = scales[16384 + id1];
    float* orow = p.out + (size_t)t * DM;
    float xr[32];
    float sumx = 0.f;
#pragma unroll
    for (int c = 0; c < 2; ++c)
#pragma unroll
      for (int q = 0; q < 4; ++q) {
        f32x4 v = *(const f32x4*)(orow + c * 1024 + lane * 16 + q * 4);
#pragma unroll
        for (int k = 0; k < 4; ++k) { xr[c * 16 + q * 4 + k] = v[k]; sumx += v[k]; }
      }
    sumx = wave_sum(sumx);
    float sq = (lane < 32) ? ssq2[(size_t)t * 32 + lane] : 0.f;
    sq = wave_sum(sq);
    const float rs2 = rsqrtf(sq * (1.f / 2048.f) + EPSV);
    float w0 = 0.f, w1 = 0.f;
#pragma unroll 1
    for (int half = 0; half < 2; ++half) {
      const int idv = half ? id1 : id0;
      float wv = 0.f;
#pragma unroll 1
      for (int j0 = 0; j0 < 64; j0 += GROWS) {
        u32x4 r[GROWS][2];
#pragma unroll
        for (int k = 0; k < GROWS; ++k) {
          const int e = __builtin_amdgcn_readlane(idv, j0 + k);
          const unsigned char* rp = ub + (size_t)e * DM + lane * 16;
          r[k][0] = *(const u32x4*)rp;
          r[k][1] = *(const u32x4*)(rp + 1024);
        }
#pragma unroll
        for (int k = 0; k < GROWS; ++k) {
          float d0 = 0.f, d1 = 0.f;
#pragma unroll
          for (int c = 0; c < 2; ++c)
#pragma unroll
            for (int q = 0; q < 4; ++q) {
              const unsigned w = r[k][c][q];
              d0 += ub0(w) * xr[c * 16 + q * 4 + 0];
              d1 += ub1(w) * xr[c * 16 + q * 4 + 1];
              d0 += ub2(w) * xr[c * 16 + q * 4 + 2];
              d1 += ub3(w) * xr[c * 16 + q * 4 + 3];
            }
          const float d = wave_sum(d0 + d1);
          if (lane == j0 + k) wv = d;
        }
      }
      const float su = half ? su1 : su0;
      const float a = gelu_((wv - 128.f * sumx) * su * rs2);
      if (half) w1 = a * g1 * sv1; else w0 = a * g0 * sv0;
    }
    float acc[32];
#pragma unroll
    for (int i = 0; i < 32; ++i) acc[i] = 0.f;
    const float csum = wave_sum(w0 + w1);
#pragma unroll 1
    for (int half = 0; half < 2; ++half) {
      const int idv = half ? id1 : id0;
      const float wvv = half ? w1 : w0;
#pragma unroll 1
      for (int j0 = 0; j0 < 64; j0 += GROWS) {
        u32x4 r[GROWS][2];
        float wk[GROWS];
#pragma unroll
        for (int k = 0; k < GROWS; ++k) {
          const int e = __builtin_amdgcn_readlane(idv, j0 + k);
          wk[k] = __builtin_bit_cast(float, __builtin_amdgcn_readlane(__builtin_bit_cast(int, wvv), j0 + k));
          const unsigned char* rp = vb + (size_t)e * DM + lane * 16;
          r[k][0] = *(const u32x4*)rp;
          r[k][1] = *(const u32x4*)(rp + 1024);
        }
#pragma unroll
        for (int k = 0; k < GROWS; ++k)
#pragma unroll
          for (int c = 0; c < 2; ++c)
#pragma unroll
            for (int q = 0; q < 4; ++q) {
              const unsigned w = r[k][c][q];
              acc[c * 16 + q * 4 + 0] += wk[k] * ub0(w);
              acc[c * 16 + q * 4 + 1] += wk[k] * ub1(w);
              acc[c * 16 + q * 4 + 2] += wk[k] * ub2(w);
              acc[c * 16 + q * 4 + 3] += wk[k] * ub3(w);
            }
      }
    }
    const float off = 128.f * csum;
    float ss = 0.f;
#pragma unroll
    for (int i = 0; i < 32; ++i) {
      acc[i] = acc[i] - off + xr[i];
      ss += acc[i] * acc[i];
    }
    ss = wave_sum(ss);
    const float rs3 = rsqrtf(ss * (1.f / 2048.f) + EPSV);
#pragma unroll
    for (int c = 0; c < 2; ++c)
#pragma unroll
      for (int q = 0; q < 4; ++q) {
        const int d = c * 1024 + lane * 16 + q * 4;
        f32x4 wf = *(const f32x4*)(p.norm_final_w + d);
        f32x4 o = {acc[c * 16 + q * 4 + 0] * rs3 * wf[0], acc[c * 16 + q * 4 + 1] * rs3 * wf[1],
                   acc[c * 16 + q * 4 + 2] * rs3 * wf[2], acc[c * 16 + q * 4 + 3] * rs3 * wf[3]};
        *(f32x4*)(orow + d) = o;
      }
  }
}

__global__ void __launch_bounds__(NTHR, 2) fwd_kernel(Params p) {
  __shared__ __attribute__((aligned(16))) unsigned char smem[SMEM_BYTES];
  cg::grid_group grid = cg::this_grid();
  unsigned char* ws = p.ws;
#define PHASE_ON(n) (p.phase_lo <= (n) && (n) <= p.phase_hi)
#define PHASE_SYNC(n) if (p.coop && PHASE_ON(n) && (n) < p.phase_hi) grid.sync();
  if (PHASE_ON(0)) phase_prep(p, smem);
  PHASE_SYNC(0)
  if (PHASE_ON(1)) {
    for (int u = blockIdx.x; u < 128 * 37; u += gridDim.x)
      gemm_tile<1>(p, smem, (const bf16_t*)(ws + OFF_XB), (const bf16_t*)(ws + OFF_WINT), u & 127, u >> 7);
  }
  PHASE_SYNC(1)
  if (PHASE_ON(2)) {
    for (int u = blockIdx.x; u < 2048; u += gridDim.x) ssd_local_unit(p, smem, u);
    for (int u = blockIdx.x; u < 2048; u += gridDim.x) lru_local_unit(p, smem, u);
  }
  PHASE_SYNC(2)
  if (PHASE_ON(3)) phase_carry(p);
  PHASE_SYNC(3)
  if (PHASE_ON(4)) phase_mix_final(p);
  PHASE_SYNC(4)
  if (PHASE_ON(5)) {
    for (int u = blockIdx.x; u < 128 * 16; u += gridDim.x)
      gemm_tile<2>(p, smem, (const bf16_t*)(ws + OFF_XB), (const bf16_t*)(ws + OFF_WOUTT), u & 127, u >> 7);
  }
  PHASE_SYNC(5)
  if (PHASE_ON(6)) {
    for (int u = blockIdx.x; u < 128 * 16; u += gridDim.x)
      gemm_tile<3>(p, smem, (const bf16_t*)(ws + OFF_X1B), (const bf16_t*)(ws + OFF_WQT), u & 127, u >> 7);
    convert_uv(p);
  }
  PHASE_SYNC(6)
  if (PHASE_ON(7)) {
    for (int u = blockIdx.x; u < 2048; u += gridDim.x) topk_unit(p, smem, u);
  }
  PHASE_SYNC(7)
  if (PHASE_ON(8)) phase_gather(p);
}

extern "C" void kernel_launch(void* const* d_in, const int* in_sizes, int n_in, void* d_out, int out_size,
                              void* d_ws, size_t ws_size, hipStream_t stream) {
  Params p{};
  const float** fp = (const float**)&p;
  for (int i = 0; i < 23; ++i) fp[i] = (const float*)d_in[i];
  p.out = (float*)d_out;
  p.ws = (unsigned char*)d_ws;
  static int grid_blocks = 0;
  if (!grid_blocks) {
    int dev = 0, cus = 0, per_cu = 0;
    hipGetDevice(&dev);
    hipDeviceGetAttribute(&cus, hipDeviceAttributeMultiprocessorCount, dev);
    hipOccupancyMaxActiveBlocksPerMultiprocessor(&per_cu, fwd_kernel, NTHR, 0);
    if (per_cu < 1) per_cu = 1;
    if (per_cu > 2) per_cu = 2;
    grid_blocks = cus * per_cu;
  }
#if SINGLE_LAUNCH
  p.phase_lo = 0; p.phase_hi = 8; p.coop = 1;
  void* args[] = {&p};
  hipError_t e = hipLaunchCooperativeKernel((void*)fwd_kernel, dim3(grid_blocks), dim3(NTHR), args, 0, stream);
  if (e != hipSuccess) fprintf(stderr, "cooperative launch failed: %s (grid %d)\n", hipGetErrorString(e), grid_blocks);
#else
  for (int ph = 0; ph <= 8; ++ph) {
    p.phase_lo = ph; p.phase_hi = ph; p.coop = 0;
    hipLaunchKernelGGL(fwd_kernel, dim3(grid_blocks), dim3(NTHR), 0, stream, p);
  }
#endif
}
```

```cpp
#include <hip/hip_runtime.h>
#include <hip/hip_cooperative_groups.h>
#include <cstdio>
namespace cg = cooperative_groups;

#ifndef DBL_PHASE
#define DBL_PHASE -1
#endif
#ifndef SINGLE_LAUNCH
#define SINGLE_LAUNCH 1
#endif

typedef unsigned short bf16_t;
typedef short bf16x8 __attribute__((ext_vector_type(8)));
typedef float f32x4 __attribute__((ext_vector_type(4)));
typedef unsigned u32x4 __attribute__((ext_vector_type(4)));
typedef unsigned u32x2 __attribute__((ext_vector_type(2)));
typedef __bf16 bf2_t __attribute__((ext_vector_type(2)));

#define T_TOK 16384
#define DM 2048
#define LDP 4736
#define NTHR 256
#define SMEM_BYTES 73728
#define EPSV 1e-6f
#define MIB ((size_t)1 << 20)

#define OFF_XB (0 * MIB)
#define OFF_PROJ (64 * MIB)
#define OFF_X1B (64 * MIB)
#define OFF_Q (128 * MIB)
#define OFF_IDX (192 * MIB)
#define OFF_G (200 * MIB)
#define OFF_HLOC (212 * MIB)
#define OFF_CUMA (276 * MIB)
#define OFF_YPART (340 * MIB)
#define OFF_ST (372 * MIB)
#define OFF_WINT (436 * MIB)
#define OFF_WOUTT (455 * MIB)
#define OFF_WQT (463 * MIB)
#define OFF_WAT (471 * MIB)
#define OFF_WXT (471 * MIB + 131072)
#define OFF_KEYSB (471 * MIB + 262144)
#define OFF_RS1 (472 * MIB)
#define OFF_ACS (472 * MIB + 65536)
#define OFF_LCARRY (OFF_ACS + MIB)
#define OFF_SSQ (OFF_LCARRY + 524288)
#define OFF_SSQ2 (OFF_SSQ + MIB)
#define OFF_SCALES (OFF_SSQ2 + 2 * MIB)

struct Params {
  const float *x, *norm_mix_w, *w_in, *lru_conv_w, *lru_conv_b, *lru_wa, *lru_ba, *lru_wx, *lru_bx, *lru_lambda;
  const float *ssd_conv_w, *ssd_conv_b, *ssd_dt_bias, *ssd_a_log, *ssd_d, *ssd_norm_w, *w_out, *norm_ffn_w, *peer_wq;
  const float *peer_sub_keys, *peer_u, *peer_v, *norm_final_w;
  float* out;
  unsigned char* ws;
  int phase_lo, phase_hi, coop, pad0;
};

__device__ __forceinline__ unsigned pk2(float lo, float hi) {
  unsigned r;
  asm("v_cvt_pk_bf16_f32 %0, %1, %2" : "=v"(r) : "v"(lo), "v"(hi));
  return r;
}
__device__ __forceinline__ float bf2f(bf16_t v) { return __uint_as_float(((unsigned)v) << 16); }
__device__ __forceinline__ float bflo(unsigned u) { return __uint_as_float(u << 16); }
__device__ __forceinline__ float bfhi(unsigned u) { return __uint_as_float(u & 0xffff0000u); }
__device__ __forceinline__ float wave_sum(float v) {
#pragma unroll
  for (int o = 32; o > 0; o >>= 1) v += __shfl_xor(v, o);
  return v;
}
__device__ __forceinline__ float sigmoid_(float x) { return 1.f / (1.f + __expf(-x)); }
__device__ __forceinline__ float silu_(float x) { return x * sigmoid_(x); }
__device__ __forceinline__ float gelu_(float x) {
  float u = 0.7978845608028654f * (x + 0.044715f * x * x * x);
  return x * sigmoid_(2.f * u);
}
__device__ __forceinline__ float softplus_(float x) { return fmaxf(x, 0.f) + log1pf(__expf(-fabsf(x))); }
__device__ __forceinline__ f32x4 mfma16(bf16x8 a, bf16x8 b, f32x4 c) {
  return __builtin_amdgcn_mfma_f32_16x16x32_bf16(a, b, c, 0, 0, 0);
}
__device__ __forceinline__ bf16x8 as_frag(u32x4 v) { return __builtin_bit_cast(bf16x8, v); }
__device__ __forceinline__ int sw256(int row, int chunk) { return row * 256 + ((chunk ^ (row & 15)) << 4); }
__device__ __forceinline__ int sw128(int row, int chunk) { return row * 128 + ((chunk ^ ((row >> 1) & 7)) << 4); }

__device__ __forceinline__ float rs_from_ssq2(const float* ssq2, int row) {
  const f32x4* pp = (const f32x4*)(ssq2 + (size_t)row * 32);
  float s = 0.f;
#pragma unroll
  for (int i = 0; i < 8; ++i) { f32x4 v = pp[i]; s += v[0] + v[1] + v[2] + v[3]; }
  return rsqrtf(s * (1.f / 2048.f) + EPSV);
}
__device__ __forceinline__ float rs_from_ssq(const float* ssq, int row) {
  const f32x4* pp = (const f32x4*)(ssq + (size_t)row * 16);
  float s = 0.f;
#pragma unroll
  for (int i = 0; i < 4; ++i) { f32x4 v = pp[i]; s += v[0] + v[1] + v[2] + v[3]; }
  return rsqrtf(s * (1.f / 1024.f) + EPSV);
}

__device__ void transpose_tile(const float* __restrict__ src, int ld_src, int r0, int c0, int c_valid,
                               bf16_t* __restrict__ dst, int ld_dst, const float* __restrict__ scale, int scale_from,
                               float* tile) {
  const int tid = threadIdx.x;
  {
    const int j = tid & 63, i0 = tid >> 6;
#pragma unroll 4
    for (int ii = 0; ii < 16; ++ii) {
      const int i = i0 + 4 * ii;
      float v = 0.f;
      if (c0 + j < c_valid) {
        v = src[(size_t)(r0 + i) * ld_src + c0 + j];
        if (scale != nullptr && (r0 + i) >= scale_from) v *= scale[r0 + i - scale_from];
      }
      tile[i * 65 + j] = v;
    }
  }
  __syncthreads();
  {
    const int i = tid & 63, j0 = tid >> 6;
#pragma unroll 4
    for (int jj = 0; jj < 16; ++jj) {
      const int j = j0 + 4 * jj;
      dst[(size_t)(c0 + j) * ld_dst + r0 + i] = (bf16_t)(pk2(tile[i * 65 + j], 0.f) & 0xffffu);
    }
  }
  __syncthreads();
}

__device__ void phase_prep(const Params& p, unsigned char* smem) {
  const int tid = threadIdx.x, lane = tid & 63, wid = tid >> 6;
  unsigned char* ws = p.ws;
  bf16_t* xb = (bf16_t*)(ws + OFF_XB);
  float* rs1 = (float*)(ws + OFF_RS1);
  for (int t = blockIdx.x * 4 + wid; t < T_TOK; t += gridDim.x * 4) {
    const float* xr = p.x + (size_t)t * DM;
    bf16_t* xo = xb + (size_t)t * DM;
    float ss = 0.f;
#pragma unroll
    for (int c = 0; c < 8; ++c) {
      f32x4 v = *(const f32x4*)(xr + c * 256 + lane * 4);
      ss += v[0] * v[0] + v[1] * v[1] + v[2] * v[2] + v[3] * v[3];
      u32x2 o = {pk2(v[0], v[1]), pk2(v[2], v[3])};
      *(u32x2*)(xo + c * 256 + lane * 4) = o;
    }
    ss = wave_sum(ss);
    if (lane == 0) rs1[t] = rsqrtf(ss * (1.f / 2048.f) + EPSV);
  }
  float* tile = (float*)smem;
  const int NT_WIN = 32 * 74, NT_SQ = 32 * 32;
  const int total = NT_WIN + 2 * NT_SQ + 32;
  for (int u = blockIdx.x; u < total; u += gridDim.x) {
    if (u < NT_WIN) {
      const int ri = u & 31, cj = u >> 5;
      transpose_tile(p.w_in, 4624, ri * 64, cj * 64, 4624, (bf16_t*)(ws + OFF_WINT), 2048, p.norm_mix_w, 0, tile);
    } else if (u < NT_WIN + NT_SQ) {
      const int v = u - NT_WIN, ri = v & 31, cj = v >> 5;
      transpose_tile(p.w_out, 2048, ri * 64, cj * 64, 2048, (bf16_t*)(ws + OFF_WOUTT), 2048, p.ssd_norm_w, 1024, tile);
    } else if (u < NT_WIN + 2 * NT_SQ) {
      const int v = u - NT_WIN - NT_SQ, ri = v & 31, cj = v >> 5;
      transpose_tile(p.peer_wq, 2048, ri * 64, cj * 64, 2048, (bf16_t*)(ws + OFF_WQT), 2048, p.norm_ffn_w, 0, tile);
    } else {
      const int v = u - NT_WIN - 2 * NT_SQ;
      const int h = v & 15;
      const float* src = (v < 16 ? p.lru_wa : p.lru_wx) + (size_t)h * 4096;
      bf16_t* dst = (bf16_t*)(ws + (v < 16 ? OFF_WAT : OFF_WXT)) + (size_t)h * 4096;
      transpose_tile(src, 64, 0, 0, 64, dst, 64, nullptr, 0, tile);
    }
  }
  {
    bf16_t* kb = (bf16_t*)(ws + OFF_KEYSB);
    for (int i = blockIdx.x * NTHR + tid; i < 65536; i += gridDim.x * NTHR) {
      f32x4 v = *(const f32x4*)(p.peer_sub_keys + (size_t)i * 4);
      u32x2 o = {pk2(v[0], v[1]), pk2(v[2], v[3])};
      *(u32x2*)(kb + (size_t)i * 4) = o;
    }
  }
}

template <int MODE>
__device__ void gemm_tile(const Params& p, unsigned char* smem, const bf16_t* __restrict__ A,
                          const bf16_t* __restrict__ Bt, int mt, int nt) {
  const int tid = threadIdx.x, lane = tid & 63, wid = tid >> 6, wr = wid >> 1, wc = wid & 1;
  const int l15 = lane & 15, q4 = lane >> 4;
  const int m0 = mt * 128, n0 = nt * 128;
  unsigned char* ws = p.ws;
  f32x4 acc[4][4];
#pragma unroll
  for (int i = 0; i < 4; ++i)
#pragma unroll
    for (int j = 0; j < 4; ++j) acc[i][j] = (f32x4){0.f, 0.f, 0.f, 0.f};
  const int srow = tid >> 3, skc = tid & 7;
  const bf16_t* Ag = A + (size_t)(m0 + srow) * 2048 + skc * 8;
  const bf16_t* Bg = Bt + (size_t)(n0 + srow) * 2048 + skc * 8;
  const int soff = srow * 128 + ((skc ^ ((srow >> 1) & 7)) << 4);
  u32x4 ra[2][4], rb[2][4];
  constexpr int NK = 32;
#define KIDX(kt) ((MODE == 2) ? (((kt) + 16) & 31) : (kt))
#define GLOAD(set, kt)                                                        \
  {                                                                           \
    const int kk_ = KIDX(kt);                                                 \
    _Pragma("unroll") for (int i = 0; i < 4; ++i) {                           \
      ra[set][i] = *(const u32x4*)(Ag + (size_t)i * 32 * 2048 + kk_ * 64);    \
      rb[set][i] = *(const u32x4*)(Bg + (size_t)i * 32 * 2048 + kk_ * 64);    \
    }                                                                         \
  }
#define LSTORE(set, buf)                                                      \
  {                                                                           \
    unsigned char* d_ = smem + (buf) * 32768 + soff;                          \
    _Pragma("unroll") for (int i = 0; i < 4; ++i) {                           \
      *(u32x4*)(d_ + i * 4096) = ra[set][i];                                  \
      *(u32x4*)(d_ + 16384 + i * 4096) = rb[set][i];                          \
    }                                                                         \
  }
#define COMPUTE(buf)                                                          \
  {                                                                           \
    const unsigned char* As = smem + (buf) * 32768;                           \
    const unsigned char* Bs = As + 16384;                                     \
    _Pragma("unroll") for (int ks = 0; ks < 2; ++ks) {                        \
      bf16x8 af[4], bfr[4];                                                   \
      const int chunk = ks * 4 + q4;                                          \
      _Pragma("unroll") for (int mi = 0; mi < 4; ++mi)                        \
          af[mi] = *(const bf16x8*)(As + sw128(wr * 64 + mi * 16 + l15, chunk)); \
      _Pragma("unroll") for (int ni = 0; ni < 4; ++ni)                        \
          bfr[ni] = *(const bf16x8*)(Bs + sw128(wc * 64 + ni * 16 + l15, chunk)); \
      _Pragma("unroll") for (int mi = 0; mi < 4; ++mi)                        \
        _Pragma("unroll") for (int ni = 0; ni < 4; ++ni)                      \
            acc[mi][ni] = mfma16(bfr[ni], af[mi], acc[mi][ni]);               \
    }                                                                         \
  }
#define MIDSCALE(kt)                                                          \
  if (MODE == 2 && (kt) == 15) {                                              \
    const float* ssq = (const float*)(ws + OFF_SSQ);                          \
    _Pragma("unroll") for (int mi = 0; mi < 4; ++mi) {                        \
      const float s_ = rs_from_ssq(ssq, m0 + wr * 64 + mi * 16 + l15);        \
      _Pragma("unroll") for (int ni = 0; ni < 4; ++ni) acc[mi][ni] *= s_;     \
    }                                                                         \
  }
  GLOAD(0, 0);
  GLOAD(1, 1);
  LSTORE(0, 0);
  __syncthreads();
#pragma unroll
  for (int kt = 0; kt < NK; kt += 2) {
    if (kt + 2 < NK) GLOAD(0, kt + 2);
    COMPUTE(0);
    MIDSCALE(kt);
    LSTORE(1, 1);
    __syncthreads();
    if (kt + 3 < NK) GLOAD(1, kt + 3);
    COMPUTE(1);
    MIDSCALE(kt + 1);
    if (kt + 2 < NK) LSTORE(0, 0);
    __syncthreads();
  }
#undef GLOAD
#undef LSTORE
#undef COMPUTE
#undef MIDSCALE
#undef KIDX
  if (MODE == 1) {
    const float* rs1 = (const float*)(ws + OFF_RS1);
    bf16_t* proj = (bf16_t*)(ws + OFF_PROJ);
#pragma unroll
    for (int mi = 0; mi < 4; ++mi) {
      const int row = m0 + wr * 64 + mi * 16 + l15;
      const float s = rs1[row];
#pragma unroll
      for (int ni = 0; ni < 4; ++ni) {
        const int col = n0 + wc * 64 + ni * 16 + q4 * 4;
        f32x4 v = acc[mi][ni] * s;
        u32x2 o = {pk2(v[0], v[1]), pk2(v[2], v[3])};
        *(u32x2*)(proj + (size_t)row * LDP + col) = o;
      }
    }
  } else if (MODE == 2) {
    bf16_t* x1b = (bf16_t*)(ws + OFF_X1B);
    float* ssq2 = (float*)(ws + OFF_SSQ2);
#pragma unroll
    for (int mi = 0; mi < 4; ++mi) {
      const int row = m0 + wr * 64 + mi * 16 + l15;
      float ss = 0.f;
#pragma unroll
      for (int ni = 0; ni < 4; ++ni) {
        const int col = n0 + wc * 64 + ni * 16 + q4 * 4;
        f32x4 xr = *(const f32x4*)(p.x + (size_t)row * DM + col);
        f32x4 v = acc[mi][ni] + xr;
        *(f32x4*)(p.out + (size_t)row * DM + col) = v;
        u32x2 o = {pk2(v[0], v[1]), pk2(v[2], v[3])};
        *(u32x2*)(x1b + (size_t)row * DM + col) = o;
        ss += v[0] * v[0] + v[1] * v[1] + v[2] * v[2] + v[3] * v[3];
      }
      ss += __shfl_xor(ss, 16);
      ss += __shfl_xor(ss, 32);
      if (q4 == 0) ssq2[(size_t)row * 32 + nt * 2 + wc] = ss;
    }
  } else {
    const float* ssq2 = (const float*)(ws + OFF_SSQ2);
    bf16_t* qo = (bf16_t*)(ws + OFF_Q);
#pragma unroll
    for (int mi = 0; mi < 4; ++mi) {
      const int row = m0 + wr * 64 + mi * 16 + l15;
      const float s = rs_from_ssq2(ssq2, row);
#pragma unroll
      for (int ni = 0; ni < 4; ++ni) {
        const int col = n0 + wc * 64 + ni * 16 + q4 * 4;
        f32x4 v = acc[mi][ni] * s;
        u32x2 o = {pk2(v[0], v[1]), pk2(v[2], v[3])};
        *(u32x2*)(qo + (size_t)row * DM + col) = o;
      }
    }
  }
}

__device__ __forceinline__ void conv8(const bf16_t* __restrict__ proj, int t, int tt_in_seq, int col,
                                      const float* __restrict__ cw, int ld_w, const float* __restrict__ cb, int ch,
                                      float* o) {
  f32x4 b0 = *(const f32x4*)(cb + ch), b1 = *(const f32x4*)(cb + ch + 4);
  o[0] = b0[0]; o[1] = b0[1]; o[2] = b0[2]; o[3] = b0[3];
  o[4] = b1[0]; o[5] = b1[1]; o[6] = b1[2]; o[7] = b1[3];
#pragma unroll
  for (int k = 0; k < 4; ++k) {
    if (tt_in_seq - 3 + k >= 0) {
      u32x4 v = *(const u32x4*)(proj + (size_t)(t - 3 + k) * LDP + col);
      f32x4 w0 = *(const f32x4*)(cw + k * ld_w + ch), w1 = *(const f32x4*)(cw + k * ld_w + ch + 4);
      o[0] += w0[0] * bflo(v[0]); o[1] += w0[1] * bfhi(v[0]);
      o[2] += w0[2] * bflo(v[1]); o[3] += w0[3] * bfhi(v[1]);
      o[4] += w1[0] * bflo(v[2]); o[5] += w1[1] * bfhi(v[2]);
      o[6] += w1[2] * bflo(v[3]); o[7] += w1[3] * bfhi(v[3]);
    }
  }
}
__device__ __forceinline__ void conv4(const bf16_t* __restrict__ proj, int t, int tt_in_seq, int col,
                                      const float* __restrict__ cw, int ld_w, const float* __restrict__ cb, int ch,
                                      float* o) {
  f32x4 b0 = *(const f32x4*)(cb + ch);
  o[0] = b0[0]; o[1] = b0[1]; o[2] = b0[2]; o[3] = b0[3];
#pragma unroll
  for (int k = 0; k < 4; ++k) {
    if (tt_in_seq - 3 + k >= 0) {
      u32x2 v = *(const u32x2*)(proj + (size_t)(t - 3 + k) * LDP + col);
      f32x4 w0 = *(const f32x4*)(cw + k * ld_w + ch);
      o[0] += w0[0] * bflo(v[0]); o[1] += w0[1] * bfhi(v[0]);
      o[2] += w0[2] * bflo(v[1]); o[3] += w0[3] * bfhi(v[1]);
    }
  }
}
__device__ __forceinline__ bf16x8 cfrag(const Params& p, const bf16_t* proj, int t, int tseq, int g, int n8) {
  float o[8];
  const int ch = 1280 + g * 128 + n8;
  conv8(proj, t, tseq, 3072 + ch, p.ssd_conv_w, 1536, p.ssd_conv_b, ch, o);
#pragma unroll
  for (int i = 0; i < 8; ++i) o[i] = silu_(o[i]);
  u32x4 r = {pk2(o[0], o[1]), pk2(o[2], o[3]), pk2(o[4], o[5]), pk2(o[6], o[7])};
  return as_frag(r);
}

__device__ void lru_local_unit(const Params& p, unsigned char* smem, int unit) {
  const int tid = threadIdx.x, lane = tid & 63, wid = tid >> 6, l15 = lane & 15, q4 = lane >> 4;
  const int hh = unit & 15, c = (unit >> 4) & 15, b = unit >> 8;
  const int t0 = b * 2048 + c * 128, ch0 = hh * 64;
  unsigned char* ws = p.ws;
  const bf16_t* proj = (const bf16_t*)(ws + OFF_PROJ);
  float* R1 = (float*)smem;
  float* R2 = (float*)(smem + 33536);
  float* R3 = (float*)(smem + 33536 + 32768);
#pragma unroll 2
  for (int e = tid; e < 131 * 64; e += NTHR) {
    const int r = e >> 6, j = e & 63, tt = r - 3;
    float v = 0.f;
    if (c * 128 + tt >= 0) v = bf2f(proj[(size_t)(t0 + tt) * LDP + ch0 + j]);
    R1[e] = v;
  }
  __syncthreads();
  {
    const int j = tid & 63;
    const float cb = p.lru_conv_b[ch0 + j];
    const float w0 = p.lru_conv_w[0 * 1024 + ch0 + j], w1 = p.lru_conv_w[1 * 1024 + ch0 + j],
                w2 = p.lru_conv_w[2 * 1024 + ch0 + j], w3 = p.lru_conv_w[3 * 1024 + ch0 + j];
#pragma unroll 4
    for (int tt = tid >> 6; tt < 128; tt += 4) {
      R2[tt * 64 + j] = cb + w0 * R1[tt * 64 + j] + w1 * R1[(tt + 1) * 64 + j] + w2 * R1[(tt + 2) * 64 + j] +
                        w3 * R1[(tt + 3) * 64 + j];
    }
  }
  __syncthreads();
  {
    const bf16_t* waT = (const bf16_t*)(ws + OFF_WAT) + (size_t)hh * 4096;
    const bf16_t* wxT = (const bf16_t*)(ws + OFF_WXT) + (size_t)hh * 4096;
    f32x4 aa[2][4], ax[2][4];
#pragma unroll
    for (int i = 0; i < 2; ++i)
#pragma unroll
      for (int j = 0; j < 4; ++j) { aa[i][j] = (f32x4){0, 0, 0, 0}; ax[i][j] = (f32x4){0, 0, 0, 0}; }
#pragma unroll
    for (int ks = 0; ks < 2; ++ks) {
      bf16x8 af[2];
#pragma unroll
      for (int mi = 0; mi < 2; ++mi) {
        const float* src = R2 + (wid * 32 + mi * 16 + l15) * 64 + ks * 32 + q4 * 8;
        f32x4 v0 = *(const f32x4*)src, v1 = *(const f32x4*)(src + 4);
        u32x4 r = {pk2(v0[0], v0[1]), pk2(v0[2], v0[3]), pk2(v1[0], v1[1]), pk2(v1[2], v1[3])};
        af[mi] = as_frag(r);
      }
#pragma unroll
      for (int ni = 0; ni < 4; ++ni) {
        const size_t wo = (size_t)(ni * 16 + l15) * 64 + ks * 32 + q4 * 8;
        bf16x8 ba = as_frag(*(const u32x4*)(waT + wo));
        bf16x8 bx = as_frag(*(const u32x4*)(wxT + wo));
#pragma unroll
        for (int mi = 0; mi < 2; ++mi) {
          aa[mi][ni] = mfma16(af[mi], ba, aa[mi][ni]);
          ax[mi][ni] = mfma16(af[mi], bx, ax[mi][ni]);
        }
      }
    }
#pragma unroll
    for (int ni = 0; ni < 4; ++ni) {
      const int j = ni * 16 + l15;
      const float ba = p.lru_ba[ch0 + j], bx = p.lru_bx[ch0 + j];
      const float lam = p.lru_lambda[ch0 + j];
      const float spl = -8.f * log1pf(__expf(-lam));
#pragma unroll
      for (int mi = 0; mi < 2; ++mi)
#pragma unroll
        for (int r = 0; r < 4; ++r) {
          const int tt = wid * 32 + mi * 16 + q4 * 4 + r;
          const float rg = sigmoid_(aa[mi][ni][r] + ba);
          const float ig = sigmoid_(ax[mi][ni][r] + bx);
          const float log_a = spl * rg;
          const float av = __expf(log_a);
          const float xl = R2[tt * 64 + j];
          const float bv = sqrtf(fmaxf(-expm1f(2.f * log_a), 0.f)) * (ig * xl);
          R1[tt * 64 + j] = av;
          R2[tt * 64 + j] = bv;
        }
    }
  }
  __syncthreads();
  {
    const int j = tid & 63, seg = tid >> 6;
    float h = 0.f, Ac = 1.f;
#pragma unroll 4
    for (int s = 0; s < 32; ++s) {
      const int tt = seg * 32 + s;
      const float a = R1[tt * 64 + j], bb = R2[tt * 64 + j];
      h = a * h + bb;
      Ac *= a;
      R2[tt * 64 + j] = h;
      R1[tt * 64 + j] = Ac;
    }
    R3[seg * 64 + j] = h;
    R3[256 + seg * 64 + j] = Ac;
    __syncthreads();
    float cin = 0.f, Ain = 1.f;
    for (int s2 = 0; s2 < seg; ++s2) {
      cin = R3[256 + s2 * 64 + j] * cin + R3[s2 * 64 + j];
      Ain *= R3[256 + s2 * 64 + j];
    }
    float* hloc = (float*)(ws + OFF_HLOC);
    float* cumA = (float*)(ws + OFF_CUMA);
#pragma unroll 4
    for (int s = 0; s < 32; ++s) {
      const int tt = seg * 32 + s;
      const float hl = R2[tt * 64 + j] + R1[tt * 64 + j] * cin;
      const float Al = R1[tt * 64 + j] * Ain;
      hloc[(size_t)(t0 + tt) * 1024 + ch0 + j] = hl;
      cumA[(size_t)(t0 + tt) * 1024 + ch0 + j] = Al;
    }
  }
  __syncthreads();
}

__device__ void ssd_local_unit(const Params& p, unsigned char* smem, int unit) {
  const int tid = threadIdx.x, lane = tid & 63, wid = tid >> 6, l15 = lane & 15, q4 = lane >> 4;
  const int hh = unit & 15, c = (unit >> 4) & 15, b = unit >> 8, g = hh >> 3;
  const int t0 = b * 2048 + c * 128, ts0 = c * 128;
  unsigned char* ws = p.ws;
  const bf16_t* proj = (const bf16_t*)(ws + OFF_PROJ);
  unsigned char* Bm = smem;
  unsigned char* XT = smem + 32768;
  unsigned char* Pw = smem + 49152 + wid * 4096;
  float* dts = (float*)(smem + 65536);
  float* acs = dts + 128;
  float* adt = acs + 128;
  if (tid < 128) {
    const float raw = bf2f(proj[(size_t)(t0 + tid) * LDP + 4608 + hh]);
    const float dtv = softplus_(raw + p.ssd_dt_bias[hh]);
    dts[tid] = dtv;
    adt[tid] = -__expf(p.ssd_a_log[hh]) * dtv;
  }
  __syncthreads();
  if (tid < 128) {
    float s = 0.f;
    for (int k = 0; k <= tid; ++k) s += adt[k];
    acs[tid] = s;
    ((float*)(ws + OFF_ACS))[(size_t)(t0 + tid) * 16 + hh] = s;
  }
  {
    const int chunk = tid & 15;
    const int ch = 1024 + g * 128 + chunk * 8;
#pragma unroll 1
    for (int i = 0; i < 8; ++i) {
      const int tt = (tid >> 4) + 16 * i;
      float o[8];
      conv8(proj, t0 + tt, ts0 + tt, 3072 + ch, p.ssd_conv_w, 1536, p.ssd_conv_b, ch, o);
#pragma unroll
      for (int e = 0; e < 8; ++e) o[e] = silu_(o[e]);
      u32x4 r = {pk2(o[0], o[1]), pk2(o[2], o[3]), pk2(o[4], o[5]), pk2(o[6], o[7])};
      *(u32x4*)(Bm + sw256(tt, chunk)) = r;
    }
  }
  __syncthreads();
  {
    const int pp = tid & 63;
    const int ch = hh * 64 + pp;
    const float cb = p.ssd_conv_b[ch];
    const float w0 = p.ssd_conv_w[ch], w1 = p.ssd_conv_w[1536 + ch], w2 = p.ssd_conv_w[2 * 1536 + ch],
                w3 = p.ssd_conv_w[3 * 1536 + ch];
#pragma unroll 1
    for (int i = 0; i < 4; ++i) {
      const int chunk = (tid >> 6) * 4 + i;
      const int tt0 = chunk * 8;
      float xv[11];
#pragma unroll
      for (int k = 0; k < 11; ++k) {
        const int tt = tt0 - 3 + k;
        xv[k] = (ts0 + tt >= 0) ? bf2f(proj[(size_t)(t0 + tt) * LDP + 3072 + ch]) : 0.f;
      }
      float o[8];
#pragma unroll
      for (int e = 0; e < 8; ++e) {
        const float cv = cb + w0 * xv[e] + w1 * xv[e + 1] + w2 * xv[e + 2] + w3 * xv[e + 3];
        o[e] = silu_(cv) * dts[tt0 + e];
      }
      u32x4 r = {pk2(o[0], o[1]), pk2(o[2], o[3]), pk2(o[4], o[5]), pk2(o[6], o[7])};
      *(u32x4*)(XT + sw256(pp, chunk)) = r;
    }
  }
  __syncthreads();
  bf16_t* ypart = (bf16_t*)(ws + OFF_YPART);
  const float Dh = p.ssd_d[hh];
#pragma unroll 1
  for (int mt = 0; mt < 2; ++mt) {
    const int M = wid * 2 + mt;
    const int lrow = M * 16 + l15;
    bf16x8 cf[4];
#pragma unroll
    for (int ks = 0; ks < 4; ++ks) cf[ks] = cfrag(p, proj, t0 + lrow, ts0 + lrow, g, ks * 32 + q4 * 8);
    const float acl = acs[lrow];
    const int ntmax = M | 1;
#pragma unroll 1
    for (int nt = 0; nt <= ntmax; ++nt) {
      f32x4 a4 = (f32x4){0, 0, 0, 0};
      if (nt <= M) {
#pragma unroll
        for (int ks = 0; ks < 4; ++ks) {
          bf16x8 bfr = *(const bf16x8*)(Bm + sw256(nt * 16 + l15, ks * 4 + q4));
          a4 = mfma16(bfr, cf[ks], a4);
        }
      }
      float pv[4];
#pragma unroll
      for (int r = 0; r < 4; ++r) {
        const int s = nt * 16 + q4 * 4 + r;
        pv[r] = (s <= lrow) ? a4[r] * __expf(acl - acs[s]) : 0.f;
      }
      u32x2 o = {pk2(pv[0], pv[1]), pk2(pv[2], pv[3])};
      const int chunk = nt * 2 + (q4 >> 1);
      *(u32x2*)(Pw + sw256(l15, chunk) + (q4 & 1) * 8) = o;
    }
    f32x4 ya[4];
#pragma unroll
    for (int pt = 0; pt < 4; ++pt) ya[pt] = (f32x4){0, 0, 0, 0};
    const int ksmax = M >> 1;
#pragma unroll 1
    for (int ks = 0; ks <= ksmax; ++ks) {
      bf16x8 pf = *(const bf16x8*)(Pw + sw256(l15, ks * 4 + q4));
#pragma unroll
      for (int pt = 0; pt < 4; ++pt) {
        bf16x8 xf = *(const bf16x8*)(XT + sw256(pt * 16 + l15, ks * 4 + q4));
        ya[pt] = mfma16(xf, pf, ya[pt]);
      }
    }
#pragma unroll
    for (int pt = 0; pt < 4; ++pt) {
      const int pc = pt * 16 + q4 * 4;
      const int ch = hh * 64 + pc;
      float xo[4];
      conv4(proj, t0 + lrow, ts0 + lrow, 3072 + ch, p.ssd_conv_w, 1536, p.ssd_conv_b, ch, xo);
      float y0 = ya[pt][0] + Dh * silu_(xo[0]), y1 = ya[pt][1] + Dh * silu_(xo[1]);
      float y2 = ya[pt][2] + Dh * silu_(xo[2]), y3 = ya[pt][3] + Dh * silu_(xo[3]);
      u32x2 o = {pk2(y0, y1), pk2(y2, y3)};
      *(u32x2*)(ypart + (size_t)(t0 + lrow) * 1024 + ch) = o;
    }
  }
  {
    f32x4 sa[2][4];
#pragma unroll
    for (int i = 0; i < 2; ++i)
#pragma unroll
      for (int j = 0; j < 4; ++j) sa[i][j] = (f32x4){0, 0, 0, 0};
    const float aend = acs[127];
#pragma unroll 1
    for (int ks = 0; ks < 4; ++ks) {
      float dec[8];
#pragma unroll
      for (int e = 0; e < 8; ++e) dec[e] = __expf(aend - acs[ks * 32 + q4 * 8 + e]);
      bf16x8 bd[2];
#pragma unroll
      for (int ni = 0; ni < 2; ++ni) {
        const int n = wid * 32 + ni * 16 + l15;
        float v[8];
#pragma unroll
        for (int e = 0; e < 8; ++e) {
          const int l = ks * 32 + q4 * 8 + e;
          const bf16_t raw = *(const bf16_t*)(Bm + sw256(l, n >> 3) + (n & 7) * 2);
          v[e] = bf2f(raw) * dec[e];
        }
        u32x4 r = {pk2(v[0], v[1]), pk2(v[2], v[3]), pk2(v[4], v[5]), pk2(v[6], v[7])};
        bd[ni] = as_frag(r);
      }
#pragma unroll
      for (int pt = 0; pt < 4; ++pt) {
        bf16x8 xf = *(const bf16x8*)(XT + sw256(pt * 16 + l15, ks * 4 + q4));
#pragma unroll
        for (int ni = 0; ni < 2; ++ni) sa[ni][pt] = mfma16(bd[ni], xf, sa[ni][pt]);
      }
    }
    float* St = (float*)(ws + OFF_ST) + (size_t)((b * 16 + c) * 16 + hh) * 8192;
#pragma unroll
    for (int ni = 0; ni < 2; ++ni)
#pragma unroll
      for (int pt = 0; pt < 4; ++pt) {
        const int pr = pt * 16 + l15, n = wid * 32 + ni * 16 + q4 * 4;
        *(f32x4*)(St + pr * 128 + n) = sa[ni][pt];
      }
  }
  __syncthreads();
}

__device__ void phase_carry(const Params& p) {
  unsigned char* ws = p.ws;
  const int gt = blockIdx.x * NTHR + threadIdx.x, ng = gridDim.x * NTHR;
  const float* hloc = (const float*)(ws + OFF_HLOC);
  const float* cumA = (const float*)(ws + OFF_CUMA);
  float* lcarry = (float*)(ws + OFF_LCARRY);
  for (int i = gt; i < 8192; i += ng) {
    const int b = i >> 10, ch = i & 1023;
    float carry = 0.f;
    for (int c = 0; c < 16; ++c) {
      lcarry[(size_t)(b * 16 + c) * 1024 + ch] = carry;
      const size_t tl = (size_t)(b * 2048 + c * 128 + 127) * 1024 + ch;
      carry = cumA[tl] * carry + hloc[tl];
    }
  }
  const float* acsG = (const float*)(ws + OFF_ACS);
  float* St = (float*)(ws + OFF_ST);
  for (int i = gt; i < 128 * 2048; i += ng) {
    const int bh = i >> 11, e4 = i & 2047, b = bh >> 4, hh = bh & 15;
    f32x4 s = (f32x4){0, 0, 0, 0};
    for (int c = 0; c < 16; ++c) {
      const float Ad = __expf(acsG[(size_t)(b * 2048 + c * 128 + 127) * 16 + hh]);
      f32x4* ptr = (f32x4*)(St + (size_t)((b * 16 + c) * 16 + hh) * 8192 + e4 * 4);
      f32x4 tmp = *ptr;
      *ptr = s;
      s = s * Ad + tmp;
    }
  }
}

__device__ void ssd_final_unit(const Params& p, int unit) {
  const int tid = threadIdx.x, lane = tid & 63, wid = tid >> 6, l15 = lane & 15, q4 = lane >> 4;
  const int hh = unit & 15, c = (unit >> 4) & 15, b = unit >> 8, g = hh >> 3;
  const int t0 = b * 2048 + c * 128, ts0 = c * 128;
  unsigned char* ws = p.ws;
  const bf16_t* proj = (const bf16_t*)(ws + OFF_PROJ);
  const float* Sin = (const float*)(ws + OFF_ST) + (size_t)((b * 16 + c) * 16 + hh) * 8192;
  const bf16_t* ypart = (const bf16_t*)(ws + OFF_YPART);
  const float* acsG = (const float*)(ws + OFF_ACS);
  bf16_t* A2 = (bf16_t*)(ws + OFF_XB);
  float* ssq = (float*)(ws + OFF_SSQ);
#pragma unroll 1
  for (int mt = 0; mt < 2; ++mt) {
    const int lrow = (wid * 2 + mt) * 16 + l15;
    f32x4 ya[4];
#pragma unroll
    for (int pt = 0; pt < 4; ++pt) ya[pt] = (f32x4){0, 0, 0, 0};
    if (c > 0) {
#pragma unroll 1
      for (int ks = 0; ks < 4; ++ks) {
        bf16x8 cf = cfrag(p, proj, t0 + lrow, ts0 + lrow, g, ks * 32 + q4 * 8);
#pragma unroll
        for (int pt = 0; pt < 4; ++pt) {
          const float* sp = Sin + (pt * 16 + l15) * 128 + ks * 32 + q4 * 8;
          f32x4 v0 = *(const f32x4*)sp, v1 = *(const f32x4*)(sp + 4);
          u32x4 r = {pk2(v0[0], v0[1]), pk2(v0[2], v0[3]), pk2(v1[0], v1[1]), pk2(v1[2], v1[3])};
          ya[pt] = mfma16(as_frag(r), cf, ya[pt]);
        }
      }
    }
    const size_t t = (size_t)(t0 + lrow);
    const float ea = __expf(acsG[t * 16 + hh]);
    float ss = 0.f;
#pragma unroll
    for (int pt = 0; pt < 4; ++pt) {
      const int ch = hh * 64 + pt * 16 + q4 * 4;
      u32x2 yp = *(const u32x2*)(ypart + t * 1024 + ch);
      u32x2 zz = *(const u32x2*)(proj + t * LDP + 2048 + ch);
      float y[4] = {bflo(yp[0]) + ea * ya[pt][0], bfhi(yp[0]) + ea * ya[pt][1], bflo(yp[1]) + ea * ya[pt][2],
                    bfhi(yp[1]) + ea * ya[pt][3]};
      float z[4] = {bflo(zz[0]), bfhi(zz[0]), bflo(zz[1]), bfhi(zz[1])};
#pragma unroll
      for (int r = 0; r < 4; ++r) { y[r] = y[r] * silu_(z[r]); ss += y[r] * y[r]; }
      u32x2 o = {pk2(y[0], y[1]), pk2(y[2], y[3])};
      *(u32x2*)(A2 + t * DM + 1024 + ch) = o;
    }
    ss += __shfl_xor(ss, 16);
    ss += __shfl_xor(ss, 32);
    if (q4 == 0) ssq[t * 16 + hh] = ss;
  }
}

__device__ void phase_mix_final(const Params& p) {
  unsigned char* ws = p.ws;
  const bf16_t* proj = (const bf16_t*)(ws + OFF_PROJ);
  const f32x4* hloc = (const f32x4*)(ws + OFF_HLOC);
  const f32x4* cumA = (const f32x4*)(ws + OFF_CUMA);
  const float* lcarry = (const float*)(ws + OFF_LCARRY);
  bf16_t* A2 = (bf16_t*)(ws + OFF_XB);
  for (int u = blockIdx.x; u < 2048; u += gridDim.x) ssd_final_unit(p, u);
  for (int i = blockIdx.x * NTHR + threadIdx.x; i < T_TOK * 256; i += gridDim.x * NTHR) {
    const int t = i >> 8, ch = (i & 255) * 4;
    f32x4 h = hloc[i], ca = cumA[i];
    f32x4 cr = *(const f32x4*)(lcarry + (size_t)(t >> 7) * 1024 + ch);
    u32x2 gg = *(const u32x2*)(proj + (size_t)t * LDP + 1024 + ch);
    float y0 = (h[0] + ca[0] * cr[0]) * gelu_(bflo(gg[0]));
    float y1 = (h[1] + ca[1] * cr[1]) * gelu_(bfhi(gg[0]));
    float y2 = (h[2] + ca[2] * cr[2]) * gelu_(bflo(gg[1]));
    float y3 = (h[3] + ca[3] * cr[3]) * gelu_(bfhi(gg[1]));
    u32x2 o = {pk2(y0, y1), pk2(y2, y3)};
    *(u32x2*)(A2 + (size_t)t * DM + ch) = o;
  }
}

__device__ void convert_uv(const Params& p) {
  unsigned char* ws = p.ws;
  const int lane = threadIdx.x & 63, wid = threadIdx.x >> 6;
  unsigned char* tb = ws + OFF_XB;
  float* scales = (float*)(ws + OFF_SCALES);
  for (int row = blockIdx.x * 4 + wid; row < 32768; row += gridDim.x * 4) {
    const bool isv = row >= 16384;
    const int e = row & 16383;
    const float* src = (isv ? p.peer_v : p.peer_u) + (size_t)e * DM + lane * 32;
    float vals[32];
    float ss = 0.f;
#pragma unroll
    for (int q = 0; q < 8; ++q) {
      f32x4 t = *(const f32x4*)(src + q * 4);
      if (!isv) t *= *(const f32x4*)(p.norm_ffn_w + lane * 32 + q * 4);
#pragma unroll
      for (int k = 0; k < 4; ++k) {
        vals[q * 4 + k] = t[k];
        ss += t[k] * t[k];
      }
    }
    ss = wave_sum(ss);
    const float rms = sqrtf(ss * (1.f / 2048.f));
    const float sc = rms * (2.6f / 7.f);
    const float inv = sc > 0.f ? 1.f / sc : 0.f;
    u32x4 o;
#pragma unroll
    for (int m = 0; m < 4; ++m) {
      unsigned w = 0;
#pragma unroll
      for (int j = 0; j < 4; ++j) {
        const float lo = fminf(fmaxf(rintf(vals[m * 8 + j] * inv), -7.f), 7.f);
        const float hi = fminf(fmaxf(rintf(vals[m * 8 + 4 + j] * inv), -7.f), 7.f);
        const unsigned bl = (unsigned)((int)lo + 8), bh = (unsigned)((int)hi + 8);
        w |= (bl | (bh << 4)) << (8 * j);
      }
      o[m] = w;
    }
    *(u32x4*)(tb + (size_t)row * 1024 + lane * 16) = o;
    if (lane == 0) scales[row] = sc;
  }
}

__device__ const unsigned char cand_tab[64] = {
    0x00, 0x01, 0x02, 0x03, 0x04, 0x05, 0x06, 0x07, 0x08, 0x09, 0x0a, 0x0b, 0x0c, 0x0d, 0x0e, 0x0f,
    0x10, 0x11, 0x12, 0x13, 0x14, 0x15, 0x16, 0x17,
    0x20, 0x21, 0x22, 0x23, 0x24,
    0x30, 0x31, 0x32, 0x33,
    0x40, 0x41, 0x42,
    0x50, 0x51, 0x60, 0x61, 0x70, 0x71,
    0x80, 0x90, 0xa0, 0xb0, 0xc0, 0xd0, 0xe0, 0xf0,
    0xff, 0xff, 0xff, 0xff, 0xff, 0xff, 0xff, 0xff, 0xff, 0xff, 0xff, 0xff, 0xff, 0xff};

__device__ __forceinline__ unsigned ord_key(float f) {
  unsigned u = __float_as_uint(f);
  return u ^ ((u >> 31) ? 0xffffffffu : 0x80000000u);
}
__device__ __forceinline__ float ord_dec(unsigned k) {
  unsigned u = (k >> 31) ? (k ^ 0x80000000u) : ~k;
  return __uint_as_float(u);
}

__device__ void topk_unit(const Params& p, unsigned char* smem, int unit) {
  const int tid = threadIdx.x, lane = tid & 63, wid = tid >> 6, l15 = lane & 15, q4 = lane >> 4;
  const int h = unit & 7, tile = unit >> 3;
  const int tok0 = tile * 64 + wid * 16;
  unsigned char* ws = p.ws;
  const bf16_t* qg = (const bf16_t*)(ws + OFF_Q);
  const bf16_t* kb = (const bf16_t*)(ws + OFF_KEYSB);
  unsigned* S = (unsigned*)(smem + wid * 16640);
  float* tops = (float*)(smem + 4 * 16640 + wid * 256);
  int* topi = (int*)(tops + 32);
#pragma unroll
  for (int k = 0; k < 2; ++k) {
    f32x4 sc[8];
#pragma unroll
    for (int i = 0; i < 8; ++i) sc[i] = (f32x4){0, 0, 0, 0};
#pragma unroll
    for (int ks = 0; ks < 4; ++ks) {
      bf16x8 qf = as_frag(*(const u32x4*)(qg + (size_t)(tok0 + l15) * DM + h * 256 + k * 128 + ks * 32 + q4 * 8));
#pragma unroll
      for (int nt = 0; nt < 8; ++nt) {
        bf16x8 kf = as_frag(*(const u32x4*)(kb + (size_t)((h * 2 + k) * 128 + nt * 16 + l15) * 128 + ks * 32 + q4 * 8));
        sc[nt] = mfma16(kf, qf, sc[nt]);
      }
    }
#pragma unroll
    for (int nt = 0; nt < 8; ++nt) {
      const int n = nt * 16 + q4 * 4;
      u32x4 kk;
#pragma unroll
      for (int r = 0; r < 4; ++r) kk[r] = (ord_key(sc[nt][r]) & ~127u) | (unsigned)(127 - (n + r));
      *(u32x4*)(S + l15 * 260 + k * 128 + n) = kk;
    }
  }
  const unsigned ct = cand_tab[lane];
  const int ca = ct >> 4, cbb = ct & 15;
  int* idxo = (int*)(ws + OFF_IDX);
  float* go = (float*)(ws + OFF_G);
  for (int tk = 0; tk < 16; ++tk) {
    const unsigned* row = S + tk * 260;
    const unsigned k0 = row[lane], k1 = row[lane + 64], k2 = row[128 + lane], k3 = row[192 + lane];
    int r0 = 0, r1 = 0, r2 = 0, r3 = 0;
#pragma unroll 8
    for (int j = 0; j < 32; ++j) {
      u32x4 a = *(const u32x4*)(row + j * 4);
      u32x4 bq = *(const u32x4*)(row + 128 + j * 4);
#pragma unroll
      for (int e = 0; e < 4; ++e) {
        r0 += (a[e] > k0) ? 1 : 0;
        r1 += (a[e] > k1) ? 1 : 0;
        r2 += (bq[e] > k2) ? 1 : 0;
        r3 += (bq[e] > k3) ? 1 : 0;
      }
    }
    if (r0 < 16) { tops[r0] = ord_dec(k0 & ~127u); topi[r0] = lane; }
    if (r1 < 16) { tops[r1] = ord_dec(k1 & ~127u); topi[r1] = lane + 64; }
    if (r2 < 16) { tops[16 + r2] = ord_dec(k2 & ~127u); topi[16 + r2] = lane; }
    if (r3 < 16) { tops[16 + r3] = ord_dec(k3 & ~127u); topi[16 + r3] = lane + 64; }
    float cs = 0.f;
    unsigned ck = 0u;
    if (lane < 50) {
      cs = tops[ca] + tops[16 + cbb];
      ck = (ord_key(cs) & ~255u) | (unsigned)(255 - (ca * 16 + cbb));
    }
    int rk = 0;
#pragma unroll
    for (int j = 0; j < 50; ++j) {
      const unsigned oj = (unsigned)__builtin_amdgcn_readlane((int)ck, j);
      rk += (oj > ck) ? 1 : 0;
    }
    const float mx = tops[0] + tops[16];
    const bool sel = (lane < 50) && (rk < 16);
    const float ev = sel ? __expf(cs - mx) : 0.f;
    const float sum = wave_sum(ev);
    if (sel) {
      const size_t o = (size_t)(tok0 + tk) * 128 + h * 16 + rk;
      idxo[o] = topi[ca] * 128 + topi[16 + cbb];
      go[o] = ev / sum;
    }
  }
  __syncthreads();
}

__device__ __forceinline__ float ub0(unsigned w) { return (float)(w & 0xffu); }
__device__ __forceinline__ float ub1(unsigned w) { return (float)((w >> 8) & 0xffu); }
__device__ __forceinline__ float ub2(unsigned w) { return (float)((w >> 16) & 0xffu); }
__device__ __forceinline__ float ub3(unsigned w) { return (float)(w >> 24); }

#define GROWS 8
#ifndef USE_SDOT4
#define USE_SDOT4 1
#endif
typedef float f32x2 __attribute__((ext_vector_type(2)));
__device__ void phase_gather(const Params& p) {
  const int tid = threadIdx.x, lane = tid & 63, wid = tid >> 6;
  unsigned char* ws = p.ws;
  const unsigned char* ub = ws + OFF_XB;
  const unsigned char* vb = ws + OFF_XB + 16 * MIB;
  const float* scales = (const float*)(ws + OFF_SCALES);
  const int* idxg = (const int*)(ws + OFF_IDX);
  const float* gg = (const float*)(ws + OFF_G);
  const float* ssq2 = (const float*)(ws + OFF_SSQ2);
  const bool b5 = (lane & 32) != 0, b4 = (lane & 16) != 0, b3 = (lane & 8) != 0;
  const int srcl = ((lane & 1) << 3) | (((lane >> 1) & 1) << 4) | (((lane >> 2) & 1) << 5);
  for (int t = blockIdx.x * 4 + wid; t < T_TOK; t += gridDim.x * 4) {
    const int id0 = idxg[(size_t)t * 128 + lane], id1 = idxg[(size_t)t * 128 + 64 + lane];
    const float g0 = gg[(size_t)t * 128 + lane], g1 = gg[(size_t)t * 128 + 64 + lane];
    const float su0 = scales[id0], su1 = scales[id1], sv0 = scales[16384 + id0], sv1 = scales[16384 + id1];
    float* orow = p.out + (size_t)t * DM + lane * 32;
    int xlo[4], xhi[4];
    float sx;
    int sumq;
    {
      float xr[32];
      float amax = 0.f;
#pragma unroll
      for (int q = 0; q < 8; ++q) {
        f32x4 v = *(const f32x4*)(orow + q * 4);
#pragma unroll
        for (int k = 0; k < 4; ++k) { xr[q * 4 + k] = v[k]; amax = fmaxf(amax, fabsf(v[k])); }
      }
#pragma unroll
      for (int o = 32; o > 0; o >>= 1) amax = fmaxf(amax, __shfl_xor(amax, o));
      sx = amax * (1.f / 127.f);
      const float inv = amax > 0.f ? 127.f / amax : 0.f;
      int sq_ = 0;
#pragma unroll
      for (int m = 0; m < 4; ++m) {
        unsigned wl = 0, wh = 0;
#pragma unroll
        for (int j = 0; j < 4; ++j) {
          const int a_ = __float2int_rn(xr[m * 8 + j] * inv), b_ = __float2int_rn(xr[m * 8 + 4 + j] * inv);
          sq_ += a_ + b_;
          wl |= ((unsigned)a_ & 0xffu) << (8 * j);
          wh |= ((unsigned)b_ & 0xffu) << (8 * j);
        }
        xlo[m] = (int)wl;
        xhi[m] = (int)wh;
      }
#pragma unroll
      for (int o = 32; o > 0; o >>= 1) sq_ += __shfl_xor(sq_, o);
      sumq = sq_;
    }
    float sq = (lane < 32) ? ssq2[(size_t)t * 32 + lane] : 0.f;
    sq = wave_sum(sq);
    const float rs2 = rsqrtf(sq * (1.f / 2048.f) + EPSV);
    float w0 = 0.f, w1 = 0.f;
#pragma unroll 1
    for (int half = 0; half < 2; ++half) {
      const int idv = half ? id1 : id0;
      int wv = 0;
#pragma unroll 1
      for (int j0 = 0; j0 < 64; j0 += GROWS) {
        u32x4 r[GROWS];
#pragma unroll
        for (int k = 0; k < GROWS; ++k) {
          const int e = __builtin_amdgcn_readlane(idv, j0 + k);
          r[k] = *(const u32x4*)(ub + (size_t)e * 1024 + lane * 16);
        }
        int dv[GROWS];
#pragma unroll
        for (int k = 0; k < GROWS; ++k) {
          int d = 0;
#pragma unroll
          for (int m = 0; m < 4; ++m) {
            const unsigned w = r[k][m];
            const int lo = (int)(w & 0x0f0f0f0fu), hi = (int)((w >> 4) & 0x0f0f0f0fu);
#if USE_SDOT4
            d = __builtin_amdgcn_sdot4(lo, xlo[m], d, false);
            d = __builtin_amdgcn_sdot4(hi, xhi[m], d, false);
#else
#pragma unroll
            for (int j = 0; j < 4; ++j) {
              d += ((lo >> (8 * j)) & 0xff) * (int)(signed char)((xlo[m] >> (8 * j)) & 0xff);
              d += ((hi >> (8 * j)) & 0xff) * (int)(signed char)((xhi[m] >> (8 * j)) & 0xff);
            }
#endif
          }
          dv[k] = d;
        }
        int a4[4], a2[2];
#pragma unroll
        for (int k = 0; k < 4; ++k) {
          const int mine = b5 ? dv[k + 4] : dv[k], oth = b5 ? dv[k] : dv[k + 4];
          a4[k] = mine + __shfl_xor(oth, 32);
        }
#pragma unroll
        for (int k = 0; k < 2; ++k) {
          const int mine = b4 ? a4[k + 2] : a4[k], oth = b4 ? a4[k] : a4[k + 2];
          a2[k] = mine + __shfl_xor(oth, 16);
        }
        int c1;
        {
          const int mine = b3 ? a2[1] : a2[0], oth = b3 ? a2[0] : a2[1];
          c1 = mine + __shfl_xor(oth, 8);
        }
        c1 += __shfl_xor(c1, 4);
        c1 += __shfl_xor(c1, 2);
        c1 += __shfl_xor(c1, 1);
        const int val = __shfl(c1, srcl);
        if ((lane & ~7) == j0) wv = val;
      }
      const float su = half ? su1 : su0;
      const float a = gelu_((float)(wv - 8 * sumq) * (su * sx * rs2));
      if (half) w1 = a * g1 * sv1; else w0 = a * g0 * sv0;
    }
    f32x2 acc[16];
#pragma unroll
    for (int i = 0; i < 16; ++i) acc[i] = (f32x2){0.f, 0.f};
    const float csum = wave_sum(w0 + w1);
#pragma unroll 1
    for (int half = 0; half < 2; ++half) {
      const int idv = half ? id1 : id0;
      const float wvv = half ? w1 : w0;
#pragma unroll 1
      for (int j0 = 0; j0 < 64; j0 += GROWS) {
        u32x4 r[GROWS];
        float wk[GROWS];
#pragma unroll
        for (int k = 0; k < GROWS; ++k) {
          const int e = __builtin_amdgcn_readlane(idv, j0 + k);
          wk[k] = __builtin_bit_cast(float, __builtin_amdgcn_readlane(__builtin_bit_cast(int, wvv), j0 + k));
          r[k] = *(const u32x4*)(vb + (size_t)e * 1024 + lane * 16);
        }
#pragma unroll
        for (int k = 0; k < GROWS; ++k) {
          const f32x2 w2 = {wk[k], wk[k]};
#pragma unroll
          for (int m = 0; m < 4; ++m) {
            const unsigned w = r[k][m];
            const unsigned lo = w & 0x0f0f0f0fu, hi = (w >> 4) & 0x0f0f0f0fu;
            acc[m * 4 + 0] += w2 * (f32x2){ub0(lo), ub1(lo)};
            acc[m * 4 + 1] += w2 * (f32x2){ub2(lo), ub3(lo)};
            acc[m * 4 + 2] += w2 * (f32x2){ub0(hi), ub1(hi)};
            acc[m * 4 + 3] += w2 * (f32x2){ub2(hi), ub3(hi)};
          }
        }
      }
    }
    const float off = 8.f * csum;
    float ss = 0.f;
#pragma unroll
    for (int q = 0; q < 8; ++q) {
      f32x4 v = *(const f32x4*)(orow + q * 4);
      acc[q * 2][0] += v[0] - off;
      acc[q * 2][1] += v[1] - off;
      acc[q * 2 + 1][0] += v[2] - off;
      acc[q * 2 + 1][1] += v[3] - off;
      ss += acc[q * 2][0] * acc[q * 2][0] + acc[q * 2][1] * acc[q * 2][1] + acc[q * 2 + 1][0] * acc[q * 2 + 1][0] +
            acc[q * 2 + 1][1] * acc[q * 2 + 1][1];
    }
    ss = wave_sum(ss);
    const float rs3 = rsqrtf(ss * (1.f / 2048.f) + EPSV);
#pragma unroll
    for (int q = 0; q < 8; ++q) {
      f32x4 wf = *(const f32x4*)(p.norm_final_w + lane * 32 + q * 4);
      f32x4 o = {acc[q * 2][0] * rs3 * wf[0], acc[q * 2][1] * rs3 * wf[1], acc[q * 2 + 1][0] * rs3 * wf[2],
                 acc[q * 2 + 1][1] * rs3 * wf[3]};
      *(f32x4*)(orow + q * 4) = o;
    }
  }
}

__global__ void __launch_bounds__(NTHR, 2) fwd_kernel(Params p) {
  __shared__ __attribute__((aligned(16))) unsigned char smem[SMEM_BYTES];
  cg::grid_group grid = cg::this_grid();
  unsigned char* ws = p.ws;
#define PHASE_ON(n) (p.phase_lo <= (n) && (n) <= p.phase_hi)
#define PHASE_SYNC(n) if (p.coop && PHASE_ON(n) && (n) < p.phase_hi) grid.sync();
  for (int rep = 0; rep < (DBL_PHASE == 0 ? 2 : 1); ++rep)
  if (PHASE_ON(0)) phase_prep(p, smem);
  PHASE_SYNC(0)
  for (int rep = 0; rep < (DBL_PHASE == 1 ? 2 : 1); ++rep)
  if (PHASE_ON(1)) {
    for (int u = blockIdx.x; u < 128 * 37; u += gridDim.x)
      gemm_tile<1>(p, smem, (const bf16_t*)(ws + OFF_XB), (const bf16_t*)(ws + OFF_WINT), u & 127, u >> 7);
  }
  PHASE_SYNC(1)
  for (int rep = 0; rep < (DBL_PHASE == 2 ? 2 : 1); ++rep)
  if (PHASE_ON(2)) {
    for (int u = blockIdx.x; u < 2048; u += gridDim.x) ssd_local_unit(p, smem, u);
    for (int u = blockIdx.x; u < 2048; u += gridDim.x) lru_local_unit(p, smem, u);
  }
  PHASE_SYNC(2)
  if (PHASE_ON(3)) phase_carry(p);
  PHASE_SYNC(3)
  for (int rep = 0; rep < (DBL_PHASE == 4 ? 2 : 1); ++rep)
  if (PHASE_ON(4)) phase_mix_final(p);
  PHASE_SYNC(4)
  for (int rep = 0; rep < (DBL_PHASE == 5 ? 2 : 1); ++rep)
  if (PHASE_ON(5)) {
    for (int u = blockIdx.x; u < 128 * 16; u += gridDim.x)
      gemm_tile<2>(p, smem, (const bf16_t*)(ws + OFF_XB), (const bf16_t*)(ws + OFF_WOUTT), u & 127, u >> 7);
  }
  PHASE_SYNC(5)
  for (int rep = 0; rep < (DBL_PHASE == 6 ? 2 : 1); ++rep)
  if (PHASE_ON(6)) {
    for (int u = blockIdx.x; u < 128 * 16; u += gridDim.x)
      gemm_tile<3>(p, smem, (const bf16_t*)(ws + OFF_X1B), (const bf16_t*)(ws + OFF_WQT), u & 127, u >> 7);
    convert_uv(p);
  }
  PHASE_SYNC(6)
  for (int rep = 0; rep < (DBL_PHASE == 7 ? 2 : 1); ++rep)
  if (PHASE_ON(7)) {
    for (int u = blockIdx.x; u < 2048; u += gridDim.x) topk_unit(p, smem, u);
  }
  PHASE_SYNC(7)
  if (PHASE_ON(8)) phase_gather(p);
}

extern "C" void kernel_launch(void* const* d_in, const int* in_sizes, int n_in, void* d_out, int out_size,
                              void* d_ws, size_t ws_size, hipStream_t stream) {
  Params p{};
  const float** fp = (const float**)&p;
  for (int i = 0; i < 23; ++i) fp[i] = (const float*)d_in[i];
  p.out = (float*)d_out;
  p.ws = (unsigned char*)d_ws;
  static int grid_blocks = 0;
  if (!grid_blocks) {
    int dev = 0, cus = 0, per_cu = 0;
    hipGetDevice(&dev);
    hipDeviceGetAttribute(&cus, hipDeviceAttributeMultiprocessorCount, dev);
    hipOccupancyMaxActiveBlocksPerMultiprocessor(&per_cu, fwd_kernel, NTHR, 0);
    if (per_cu < 1) per_cu = 1;
    if (per_cu > 2) per_cu = 2;
    grid_blocks = cus * per_cu;
  }
#if SINGLE_LAUNCH
  p.phase_lo = 0; p.phase_hi = 8; p.coop = 1;
  void* args[] = {&p};
  hipError_t e = hipLaunchCooperativeKernel((void*)fwd_kernel, dim3(grid_blocks), dim3(NTHR), args, 0, stream);
  if (e != hipSuccess) fprintf(stderr, "cooperative launch failed: %s (grid %d)\n", hipGetErrorString(e), grid_blocks);
#else
  for (int ph = 0; ph <= 8; ++ph) {
    p.phase_lo = ph; p.phase_hi = ph; p.coop = 0;
    hipLaunchKernelGGL(fwd_kernel, dim3(grid_blocks), dim3(NTHR), 0, stream, p);
  }
#endif
}
```

```cpp
#include <hip/hip_runtime.h>
#include <hip/hip_cooperative_groups.h>
#include <cstdio>
namespace cg = cooperative_groups;

#ifndef DBL_PHASE
#define DBL_PHASE -1
#endif
#ifndef SINGLE_LAUNCH
#define SINGLE_LAUNCH 1
#endif

typedef unsigned short bf16_t;
typedef short bf16x8 __attribute__((ext_vector_type(8)));
typedef float f32x4 __attribute__((ext_vector_type(4)));
typedef unsigned u32x4 __attribute__((ext_vector_type(4)));
typedef unsigned u32x2 __attribute__((ext_vector_type(2)));
typedef __bf16 bf2_t __attribute__((ext_vector_type(2)));

#define T_TOK 16384
#define DM 2048
#define LDP 4736
#define NTHR 256
#define SMEM_BYTES 73728
#define EPSV 1e-6f
#define MIB ((size_t)1 << 20)

#define OFF_XB (0 * MIB)
#define OFF_PROJ (64 * MIB)
#define OFF_X1B (64 * MIB)
#define OFF_Q (128 * MIB)
#define OFF_IDX (192 * MIB)
#define OFF_G (200 * MIB)
#define OFF_HLOC (212 * MIB)
#define OFF_CUMA (276 * MIB)
#define OFF_YPART (340 * MIB)
#define OFF_ST (372 * MIB)
#define OFF_WINT (436 * MIB)
#define OFF_WOUTT (455 * MIB)
#define OFF_WQT (463 * MIB)
#define OFF_WAT (471 * MIB)
#define OFF_WXT (471 * MIB + 131072)
#define OFF_KEYSB (471 * MIB + 262144)
#define OFF_RS1 (472 * MIB)
#define OFF_ACS (472 * MIB + 65536)
#define OFF_LCARRY (OFF_ACS + MIB)
#define OFF_SSQ (OFF_LCARRY + 524288)
#define OFF_SSQ2 (OFF_SSQ + MIB)
#define OFF_SCALES (OFF_SSQ2 + 2 * MIB)

struct Params {
  const float *x, *norm_mix_w, *w_in, *lru_conv_w, *lru_conv_b, *lru_wa, *lru_ba, *lru_wx, *lru_bx, *lru_lambda;
  const float *ssd_conv_w, *ssd_conv_b, *ssd_dt_bias, *ssd_a_log, *ssd_d, *ssd_norm_w, *w_out, *norm_ffn_w, *peer_wq;
  const float *peer_sub_keys, *peer_u, *peer_v, *norm_final_w;
  float* out;
  unsigned char* ws;
  int phase_lo, phase_hi, coop, pad0;
};

__device__ __forceinline__ unsigned pk2(float lo, float hi) {
  unsigned r;
  asm("v_cvt_pk_bf16_f32 %0, %1, %2" : "=v"(r) : "v"(lo), "v"(hi));
  return r;
}
__device__ __forceinline__ float bf2f(bf16_t v) { return __uint_as_float(((unsigned)v) << 16); }
__device__ __forceinline__ float bflo(unsigned u) { return __uint_as_float(u << 16); }
__device__ __forceinline__ float bfhi(unsigned u) { return __uint_as_float(u & 0xffff0000u); }
__device__ __forceinline__ float wave_sum(float v) {
#pragma unroll
  for (int o = 32; o > 0; o >>= 1) v += __shfl_xor(v, o);
  return v;
}
__device__ __forceinline__ float sigmoid_(float x) { return 1.f / (1.f + __expf(-x)); }
__device__ __forceinline__ float silu_(float x) { return x * sigmoid_(x); }
__device__ __forceinline__ float gelu_(float x) {
  float u = 0.7978845608028654f * (x + 0.044715f * x * x * x);
  return x * sigmoid_(2.f * u);
}
__device__ __forceinline__ float softplus_(float x) { return fmaxf(x, 0.f) + log1pf(__expf(-fabsf(x))); }
__device__ __forceinline__ f32x4 mfma16(bf16x8 a, bf16x8 b, f32x4 c) {
  return __builtin_amdgcn_mfma_f32_16x16x32_bf16(a, b, c, 0, 0, 0);
}
__device__ __forceinline__ bf16x8 as_frag(u32x4 v) { return __builtin_bit_cast(bf16x8, v); }
__device__ __forceinline__ int sw256(int row, int chunk) { return row * 256 + ((chunk ^ (row & 15)) << 4); }
__device__ __forceinline__ int sw128(int row, int chunk) { return row * 128 + ((chunk ^ ((row >> 1) & 7)) << 4); }

__device__ __forceinline__ float rs_from_ssq2(const float* ssq2, int row) {
  const f32x4* pp = (const f32x4*)(ssq2 + (size_t)row * 32);
  float s = 0.f;
#pragma unroll
  for (int i = 0; i < 8; ++i) { f32x4 v = pp[i]; s += v[0] + v[1] + v[2] + v[3]; }
  return rsqrtf(s * (1.f / 2048.f) + EPSV);
}
__device__ __forceinline__ float rs_from_ssq(const float* ssq, int row) {
  const f32x4* pp = (const f32x4*)(ssq + (size_t)row * 16);
  float s = 0.f;
#pragma unroll
  for (int i = 0; i < 4; ++i) { f32x4 v = pp[i]; s += v[0] + v[1] + v[2] + v[3]; }
  return rsqrtf(s * (1.f / 1024.f) + EPSV);
}

__device__ void transpose_tile(const float* __restrict__ src, int ld_src, int r0, int c0, int c_valid,
                               bf16_t* __restrict__ dst, int ld_dst, const float* __restrict__ scale, int scale_from,
                               float* tile) {
  const int tid = threadIdx.x;
  {
    const int j = tid & 63, i0 = tid >> 6;
#pragma unroll 4
    for (int ii = 0; ii < 16; ++ii) {
      const int i = i0 + 4 * ii;
      float v = 0.f;
      if (c0 + j < c_valid) {
        v = src[(size_t)(r0 + i) * ld_src + c0 + j];
        if (scale != nullptr && (r0 + i) >= scale_from) v *= scale[r0 + i - scale_from];
      }
      tile[i * 65 + j] = v;
    }
  }
  __syncthreads();
  {
    const int i = tid & 63, j0 = tid >> 6;
#pragma unroll 4
    for (int jj = 0; jj < 16; ++jj) {
      const int j = j0 + 4 * jj;
      dst[(size_t)(c0 + j) * ld_dst + r0 + i] = (bf16_t)(pk2(tile[i * 65 + j], 0.f) & 0xffffu);
    }
  }
  __syncthreads();
}

__device__ void phase_prep(const Params& p, unsigned char* smem) {
  const int tid = threadIdx.x, lane = tid & 63, wid = tid >> 6;
  unsigned char* ws = p.ws;
  bf16_t* xb = (bf16_t*)(ws + OFF_XB);
  float* rs1 = (float*)(ws + OFF_RS1);
  for (int t = blockIdx.x * 4 + wid; t < T_TOK; t += gridDim.x * 4) {
    const float* xr = p.x + (size_t)t * DM;
    bf16_t* xo = xb + (size_t)t * DM;
    float ss = 0.f;
#pragma unroll
    for (int c = 0; c < 8; ++c) {
      f32x4 v = *(const f32x4*)(xr + c * 256 + lane * 4);
      ss += v[0] * v[0] + v[1] * v[1] + v[2] * v[2] + v[3] * v[3];
      u32x2 o = {pk2(v[0], v[1]), pk2(v[2], v[3])};
      *(u32x2*)(xo + c * 256 + lane * 4) = o;
    }
    ss = wave_sum(ss);
    if (lane == 0) rs1[t] = rsqrtf(ss * (1.f / 2048.f) + EPSV);
  }
  float* tile = (float*)smem;
  const int NT_WIN = 32 * 74, NT_SQ = 32 * 32;
  const int total = NT_WIN + 2 * NT_SQ + 32;
  for (int u = blockIdx.x; u < total; u += gridDim.x) {
    if (u < NT_WIN) {
      const int ri = u & 31, cj = u >> 5;
      transpose_tile(p.w_in, 4624, ri * 64, cj * 64, 4624, (bf16_t*)(ws + OFF_WINT), 2048, p.norm_mix_w, 0, tile);
    } else if (u < NT_WIN + NT_SQ) {
      const int v = u - NT_WIN, ri = v & 31, cj = v >> 5;
      transpose_tile(p.w_out, 2048, ri * 64, cj * 64, 2048, (bf16_t*)(ws + OFF_WOUTT), 2048, p.ssd_norm_w, 1024, tile);
    } else if (u < NT_WIN + 2 * NT_SQ) {
      const int v = u - NT_WIN - NT_SQ, ri = v & 31, cj = v >> 5;
      transpose_tile(p.peer_wq, 2048, ri * 64, cj * 64, 2048, (bf16_t*)(ws + OFF_WQT), 2048, p.norm_ffn_w, 0, tile);
    } else {
      const int v = u - NT_WIN - 2 * NT_SQ;
      const int h = v & 15;
      const float* src = (v < 16 ? p.lru_wa : p.lru_wx) + (size_t)h * 4096;
      bf16_t* dst = (bf16_t*)(ws + (v < 16 ? OFF_WAT : OFF_WXT)) + (size_t)h * 4096;
      transpose_tile(src, 64, 0, 0, 64, dst, 64, nullptr, 0, tile);
    }
  }
  {
    bf16_t* kb = (bf16_t*)(ws + OFF_KEYSB);
    for (int i = blockIdx.x * NTHR + tid; i < 65536; i += gridDim.x * NTHR) {
      f32x4 v = *(const f32x4*)(p.peer_sub_keys + (size_t)i * 4);
      u32x2 o = {pk2(v[0], v[1]), pk2(v[2], v[3])};
      *(u32x2*)(kb + (size_t)i * 4) = o;
    }
  }
}

template <int MODE>
__device__ void gemm_tile(const Params& p, unsigned char* smem, const bf16_t* __restrict__ A,
                          const bf16_t* __restrict__ Bt, int mt, int nt) {
  const int tid = threadIdx.x, lane = tid & 63, wid = tid >> 6, wr = wid >> 1, wc = wid & 1;
  const int l15 = lane & 15, q4 = lane >> 4;
  const int m0 = mt * 128, n0 = nt * 128;
  unsigned char* ws = p.ws;
  f32x4 acc[4][4];
#pragma unroll
  for (int i = 0; i < 4; ++i)
#pragma unroll
    for (int j = 0; j < 4; ++j) acc[i][j] = (f32x4){0.f, 0.f, 0.f, 0.f};
  const int srow = tid >> 3, skc = tid & 7;
  const bf16_t* Ag = A + (size_t)(m0 + srow) * 2048 + skc * 8;
  const bf16_t* Bg = Bt + (size_t)(n0 + srow) * 2048 + skc * 8;
  const int soff = srow * 128 + ((skc ^ ((srow >> 1) & 7)) << 4);
  u32x4 ra[2][4], rb[2][4];
  constexpr int NK = 32;
#define KIDX(kt) ((MODE == 2) ? (((kt) + 16) & 31) : (kt))
#define GLOAD(set, kt)                                                        \
  {                                                                           \
    const int kk_ = KIDX(kt);                                                 \
    _Pragma("unroll") for (int i = 0; i < 4; ++i) {                           \
      ra[set][i] = *(const u32x4*)(Ag + (size_t)i * 32 * 2048 + kk_ * 64);    \
      rb[set][i] = *(const u32x4*)(Bg + (size_t)i * 32 * 2048 + kk_ * 64);    \
    }                                                                         \
  }
#define LSTORE(set, buf)                                                      \
  {                                                                           \
    unsigned char* d_ = smem + (buf) * 32768 + soff;                          \
    _Pragma("unroll") for (int i = 0; i < 4; ++i) {                           \
      *(u32x4*)(d_ + i * 4096) = ra[set][i];                                  \
      *(u32x4*)(d_ + 16384 + i * 4096) = rb[set][i];                          \
    }                                                                         \
  }
#define COMPUTE(buf)                                                          \
  {                                                                           \
    const unsigned char* As = smem + (buf) * 32768;                           \
    const unsigned char* Bs = As + 16384;                                     \
    _Pragma("unroll") for (int ks = 0; ks < 2; ++ks) {                        \
      bf16x8 af[4], bfr[4];                                                   \
      const int chunk = ks * 4 + q4;                                          \
      _Pragma("unroll") for (int mi = 0; mi < 4; ++mi)                        \
          af[mi] = *(const bf16x8*)(As + sw128(wr * 64 + mi * 16 + l15, chunk)); \
      _Pragma("unroll") for (int ni = 0; ni < 4; ++ni)                        \
          bfr[ni] = *(const bf16x8*)(Bs + sw128(wc * 64 + ni * 16 + l15, chunk)); \
      _Pragma("unroll") for (int mi = 0; mi < 4; ++mi)                        \
        _Pragma("unroll") for (int ni = 0; ni < 4; ++ni)                      \
            acc[mi][ni] = mfma16(bfr[ni], af[mi], acc[mi][ni]);               \
    }                                                                         \
  }
#define MIDSCALE(kt)                                                          \
  if (MODE == 2 && (kt) == 15) {                                              \
    const float* ssq = (const float*)(ws + OFF_SSQ);                          \
    _Pragma("unroll") for (int mi = 0; mi < 4; ++mi) {                        \
      const float s_ = rs_from_ssq(ssq, m0 + wr * 64 + mi * 16 + l15);        \
      _Pragma("unroll") for (int ni = 0; ni < 4; ++ni) acc[mi][ni] *= s_;     \
    }                                                                         \
  }
  GLOAD(0, 0);
  GLOAD(1, 1);
  LSTORE(0, 0);
  __syncthreads();
#pragma unroll
  for (int kt = 0; kt < NK; kt += 2) {
    if (kt + 2 < NK) GLOAD(0, kt + 2);
    COMPUTE(0);
    MIDSCALE(kt);
    LSTORE(1, 1);
    __syncthreads();
    if (kt + 3 < NK) GLOAD(1, kt + 3);
    COMPUTE(1);
    MIDSCALE(kt + 1);
    if (kt + 2 < NK) LSTORE(0, 0);
    __syncthreads();
  }
#undef GLOAD
#undef LSTORE
#undef COMPUTE
#undef MIDSCALE
#undef KIDX
  if (MODE == 1) {
    const float* rs1 = (const float*)(ws + OFF_RS1);
    bf16_t* proj = (bf16_t*)(ws + OFF_PROJ);
#pragma unroll
    for (int mi = 0; mi < 4; ++mi) {
      const int row = m0 + wr * 64 + mi * 16 + l15;
      const float s = rs1[row];
#pragma unroll
      for (int ni = 0; ni < 4; ++ni) {
        const int col = n0 + wc * 64 + ni * 16 + q4 * 4;
        f32x4 v = acc[mi][ni] * s;
        u32x2 o = {pk2(v[0], v[1]), pk2(v[2], v[3])};
        *(u32x2*)(proj + (size_t)row * LDP + col) = o;
      }
    }
  } else if (MODE == 2) {
    bf16_t* x1b = (bf16_t*)(ws + OFF_X1B);
    float* ssq2 = (float*)(ws + OFF_SSQ2);
#pragma unroll
    for (int mi = 0; mi < 4; ++mi) {
      const int row = m0 + wr * 64 + mi * 16 + l15;
      float ss = 0.f;
#pragma unroll
      for (int ni = 0; ni < 4; ++ni) {
        const int col = n0 + wc * 64 + ni * 16 + q4 * 4;
        f32x4 xr = *(const f32x4*)(p.x + (size_t)row * DM + col);
        f32x4 v = acc[mi][ni] + xr;
        *(f32x4*)(p.out + (size_t)row * DM + col) = v;
        u32x2 o = {pk2(v[0], v[1]), pk2(v[2], v[3])};
        *(u32x2*)(x1b + (size_t)row * DM + col) = o;
        ss += v[0] * v[0] + v[1] * v[1] + v[2] * v[2] + v[3] * v[3];
      }
      ss += __shfl_xor(ss, 16);
      ss += __shfl_xor(ss, 32);
      if (q4 == 0) ssq2[(size_t)row * 32 + nt * 2 + wc] = ss;
    }
  } else {
    const float* ssq2 = (const float*)(ws + OFF_SSQ2);
    bf16_t* qo = (bf16_t*)(ws + OFF_Q);
#pragma unroll
    for (int mi = 0; mi < 4; ++mi) {
      const int row = m0 + wr * 64 + mi * 16 + l15;
      const float s = rs_from_ssq2(ssq2, row);
#pragma unroll
      for (int ni = 0; ni < 4; ++ni) {
        const int col = n0 + wc * 64 + ni * 16 + q4 * 4;
        f32x4 v = acc[mi][ni] * s;
        u32x2 o = {pk2(v[0], v[1]), pk2(v[2], v[3])};
        *(u32x2*)(qo + (size_t)row * DM + col) = o;
      }
    }
  }
}

__device__ __forceinline__ void conv8(const bf16_t* __restrict__ proj, int t, int tt_in_seq, int col,
                                      const float* __restrict__ cw, int ld_w, const float* __restrict__ cb, int ch,
                                      float* o) {
  f32x4 b0 = *(const f32x4*)(cb + ch), b1 = *(const f32x4*)(cb + ch + 4);
  o[0] = b0[0]; o[1] = b0[1]; o[2] = b0[2]; o[3] = b0[3];
  o[4] = b1[0]; o[5] = b1[1]; o[6] = b1[2]; o[7] = b1[3];
#pragma unroll
  for (int k = 0; k < 4; ++k) {
    if (tt_in_seq - 3 + k >= 0) {
      u32x4 v = *(const u32x4*)(proj + (size_t)(t - 3 + k) * LDP + col);
      f32x4 w0 = *(const f32x4*)(cw + k * ld_w + ch), w1 = *(const f32x4*)(cw + k * ld_w + ch + 4);
      o[0] += w0[0] * bflo(v[0]); o[1] += w0[1] * bfhi(v[0]);
      o[2] += w0[2] * bflo(v[1]); o[3] += w0[3] * bfhi(v[1]);
      o[4] += w1[0] * bflo(v[2]); o[5] += w1[1] * bfhi(v[2]);
      o[6] += w1[2] * bflo(v[3]); o[7] += w1[3] * bfhi(v[3]);
    }
  }
}
__device__ __forceinline__ void conv4(const bf16_t* __restrict__ proj, int t, int tt_in_seq, int col,
                                      const float* __restrict__ cw, int ld_w, const float* __restrict__ cb, int ch,
                                      float* o) {
  f32x4 b0 = *(const f32x4*)(cb + ch);
  o[0] = b0[0]; o[1] = b0[1]; o[2] = b0[2]; o[3] = b0[3];
#pragma unroll
  for (int k = 0; k < 4; ++k) {
    if (tt_in_seq - 3 + k >= 0) {
      u32x2 v = *(const u32x2*)(proj + (size_t)(t - 3 + k) * LDP + col);
      f32x4 w0 = *(const f32x4*)(cw + k * ld_w + ch);
      o[0] += w0[0] * bflo(v[0]); o[1] += w0[1] * bfhi(v[0]);
      o[2] += w0[2] * bflo(v[1]); o[3] += w0[3] * bfhi(v[1]);
    }
  }
}
__device__ __forceinline__ bf16x8 cfrag(const Params& p, const bf16_t* proj, int t, int tseq, int g, int n8) {
  float o[8];
  const int ch = 1280 + g * 128 + n8;
  conv8(proj, t, tseq, 3072 + ch, p.ssd_conv_w, 1536, p.ssd_conv_b, ch, o);
#pragma unroll
  for (int i = 0; i < 8; ++i) o[i] = silu_(o[i]);
  u32x4 r = {pk2(o[0], o[1]), pk2(o[2], o[3]), pk2(o[4], o[5]), pk2(o[6], o[7])};
  return as_frag(r);
}

__device__ void lru_local_unit(const Params& p, unsigned char* smem, int unit) {
  const int tid = threadIdx.x, lane = tid & 63, wid = tid >> 6, l15 = lane & 15, q4 = lane >> 4;
  const int hh = unit & 15, c = (unit >> 4) & 15, b = unit >> 8;
  const int t0 = b * 2048 + c * 128, ch0 = hh * 64;
  unsigned char* ws = p.ws;
  const bf16_t* proj = (const bf16_t*)(ws + OFF_PROJ);
  float* R1 = (float*)smem;
  float* R2 = (float*)(smem + 33536);
  float* R3 = (float*)(smem + 33536 + 32768);
#pragma unroll 11
  for (int e = tid; e < 131 * 64; e += NTHR) {
    const int r = e >> 6, j = e & 63, tt = r - 3;
    float v = 0.f;
    if (c * 128 + tt >= 0) v = bf2f(proj[(size_t)(t0 + tt) * LDP + ch0 + j]);
    R1[e] = v;
  }
  __syncthreads();
  {
    const int j = tid & 63;
    const float cb = p.lru_conv_b[ch0 + j];
    const float w0 = p.lru_conv_w[0 * 1024 + ch0 + j], w1 = p.lru_conv_w[1 * 1024 + ch0 + j],
                w2 = p.lru_conv_w[2 * 1024 + ch0 + j], w3 = p.lru_conv_w[3 * 1024 + ch0 + j];
#pragma unroll 8
    for (int tt = tid >> 6; tt < 128; tt += 4) {
      R2[tt * 64 + j] = cb + w0 * R1[tt * 64 + j] + w1 * R1[(tt + 1) * 64 + j] + w2 * R1[(tt + 2) * 64 + j] +
                        w3 * R1[(tt + 3) * 64 + j];
    }
  }
  __syncthreads();
  {
    const bf16_t* waT = (const bf16_t*)(ws + OFF_WAT) + (size_t)hh * 4096;
    const bf16_t* wxT = (const bf16_t*)(ws + OFF_WXT) + (size_t)hh * 4096;
    f32x4 aa[2][4], ax[2][4];
#pragma unroll
    for (int i = 0; i < 2; ++i)
#pragma unroll
      for (int j = 0; j < 4; ++j) { aa[i][j] = (f32x4){0, 0, 0, 0}; ax[i][j] = (f32x4){0, 0, 0, 0}; }
#pragma unroll
    for (int ks = 0; ks < 2; ++ks) {
      bf16x8 af[2];
#pragma unroll
      for (int mi = 0; mi < 2; ++mi) {
        const float* src = R2 + (wid * 32 + mi * 16 + l15) * 64 + ks * 32 + q4 * 8;
        f32x4 v0 = *(const f32x4*)src, v1 = *(const f32x4*)(src + 4);
        u32x4 r = {pk2(v0[0], v0[1]), pk2(v0[2], v0[3]), pk2(v1[0], v1[1]), pk2(v1[2], v1[3])};
        af[mi] = as_frag(r);
      }
#pragma unroll
      for (int ni = 0; ni < 4; ++ni) {
        const size_t wo = (size_t)(ni * 16 + l15) * 64 + ks * 32 + q4 * 8;
        bf16x8 ba = as_frag(*(const u32x4*)(waT + wo));
        bf16x8 bx = as_frag(*(const u32x4*)(wxT + wo));
#pragma unroll
        for (int mi = 0; mi < 2; ++mi) {
          aa[mi][ni] = mfma16(af[mi], ba, aa[mi][ni]);
          ax[mi][ni] = mfma16(af[mi], bx, ax[mi][ni]);
        }
      }
    }
#pragma unroll
    for (int ni = 0; ni < 4; ++ni) {
      const int j = ni * 16 + l15;
      const float ba = p.lru_ba[ch0 + j], bx = p.lru_bx[ch0 + j];
      const float lam = p.lru_lambda[ch0 + j];
      const float spl = -8.f * log1pf(__expf(-lam));
#pragma unroll
      for (int mi = 0; mi < 2; ++mi)
#pragma unroll
        for (int r = 0; r < 4; ++r) {
          const int tt = wid * 32 + mi * 16 + q4 * 4 + r;
          const float rg = sigmoid_(aa[mi][ni][r] + ba);
          const float ig = sigmoid_(ax[mi][ni][r] + bx);
          const float log_a = spl * rg;
          const float av = __expf(log_a);
          const float xl = R2[tt * 64 + j];
          const float bv = sqrtf(fmaxf(-expm1f(2.f * log_a), 0.f)) * (ig * xl);
          R1[tt * 64 + j] = av;
          R2[tt * 64 + j] = bv;
        }
    }
  }
  __syncthreads();
  {
    const int j = tid & 63, seg = tid >> 6;
    float h = 0.f, Ac = 1.f;
#pragma unroll 4
    for (int s = 0; s < 32; ++s) {
      const int tt = seg * 32 + s;
      const float a = R1[tt * 64 + j], bb = R2[tt * 64 + j];
      h = a * h + bb;
      Ac *= a;
      R2[tt * 64 + j] = h;
      R1[tt * 64 + j] = Ac;
    }
    R3[seg * 64 + j] = h;
    R3[256 + seg * 64 + j] = Ac;
    __syncthreads();
    float cin = 0.f, Ain = 1.f;
    for (int s2 = 0; s2 < seg; ++s2) {
      cin = R3[256 + s2 * 64 + j] * cin + R3[s2 * 64 + j];
      Ain *= R3[256 + s2 * 64 + j];
    }
    float* hloc = (float*)(ws + OFF_HLOC);
    float* cumA = (float*)(ws + OFF_CUMA);
#pragma unroll 4
    for (int s = 0; s < 32; ++s) {
      const int tt = seg * 32 + s;
      const float hl = R2[tt * 64 + j] + R1[tt * 64 + j] * cin;
      const float Al = R1[tt * 64 + j] * Ain;
      hloc[(size_t)(t0 + tt) * 1024 + ch0 + j] = hl;
      cumA[(size_t)(t0 + tt) * 1024 + ch0 + j] = Al;
    }
  }
  __syncthreads();
}

__device__ void ssd_local_unit(const Params& p, unsigned char* smem, int unit) {
  const int tid = threadIdx.x, lane = tid & 63, wid = tid >> 6, l15 = lane & 15, q4 = lane >> 4;
  const int hh = unit & 15, c = (unit >> 4) & 15, b = unit >> 8, g = hh >> 3;
  const int t0 = b * 2048 + c * 128, ts0 = c * 128;
  unsigned char* ws = p.ws;
  const bf16_t* proj = (const bf16_t*)(ws + OFF_PROJ);
  unsigned char* Bm = smem;
  unsigned char* XT = smem + 32768;
  unsigned char* Pw = smem + 49152 + wid * 4096;
  float* dts = (float*)(smem + 65536);
  float* acs = dts + 128;
  float* adt = acs + 128;
  if (tid < 128) {
    const float raw = bf2f(proj[(size_t)(t0 + tid) * LDP + 4608 + hh]);
    const float dtv = softplus_(raw + p.ssd_dt_bias[hh]);
    dts[tid] = dtv;
    adt[tid] = -__expf(p.ssd_a_log[hh]) * dtv;
  }
  __syncthreads();
  if (tid < 128) {
    float s = 0.f;
    for (int k = 0; k <= tid; ++k) s += adt[k];
    acs[tid] = s;
    ((float*)(ws + OFF_ACS))[(size_t)(t0 + tid) * 16 + hh] = s;
  }
  {
    const int chunk = tid & 15;
    const int ch = 1024 + g * 128 + chunk * 8;
#pragma unroll 4
    for (int i = 0; i < 8; ++i) {
      const int tt = (tid >> 4) + 16 * i;
      float o[8];
      conv8(proj, t0 + tt, ts0 + tt, 3072 + ch, p.ssd_conv_w, 1536, p.ssd_conv_b, ch, o);
#pragma unroll
      for (int e = 0; e < 8; ++e) o[e] = silu_(o[e]);
      u32x4 r = {pk2(o[0], o[1]), pk2(o[2], o[3]), pk2(o[4], o[5]), pk2(o[6], o[7])};
      *(u32x4*)(Bm + sw256(tt, chunk)) = r;
    }
  }
  __syncthreads();
  {
    const int pp = tid & 63;
    const int ch = hh * 64 + pp;
    const float cb = p.ssd_conv_b[ch];
    const float w0 = p.ssd_conv_w[ch], w1 = p.ssd_conv_w[1536 + ch], w2 = p.ssd_conv_w[2 * 1536 + ch],
                w3 = p.ssd_conv_w[3 * 1536 + ch];
#pragma unroll 2
    for (int i = 0; i < 4; ++i) {
      const int chunk = (tid >> 6) * 4 + i;
      const int tt0 = chunk * 8;
      float xv[11];
#pragma unroll
      for (int k = 0; k < 11; ++k) {
        const int tt = tt0 - 3 + k;
        xv[k] = (ts0 + tt >= 0) ? bf2f(proj[(size_t)(t0 + tt) * LDP + 3072 + ch]) : 0.f;
      }
      float o[8];
#pragma unroll
      for (int e = 0; e < 8; ++e) {
        const float cv = cb + w0 * xv[e] + w1 * xv[e + 1] + w2 * xv[e + 2] + w3 * xv[e + 3];
        o[e] = silu_(cv) * dts[tt0 + e];
      }
      u32x4 r = {pk2(o[0], o[1]), pk2(o[2], o[3]), pk2(o[4], o[5]), pk2(o[6], o[7])};
      *(u32x4*)(XT + sw256(pp, chunk)) = r;
    }
  }
  __syncthreads();
  bf16_t* ypart = (bf16_t*)(ws + OFF_YPART);
  const float Dh = p.ssd_d[hh];
#pragma unroll 1
  for (int mt = 0; mt < 2; ++mt) {
    const int M = wid * 2 + mt;
    const int lrow = M * 16 + l15;
    bf16x8 cf[4];
#pragma unroll
    for (int ks = 0; ks < 4; ++ks) cf[ks] = cfrag(p, proj, t0 + lrow, ts0 + lrow, g, ks * 32 + q4 * 8);
    const float acl = acs[lrow];
    const int ntmax = M | 1;
#pragma unroll 1
    for (int nt = 0; nt <= ntmax; ++nt) {
      f32x4 a4 = (f32x4){0, 0, 0, 0};
      if (nt <= M) {
#pragma unroll
        for (int ks = 0; ks < 4; ++ks) {
          bf16x8 bfr = *(const bf16x8*)(Bm + sw256(nt * 16 + l15, ks * 4 + q4));
          a4 = mfma16(bfr, cf[ks], a4);
        }
      }
      float pv[4];
#pragma unroll
      for (int r = 0; r < 4; ++r) {
        const int s = nt * 16 + q4 * 4 + r;
        pv[r] = (s <= lrow) ? a4[r] * __expf(acl - acs[s]) : 0.f;
      }
      u32x2 o = {pk2(pv[0], pv[1]), pk2(pv[2], pv[3])};
      const int chunk = nt * 2 + (q4 >> 1);
      *(u32x2*)(Pw + sw256(l15, chunk) + (q4 & 1) * 8) = o;
    }
    f32x4 ya[4];
#pragma unroll
    for (int pt = 0; pt < 4; ++pt) ya[pt] = (f32x4){0, 0, 0, 0};
    const int ksmax = M >> 1;
#pragma unroll 1
    for (int ks = 0; ks <= ksmax; ++ks) {
      bf16x8 pf = *(const bf16x8*)(Pw + sw256(l15, ks * 4 + q4));
#pragma unroll
      for (int pt = 0; pt < 4; ++pt) {
        bf16x8 xf = *(const bf16x8*)(XT + sw256(pt * 16 + l15, ks * 4 + q4));
        ya[pt] = mfma16(xf, pf, ya[pt]);
      }
    }
#pragma unroll
    for (int pt = 0; pt < 4; ++pt) {
      const int pc = pt * 16 + q4 * 4;
      const int ch = hh * 64 + pc;
      float xo[4];
      conv4(proj, t0 + lrow, ts0 + lrow, 3072 + ch, p.ssd_conv_w, 1536, p.ssd_conv_b, ch, xo);
      float y0 = ya[pt][0] + Dh * silu_(xo[0]), y1 = ya[pt][1] + Dh * silu_(xo[1]);
      float y2 = ya[pt][2] + Dh * silu_(xo[2]), y3 = ya[pt][3] + Dh * silu_(xo[3]);
      u32x2 o = {pk2(y0, y1), pk2(y2, y3)};
      *(u32x2*)(ypart + (size_t)(t0 + lrow) * 1024 + ch) = o;
    }
  }
  {
    f32x4 sa[2][4];
#pragma unroll
    for (int i = 0; i < 2; ++i)
#pragma unroll
      for (int j = 0; j < 4; ++j) sa[i][j] = (f32x4){0, 0, 0, 0};
    const float aend = acs[127];
#pragma unroll 1
    for (int ks = 0; ks < 4; ++ks) {
      float dec[8];
#pragma unroll
      for (int e = 0; e < 8; ++e) dec[e] = __expf(aend - acs[ks * 32 + q4 * 8 + e]);
      bf16x8 bd[2];
#pragma unroll
      for (int ni = 0; ni < 2; ++ni) {
        const int n = wid * 32 + ni * 16 + l15;
        float v[8];
#pragma unroll
        for (int e = 0; e < 8; ++e) {
          const int l = ks * 32 + q4 * 8 + e;
          const bf16_t raw = *(const bf16_t*)(Bm + sw256(l, n >> 3) + (n & 7) * 2);
          v[e] = bf2f(raw) * dec[e];
        }
        u32x4 r = {pk2(v[0], v[1]), pk2(v[2], v[3]), pk2(v[4], v[5]), pk2(v[6], v[7])};
        bd[ni] = as_frag(r);
      }
#pragma unroll
      for (int pt = 0; pt < 4; ++pt) {
        bf16x8 xf = *(const bf16x8*)(XT + sw256(pt * 16 + l15, ks * 4 + q4));
#pragma unroll
        for (int ni = 0; ni < 2; ++ni) sa[ni][pt] = mfma16(bd[ni], xf, sa[ni][pt]);
      }
    }
    float* St = (float*)(ws + OFF_ST) + (size_t)((b * 16 + c) * 16 + hh) * 8192;
#pragma unroll
    for (int ni = 0; ni < 2; ++ni)
#pragma unroll
      for (int pt = 0; pt < 4; ++pt) {
        const int pr = pt * 16 + l15, n = wid * 32 + ni * 16 + q4 * 4;
        *(f32x4*)(St + pr * 128 + n) = sa[ni][pt];
      }
  }
  __syncthreads();
}

__device__ void phase_carry(const Params& p) {
  unsigned char* ws = p.ws;
  const int gt = blockIdx.x * NTHR + threadIdx.x, ng = gridDim.x * NTHR;
  const float* hloc = (const float*)(ws + OFF_HLOC);
  const float* cumA = (const float*)(ws + OFF_CUMA);
  float* lcarry = (float*)(ws + OFF_LCARRY);
  for (int i = gt; i < 8192; i += ng) {
    const int b = i >> 10, ch = i & 1023;
    float ca[16], hl[16];
#pragma unroll
    for (int c = 0; c < 16; ++c) {
      const size_t tl = (size_t)(b * 2048 + c * 128 + 127) * 1024 + ch;
      ca[c] = cumA[tl];
      hl[c] = hloc[tl];
    }
    float carry = 0.f;
#pragma unroll
    for (int c = 0; c < 16; ++c) {
      lcarry[(size_t)(b * 16 + c) * 1024 + ch] = carry;
      carry = ca[c] * carry + hl[c];
    }
  }
  const float* acsG = (const float*)(ws + OFF_ACS);
  float* St = (float*)(ws + OFF_ST);
  for (int i = gt; i < 128 * 2048; i += ng) {
    const int bh = i >> 11, e4 = i & 2047, b = bh >> 4, hh = bh & 15;
    f32x4 tmp[16];
    float Ad[16];
#pragma unroll
    for (int c = 0; c < 16; ++c) {
      Ad[c] = __expf(acsG[(size_t)(b * 2048 + c * 128 + 127) * 16 + hh]);
      tmp[c] = *(const f32x4*)(St + (size_t)((b * 16 + c) * 16 + hh) * 8192 + e4 * 4);
    }
    f32x4 s = (f32x4){0, 0, 0, 0};
#pragma unroll
    for (int c = 0; c < 16; ++c) {
      *(f32x4*)(St + (size_t)((b * 16 + c) * 16 + hh) * 8192 + e4 * 4) = s;
      s = s * Ad[c] + tmp[c];
    }
  }
}

__device__ void ssd_final_unit(const Params& p, int unit) {
  const int tid = threadIdx.x, lane = tid & 63, wid = tid >> 6, l15 = lane & 15, q4 = lane >> 4;
  const int hh = unit & 15, c = (unit >> 4) & 15, b = unit >> 8, g = hh >> 3;
  const int t0 = b * 2048 + c * 128, ts0 = c * 128;
  unsigned char* ws = p.ws;
  const bf16_t* proj = (const bf16_t*)(ws + OFF_PROJ);
  const float* Sin = (const float*)(ws + OFF_ST) + (size_t)((b * 16 + c) * 16 + hh) * 8192;
  const bf16_t* ypart = (const bf16_t*)(ws + OFF_YPART);
  const float* acsG = (const float*)(ws + OFF_ACS);
  bf16_t* A2 = (bf16_t*)(ws + OFF_XB);
  float* ssq = (float*)(ws + OFF_SSQ);
#pragma unroll 1
  for (int mt = 0; mt < 2; ++mt) {
    const int lrow = (wid * 2 + mt) * 16 + l15;
    f32x4 ya[4];
#pragma unroll
    for (int pt = 0; pt < 4; ++pt) ya[pt] = (f32x4){0, 0, 0, 0};
    if (c > 0) {
#pragma unroll 2
      for (int ks = 0; ks < 4; ++ks) {
        bf16x8 cf = cfrag(p, proj, t0 + lrow, ts0 + lrow, g, ks * 32 + q4 * 8);
#pragma unroll
        for (int pt = 0; pt < 4; ++pt) {
          const float* sp = Sin + (pt * 16 + l15) * 128 + ks * 32 + q4 * 8;
          f32x4 v0 = *(const f32x4*)sp, v1 = *(const f32x4*)(sp + 4);
          u32x4 r = {pk2(v0[0], v0[1]), pk2(v0[2], v0[3]), pk2(v1[0], v1[1]), pk2(v1[2], v1[3])};
          ya[pt] = mfma16(as_frag(r), cf, ya[pt]);
        }
      }
    }
    const size_t t = (size_t)(t0 + lrow);
    const float ea = __expf(acsG[t * 16 + hh]);
    float ss = 0.f;
#pragma unroll
    for (int pt = 0; pt < 4; ++pt) {
      const int ch = hh * 64 + pt * 16 + q4 * 4;
      u32x2 yp = *(const u32x2*)(ypart + t * 1024 + ch);
      u32x2 zz = *(const u32x2*)(proj + t * LDP + 2048 + ch);
      float y[4] = {bflo(yp[0]) + ea * ya[pt][0], bfhi(yp[0]) + ea * ya[pt][1], bflo(yp[1]) + ea * ya[pt][2],
                    bfhi(yp[1]) + ea * ya[pt][3]};
      float z[4] = {bflo(zz[0]), bfhi(zz[0]), bflo(zz[1]), bfhi(zz[1])};
#pragma unroll
      for (int r = 0; r < 4; ++r) { y[r] = y[r] * silu_(z[r]); ss += y[r] * y[r]; }
      u32x2 o = {pk2(y[0], y[1]), pk2(y[2], y[3])};
      *(u32x2*)(A2 + t * DM + 1024 + ch) = o;
    }
    ss += __shfl_xor(ss, 16);
    ss += __shfl_xor(ss, 32);
    if (q4 == 0) ssq[t * 16 + hh] = ss;
  }
}

__device__ void phase_mix_final(const Params& p) {
  unsigned char* ws = p.ws;
  const bf16_t* proj = (const bf16_t*)(ws + OFF_PROJ);
  const f32x4* hloc = (const f32x4*)(ws + OFF_HLOC);
  const f32x4* cumA = (const f32x4*)(ws + OFF_CUMA);
  const float* lcarry = (const float*)(ws + OFF_LCARRY);
  bf16_t* A2 = (bf16_t*)(ws + OFF_XB);
  for (int u = blockIdx.x; u < 2048; u += gridDim.x) ssd_final_unit(p, u);
#pragma unroll 4
  for (int i = blockIdx.x * NTHR + threadIdx.x; i < T_TOK * 256; i += gridDim.x * NTHR) {
    const int t = i >> 8, ch = (i & 255) * 4;
    f32x4 h = hloc[i], ca = cumA[i];
    f32x4 cr = *(const f32x4*)(lcarry + (size_t)(t >> 7) * 1024 + ch);
    u32x2 gg = *(const u32x2*)(proj + (size_t)t * LDP + 1024 + ch);
    float y0 = (h[0] + ca[0] * cr[0]) * gelu_(bflo(gg[0]));
    float y1 = (h[1] + ca[1] * cr[1]) * gelu_(bfhi(gg[0]));
    float y2 = (h[2] + ca[2] * cr[2]) * gelu_(bflo(gg[1]));
    float y3 = (h[3] + ca[3] * cr[3]) * gelu_(bfhi(gg[1]));
    u32x2 o = {pk2(y0, y1), pk2(y2, y3)};
    *(u32x2*)(A2 + (size_t)t * DM + ch) = o;
  }
}

__device__ void convert_uv(const Params& p) {
  unsigned char* ws = p.ws;
  const int lane = threadIdx.x & 63, wid = threadIdx.x >> 6;
  unsigned char* tb = ws + OFF_XB;
  float* scales = (float*)(ws + OFF_SCALES);
  for (int row = blockIdx.x * 4 + wid; row < 32768; row += gridDim.x * 4) {
    const bool isv = row >= 16384;
    const int e = row & 16383;
    const float* src = (isv ? p.peer_v : p.peer_u) + (size_t)e * DM + lane * 32;
    float vals[32];
    float ss = 0.f;
#pragma unroll
    for (int q = 0; q < 8; ++q) {
      f32x4 t = *(const f32x4*)(src + q * 4);
      if (!isv) t *= *(const f32x4*)(p.norm_ffn_w + lane * 32 + q * 4);
#pragma unroll
      for (int k = 0; k < 4; ++k) {
        vals[q * 4 + k] = t[k];
        ss += t[k] * t[k];
      }
    }
    ss = wave_sum(ss);
    const float rms = sqrtf(ss * (1.f / 2048.f));
    const float sc = rms * (2.6f / 7.f);
    const float inv = sc > 0.f ? 1.f / sc : 0.f;
    u32x4 o;
#pragma unroll
    for (int m = 0; m < 4; ++m) {
      unsigned w = 0;
#pragma unroll
      for (int j = 0; j < 4; ++j) {
        const float lo = fminf(fmaxf(rintf(vals[m * 8 + j] * inv), -7.f), 7.f);
        const float hi = fminf(fmaxf(rintf(vals[m * 8 + 4 + j] * inv), -7.f), 7.f);
        const unsigned bl = (unsigned)((int)lo + 8), bh = (unsigned)((int)hi + 8);
        w |= (bl | (bh << 4)) << (8 * j);
      }
      o[m] = w;
    }
    *(u32x4*)(tb + (size_t)row * 1024 + lane * 16) = o;
    if (lane == 0) scales[row] = sc;
  }
}

__device__ const unsigned char cand_tab[64] = {
    0x00, 0x01, 0x02, 0x03, 0x04, 0x05, 0x06, 0x07, 0x08, 0x09, 0x0a, 0x0b, 0x0c, 0x0d, 0x0e, 0x0f,
    0x10, 0x11, 0x12, 0x13, 0x14, 0x15, 0x16, 0x17,
    0x20, 0x21, 0x22, 0x23, 0x24,
    0x30, 0x31, 0x32, 0x33,
    0x40, 0x41, 0x42,
    0x50, 0x51, 0x60, 0x61, 0x70, 0x71,
    0x80, 0x90, 0xa0, 0xb0, 0xc0, 0xd0, 0xe0, 0xf0,
    0xff, 0xff, 0xff, 0xff, 0xff, 0xff, 0xff, 0xff, 0xff, 0xff, 0xff, 0xff, 0xff, 0xff};

__device__ __forceinline__ unsigned ord_key(float f) {
  unsigned u = __float_as_uint(f);
  return u ^ ((u >> 31) ? 0xffffffffu : 0x80000000u);
}
__device__ __forceinline__ float ord_dec(unsigned k) {
  unsigned u = (k >> 31) ? (k ^ 0x80000000u) : ~k;
  return __uint_as_float(u);
}

__device__ void topk_unit(const Params& p, unsigned char* smem, int unit) {
  const int tid = threadIdx.x, lane = tid & 63, wid = tid >> 6, l15 = lane & 15, q4 = lane >> 4;
  const int h = unit & 7, tile = unit >> 3;
  const int tok0 = tile * 64 + wid * 16;
  unsigned char* ws = p.ws;
  const bf16_t* qg = (const bf16_t*)(ws + OFF_Q);
  const bf16_t* kb = (const bf16_t*)(ws + OFF_KEYSB);
  unsigned* S = (unsigned*)(smem + wid * 16640);
  float* tops = (float*)(smem + 4 * 16640 + wid * 256);
  int* topi = (int*)(tops + 32);
  unsigned* Ms = (unsigned*)(smem + 67584 + wid * 512);
  unsigned* Cs = Ms + 64;
#pragma unroll
  for (int k = 0; k < 2; ++k) {
    f32x4 sc[8];
#pragma unroll
    for (int i = 0; i < 8; ++i) sc[i] = (f32x4){0, 0, 0, 0};
#pragma unroll
    for (int ks = 0; ks < 4; ++ks) {
      bf16x8 qf = as_frag(*(const u32x4*)(qg + (size_t)(tok0 + l15) * DM + h * 256 + k * 128 + ks * 32 + q4 * 8));
#pragma unroll
      for (int nt = 0; nt < 8; ++nt) {
        bf16x8 kf = as_frag(*(const u32x4*)(kb + (size_t)((h * 2 + k) * 128 + nt * 16 + l15) * 128 + ks * 32 + q4 * 8));
        sc[nt] = mfma16(kf, qf, sc[nt]);
      }
    }
#pragma unroll
    for (int nt = 0; nt < 8; ++nt) {
      const int n = nt * 16 + q4 * 4;
      u32x4 kk;
#pragma unroll
      for (int r = 0; r < 4; ++r) kk[r] = (ord_key(sc[nt][r]) & ~127u) | (unsigned)(127 - (n + r));
      *(u32x4*)(S + l15 * 260 + k * 128 + n) = kk;
    }
  }
  const unsigned ct = cand_tab[lane];
  const int ca = ct >> 4, cbb = ct & 15;
  int* idxo = (int*)(ws + OFF_IDX);
  float* go = (float*)(ws + OFF_G);
  for (int tk = 0; tk < 16; ++tk) {
    const unsigned* row = S + tk * 260;
#pragma unroll
    for (int hf = 0; hf < 2; ++hf) {
      const unsigned ka = row[hf * 128 + lane], kb = row[hf * 128 + 64 + lane];
      const unsigned mxk = ka > kb ? ka : kb;
      Ms[lane] = mxk;
      int cnt = 0;
#pragma unroll
      for (int j = 0; j < 16; ++j) {
        u32x4 x = *(const u32x4*)(Ms + j * 4);
#pragma unroll
        for (int e = 0; e < 4; ++e) cnt += (x[e] > mxk) ? 1 : 0;
      }
      const unsigned long long bm = __ballot(cnt == 15);
      const int srcT = __ffsll((long long)bm) - 1;
      const unsigned T0 = (unsigned)__shfl((int)mxk, srcT);
      const bool ca_ = ka >= T0, cb_ = kb >= T0;
      const unsigned long long ba = __ballot(ca_), bb = __ballot(cb_);
      const unsigned long long lt = (1ull << lane) - 1ull;
      const int na = __popcll(ba);
      const int pa = __popcll(ba & lt), pb = na + __popcll(bb & lt);
      const int ncand = na + __popcll(bb);
      if (lane < 32) Cs[lane] = 0u;
      if (ca_) Cs[pa] = ka;
      if (cb_) Cs[pb] = kb;
      const unsigned my = Cs[lane & 31];
      int rk2 = 0;
#pragma unroll
      for (int j = 0; j < 8; ++j) {
        u32x4 x = *(const u32x4*)(Cs + j * 4);
#pragma unroll
        for (int e = 0; e < 4; ++e) rk2 += (x[e] > my) ? 1 : 0;
      }
      if (lane < ncand && rk2 < 16) {
        tops[hf * 16 + rk2] = ord_dec(my & ~127u);
        topi[hf * 16 + rk2] = 127 - (int)(my & 127u);
      }
    }
    float cs = 0.f;
    unsigned ck = 0u;
    if (lane < 50) {
      cs = tops[ca] + tops[16 + cbb];
      ck = (ord_key(cs) & ~255u) | (unsigned)(255 - (ca * 16 + cbb));
    }
    int rk = 0;
#pragma unroll
    for (int j = 0; j < 50; ++j) {
      const unsigned oj = (unsigned)__builtin_amdgcn_readlane((int)ck, j);
      rk += (oj > ck) ? 1 : 0;
    }
    const float mx = tops[0] + tops[16];
    const bool sel = (lane < 50) && (rk < 16);
    const float ev = sel ? __expf(cs - mx) : 0.f;
    const float sum = wave_sum(ev);
    if (sel) {
      const size_t o = (size_t)(tok0 + tk) * 128 + h * 16 + rk;
      idxo[o] = topi[ca] * 128 + topi[16 + cbb];
      go[o] = ev / sum;
    }
  }
  __syncthreads();
}

__device__ __forceinline__ float ub0(unsigned w) { return (float)(w & 0xffu); }
__device__ __forceinline__ float ub1(unsigned w) { return (float)((w >> 8) & 0xffu); }
__device__ __forceinline__ float ub2(unsigned w) { return (float)((w >> 16) & 0xffu); }
__device__ __forceinline__ float ub3(unsigned w) { return (float)(w >> 24); }

#define GROWS 8
#ifndef USE_SDOT4
#define USE_SDOT4 1
#endif
typedef float f32x2 __attribute__((ext_vector_type(2)));
__device__ void phase_gather(const Params& p) {
  const int tid = threadIdx.x, lane = tid & 63, wid = tid >> 6;
  unsigned char* ws = p.ws;
  const unsigned char* ub = ws + OFF_XB;
  const unsigned char* vb = ws + OFF_XB + 16 * MIB;
  const float* scales = (const float*)(ws + OFF_SCALES);
  const int* idxg = (const int*)(ws + OFF_IDX);
  const float* gg = (const float*)(ws + OFF_G);
  const float* ssq2 = (const float*)(ws + OFF_SSQ2);
  const bool b5 = (lane & 32) != 0, b4 = (lane & 16) != 0, b3 = (lane & 8) != 0;
  const int srcl = ((lane & 1) << 3) | (((lane >> 1) & 1) << 4) | (((lane >> 2) & 1) << 5);
  for (int t = blockIdx.x * 4 + wid; t < T_TOK; t += gridDim.x * 4) {
    const int id0 = idxg[(size_t)t * 128 + lane], id1 = idxg[(size_t)t * 128 + 64 + lane];
    const float g0 = gg[(size_t)t * 128 + lane], g1 = gg[(size_t)t * 128 + 64 + lane];
    const float su0 = scales[id0], su1 = scales[id1], sv0 = scales[16384 + id0], sv1 = scales[16384 + id1];
    float* orow = p.out + (size_t)t * DM + lane * 32;
    int xlo[4], xhi[4];
    float sx;
    int sumq;
    {
      float xr[32];
      float amax = 0.f;
#pragma unroll
      for (int q = 0; q < 8; ++q) {
        f32x4 v = *(const f32x4*)(orow + q * 4);
#pragma unroll
        for (int k = 0; k < 4; ++k) { xr[q * 4 + k] = v[k]; amax = fmaxf(amax, fabsf(v[k])); }
      }
#pragma unroll
      for (int o = 32; o > 0; o >>= 1) amax = fmaxf(amax, __shfl_xor(amax, o));
      sx = amax * (1.f / 127.f);
      const float inv = amax > 0.f ? 127.f / amax : 0.f;
      int sq_ = 0;
#pragma unroll
      for (int m = 0; m < 4; ++m) {
        unsigned wl = 0, wh = 0;
#pragma unroll
        for (int j = 0; j < 4; ++j) {
          const int a_ = __float2int_rn(xr[m * 8 + j] * inv), b_ = __float2int_rn(xr[m * 8 + 4 + j] * inv);
          sq_ += a_ + b_;
          wl |= ((unsigned)a_ & 0xffu) << (8 * j);
          wh |= ((unsigned)b_ & 0xffu) << (8 * j);
        }
        xlo[m] = (int)wl;
        xhi[m] = (int)wh;
      }
#pragma unroll
      for (int o = 32; o > 0; o >>= 1) sq_ += __shfl_xor(sq_, o);
      sumq = sq_;
    }
    float sq = (lane < 32) ? ssq2[(size_t)t * 32 + lane] : 0.f;
    sq = wave_sum(sq);
    const float rs2 = rsqrtf(sq * (1.f / 2048.f) + EPSV);
    float w0 = 0.f, w1 = 0.f;
#pragma unroll 1
    for (int half = 0; half < 2; ++half) {
      const int idv = half ? id1 : id0;
      int wv = 0;
      u32x4 rr[2][GROWS];
#pragma unroll
      for (int k = 0; k < GROWS; ++k) {
        const int e = __builtin_amdgcn_readlane(idv, k);
        rr[0][k] = *(const u32x4*)(ub + (size_t)e * 1024 + lane * 16);
      }
#pragma unroll
      for (int gi = 0; gi < 64 / GROWS; ++gi) {
        const int j0 = gi * GROWS;
        if (gi + 1 < 64 / GROWS) {
#pragma unroll
          for (int k = 0; k < GROWS; ++k) {
            const int e = __builtin_amdgcn_readlane(idv, j0 + GROWS + k);
            rr[(gi + 1) & 1][k] = *(const u32x4*)(ub + (size_t)e * 1024 + lane * 16);
          }
        }
        int dv[GROWS];
#pragma unroll
        for (int k = 0; k < GROWS; ++k) {
          int d = 0;
#pragma unroll
          for (int m = 0; m < 4; ++m) {
            const unsigned w = rr[gi & 1][k][m];
            const int lo = (int)(w & 0x0f0f0f0fu), hi = (int)((w >> 4) & 0x0f0f0f0fu);
            d = __builtin_amdgcn_sdot4(lo, xlo[m], d, false);
            d = __builtin_amdgcn_sdot4(hi, xhi[m], d, false);
          }
          dv[k] = d;
        }
        int a4[4], a2[2];
#pragma unroll
        for (int k = 0; k < 4; ++k) {
          const int mine = b5 ? dv[k + 4] : dv[k], oth = b5 ? dv[k] : dv[k + 4];
          a4[k] = mine + __shfl_xor(oth, 32);
        }
#pragma unroll
        for (int k = 0; k < 2; ++k) {
          const int mine = b4 ? a4[k + 2] : a4[k], oth = b4 ? a4[k] : a4[k + 2];
          a2[k] = mine + __shfl_xor(oth, 16);
        }
        int c1;
        {
          const int mine = b3 ? a2[1] : a2[0], oth = b3 ? a2[0] : a2[1];
          c1 = mine + __shfl_xor(oth, 8);
        }
        c1 += __shfl_xor(c1, 4);
        c1 += __shfl_xor(c1, 2);
        c1 += __shfl_xor(c1, 1);
        const int val = __shfl(c1, srcl);
        if ((lane & ~7) == j0) wv = val;
      }
      const float su = half ? su1 : su0;
      const float a = gelu_((float)(wv - 8 * sumq) * (su * sx * rs2));
      if (half) w1 = a * g1 * sv1; else w0 = a * g0 * sv0;
    }
    f32x2 acc[16];
#pragma unroll
    for (int i = 0; i < 16; ++i) acc[i] = (f32x2){0.f, 0.f};
    const float csum = wave_sum(w0 + w1);
#pragma unroll 1
    for (int half = 0; half < 2; ++half) {
      const int idv = half ? id1 : id0;
      const float wvv = half ? w1 : w0;
      u32x4 rr[2][GROWS];
#pragma unroll
      for (int k = 0; k < GROWS; ++k) {
        const int e = __builtin_amdgcn_readlane(idv, k);
        rr[0][k] = *(const u32x4*)(vb + (size_t)e * 1024 + lane * 16);
      }
#pragma unroll
      for (int gi = 0; gi < 64 / GROWS; ++gi) {
        const int j0 = gi * GROWS;
        if (gi + 1 < 64 / GROWS) {
#pragma unroll
          for (int k = 0; k < GROWS; ++k) {
            const int e = __builtin_amdgcn_readlane(idv, j0 + GROWS + k);
            rr[(gi + 1) & 1][k] = *(const u32x4*)(vb + (size_t)e * 1024 + lane * 16);
          }
        }
#pragma unroll
        for (int k = 0; k < GROWS; ++k) {
          const float wkk = __builtin_bit_cast(float, __builtin_amdgcn_readlane(__builtin_bit_cast(int, wvv), j0 + k));
          const f32x2 w2 = {wkk, wkk};
#pragma unroll
          for (int m = 0; m < 4; ++m) {
            const unsigned w = rr[gi & 1][k][m];
            const unsigned lo = w & 0x0f0f0f0fu, hi = (w >> 4) & 0x0f0f0f0fu;
            acc[m * 4 + 0] += w2 * (f32x2){ub0(lo), ub1(lo)};
            acc[m * 4 + 1] += w2 * (f32x2){ub2(lo), ub3(lo)};
            acc[m * 4 + 2] += w2 * (f32x2){ub0(hi), ub1(hi)};
            acc[m * 4 + 3] += w2 * (f32x2){ub2(hi), ub3(hi)};
          }
        }
      }
    }
    const float off = 8.f * csum;
    float ss = 0.f;
#pragma unroll
    for (int q = 0; q < 8; ++q) {
      f32x4 v = *(const f32x4*)(orow + q * 4);
      acc[q * 2][0] += v[0] - off;
      acc[q * 2][1] += v[1] - off;
      acc[q * 2 + 1][0] += v[2] - off;
      acc[q * 2 + 1][1] += v[3] - off;
      ss += acc[q * 2][0] * acc[q * 2][0] + acc[q * 2][1] * acc[q * 2][1] + acc[q * 2 + 1][0] * acc[q * 2 + 1][0] +
            acc[q * 2 + 1][1] * acc[q * 2 + 1][1];
    }
    ss = wave_sum(ss);
    const float rs3 = rsqrtf(ss * (1.f / 2048.f) + EPSV);
#pragma unroll
    for (int q = 0; q < 8; ++q) {
      f32x4 wf = *(const f32x4*)(p.norm_final_w + lane * 32 + q * 4);
      f32x4 o = {acc[q * 2][0] * rs3 * wf[0], acc[q * 2][1] * rs3 * wf[1], acc[q * 2 + 1][0] * rs3 * wf[2],
                 acc[q * 2 + 1][1] * rs3 * wf[3]};
      *(f32x4*)(orow + q * 4) = o;
    }
  }
}

__global__ void __launch_bounds__(NTHR, 2) fwd_kernel(Params p) {
  __shared__ __attribute__((aligned(16))) unsigned char smem[SMEM_BYTES];
  cg::grid_group grid = cg::this_grid();
  unsigned char* ws = p.ws;
#define PHASE_ON(n) (p.phase_lo <= (n) && (n) <= p.phase_hi)
#define PHASE_SYNC(n) if (p.coop && PHASE_ON(n) && (n) < p.phase_hi) grid.sync();
  for (int rep = 0; rep < (DBL_PHASE == 0 ? 2 : 1); ++rep)
  if (PHASE_ON(0)) phase_prep(p, smem);
  PHASE_SYNC(0)
  for (int rep = 0; rep < (DBL_PHASE == 1 ? 2 : 1); ++rep)
  if (PHASE_ON(1)) {
    for (int u = blockIdx.x; u < 128 * 37; u += gridDim.x)
      gemm_tile<1>(p, smem, (const bf16_t*)(ws + OFF_XB), (const bf16_t*)(ws + OFF_WINT), u & 127, u >> 7);
  }
  PHASE_SYNC(1)
  for (int rep = 0; rep < (DBL_PHASE == 2 ? 2 : 1); ++rep)
  if (PHASE_ON(2)) {
    for (int u = blockIdx.x; u < 2048; u += gridDim.x) ssd_local_unit(p, smem, u);
    for (int u = blockIdx.x; u < 2048; u += gridDim.x) lru_local_unit(p, smem, u);
  }
  PHASE_SYNC(2)
  if (PHASE_ON(3)) phase_carry(p);
  PHASE_SYNC(3)
  for (int rep = 0; rep < (DBL_PHASE == 4 ? 2 : 1); ++rep)
  if (PHASE_ON(4)) phase_mix_final(p);
  PHASE_SYNC(4)
  for (int rep = 0; rep < (DBL_PHASE == 5 ? 2 : 1); ++rep)
  if (PHASE_ON(5)) {
    for (int u = blockIdx.x; u < 128 * 16; u += gridDim.x)
      gemm_tile<2>(p, smem, (const bf16_t*)(ws + OFF_XB), (const bf16_t*)(ws + OFF_WOUTT), u & 127, u >> 7);
  }
  PHASE_SYNC(5)
  for (int rep = 0; rep < (DBL_PHASE == 6 ? 2 : 1); ++rep)
  if (PHASE_ON(6)) {
    for (int u = blockIdx.x; u < 128 * 16; u += gridDim.x)
      gemm_tile<3>(p, smem, (const bf16_t*)(ws + OFF_X1B), (const bf16_t*)(ws + OFF_WQT), u & 127, u >> 7);
    convert_uv(p);
  }
  PHASE_SYNC(6)
  for (int rep = 0; rep < (DBL_PHASE == 7 ? 2 : 1); ++rep)
  if (PHASE_ON(7)) {
    for (int u = blockIdx.x; u < 2048; u += gridDim.x) topk_unit(p, smem, u);
  }
  PHASE_SYNC(7)
  if (PHASE_ON(8)) phase_gather(p);
}

extern "C" void kernel_launch(void* const* d_in, const int* in_sizes, int n_in, void* d_out, int out_size,
                              void* d_ws, size_t ws_size, hipStream_t stream) {
  Params p{};
  const float** fp = (const float**)&p;
  for (int i = 0; i < 23; ++i) fp[i] = (const float*)d_in[i];
  p.out = (float*)d_out;
  p.ws = (unsigned char*)d_ws;
  static int grid_blocks = 0;
  if (!grid_blocks) {
    int dev = 0, cus = 0, per_cu = 0;
    hipGetDevice(&dev);
    hipDeviceGetAttribute(&cus, hipDeviceAttributeMultiprocessorCount, dev);
    hipOccupancyMaxActiveBlocksPerMultiprocessor(&per_cu, fwd_kernel, NTHR, 0);
    if (per_cu < 1) per_cu = 1;
    if (per_cu > 2) per_cu = 2;
    grid_blocks = cus * per_cu;
  }
#if SINGLE_LAUNCH
  p.phase_lo = 0; p.phase_hi = 8; p.coop = 1;
  void* args[] = {&p};
  hipError_t e = hipLaunchCooperativeKernel((void*)fwd_kernel, dim3(grid_blocks), dim3(NTHR), args, 0, stream);
  if (e != hipSuccess) fprintf(stderr, "cooperative launch failed: %s (grid %d)\n", hipGetErrorString(e), grid_blocks);
#else
  for (int ph = 0; ph <= 8; ++ph) {
    p.phase_lo = ph; p.phase_hi = ph; p.coop = 0;
    hipLaunchKernelGGL(fwd_kernel, dim3(grid_blocks), dim3(NTHR), 0, stream, p);
  }
#endif
}
```

```cpp
#include <hip/hip_runtime.h>
#include <hip/hip_cooperative_groups.h>
#include <cstdio>
namespace cg = cooperative_groups;

#ifndef DBL_PHASE
#define DBL_PHASE -1
#endif
#ifndef SINGLE_LAUNCH
#define SINGLE_LAUNCH 1
#endif

typedef unsigned short bf16_t;
typedef short bf16x8 __attribute__((ext_vector_type(8)));
typedef float f32x4 __attribute__((ext_vector_type(4)));
typedef unsigned u32x4 __attribute__((ext_vector_type(4)));
typedef unsigned u32x2 __attribute__((ext_vector_type(2)));
typedef __bf16 bf2_t __attribute__((ext_vector_type(2)));

#define T_TOK 16384
#define DM 2048
#define LDP 4736
#define NPAD1 4864
#define NTHR 512
#define HTHR 256
#define SMEM_HALF 73728
#define SMEM_BYTES 147456
#define EPSV 1e-6f
#define MIB ((size_t)1 << 20)

#define OFF_XB (0 * MIB)
#define OFF_PROJ (64 * MIB)
#define OFF_X1B (64 * MIB)
#define OFF_Q (128 * MIB)
#define OFF_IDX (192 * MIB)
#define OFF_G (200 * MIB)
#define OFF_HLOC (212 * MIB)
#define OFF_CUMA (276 * MIB)
#define OFF_YPART (340 * MIB)
#define OFF_ST (372 * MIB)
#define OFF_WINT (436 * MIB)
#define OFF_WOUTT (455 * MIB)
#define OFF_WQT (463 * MIB)
#define OFF_WAT (471 * MIB)
#define OFF_WXT (471 * MIB + 131072)
#define OFF_KEYSB (471 * MIB + 262144)
#define OFF_RS1 (472 * MIB)
#define OFF_ACS (472 * MIB + 65536)
#define OFF_LCARRY (OFF_ACS + MIB)
#define OFF_SSQ (OFF_LCARRY + 524288)
#define OFF_SSQ2 (OFF_SSQ + MIB)
#define OFF_SCALES (OFF_SSQ2 + 2 * MIB)

struct Params {
  const float *x, *norm_mix_w, *w_in, *lru_conv_w, *lru_conv_b, *lru_wa, *lru_ba, *lru_wx, *lru_bx, *lru_lambda;
  const float *ssd_conv_w, *ssd_conv_b, *ssd_dt_bias, *ssd_a_log, *ssd_d, *ssd_norm_w, *w_out, *norm_ffn_w, *peer_wq;
  const float *peer_sub_keys, *peer_u, *peer_v, *norm_final_w;
  float* out;
  unsigned char* ws;
  int phase_lo, phase_hi, coop, pad0;
};

__device__ __forceinline__ unsigned pk2(float lo, float hi) {
  unsigned r;
  asm("v_cvt_pk_bf16_f32 %0, %1, %2" : "=v"(r) : "v"(lo), "v"(hi));
  return r;
}
__device__ __forceinline__ float bf2f(bf16_t v) { return __uint_as_float(((unsigned)v) << 16); }
__device__ __forceinline__ float bflo(unsigned u) { return __uint_as_float(u << 16); }
__device__ __forceinline__ float bfhi(unsigned u) { return __uint_as_float(u & 0xffff0000u); }
__device__ __forceinline__ float wave_sum(float v) {
#pragma unroll
  for (int o = 32; o > 0; o >>= 1) v += __shfl_xor(v, o);
  return v;
}
__device__ __forceinline__ float sigmoid_(float x) { return 1.f / (1.f + __expf(-x)); }
__device__ __forceinline__ float silu_(float x) { return x * sigmoid_(x); }
__device__ __forceinline__ float gelu_(float x) {
  float u = 0.7978845608028654f * (x + 0.044715f * x * x * x);
  return x * sigmoid_(2.f * u);
}
__device__ __forceinline__ float softplus_(float x) { return fmaxf(x, 0.f) + log1pf(__expf(-fabsf(x))); }
__device__ __forceinline__ f32x4 mfma16(bf16x8 a, bf16x8 b, f32x4 c) {
  return __builtin_amdgcn_mfma_f32_16x16x32_bf16(a, b, c, 0, 0, 0);
}
__device__ __forceinline__ bf16x8 as_frag(u32x4 v) { return __builtin_bit_cast(bf16x8, v); }
__device__ __forceinline__ int sw256(int row, int chunk) { return row * 256 + ((chunk ^ (row & 15)) << 4); }
__device__ __forceinline__ int sw128(int row, int chunk) { return row * 128 + ((chunk ^ ((row >> 1) & 7)) << 4); }

__device__ __forceinline__ float rs_from_ssq2(const float* ssq2, int row) {
  const f32x4* pp = (const f32x4*)(ssq2 + (size_t)row * 32);
  float s = 0.f;
#pragma unroll
  for (int i = 0; i < 8; ++i) { f32x4 v = pp[i]; s += v[0] + v[1] + v[2] + v[3]; }
  return rsqrtf(s * (1.f / 2048.f) + EPSV);
}
__device__ __forceinline__ float rs_from_ssq(const float* ssq, int row) {
  const f32x4* pp = (const f32x4*)(ssq + (size_t)row * 16);
  float s = 0.f;
#pragma unroll
  for (int i = 0; i < 4; ++i) { f32x4 v = pp[i]; s += v[0] + v[1] + v[2] + v[3]; }
  return rsqrtf(s * (1.f / 1024.f) + EPSV);
}

__device__ void transpose_tile(const float* __restrict__ src, int ld_src, int r0, int c0, int c_valid,
                               bf16_t* __restrict__ dst, int ld_dst, const float* __restrict__ scale, int scale_from,
                               float* tile, bool valid) {
  const int tid = threadIdx.x & 255;
  {
    const int j = tid & 63, i0 = tid >> 6;
#pragma unroll 4
    for (int ii = 0; ii < 16; ++ii) {
      const int i = i0 + 4 * ii;
      float v = 0.f;
      if (valid && c0 + j < c_valid) {
        v = src[(size_t)(r0 + i) * ld_src + c0 + j];
        if (scale != nullptr && (r0 + i) >= scale_from) v *= scale[r0 + i - scale_from];
      }
      tile[i * 65 + j] = v;
    }
  }
  __syncthreads();
  {
    const int i = tid & 63, j0 = tid >> 6;
#pragma unroll 4
    for (int jj = 0; jj < 16; ++jj) {
      const int j = j0 + 4 * jj;
      if (valid) dst[(size_t)(c0 + j) * ld_dst + r0 + i] = (bf16_t)(pk2(tile[i * 65 + j], 0.f) & 0xffffu);
    }
  }
  __syncthreads();
}

__device__ void phase_prep(const Params& p, unsigned char* smem) {
  const int tid = threadIdx.x, lane = tid & 63, wid = tid >> 6, hb = tid >> 8;
  unsigned char* ws = p.ws;
  bf16_t* xb = (bf16_t*)(ws + OFF_XB);
  float* rs1 = (float*)(ws + OFF_RS1);
  for (int t = blockIdx.x * 8 + wid; t < T_TOK; t += gridDim.x * 8) {
    const float* xr = p.x + (size_t)t * DM;
    bf16_t* xo = xb + (size_t)t * DM;
    float ss = 0.f;
#pragma unroll
    for (int c = 0; c < 8; ++c) {
      f32x4 v = *(const f32x4*)(xr + c * 256 + lane * 4);
      ss += v[0] * v[0] + v[1] * v[1] + v[2] * v[2] + v[3] * v[3];
      u32x2 o = {pk2(v[0], v[1]), pk2(v[2], v[3])};
      *(u32x2*)(xo + c * 256 + lane * 4) = o;
    }
    ss = wave_sum(ss);
    if (lane == 0) rs1[t] = rsqrtf(ss * (1.f / 2048.f) + EPSV);
  }
  float* tile = (float*)(smem + hb * SMEM_HALF);
  const int NT_WIN = 32 * 76, NT_SQ = 32 * 32;
  const int total = NT_WIN + 2 * NT_SQ + 32;
  for (int u0 = blockIdx.x * 2; u0 < total; u0 += gridDim.x * 2) {
    const bool valid = (u0 + hb) < total;
    const int u = valid ? (u0 + hb) : u0;
    if (u < NT_WIN) {
      const int ri = u & 31, cj = u >> 5;
      transpose_tile(p.w_in, 4624, ri * 64, cj * 64, 4624, (bf16_t*)(ws + OFF_WINT), 2048, p.norm_mix_w, 0, tile, valid);
    } else if (u < NT_WIN + NT_SQ) {
      const int v = u - NT_WIN, ri = v & 31, cj = v >> 5;
      transpose_tile(p.w_out, 2048, ri * 64, cj * 64, 2048, (bf16_t*)(ws + OFF_WOUTT), 2048, p.ssd_norm_w, 1024, tile, valid);
    } else if (u < NT_WIN + 2 * NT_SQ) {
      const int v = u - NT_WIN - NT_SQ, ri = v & 31, cj = v >> 5;
      transpose_tile(p.peer_wq, 2048, ri * 64, cj * 64, 2048, (bf16_t*)(ws + OFF_WQT), 2048, p.norm_ffn_w, 0, tile, valid);
    } else {
      const int v = u - NT_WIN - 2 * NT_SQ;
      const int h = v & 15;
      const float* src = (v < 16 ? p.lru_wa : p.lru_wx) + (size_t)h * 4096;
      bf16_t* dst = (bf16_t*)(ws + (v < 16 ? OFF_WAT : OFF_WXT)) + (size_t)h * 4096;
      transpose_tile(src, 64, 0, 0, 64, dst, 64, nullptr, 0, tile, valid);
    }
  }
  {
    bf16_t* kb = (bf16_t*)(ws + OFF_KEYSB);
    for (int i = blockIdx.x * NTHR + tid; i < 65536; i += gridDim.x * NTHR) {
      f32x4 v = *(const f32x4*)(p.peer_sub_keys + (size_t)i * 4);
      u32x2 o = {pk2(v[0], v[1]), pk2(v[2], v[3])};
      *(u32x2*)(kb + (size_t)i * 4) = o;
    }
  }
}

namespace pg8 {
#define PG8_LAS __attribute__((address_space(3)))
constexpr int BM = 256, BK = 64, HALF = 128, HTB = HALF * BK * 2;
__device__ __forceinline__ int lds_byte(int r, int c) { const int st = (r >> 4) * 2 + (c >> 5), rr = r & 15, cc = c & 31, ob = rr * 64 + cc * 2; return st * 1024 + (ob ^ (((ob >> 9) & 1) << 5)); }
__device__ __forceinline__ void stage_rc(int b, int& R, int& C) { const int st = b / 1024, sb = b % 1024, swz = sb ^ (((sb >> 9) & 1) << 5); R = (st >> 1) * 16 + swz / 64; C = (st & 1) * 32 + (swz % 64) / 2; }
struct Unit { int pm, pn; };
struct Gemm { const bf16_t* A; const bf16_t* Bt; int M, N, K; };
struct SimpleOrder {
  int nM, nwg, G, c;
  __device__ void init(int M, int N, int G_, int c_) { nM = M / BM; nwg = nM * (N / BM); G = G_; c = c_; }
  __device__ bool next(int i, Unit& u) const { const int L = i * G + c; if (L >= nwg) return false; u.pm = L % nM; u.pn = L / nM; return true; }
};
struct Epi1 {
  static constexpr bool MID = false;
  const float* rs1; bf16_t* proj;
  __device__ __forceinline__ void mid(f32x4 (&)[2][2][4][2], const Unit&, int, int) const {}
  __device__ __forceinline__ void operator()(const f32x4 (&acc)[2][2][4][2], const Unit& u, int wr, int wc, int fr, int fq) const {
    const int row0 = u.pm * BM + wr * 64 + fr, col0 = u.pn * BM + wc * 32 + 4 * fq;
#pragma unroll
    for (int ai = 0; ai < 2; ++ai)
#pragma unroll
      for (int m = 0; m < 4; ++m) {
        const int row = row0 + ai * HALF + m * 16;
        const float s = rs1[row];
#pragma unroll
        for (int bj = 0; bj < 2; ++bj)
#pragma unroll
          for (int n = 0; n < 2; ++n) {
            const int col = col0 + bj * HALF + n * 16;
            if (col < LDP) {
              f32x4 v = acc[ai][bj][m][n] * s;
              u32x2 o = {pk2(v[0], v[1]), pk2(v[2], v[3])};
              *(u32x2*)(proj + (size_t)row * LDP + col) = o;
            }
          }
      }
  }
};
struct Epi2 {
  static constexpr bool MID = true;
  const float* x; float* out; bf16_t* x1b; float* ssq2; const float* ssq;
  __device__ __forceinline__ void mid(f32x4 (&acc)[2][2][4][2], const Unit& u, int wr, int fr) const {
#pragma unroll
    for (int ai = 0; ai < 2; ++ai)
#pragma unroll
      for (int m = 0; m < 4; ++m) {
        const float s = rs_from_ssq(ssq, u.pm * BM + wr * 64 + fr + ai * HALF + m * 16);
#pragma unroll
        for (int bj = 0; bj < 2; ++bj)
#pragma unroll
          for (int n = 0; n < 2; ++n) acc[ai][bj][m][n] *= s;
        __builtin_amdgcn_sched_barrier(0);
      }
  }
  __device__ __forceinline__ void operator()(const f32x4 (&acc)[2][2][4][2], const Unit& u, int wr, int wc, int fr, int fq) const {
    const int row0 = u.pm * BM + wr * 64 + fr, col0 = u.pn * BM + wc * 32 + 4 * fq;
#pragma unroll
    for (int ai = 0; ai < 2; ++ai)
#pragma unroll
      for (int m = 0; m < 4; ++m) {
        const int row = row0 + ai * HALF + m * 16;
        float ss = 0.f;
#pragma unroll
        for (int bj = 0; bj < 2; ++bj)
#pragma unroll
          for (int n = 0; n < 2; ++n) {
            const int col = col0 + bj * HALF + n * 16;
            f32x4 xr = *(const f32x4*)(x + (size_t)row * DM + col);
            f32x4 v = acc[ai][bj][m][n] + xr;
            *(f32x4*)(out + (size_t)row * DM + col) = v;
            u32x2 o = {pk2(v[0], v[1]), pk2(v[2], v[3])};
            *(u32x2*)(x1b + (size_t)row * DM + col) = o;
            ss += v[0] * v[0] + v[1] * v[1] + v[2] * v[2] + v[3] * v[3];
          }
        ss += __shfl_xor(ss, 16);
        ss += __shfl_xor(ss, 32);
        if (fq == 0) ssq2[(size_t)row * 32 + u.pn * 4 + wc] = ss;
        __builtin_amdgcn_sched_barrier(0);
      }
  }
};
struct Epi3 {
  static constexpr bool MID = false;
  const float* ssq2; bf16_t* q;
  __device__ __forceinline__ void mid(f32x4 (&)[2][2][4][2], const Unit&, int, int) const {}
  __device__ __forceinline__ void operator()(const f32x4 (&acc)[2][2][4][2], const Unit& u, int wr, int wc, int fr, int fq) const {
    const int row0 = u.pm * BM + wr * 64 + fr, col0 = u.pn * BM + wc * 32 + 4 * fq;
#pragma unroll
    for (int ai = 0; ai < 2; ++ai)
#pragma unroll
      for (int m = 0; m < 4; ++m) {
        const int row = row0 + ai * HALF + m * 16;
        const float s = rs_from_ssq2(ssq2, row);
#pragma unroll
        for (int bj = 0; bj < 2; ++bj)
#pragma unroll
          for (int n = 0; n < 2; ++n) {
            const int col = col0 + bj * HALF + n * 16;
            f32x4 v = acc[ai][bj][m][n] * s;
            u32x2 o = {pk2(v[0], v[1]), pk2(v[2], v[3])};
            *(u32x2*)(q + (size_t)row * DM + col) = o;
          }
      }
  }
};

template <class Epi, class Sched, int KROT>
__device__ __forceinline__ void gemm_phase(PG8_LAS unsigned char* lds, const Gemm g, const Sched& S, const Epi& E) {
  const int tid = threadIdx.x, wid = __builtin_amdgcn_readfirstlane(tid >> 6), lane = tid & 63, wr = wid >> 2, wc = wid & 3, fr = lane & 15, fq = lane >> 4;
  const int K = g.K, nt = K / BK;
#define PG8_KX(t) (((t) + KROT) & 31)
  unsigned voff[2];
#pragma unroll
  for (int i = 0; i < 2; ++i) { int R, C; stage_rc(tid * 16 + i * 8192, R, C); voff[i] = (unsigned)(R * K + C) * 2u; }
  const size_t kstep = (size_t)(BK * 2);
  const size_t hstep = (size_t)HALF * K * 2;
  const size_t tstep = 2 * hstep;
  const unsigned ldsw = (unsigned)wid * 1024u;
  const int aoff = lds_byte(wr * 64 + fr, fq * 8), boff = lds_byte(wc * 32 + fr, fq * 8);
#define PG8_SA(b, h) (((b) * 2 + (h)) * HTB)
#define PG8_SB(b, h) ((4 + (b) * 2 + (h)) * HTB)
#define PG8_STAGE(bufoff, gbase) do { _Pragma("unroll") for (int _i = 0; _i < 2; ++_i) \
    __builtin_amdgcn_global_load_lds((const unsigned*)((const char*)(gbase) + voff[_i]), (PG8_LAS unsigned*)(lds + (bufoff) + ldsw + _i * 8192), 16, 0, 0); } while (0)
#define PG8_LDA(dst, b, h) do { _Pragma("unroll") for (int m = 0; m < 4; ++m) _Pragma("unroll") for (int k = 0; k < 2; ++k) dst[m][k] = *(const PG8_LAS bf16x8*)(lds + PG8_SA(b, h) + aoff + m * 2048 + k * 1024); } while (0)
#define PG8_LDB(dst, b, h) do { _Pragma("unroll") for (int n = 0; n < 2; ++n) _Pragma("unroll") for (int k = 0; k < 2; ++k) dst[n][k] = *(const PG8_LAS bf16x8*)(lds + PG8_SB(b, h) + boff + n * 2048 + k * 1024); } while (0)
#define PG8_MMA(ai, bj, At, Bt) do { __builtin_amdgcn_s_setprio(1); _Pragma("unroll") for (int m = 0; m < 4; ++m) _Pragma("unroll") for (int n = 0; n < 2; ++n) _Pragma("unroll") for (int k = 0; k < 2; ++k) \
    acc[ai][bj][m][n] = __builtin_amdgcn_mfma_f32_16x16x32_bf16(Bt[n][k], At[m][k], acc[ai][bj][m][n], 0, 0, 0); __builtin_amdgcn_s_setprio(0); } while (0)
#define PG8_WAIT_V(n) asm volatile("s_waitcnt vmcnt(" #n ")" ::: "memory")
#define PG8_WAIT_L(n) asm volatile("s_waitcnt lgkmcnt(" #n ")" ::: "memory")
#define PG8_BAR __builtin_amdgcn_s_barrier()
#define PG8_SCHED __builtin_amdgcn_sched_barrier(0)
  Unit cur, nxt; int ui = 0;
  if (!S.next(0, cur)) return;
  f32x4 acc[2][2][4][2];
#pragma unroll
  for (int a = 0; a < 2; ++a)
#pragma unroll
    for (int b = 0; b < 2; ++b)
#pragma unroll
      for (int m = 0; m < 4; ++m)
#pragma unroll
        for (int n = 0; n < 2; ++n) acc[a][b][m][n] = (f32x4){0.f, 0.f, 0.f, 0.f};
  bf16x8 At[4][2], B0[2][2], B1[2][2];
  const char* cA = (const char*)g.A + (size_t)cur.pm * tstep; const char* cB = (const char*)g.Bt + (size_t)cur.pn * tstep;
  { const char* a0 = cA + (size_t)PG8_KX(0) * kstep; const char* b0 = cB + (size_t)PG8_KX(0) * kstep;
    const char* a1 = cA + (size_t)PG8_KX(1) * kstep; const char* b1 = cB + (size_t)PG8_KX(1) * kstep;
    PG8_STAGE(PG8_SB(0, 0), b0); PG8_STAGE(PG8_SA(0, 0), a0); PG8_STAGE(PG8_SB(0, 1), b0 + hstep); PG8_STAGE(PG8_SA(0, 1), a0 + hstep);
    if (wr == 1) PG8_BAR;
    PG8_WAIT_V(4); PG8_BAR;
    PG8_STAGE(PG8_SB(1, 0), b1); PG8_STAGE(PG8_SA(1, 0), a1); PG8_STAGE(PG8_SB(1, 1), b1 + hstep);
    PG8_WAIT_V(6); PG8_BAR; }
  for (;;) {
    const bool has_next = S.next(ui + 1, nxt);
    const char* nA = has_next ? (const char*)g.A + (size_t)nxt.pm * tstep : cA; const char* nB = has_next ? (const char*)g.Bt + (size_t)nxt.pn * tstep : cB;
#define PG8_ITER(t) {\
      const bool last = (t == nt - 2);\
      const char* a1 = cA + (size_t)PG8_KX(t + 1) * kstep;\
      const char* a2 = last ? nA + (size_t)PG8_KX(0) * kstep : cA + (size_t)PG8_KX(t + 2) * kstep;\
      const char* b2 = last ? nB + (size_t)PG8_KX(0) * kstep : cB + (size_t)PG8_KX(t + 2) * kstep;\
      const char* a3 = last ? nA + (size_t)PG8_KX(1) * kstep : cA + (size_t)PG8_KX(t + 3) * kstep;\
      const char* b3 = last ? nB + (size_t)PG8_KX(1) * kstep : cB + (size_t)PG8_KX(t + 3) * kstep;\
      PG8_LDB(B0, 0, 0); PG8_SCHED; PG8_LDA(At, 0, 0); PG8_STAGE(PG8_SA(1, 1), a1 + hstep);\
      PG8_WAIT_L(8); PG8_BAR; PG8_WAIT_L(0); PG8_MMA(0, 0, At, B0); PG8_BAR; PG8_SCHED;\
      PG8_LDB(B1, 0, 1); PG8_STAGE(PG8_SB(0, 0), b2);\
      PG8_BAR; PG8_WAIT_L(0); PG8_MMA(0, 1, At, B1); PG8_BAR;\
      PG8_LDA(At, 0, 1); PG8_STAGE(PG8_SA(0, 0), a2);\
      PG8_BAR; PG8_WAIT_L(0); PG8_MMA(1, 0, At, B0); PG8_BAR; PG8_SCHED;\
      PG8_STAGE(PG8_SB(0, 1), b2 + hstep);\
      PG8_WAIT_V(6); PG8_BAR; PG8_MMA(1, 1, At, B1); PG8_BAR;\
      PG8_LDB(B0, 1, 0); PG8_SCHED; PG8_LDA(At, 1, 0); PG8_STAGE(PG8_SA(0, 1), a2 + hstep);\
      PG8_WAIT_L(8); PG8_BAR; PG8_WAIT_L(0); PG8_MMA(0, 0, At, B0); PG8_BAR; PG8_SCHED;\
      PG8_LDB(B1, 1, 1); PG8_STAGE(PG8_SB(1, 0), b3);\
      PG8_BAR; PG8_WAIT_L(0); PG8_MMA(0, 1, At, B1); PG8_BAR;\
      PG8_LDA(At, 1, 1); PG8_STAGE(PG8_SA(1, 0), a3);\
      PG8_BAR; PG8_WAIT_L(0); PG8_MMA(1, 0, At, B0); PG8_BAR; PG8_SCHED;\
      PG8_STAGE(PG8_SB(1, 1), b3 + hstep);\
      PG8_WAIT_V(6); PG8_BAR; PG8_MMA(1, 1, At, B1); PG8_BAR;\
}
    if (Epi::MID) {
      for (int t = 0; t < 16; t += 2) PG8_ITER(t)
      E.mid(acc, cur, wr, fr);
      for (int t = 16; t < nt; t += 2) PG8_ITER(t)
    } else {
      for (int t = 0; t < nt; t += 2) PG8_ITER(t)
    }
#undef PG8_ITER
    E(acc, cur, wr, wc, fr, fq);
    if (!has_next) break;
#pragma unroll
    for (int a = 0; a < 2; ++a)
#pragma unroll
      for (int b = 0; b < 2; ++b)
#pragma unroll
        for (int m = 0; m < 4; ++m)
#pragma unroll
          for (int n = 0; n < 2; ++n) acc[a][b][m][n] = (f32x4){0.f, 0.f, 0.f, 0.f};
    cur = nxt; cA = nA; cB = nB; ++ui;
  }
  PG8_WAIT_V(0);
  if (wr == 0) PG8_BAR;
  PG8_BAR;
#undef PG8_KX
#undef PG8_SA
#undef PG8_SB
#undef PG8_STAGE
#undef PG8_LDA
#undef PG8_LDB
#undef PG8_MMA
#undef PG8_WAIT_V
#undef PG8_WAIT_L
#undef PG8_BAR
#undef PG8_SCHED
}
}

__device__ __forceinline__ void conv8(const bf16_t* __restrict__ proj, int t, int tt_in_seq, int col,
                                      const float* __restrict__ cw, int ld_w, const float* __restrict__ cb, int ch,
                                      float* o) {
  f32x4 b0 = *(const f32x4*)(cb + ch), b1 = *(const f32x4*)(cb + ch + 4);
  o[0] = b0[0]; o[1] = b0[1]; o[2] = b0[2]; o[3] = b0[3];
  o[4] = b1[0]; o[5] = b1[1]; o[6] = b1[2]; o[7] = b1[3];
#pragma unroll
  for (int k = 0; k < 4; ++k) {
    if (tt_in_seq - 3 + k >= 0) {
      u32x4 v = *(const u32x4*)(proj + (size_t)(t - 3 + k) * LDP + col);
      f32x4 w0 = *(const f32x4*)(cw + k * ld_w + ch), w1 = *(const f32x4*)(cw + k * ld_w + ch + 4);
      o[0] += w0[0] * bflo(v[0]); o[1] += w0[1] * bfhi(v[0]);
      o[2] += w0[2] * bflo(v[1]); o[3] += w0[3] * bfhi(v[1]);
      o[4] += w1[0] * bflo(v[2]); o[5] += w1[1] * bfhi(v[2]);
      o[6] += w1[2] * bflo(v[3]); o[7] += w1[3] * bfhi(v[3]);
    }
  }
}
__device__ __forceinline__ void conv4(const bf16_t* __restrict__ proj, int t, int tt_in_seq, int col,
                                      const float* __restrict__ cw, int ld_w, const float* __restrict__ cb, int ch,
                                      float* o) {
  f32x4 b0 = *(const f32x4*)(cb + ch);
  o[0] = b0[0]; o[1] = b0[1]; o[2] = b0[2]; o[3] = b0[3];
#pragma unroll
  for (int k = 0; k < 4; ++k) {
    if (tt_in_seq - 3 + k >= 0) {
      u32x2 v = *(const u32x2*)(proj + (size_t)(t - 3 + k) * LDP + col);
      f32x4 w0 = *(const f32x4*)(cw + k * ld_w + ch);
      o[0] += w0[0] * bflo(v[0]); o[1] += w0[1] * bfhi(v[0]);
      o[2] += w0[2] * bflo(v[1]); o[3] += w0[3] * bfhi(v[1]);
    }
  }
}
__device__ __forceinline__ bf16x8 cfrag(const Params& p, const bf16_t* proj, int t, int tseq, int g, int n8) {
  float o[8];
  const int ch = 1280 + g * 128 + n8;
  conv8(proj, t, tseq, 3072 + ch, p.ssd_conv_w, 1536, p.ssd_conv_b, ch, o);
#pragma unroll
  for (int i = 0; i < 8; ++i) o[i] = silu_(o[i]);
  u32x4 r = {pk2(o[0], o[1]), pk2(o[2], o[3]), pk2(o[4], o[5]), pk2(o[6], o[7])};
  return as_frag(r);
}

__device__ void lru_local_unit(const Params& p, unsigned char* smem, int unit) {
  const int tid = threadIdx.x & 255, lane = tid & 63, wid = tid >> 6, l15 = lane & 15, q4 = lane >> 4;
  const int hh = unit & 15, c = (unit >> 4) & 15, b = unit >> 8;
  const int t0 = b * 2048 + c * 128, ch0 = hh * 64;
  unsigned char* ws = p.ws;
  const bf16_t* proj = (const bf16_t*)(ws + OFF_PROJ);
  float* R1 = (float*)smem;
  float* R2 = (float*)(smem + 33536);
  float* R3 = (float*)(smem + 33536 + 32768);
#pragma unroll 11
  for (int e = tid; e < 131 * 64; e += HTHR) {
    const int r = e >> 6, j = e & 63, tt = r - 3;
    float v = 0.f;
    if (c * 128 + tt >= 0) v = bf2f(proj[(size_t)(t0 + tt) * LDP + ch0 + j]);
    R1[e] = v;
  }
  __syncthreads();
  {
    const int j = tid & 63;
    const float cb = p.lru_conv_b[ch0 + j];
    const float w0 = p.lru_conv_w[0 * 1024 + ch0 + j], w1 = p.lru_conv_w[1 * 1024 + ch0 + j],
                w2 = p.lru_conv_w[2 * 1024 + ch0 + j], w3 = p.lru_conv_w[3 * 1024 + ch0 + j];
#pragma unroll 8
    for (int tt = tid >> 6; tt < 128; tt += 4) {
      R2[tt * 64 + j] = cb + w0 * R1[tt * 64 + j] + w1 * R1[(tt + 1) * 64 + j] + w2 * R1[(tt + 2) * 64 + j] +
                        w3 * R1[(tt + 3) * 64 + j];
    }
  }
  __syncthreads();
  {
    const bf16_t* waT = (const bf16_t*)(ws + OFF_WAT) + (size_t)hh * 4096;
    const bf16_t* wxT = (const bf16_t*)(ws + OFF_WXT) + (size_t)hh * 4096;
    f32x4 aa[2][4], ax[2][4];
#pragma unroll
    for (int i = 0; i < 2; ++i)
#pragma unroll
      for (int j = 0; j < 4; ++j) { aa[i][j] = (f32x4){0, 0, 0, 0}; ax[i][j] = (f32x4){0, 0, 0, 0}; }
#pragma unroll
    for (int ks = 0; ks < 2; ++ks) {
      bf16x8 af[2];
#pragma unroll
      for (int mi = 0; mi < 2; ++mi) {
        const float* src = R2 + (wid * 32 + mi * 16 + l15) * 64 + ks * 32 + q4 * 8;
        f32x4 v0 = *(const f32x4*)src, v1 = *(const f32x4*)(src + 4);
        u32x4 r = {pk2(v0[0], v0[1]), pk2(v0[2], v0[3]), pk2(v1[0], v1[1]), pk2(v1[2], v1[3])};
        af[mi] = as_frag(r);
      }
#pragma unroll
      for (int ni = 0; ni < 4; ++ni) {
        const size_t wo = (size_t)(ni * 16 + l15) * 64 + ks * 32 + q4 * 8;
        bf16x8 ba = as_frag(*(const u32x4*)(waT + wo));
        bf16x8 bx = as_frag(*(const u32x4*)(wxT + wo));
#pragma unroll
        for (int mi = 0; mi < 2; ++mi) {
          aa[mi][ni] = mfma16(af[mi], ba, aa[mi][ni]);
          ax[mi][ni] = mfma16(af[mi], bx, ax[mi][ni]);
        }
      }
    }
#pragma unroll
    for (int ni = 0; ni < 4; ++ni) {
      const int j = ni * 16 + l15;
      const float ba = p.lru_ba[ch0 + j], bx = p.lru_bx[ch0 + j];
      const float lam = p.lru_lambda[ch0 + j];
      const float spl = -8.f * log1pf(__expf(-lam));
#pragma unroll
      for (int mi = 0; mi < 2; ++mi)
#pragma unroll
        for (int r = 0; r < 4; ++r) {
          const int tt = wid * 32 + mi * 16 + q4 * 4 + r;
          const float rg = sigmoid_(aa[mi][ni][r] + ba);
          const float ig = sigmoid_(ax[mi][ni][r] + bx);
          const float log_a = spl * rg;
          const float av = __expf(log_a);
          const float xl = R2[tt * 64 + j];
          const float bv = sqrtf(fmaxf(-expm1f(2.f * log_a), 0.f)) * (ig * xl);
          R1[tt * 64 + j] = av;
          R2[tt * 64 + j] = bv;
        }
    }
  }
  __syncthreads();
  {
    const int j = tid & 63, seg = tid >> 6;
    float h = 0.f, Ac = 1.f;
#pragma unroll 4
    for (int s = 0; s < 32; ++s) {
      const int tt = seg * 32 + s;
      const float a = R1[tt * 64 + j], bb = R2[tt * 64 + j];
      h = a * h + bb;
      Ac *= a;
      R2[tt * 64 + j] = h;
      R1[tt * 64 + j] = Ac;
    }
    R3[seg * 64 + j] = h;
    R3[256 + seg * 64 + j] = Ac;
    __syncthreads();
    float cin = 0.f, Ain = 1.f;
    for (int s2 = 0; s2 < seg; ++s2) {
      cin = R3[256 + s2 * 64 + j] * cin + R3[s2 * 64 + j];
      Ain *= R3[256 + s2 * 64 + j];
    }
    float* hloc = (float*)(ws + OFF_HLOC);
    float* cumA = (float*)(ws + OFF_CUMA);
#pragma unroll 4
    for (int s = 0; s < 32; ++s) {
      const int tt = seg * 32 + s;
      const float hl = R2[tt * 64 + j] + R1[tt * 64 + j] * cin;
      const float Al = R1[tt * 64 + j] * Ain;
      hloc[(size_t)(t0 + tt) * 1024 + ch0 + j] = hl;
      cumA[(size_t)(t0 + tt) * 1024 + ch0 + j] = Al;
    }
  }
  __syncthreads();
}

__device__ void ssd_local_unit(const Params& p, unsigned char* smem, int unit) {
  const int tid = threadIdx.x & 255, lane = tid & 63, wid = tid >> 6, l15 = lane & 15, q4 = lane >> 4;
  const int hh = unit & 15, c = (unit >> 4) & 15, b = unit >> 8, g = hh >> 3;
  const int t0 = b * 2048 + c * 128, ts0 = c * 128;
  unsigned char* ws = p.ws;
  const bf16_t* proj = (const bf16_t*)(ws + OFF_PROJ);
  unsigned char* Bm = smem;
  unsigned char* XT = smem + 32768;
  unsigned char* Pw = smem + 49152 + wid * 4096;
  float* dts = (float*)(smem + 65536);
  float* acs = dts + 128;
  float* adt = acs + 128;
  if (tid < 128) {
    const float raw = bf2f(proj[(size_t)(t0 + tid) * LDP + 4608 + hh]);
    const float dtv = softplus_(raw + p.ssd_dt_bias[hh]);
    dts[tid] = dtv;
    adt[tid] = -__expf(p.ssd_a_log[hh]) * dtv;
  }
  __syncthreads();
  if (tid < 128) {
    float s = 0.f;
    for (int k = 0; k <= tid; ++k) s += adt[k];
    acs[tid] = s;
    ((float*)(ws + OFF_ACS))[(size_t)(t0 + tid) * 16 + hh] = s;
  }
  {
    const int chunk = tid & 15;
    const int ch = 1024 + g * 128 + chunk * 8;
#pragma unroll 4
    for (int i = 0; i < 8; ++i) {
      const int tt = (tid >> 4) + 16 * i;
      float o[8];
      conv8(proj, t0 + tt, ts0 + tt, 3072 + ch, p.ssd_conv_w, 1536, p.ssd_conv_b, ch, o);
#pragma unroll
      for (int e = 0; e < 8; ++e) o[e] = silu_(o[e]);
      u32x4 r = {pk2(o[0], o[1]), pk2(o[2], o[3]), pk2(o[4], o[5]), pk2(o[6], o[7])};
      *(u32x4*)(Bm + sw256(tt, chunk)) = r;
    }
  }
  __syncthreads();
  {
    const int pp = tid & 63;
    const int ch = hh * 64 + pp;
    const float cb = p.ssd_conv_b[ch];
    const float w0 = p.ssd_conv_w[ch], w1 = p.ssd_conv_w[1536 + ch], w2 = p.ssd_conv_w[2 * 1536 + ch],
                w3 = p.ssd_conv_w[3 * 1536 + ch];
#pragma unroll 2
    for (int i = 0; i < 4; ++i) {
      const int chunk = (tid >> 6) * 4 + i;
      const int tt0 = chunk * 8;
      float xv[11];
#pragma unroll
      for (int k = 0; k < 11; ++k) {
        const int tt = tt0 - 3 + k;
        xv[k] = (ts0 + tt >= 0) ? bf2f(proj[(size_t)(t0 + tt) * LDP + 3072 + ch]) : 0.f;
      }
      float o[8];
#pragma unroll
      for (int e = 0; e < 8; ++e) {
        const float cv = cb + w0 * xv[e] + w1 * xv[e + 1] + w2 * xv[e + 2] + w3 * xv[e + 3];
        o[e] = silu_(cv) * dts[tt0 + e];
      }
      u32x4 r = {pk2(o[0], o[1]), pk2(o[2], o[3]), pk2(o[4], o[5]), pk2(o[6], o[7])};
      *(u32x4*)(XT + sw256(pp, chunk)) = r;
    }
  }
  __syncthreads();
  bf16_t* ypart = (bf16_t*)(ws + OFF_YPART);
  const float Dh = p.ssd_d[hh];
#pragma unroll 1
  for (int mt = 0; mt < 2; ++mt) {
    const int M = wid * 2 + mt;
    const int lrow = M * 16 + l15;
    bf16x8 cf[4];
#pragma unroll
    for (int ks = 0; ks < 4; ++ks) cf[ks] = cfrag(p, proj, t0 + lrow, ts0 + lrow, g, ks * 32 + q4 * 8);
    const float acl = acs[lrow];
    const int ntmax = M | 1;
#pragma unroll 1
    for (int nt = 0; nt <= ntmax; ++nt) {
      f32x4 a4 = (f32x4){0, 0, 0, 0};
      if (nt <= M) {
#pragma unroll
        for (int ks = 0; ks < 4; ++ks) {
          bf16x8 bfr = *(const bf16x8*)(Bm + sw256(nt * 16 + l15, ks * 4 + q4));
          a4 = mfma16(bfr, cf[ks], a4);
        }
      }
      float pv[4];
#pragma unroll
      for (int r = 0; r < 4; ++r) {
        const int s = nt * 16 + q4 * 4 + r;
        pv[r] = (s <= lrow) ? a4[r] * __expf(acl - acs[s]) : 0.f;
      }
      u32x2 o = {pk2(pv[0], pv[1]), pk2(pv[2], pv[3])};
      const int chunk = nt * 2 + (q4 >> 1);
      *(u32x2*)(Pw + sw256(l15, chunk) + (q4 & 1) * 8) = o;
    }
    f32x4 ya[4];
#pragma unroll
    for (int pt = 0; pt < 4; ++pt) ya[pt] = (f32x4){0, 0, 0, 0};
    const int ksmax = M >> 1;
#pragma unroll 1
    for (int ks = 0; ks <= ksmax; ++ks) {
      bf16x8 pf = *(const bf16x8*)(Pw + sw256(l15, ks * 4 + q4));
#pragma unroll
      for (int pt = 0; pt < 4; ++pt) {
        bf16x8 xf = *(const bf16x8*)(XT + sw256(pt * 16 + l15, ks * 4 + q4));
        ya[pt] = mfma16(xf, pf, ya[pt]);
      }
    }
#pragma unroll
    for (int pt = 0; pt < 4; ++pt) {
      const int pc = pt * 16 + q4 * 4;
      const int ch = hh * 64 + pc;
      float xo[4];
      conv4(proj, t0 + lrow, ts0 + lrow, 3072 + ch, p.ssd_conv_w, 1536, p.ssd_conv_b, ch, xo);
      float y0 = ya[pt][0] + Dh * silu_(xo[0]), y1 = ya[pt][1] + Dh * silu_(xo[1]);
      float y2 = ya[pt][2] + Dh * silu_(xo[2]), y3 = ya[pt][3] + Dh * silu_(xo[3]);
      u32x2 o = {pk2(y0, y1), pk2(y2, y3)};
      *(u32x2*)(ypart + (size_t)(t0 + lrow) * 1024 + ch) = o;
    }
  }
  {
    f32x4 sa[2][4];
#pragma unroll
    for (int i = 0; i < 2; ++i)
#pragma unroll
      for (int j = 0; j < 4; ++j) sa[i][j] = (f32x4){0, 0, 0, 0};
    const float aend = acs[127];
#pragma unroll 1
    for (int ks = 0; ks < 4; ++ks) {
      float dec[8];
#pragma unroll
      for (int e = 0; e < 8; ++e) dec[e] = __expf(aend - acs[ks * 32 + q4 * 8 + e]);
      bf16x8 bd[2];
#pragma unroll
      for (int ni = 0; ni < 2; ++ni) {
        const int n = wid * 32 + ni * 16 + l15;
        float v[8];
#pragma unroll
        for (int e = 0; e < 8; ++e) {
          const int l = ks * 32 + q4 * 8 + e;
          const bf16_t raw = *(const bf16_t*)(Bm + sw256(l, n >> 3) + (n & 7) * 2);
          v[e] = bf2f(raw) * dec[e];
        }
        u32x4 r = {pk2(v[0], v[1]), pk2(v[2], v[3]), pk2(v[4], v[5]), pk2(v[6], v[7])};
        bd[ni] = as_frag(r);
      }
#pragma unroll
      for (int pt = 0; pt < 4; ++pt) {
        bf16x8 xf = *(const bf16x8*)(XT + sw256(pt * 16 + l15, ks * 4 + q4));
#pragma unroll
        for (int ni = 0; ni < 2; ++ni) sa[ni][pt] = mfma16(bd[ni], xf, sa[ni][pt]);
      }
    }
    float* St = (float*)(ws + OFF_ST) + (size_t)((b * 16 + c) * 16 + hh) * 8192;
#pragma unroll
    for (int ni = 0; ni < 2; ++ni)
#pragma unroll
      for (int pt = 0; pt < 4; ++pt) {
        const int pr = pt * 16 + l15, n = wid * 32 + ni * 16 + q4 * 4;
        *(f32x4*)(St + pr * 128 + n) = sa[ni][pt];
      }
  }
  __syncthreads();
}

__device__ void phase_carry(const Params& p) {
  unsigned char* ws = p.ws;
  const int gt = blockIdx.x * NTHR + threadIdx.x, ng = gridDim.x * NTHR;
  const float* hloc = (const float*)(ws + OFF_HLOC);
  const float* cumA = (const float*)(ws + OFF_CUMA);
  float* lcarry = (float*)(ws + OFF_LCARRY);
  for (int i = gt; i < 8192; i += ng) {
    const int b = i >> 10, ch = i & 1023;
    float ca[16], hl[16];
#pragma unroll
    for (int c = 0; c < 16; ++c) {
      const size_t tl = (size_t)(b * 2048 + c * 128 + 127) * 1024 + ch;
      ca[c] = cumA[tl];
      hl[c] = hloc[tl];
    }
    float carry = 0.f;
#pragma unroll
    for (int c = 0; c < 16; ++c) {
      lcarry[(size_t)(b * 16 + c) * 1024 + ch] = carry;
      carry = ca[c] * carry + hl[c];
    }
  }
  const float* acsG = (const float*)(ws + OFF_ACS);
  float* St = (float*)(ws + OFF_ST);
  for (int i = gt; i < 128 * 2048; i += ng) {
    const int bh = i >> 11, e4 = i & 2047, b = bh >> 4, hh = bh & 15;
    f32x4 tmp[16];
    float Ad[16];
#pragma unroll
    for (int c = 0; c < 16; ++c) {
      Ad[c] = __expf(acsG[(size_t)(b * 2048 + c * 128 + 127) * 16 + hh]);
      tmp[c] = *(const f32x4*)(St + (size_t)((b * 16 + c) * 16 + hh) * 8192 + e4 * 4);
    }
    f32x4 s = (f32x4){0, 0, 0, 0};
#pragma unroll
    for (int c = 0; c < 16; ++c) {
      *(f32x4*)(St + (size_t)((b * 16 + c) * 16 + hh) * 8192 + e4 * 4) = s;
      s = s * Ad[c] + tmp[c];
    }
  }
}

__device__ void ssd_final_unit(const Params& p, int unit) {
  const int tid = threadIdx.x & 255, lane = tid & 63, wid = tid >> 6, l15 = lane & 15, q4 = lane >> 4;
  const int hh = unit & 15, c = (unit >> 4) & 15, b = unit >> 8, g = hh >> 3;
  const int t0 = b * 2048 + c * 128, ts0 = c * 128;
  unsigned char* ws = p.ws;
  const bf16_t* proj = (const bf16_t*)(ws + OFF_PROJ);
  const float* Sin = (const float*)(ws + OFF_ST) + (size_t)((b * 16 + c) * 16 + hh) * 8192;
  const bf16_t* ypart = (const bf16_t*)(ws + OFF_YPART);
  const float* acsG = (const float*)(ws + OFF_ACS);
  bf16_t* A2 = (bf16_t*)(ws + OFF_XB);
  float* ssq = (float*)(ws + OFF_SSQ);
#pragma unroll 1
  for (int mt = 0; mt < 2; ++mt) {
    const int lrow = (wid * 2 + mt) * 16 + l15;
    f32x4 ya[4];
#pragma unroll
    for (int pt = 0; pt < 4; ++pt) ya[pt] = (f32x4){0, 0, 0, 0};
    if (c > 0) {
#pragma unroll 2
      for (int ks = 0; ks < 4; ++ks) {
        bf16x8 cf = cfrag(p, proj, t0 + lrow, ts0 + lrow, g, ks * 32 + q4 * 8);
#pragma unroll
        for (int pt = 0; pt < 4; ++pt) {
          const float* sp = Sin + (pt * 16 + l15) * 128 + ks * 32 + q4 * 8;
          f32x4 v0 = *(const f32x4*)sp, v1 = *(const f32x4*)(sp + 4);
          u32x4 r = {pk2(v0[0], v0[1]), pk2(v0[2], v0[3]), pk2(v1[0], v1[1]), pk2(v1[2], v1[3])};
          ya[pt] = mfma16(as_frag(r), cf, ya[pt]);
        }
      }
    }
    const size_t t = (size_t)(t0 + lrow);
    const float ea = __expf(acsG[t * 16 + hh]);
    float ss = 0.f;
#pragma unroll
    for (int pt = 0; pt < 4; ++pt) {
      const int ch = hh * 64 + pt * 16 + q4 * 4;
      u32x2 yp = *(const u32x2*)(ypart + t * 1024 + ch);
      u32x2 zz = *(const u32x2*)(proj + t * LDP + 2048 + ch);
      float y[4] = {bflo(yp[0]) + ea * ya[pt][0], bfhi(yp[0]) + ea * ya[pt][1], bflo(yp[1]) + ea * ya[pt][2],
                    bfhi(yp[1]) + ea * ya[pt][3]};
      float z[4] = {bflo(zz[0]), bfhi(zz[0]), bflo(zz[1]), bfhi(zz[1])};
#pragma unroll
      for (int r = 0; r < 4; ++r) { y[r] = y[r] * silu_(z[r]); ss += y[r] * y[r]; }
      u32x2 o = {pk2(y[0], y[1]), pk2(y[2], y[3])};
      *(u32x2*)(A2 + t * DM + 1024 + ch) = o;
    }
    ss += __shfl_xor(ss, 16);
    ss += __shfl_xor(ss, 32);
    if (q4 == 0) ssq[t * 16 + hh] = ss;
  }
}

__device__ void phase_mix_final(const Params& p) {
  unsigned char* ws = p.ws;
  const bf16_t* proj = (const bf16_t*)(ws + OFF_PROJ);
  const f32x4* hloc = (const f32x4*)(ws + OFF_HLOC);
  const f32x4* cumA = (const f32x4*)(ws + OFF_CUMA);
  const float* lcarry = (const float*)(ws + OFF_LCARRY);
  bf16_t* A2 = (bf16_t*)(ws + OFF_XB);
  for (int u = blockIdx.x * 2 + (threadIdx.x >> 8); u < 2048; u += gridDim.x * 2) ssd_final_unit(p, u);
#pragma unroll 4
  for (int i = blockIdx.x * NTHR + threadIdx.x; i < T_TOK * 256; i += gridDim.x * NTHR) {
    const int t = i >> 8, ch = (i & 255) * 4;
    f32x4 h = hloc[i], ca = cumA[i];
    f32x4 cr = *(const f32x4*)(lcarry + (size_t)(t >> 7) * 1024 + ch);
    u32x2 gg = *(const u32x2*)(proj + (size_t)t * LDP + 1024 + ch);
    float y0 = (h[0] + ca[0] * cr[0]) * gelu_(bflo(gg[0]));
    float y1 = (h[1] + ca[1] * cr[1]) * gelu_(bfhi(gg[0]));
    float y2 = (h[2] + ca[2] * cr[2]) * gelu_(bflo(gg[1]));
    float y3 = (h[3] + ca[3] * cr[3]) * gelu_(bfhi(gg[1]));
    u32x2 o = {pk2(y0, y1), pk2(y2, y3)};
    *(u32x2*)(A2 + (size_t)t * DM + ch) = o;
  }
}

__device__ void convert_uv(const Params& p) {
  unsigned char* ws = p.ws;
  const int lane = threadIdx.x & 63, wid = threadIdx.x >> 6;
  unsigned char* tb = ws + OFF_XB;
  float* scales = (float*)(ws + OFF_SCALES);
  for (int row = blockIdx.x * 8 + wid; row < 32768; row += gridDim.x * 8) {
    const bool isv = row >= 16384;
    const int e = row & 16383;
    const float* src = (isv ? p.peer_v : p.peer_u) + (size_t)e * DM + lane * 32;
    float vals[32];
    float ss = 0.f;
#pragma unroll
    for (int q = 0; q < 8; ++q) {
      f32x4 t = *(const f32x4*)(src + q * 4);
      if (!isv) t *= *(const f32x4*)(p.norm_ffn_w + lane * 32 + q * 4);
#pragma unroll
      for (int k = 0; k < 4; ++k) {
        vals[q * 4 + k] = t[k];
        ss += t[k] * t[k];
      }
    }
    ss = wave_sum(ss);
    const float rms = sqrtf(ss * (1.f / 2048.f));
    const float sc = rms * (2.6f / 7.f);
    const float inv = sc > 0.f ? 1.f / sc : 0.f;
    u32x4 o;
#pragma unroll
    for (int m = 0; m < 4; ++m) {
      unsigned w = 0;
#pragma unroll
      for (int j = 0; j < 4; ++j) {
        const float lo = fminf(fmaxf(rintf(vals[m * 8 + j] * inv), -7.f), 7.f);
        const float hi = fminf(fmaxf(rintf(vals[m * 8 + 4 + j] * inv), -7.f), 7.f);
        const unsigned bl = (unsigned)((int)lo + 8), bh = (unsigned)((int)hi + 8);
        w |= (bl | (bh << 4)) << (8 * j);
      }
      o[m] = w;
    }
    *(u32x4*)(tb + (size_t)row * 1024 + lane * 16) = o;
    if (lane == 0) scales[row] = sc;
  }
}

__device__ const unsigned char cand_tab[64] = {
    0x00, 0x01, 0x02, 0x03, 0x04, 0x05, 0x06, 0x07, 0x08, 0x09, 0x0a, 0x0b, 0x0c, 0x0d, 0x0e, 0x0f,
    0x10, 0x11, 0x12, 0x13, 0x14, 0x15, 0x16, 0x17,
    0x20, 0x21, 0x22, 0x23, 0x24,
    0x30, 0x31, 0x32, 0x33,
    0x40, 0x41, 0x42,
    0x50, 0x51, 0x60, 0x61, 0x70, 0x71,
    0x80, 0x90, 0xa0, 0xb0, 0xc0, 0xd0, 0xe0, 0xf0,
    0xff, 0xff, 0xff, 0xff, 0xff, 0xff, 0xff, 0xff, 0xff, 0xff, 0xff, 0xff, 0xff, 0xff};

__device__ __forceinline__ unsigned ord_key(float f) {
  unsigned u = __float_as_uint(f);
  return u ^ ((u >> 31) ? 0xffffffffu : 0x80000000u);
}
__device__ __forceinline__ float ord_dec(unsigned k) {
  unsigned u = (k >> 31) ? (k ^ 0x80000000u) : ~k;
  return __uint_as_float(u);
}

__device__ void topk_unit(const Params& p, unsigned char* smem, int unit) {
  const int tid = threadIdx.x & 255, lane = tid & 63, wid = tid >> 6, l15 = lane & 15, q4 = lane >> 4;
  const int h = unit & 7, tile = unit >> 3;
  const int tok0 = tile * 64 + wid * 16;
  unsigned char* ws = p.ws;
  const bf16_t* qg = (const bf16_t*)(ws + OFF_Q);
  const bf16_t* kb = (const bf16_t*)(ws + OFF_KEYSB);
  unsigned* S = (unsigned*)(smem + wid * 16640);
  float* tops = (float*)(smem + 4 * 16640 + wid * 256);
  int* topi = (int*)(tops + 32);
  unsigned* Ms = (unsigned*)(smem + 67584 + wid * 512);
  unsigned* Cs = Ms + 64;
#pragma unroll
  for (int k = 0; k < 2; ++k) {
    f32x4 sc[8];
#pragma unroll
    for (int i = 0; i < 8; ++i) sc[i] = (f32x4){0, 0, 0, 0};
#pragma unroll
    for (int ks = 0; ks < 4; ++ks) {
      bf16x8 qf = as_frag(*(const u32x4*)(qg + (size_t)(tok0 + l15) * DM + h * 256 + k * 128 + ks * 32 + q4 * 8));
#pragma unroll
      for (int nt = 0; nt < 8; ++nt) {
        bf16x8 kf = as_frag(*(const u32x4*)(kb + (size_t)((h * 2 + k) * 128 + nt * 16 + l15) * 128 + ks * 32 + q4 * 8));
        sc[nt] = mfma16(kf, qf, sc[nt]);
      }
    }
#pragma unroll
    for (int nt = 0; nt < 8; ++nt) {
      const int n = nt * 16 + q4 * 4;
      u32x4 kk;
#pragma unroll
      for (int r = 0; r < 4; ++r) kk[r] = (ord_key(sc[nt][r]) & ~127u) | (unsigned)(127 - (n + r));
      *(u32x4*)(S + l15 * 260 + k * 128 + n) = kk;
    }
  }
  const unsigned ct = cand_tab[lane];
  const int ca = ct >> 4, cbb = ct & 15;
  int* idxo = (int*)(ws + OFF_IDX);
  float* go = (float*)(ws + OFF_G);
  for (int tk = 0; tk < 16; ++tk) {
    const unsigned* row = S + tk * 260;
#pragma unroll
    for (int hf = 0; hf < 2; ++hf) {
      const unsigned ka = row[hf * 128 + lane], kb = row[hf * 128 + 64 + lane];
      const unsigned mxk = ka > kb ? ka : kb;
      Ms[lane] = mxk;
      int cnt = 0;
#pragma unroll
      for (int j = 0; j < 16; ++j) {
        u32x4 x = *(const u32x4*)(Ms + j * 4);
#pragma unroll
        for (int e = 0; e < 4; ++e) cnt += (x[e] > mxk) ? 1 : 0;
      }
      const unsigned long long bm = __ballot(cnt == 15);
      const int srcT = __ffsll((long long)bm) - 1;
      const unsigned T0 = (unsigned)__shfl((int)mxk, srcT);
      const bool ca_ = ka >= T0, cb_ = kb >= T0;
      const unsigned long long ba = __ballot(ca_), bb = __ballot(cb_);
      const unsigned long long lt = (1ull << lane) - 1ull;
      const int na = __popcll(ba);
      const int pa = __popcll(ba & lt), pb = na + __popcll(bb & lt);
      const int ncand = na + __popcll(bb);
      if (lane < 32) Cs[lane] = 0u;
      if (ca_) Cs[pa] = ka;
      if (cb_) Cs[pb] = kb;
      const unsigned my = Cs[lane & 31];
      int rk2 = 0;
#pragma unroll
      for (int j = 0; j < 8; ++j) {
        u32x4 x = *(const u32x4*)(Cs + j * 4);
#pragma unroll
        for (int e = 0; e < 4; ++e) rk2 += (x[e] > my) ? 1 : 0;
      }
      if (lane < ncand && rk2 < 16) {
        tops[hf * 16 + rk2] = ord_dec(my & ~127u);
        topi[hf * 16 + rk2] = 127 - (int)(my & 127u);
      }
    }
    float cs = 0.f;
    unsigned ck = 0u;
    if (lane < 50) {
      cs = tops[ca] + tops[16 + cbb];
      ck = (ord_key(cs) & ~255u) | (unsigned)(255 - (ca * 16 + cbb));
    }
    int rk = 0;
#pragma unroll
    for (int j = 0; j < 50; ++j) {
      const unsigned oj = (unsigned)__builtin_amdgcn_readlane((int)ck, j);
      rk += (oj > ck) ? 1 : 0;
    }
    const float mx = tops[0] + tops[16];
    const bool sel = (lane < 50) && (rk < 16);
    const float ev = sel ? __expf(cs - mx) : 0.f;
    const float sum = wave_sum(ev);
    if (sel) {
      const size_t o = (size_t)(tok0 + tk) * 128 + h * 16 + rk;
      idxo[o] = topi[ca] * 128 + topi[16 + cbb];
      go[o] = ev / sum;
    }
  }
}

__device__ __forceinline__ float ub0(unsigned w) { return (float)(w & 0xffu); }
__device__ __forceinline__ float ub1(unsigned w) { return (float)((w >> 8) & 0xffu); }
__device__ __forceinline__ float ub2(unsigned w) { return (float)((w >> 16) & 0xffu); }
__device__ __forceinline__ float ub3(unsigned w) { return (float)(w >> 24); }

#define GROWS 8
#ifndef USE_SDOT4
#define USE_SDOT4 1
#endif
typedef float f32x2 __attribute__((ext_vector_type(2)));
__device__ void phase_gather(const Params& p) {
  const int tid = threadIdx.x, lane = tid & 63, wid = tid >> 6;
  unsigned char* ws = p.ws;
  const unsigned char* ub = ws + OFF_XB;
  const unsigned char* vb = ws + OFF_XB + 16 * MIB;
  const float* scales = (const float*)(ws + OFF_SCALES);
  const int* idxg = (const int*)(ws + OFF_IDX);
  const float* gg = (const float*)(ws + OFF_G);
  const float* ssq2 = (const float*)(ws + OFF_SSQ2);
  const bool b5 = (lane & 32) != 0, b4 = (lane & 16) != 0, b3 = (lane & 8) != 0;
  const int srcl = ((lane & 1) << 3) | (((lane >> 1) & 1) << 4) | (((lane >> 2) & 1) << 5);
  for (int t = blockIdx.x * 8 + wid; t < T_TOK; t += gridDim.x * 8) {
    const int id0 = idxg[(size_t)t * 128 + lane], id1 = idxg[(size_t)t * 128 + 64 + lane];
    const float g0 = gg[(size_t)t * 128 + lane], g1 = gg[(size_t)t * 128 + 64 + lane];
    const float su0 = scales[id0], su1 = scales[id1], sv0 = scales[16384 + id0], sv1 = scales[16384 + id1];
    float* orow = p.out + (size_t)t * DM + lane * 32;
    int xlo[4], xhi[4];
    float sx;
    int sumq;
    {
      float xr[32];
      float amax = 0.f;
#pragma unroll
      for (int q = 0; q < 8; ++q) {
        f32x4 v = *(const f32x4*)(orow + q * 4);
#pragma unroll
        for (int k = 0; k < 4; ++k) { xr[q * 4 + k] = v[k]; amax = fmaxf(amax, fabsf(v[k])); }
      }
#pragma unroll
      for (int o = 32; o > 0; o >>= 1) amax = fmaxf(amax, __shfl_xor(amax, o));
      sx = amax * (1.f / 127.f);
      const float inv = amax > 0.f ? 127.f / amax : 0.f;
      int sq_ = 0;
#pragma unroll
      for (int m = 0; m < 4; ++m) {
        unsigned wl = 0, wh = 0;
#pragma unroll
        for (int j = 0; j < 4; ++j) {
          const int a_ = __float2int_rn(xr[m * 8 + j] * inv), b_ = __float2int_rn(xr[m * 8 + 4 + j] * inv);
          sq_ += a_ + b_;
          wl |= ((unsigned)a_ & 0xffu) << (8 * j);
          wh |= ((unsigned)b_ & 0xffu) << (8 * j);
        }
        xlo[m] = (int)wl;
        xhi[m] = (int)wh;
      }
#pragma unroll
      for (int o = 32; o > 0; o >>= 1) sq_ += __shfl_xor(sq_, o);
      sumq = sq_;
    }
    float sq = (lane < 32) ? ssq2[(size_t)t * 32 + lane] : 0.f;
    sq = wave_sum(sq);
    const float rs2 = rsqrtf(sq * (1.f / 2048.f) + EPSV);
    float w0 = 0.f, w1 = 0.f;
#pragma unroll 1
    for (int half = 0; half < 2; ++half) {
      const int idv = half ? id1 : id0;
      int wv = 0;
      u32x4 rr[2][GROWS];
#pragma unroll
      for (int k = 0; k < GROWS; ++k) {
        const int e = __builtin_amdgcn_readlane(idv, k);
        rr[0][k] = *(const u32x4*)(ub + (size_t)e * 1024 + lane * 16);
      }
#pragma unroll
      for (int gi = 0; gi < 64 / GROWS; ++gi) {
        const int j0 = gi * GROWS;
        if (gi + 1 < 64 / GROWS) {
#pragma unroll
          for (int k = 0; k < GROWS; ++k) {
            const int e = __builtin_amdgcn_readlane(idv, j0 + GROWS + k);
            rr[(gi + 1) & 1][k] = *(const u32x4*)(ub + (size_t)e * 1024 + lane * 16);
          }
        }
        int dv[GROWS];
#pragma unroll
        for (int k = 0; k < GROWS; ++k) {
          int d = 0;
#pragma unroll
          for (int m = 0; m < 4; ++m) {
            const unsigned w = rr[gi & 1][k][m];
            const int lo = (int)(w & 0x0f0f0f0fu), hi = (int)((w >> 4) & 0x0f0f0f0fu);
            d = __builtin_amdgcn_sdot4(lo, xlo[m], d, false);
            d = __builtin_amdgcn_sdot4(hi, xhi[m], d, false);
          }
          dv[k] = d;
        }
        int a4[4], a2[2];
#pragma unroll
        for (int k = 0; k < 4; ++k) {
          const int mine = b5 ? dv[k + 4] : dv[k], oth = b5 ? dv[k] : dv[k + 4];
          a4[k] = mine + __shfl_xor(oth, 32);
        }
#pragma unroll
        for (int k = 0; k < 2; ++k) {
          const int mine = b4 ? a4[k + 2] : a4[k], oth = b4 ? a4[k] : a4[k + 2];
          a2[k] = mine + __shfl_xor(oth, 16);
        }
        int c1;
        {
          const int mine = b3 ? a2[1] : a2[0], oth = b3 ? a2[0] : a2[1];
          c1 = mine + __shfl_xor(oth, 8);
        }
        c1 += __shfl_xor(c1, 4);
        c1 += __shfl_xor(c1, 2);
        c1 += __shfl_xor(c1, 1);
        const int val = __shfl(c1, srcl);
        if ((lane & ~7) == j0) wv = val;
      }
      const float su = half ? su1 : su0;
      const float a = gelu_((float)(wv - 8 * sumq) * (su * sx * rs2));
      if (half) w1 = a * g1 * sv1; else w0 = a * g0 * sv0;
    }
    f32x2 acc[16];
#pragma unroll
    for (int i = 0; i < 16; ++i) acc[i] = (f32x2){0.f, 0.f};
    const float csum = wave_sum(w0 + w1);
#pragma unroll 1
    for (int half = 0; half < 2; ++half) {
      const int idv = half ? id1 : id0;
      const float wvv = half ? w1 : w0;
      u32x4 rr[2][GROWS];
#pragma unroll
      for (int k = 0; k < GROWS; ++k) {
        const int e = __builtin_amdgcn_readlane(idv, k);
        rr[0][k] = *(const u32x4*)(vb + (size_t)e * 1024 + lane * 16);
      }
#pragma unroll
      for (int gi = 0; gi < 64 / GROWS; ++gi) {
        const int j0 = gi * GROWS;
        if (gi + 1 < 64 / GROWS) {
#pragma unroll
          for (int k = 0; k < GROWS; ++k) {
            const int e = __builtin_amdgcn_readlane(idv, j0 + GROWS + k);
            rr[(gi + 1) & 1][k] = *(const u32x4*)(vb + (size_t)e * 1024 + lane * 16);
          }
        }
#pragma unroll
        for (int k = 0; k < GROWS; ++k) {
          const float wkk = __builtin_bit_cast(float, __builtin_amdgcn_readlane(__builtin_bit_cast(int, wvv), j0 + k));
          const f32x2 w2 = {wkk, wkk};
#pragma unroll
          for (int m = 0; m < 4; ++m) {
            const unsigned w = rr[gi & 1][k][m];
            const unsigned lo = w & 0x0f0f0f0fu, hi = (w >> 4) & 0x0f0f0f0fu;
            acc[m * 4 + 0] += w2 * (f32x2){ub0(lo), ub1(lo)};
            acc[m * 4 + 1] += w2 * (f32x2){ub2(lo), ub3(lo)};
            acc[m * 4 + 2] += w2 * (f32x2){ub0(hi), ub1(hi)};
            acc[m * 4 + 3] += w2 * (f32x2){ub2(hi), ub3(hi)};
          }
        }
      }
    }
    const float off = 8.f * csum;
    float ss = 0.f;
#pragma unroll
    for (int q = 0; q < 8; ++q) {
      f32x4 v = *(const f32x4*)(orow + q * 4);
      acc[q * 2][0] += v[0] - off;
      acc[q * 2][1] += v[1] - off;
      acc[q * 2 + 1][0] += v[2] - off;
      acc[q * 2 + 1][1] += v[3] - off;
      ss += acc[q * 2][0] * acc[q * 2][0] + acc[q * 2][1] * acc[q * 2][1] + acc[q * 2 + 1][0] * acc[q * 2 + 1][0] +
            acc[q * 2 + 1][1] * acc[q * 2 + 1][1];
    }
    ss = wave_sum(ss);
    const float rs3 = rsqrtf(ss * (1.f / 2048.f) + EPSV);
#pragma unroll
    for (int q = 0; q < 8; ++q) {
      f32x4 wf = *(const f32x4*)(p.norm_final_w + lane * 32 + q * 4);
      f32x4 o = {acc[q * 2][0] * rs3 * wf[0], acc[q * 2][1] * rs3 * wf[1], acc[q * 2 + 1][0] * rs3 * wf[2],
                 acc[q * 2 + 1][1] * rs3 * wf[3]};
      *(f32x4*)(orow + q * 4) = o;
    }
  }
}

__global__ void __launch_bounds__(NTHR, 2) fwd_kernel(Params p) {
  __shared__ __attribute__((aligned(16))) unsigned char smem[SMEM_BYTES];
  cg::grid_group grid = cg::this_grid();
  unsigned char* ws = p.ws;
  const int hb = threadIdx.x >> 8;
  unsigned char* hsm = smem + hb * SMEM_HALF;
#define PHASE_ON(n) (p.phase_lo <= (n) && (n) <= p.phase_hi)
#define PHASE_SYNC(n) if (p.coop && PHASE_ON(n) && (n) < p.phase_hi) grid.sync();
  if (PHASE_ON(0)) phase_prep(p, smem);
  PHASE_SYNC(0)
  if (PHASE_ON(1)) {
    pg8::Gemm g{(const bf16_t*)(ws + OFF_XB), (const bf16_t*)(ws + OFF_WINT), T_TOK, NPAD1, 2048};
    pg8::SimpleOrder S; S.init(T_TOK, NPAD1, gridDim.x, blockIdx.x);
    pg8::Epi1 E{(const float*)(ws + OFF_RS1), (bf16_t*)(ws + OFF_PROJ)};
    pg8::gemm_phase<pg8::Epi1, pg8::SimpleOrder, 0>((PG8_LAS unsigned char*)smem, g, S, E);
  }
  PHASE_SYNC(1)
  if (PHASE_ON(2)) {
    for (int u0 = blockIdx.x * 2; u0 < 2048; u0 += gridDim.x * 2) ssd_local_unit(p, hsm, u0 + hb);
    for (int u0 = blockIdx.x * 2; u0 < 2048; u0 += gridDim.x * 2) lru_local_unit(p, hsm, u0 + hb);
  }
  PHASE_SYNC(2)
  if (PHASE_ON(3)) phase_carry(p);
  PHASE_SYNC(3)
  if (PHASE_ON(4)) phase_mix_final(p);
  PHASE_SYNC(4)
  if (PHASE_ON(5)) {
    pg8::Gemm g{(const bf16_t*)(ws + OFF_XB), (const bf16_t*)(ws + OFF_WOUTT), T_TOK, 2048, 2048};
    pg8::SimpleOrder S; S.init(T_TOK, 2048, gridDim.x, blockIdx.x);
    pg8::Epi2 E{p.x, p.out, (bf16_t*)(ws + OFF_X1B), (float*)(ws + OFF_SSQ2), (const float*)(ws + OFF_SSQ)};
    pg8::gemm_phase<pg8::Epi2, pg8::SimpleOrder, 16>((PG8_LAS unsigned char*)smem, g, S, E);
  }
  PHASE_SYNC(5)
  if (PHASE_ON(6)) {
    pg8::Gemm g{(const bf16_t*)(ws + OFF_X1B), (const bf16_t*)(ws + OFF_WQT), T_TOK, 2048, 2048};
    pg8::SimpleOrder S; S.init(T_TOK, 2048, gridDim.x, blockIdx.x);
    pg8::Epi3 E{(const float*)(ws + OFF_SSQ2), (bf16_t*)(ws + OFF_Q)};
    pg8::gemm_phase<pg8::Epi3, pg8::SimpleOrder, 0>((PG8_LAS unsigned char*)smem, g, S, E);
    convert_uv(p);
  }
  PHASE_SYNC(6)
  if (PHASE_ON(7)) {
    for (int u = blockIdx.x * 2 + hb; u < 2048; u += gridDim.x * 2) topk_unit(p, hsm, u);
  }
  PHASE_SYNC(7)
  if (PHASE_ON(8)) phase_gather(p);
}

extern "C" void kernel_launch(void* const* d_in, const int* in_sizes, int n_in, void* d_out, int out_size,
                              void* d_ws, size_t ws_size, hipStream_t stream) {
  Params p{};
  const float** fp = (const float**)&p;
  for (int i = 0; i < 23; ++i) fp[i] = (const float*)d_in[i];
  p.out = (float*)d_out;
  p.ws = (unsigned char*)d_ws;
  static int grid_blocks = 0;
  if (!grid_blocks) {
    int dev = 0, cus = 0, per_cu = 0;
    hipGetDevice(&dev);
    hipDeviceGetAttribute(&cus, hipDeviceAttributeMultiprocessorCount, dev);
    hipOccupancyMaxActiveBlocksPerMultiprocessor(&per_cu, fwd_kernel, NTHR, 0);
    if (per_cu < 1) per_cu = 1;
    if (per_cu > 1) per_cu = 1;
    grid_blocks = cus * per_cu;
  }
#if SINGLE_LAUNCH
  p.phase_lo = 0; p.phase_hi = 8; p.coop = 1;
  void* args[] = {&p};
  hipError_t e = hipLaunchCooperativeKernel((void*)fwd_kernel, dim3(grid_blocks), dim3(NTHR), args, 0, stream);
  if (e != hipSuccess) fprintf(stderr, "cooperative launch failed: %s (grid %d)\n", hipGetErrorString(e), grid_blocks);
#else
  for (int ph = 0; ph <= 8; ++ph) {
    p.phase_lo = ph; p.phase_hi = ph; p.coop = 0;
    hipLaunchKernelGGL(fwd_kernel, dim3(grid_blocks), dim3(NTHR), 0, stream, p);
  }
#endif
}
```

```cpp
#include <hip/hip_runtime.h>
#include <hip/hip_cooperative_groups.h>
#include <cstdio>
namespace cg = cooperative_groups;

#ifndef DBL_PHASE
#define DBL_PHASE -1
#endif
#ifndef SINGLE_LAUNCH
#define SINGLE_LAUNCH 1
#endif

typedef unsigned short bf16_t;
typedef short bf16x8 __attribute__((ext_vector_type(8)));
typedef float f32x4 __attribute__((ext_vector_type(4)));
typedef unsigned u32x4 __attribute__((ext_vector_type(4)));
typedef unsigned u32x2 __attribute__((ext_vector_type(2)));
typedef __bf16 bf2_t __attribute__((ext_vector_type(2)));

#define T_TOK 16384
#define DM 2048
#define LDP 4736
#define NPAD1 4864
#define NTHR 512
#define HTHR 256
#define SMEM_HALF 73728
#define SMEM_BYTES 147456
#define EPSV 1e-6f
#define MIB ((size_t)1 << 20)

#define OFF_XB (0 * MIB)
#define OFF_PROJ (64 * MIB)
#define OFF_X1B (64 * MIB)
#define OFF_Q (128 * MIB)
#define OFF_IDX (192 * MIB)
#define OFF_G (200 * MIB)
#define OFF_HLOC (212 * MIB)
#define OFF_CUMA (276 * MIB)
#define OFF_YPART (340 * MIB)
#define OFF_ST (372 * MIB)
#define OFF_WINT (436 * MIB)
#define OFF_WOUTT (455 * MIB)
#define OFF_WQT (463 * MIB)
#define OFF_WAT (471 * MIB)
#define OFF_WXT (471 * MIB + 131072)
#define OFF_KEYSB (471 * MIB + 262144)
#define OFF_RS1 (472 * MIB)
#define OFF_ACS (472 * MIB + 65536)
#define OFF_LCARRY (OFF_ACS + MIB)
#define OFF_SSQ (OFF_LCARRY + 524288)
#define OFF_SSQ2 (OFF_SSQ + MIB)
#define OFF_SCALES (OFF_SSQ2 + 2 * MIB)

struct Params {
  const float *x, *norm_mix_w, *w_in, *lru_conv_w, *lru_conv_b, *lru_wa, *lru_ba, *lru_wx, *lru_bx, *lru_lambda;
  const float *ssd_conv_w, *ssd_conv_b, *ssd_dt_bias, *ssd_a_log, *ssd_d, *ssd_norm_w, *w_out, *norm_ffn_w, *peer_wq;
  const float *peer_sub_keys, *peer_u, *peer_v, *norm_final_w;
  float* out;
  unsigned char* ws;
  int phase_lo, phase_hi, coop, pad0;
};

__device__ __forceinline__ unsigned pk2(float lo, float hi) {
  unsigned r;
  asm("v_cvt_pk_bf16_f32 %0, %1, %2" : "=v"(r) : "v"(lo), "v"(hi));
  return r;
}
__device__ __forceinline__ float bf2f(bf16_t v) { return __uint_as_float(((unsigned)v) << 16); }
__device__ __forceinline__ float bflo(unsigned u) { return __uint_as_float(u << 16); }
__device__ __forceinline__ float bfhi(unsigned u) { return __uint_as_float(u & 0xffff0000u); }
__device__ __forceinline__ float wave_sum(float v) {
#pragma unroll
  for (int o = 32; o > 0; o >>= 1) v += __shfl_xor(v, o);
  return v;
}
__device__ __forceinline__ float sigmoid_(float x) { return 1.f / (1.f + __expf(-x)); }
__device__ __forceinline__ float silu_(float x) { return x * sigmoid_(x); }
__device__ __forceinline__ float gelu_(float x) {
  float u = 0.7978845608028654f * (x + 0.044715f * x * x * x);
  return x * sigmoid_(2.f * u);
}
__device__ __forceinline__ float softplus_(float x) { return fmaxf(x, 0.f) + log1pf(__expf(-fabsf(x))); }
__device__ __forceinline__ f32x4 mfma16(bf16x8 a, bf16x8 b, f32x4 c) {
  return __builtin_amdgcn_mfma_f32_16x16x32_bf16(a, b, c, 0, 0, 0);
}
__device__ __forceinline__ bf16x8 as_frag(u32x4 v) { return __builtin_bit_cast(bf16x8, v); }
__device__ __forceinline__ int sw256(int row, int chunk) { return row * 256 + ((chunk ^ (row & 15)) << 4); }
__device__ __forceinline__ int sw128(int row, int chunk) { return row * 128 + ((chunk ^ ((row >> 1) & 7)) << 4); }

__device__ __forceinline__ float rs_from_ssq2(const float* ssq2, int row) {
  const f32x4* pp = (const f32x4*)(ssq2 + (size_t)row * 32);
  float s = 0.f;
#pragma unroll
  for (int i = 0; i < 8; ++i) { f32x4 v = pp[i]; s += v[0] + v[1] + v[2] + v[3]; }
  return rsqrtf(s * (1.f / 2048.f) + EPSV);
}
__device__ __forceinline__ float rs_from_ssq(const float* ssq, int row) {
  const f32x4* pp = (const f32x4*)(ssq + (size_t)row * 16);
  float s = 0.f;
#pragma unroll
  for (int i = 0; i < 4; ++i) { f32x4 v = pp[i]; s += v[0] + v[1] + v[2] + v[3]; }
  return rsqrtf(s * (1.f / 1024.f) + EPSV);
}

__device__ void transpose_tile(const float* __restrict__ src, int ld_src, int r0, int c0, int c_valid,
                               bf16_t* __restrict__ dst, int ld_dst, const float* __restrict__ scale, int scale_from,
                               float* tile, bool valid) {
  const int tid = threadIdx.x & 255;
  {
    const int j = tid & 63, i0 = tid >> 6;
#pragma unroll 4
    for (int ii = 0; ii < 16; ++ii) {
      const int i = i0 + 4 * ii;
      float v = 0.f;
      if (valid && c0 + j < c_valid) {
        v = src[(size_t)(r0 + i) * ld_src + c0 + j];
        if (scale != nullptr && (r0 + i) >= scale_from) v *= scale[r0 + i - scale_from];
      }
      tile[i * 65 + j] = v;
    }
  }
  __syncthreads();
  {
    const int i = tid & 63, j0 = tid >> 6;
#pragma unroll 4
    for (int jj = 0; jj < 16; ++jj) {
      const int j = j0 + 4 * jj;
      if (valid) dst[(size_t)(c0 + j) * ld_dst + r0 + i] = (bf16_t)(pk2(tile[i * 65 + j], 0.f) & 0xffffu);
    }
  }
  __syncthreads();
}

__device__ void phase_prep(const Params& p, unsigned char* smem) {
  const int tid = threadIdx.x, lane = tid & 63, wid = tid >> 6, hb = tid >> 8;
  unsigned char* ws = p.ws;
  bf16_t* xb = (bf16_t*)(ws + OFF_XB);
  float* rs1 = (float*)(ws + OFF_RS1);
  for (int t = blockIdx.x * 8 + wid; t < T_TOK; t += gridDim.x * 8) {
    const float* xr = p.x + (size_t)t * DM;
    bf16_t* xo = xb + (size_t)t * DM;
    float ss = 0.f;
#pragma unroll
    for (int c = 0; c < 8; ++c) {
      f32x4 v = *(const f32x4*)(xr + c * 256 + lane * 4);
      ss += v[0] * v[0] + v[1] * v[1] + v[2] * v[2] + v[3] * v[3];
      u32x2 o = {pk2(v[0], v[1]), pk2(v[2], v[3])};
      *(u32x2*)(xo + c * 256 + lane * 4) = o;
    }
    ss = wave_sum(ss);
    if (lane == 0) rs1[t] = rsqrtf(ss * (1.f / 2048.f) + EPSV);
  }
  float* tile = (float*)(smem + hb * SMEM_HALF);
  const int NT_WIN = 32 * 76, NT_SQ = 32 * 32;
  const int total = NT_WIN + 2 * NT_SQ + 32;
  for (int u0 = blockIdx.x * 2; u0 < total; u0 += gridDim.x * 2) {
    const bool valid = (u0 + hb) < total;
    const int u = valid ? (u0 + hb) : u0;
    if (u < NT_WIN) {
      const int ri = u & 31, cj = u >> 5;
      transpose_tile(p.w_in, 4624, ri * 64, cj * 64, 4624, (bf16_t*)(ws + OFF_WINT), 2048, p.norm_mix_w, 0, tile, valid);
    } else if (u < NT_WIN + NT_SQ) {
      const int v = u - NT_WIN, ri = v & 31, cj = v >> 5;
      transpose_tile(p.w_out, 2048, ri * 64, cj * 64, 2048, (bf16_t*)(ws + OFF_WOUTT), 2048, p.ssd_norm_w, 1024, tile, valid);
    } else if (u < NT_WIN + 2 * NT_SQ) {
      const int v = u - NT_WIN - NT_SQ, ri = v & 31, cj = v >> 5;
      transpose_tile(p.peer_wq, 2048, ri * 64, cj * 64, 2048, (bf16_t*)(ws + OFF_WQT), 2048, p.norm_ffn_w, 0, tile, valid);
    } else {
      const int v = u - NT_WIN - 2 * NT_SQ;
      const int h = v & 15;
      const float* src = (v < 16 ? p.lru_wa : p.lru_wx) + (size_t)h * 4096;
      bf16_t* dst = (bf16_t*)(ws + (v < 16 ? OFF_WAT : OFF_WXT)) + (size_t)h * 4096;
      transpose_tile(src, 64, 0, 0, 64, dst, 64, nullptr, 0, tile, valid);
    }
  }
  {
    bf16_t* kb = (bf16_t*)(ws + OFF_KEYSB);
    for (int i = blockIdx.x * NTHR + tid; i < 65536; i += gridDim.x * NTHR) {
      f32x4 v = *(const f32x4*)(p.peer_sub_keys + (size_t)i * 4);
      u32x2 o = {pk2(v[0], v[1]), pk2(v[2], v[3])};
      *(u32x2*)(kb + (size_t)i * 4) = o;
    }
  }
}

namespace pg8 {
#define PG8_LAS __attribute__((address_space(3)))
constexpr int BM = 256, BK = 64, HALF = 128, HTB = HALF * BK * 2;
__device__ __forceinline__ int lds_byte(int r, int c) { const int st = (r >> 4) * 2 + (c >> 5), rr = r & 15, cc = c & 31, ob = rr * 64 + cc * 2; return st * 1024 + (ob ^ (((ob >> 9) & 1) << 5)); }
__device__ __forceinline__ void stage_rc(int b, int& R, int& C) { const int st = b / 1024, sb = b % 1024, swz = sb ^ (((sb >> 9) & 1) << 5); R = (st >> 1) * 16 + swz / 64; C = (st & 1) * 32 + (swz % 64) / 2; }
struct Unit { int pm, pn; };
struct Gemm { const bf16_t* A; const bf16_t* Bt; int M, N, K; };
struct SimpleOrder {
  int nM, nwg, G, c;
  __device__ void init(int M, int N, int G_, int c_) { nM = M / BM; nwg = nM * (N / BM); G = G_; c = c_; }
  __device__ bool next(int i, Unit& u) const { const int L = i * G + c; if (L >= nwg) return false; u.pm = L % nM; u.pn = L / nM; return true; }
};
struct Epi1 {
  static constexpr bool MID = false;
  const float* rs1; bf16_t* proj;
  __device__ __forceinline__ void mid(f32x4 (&)[2][2][4][2], const Unit&, int, int) const {}
  __device__ __forceinline__ void operator()(const f32x4 (&acc)[2][2][4][2], const Unit& u, int wr, int wc, int fr, int fq) const {
    const int row0 = u.pm * BM + wr * 64 + fr, col0 = u.pn * BM + wc * 32 + 4 * fq;
#pragma unroll
    for (int ai = 0; ai < 2; ++ai)
#pragma unroll
      for (int m = 0; m < 4; ++m) {
        const int row = row0 + ai * HALF + m * 16;
        const float s = rs1[row];
#pragma unroll
        for (int bj = 0; bj < 2; ++bj)
#pragma unroll
          for (int n = 0; n < 2; ++n) {
            const int col = col0 + bj * HALF + n * 16;
            if (col < LDP) {
              f32x4 v = acc[ai][bj][m][n] * s;
              u32x2 o = {pk2(v[0], v[1]), pk2(v[2], v[3])};
              *(u32x2*)(proj + (size_t)row * LDP + col) = o;
            }
          }
      }
  }
};
struct Epi2 {
  static constexpr bool MID = true;
  const float* x; float* out; bf16_t* x1b; float* ssq2; const float* ssq;
  __device__ __forceinline__ void mid(f32x4 (&acc)[2][2][4][2], const Unit& u, int wr, int fr) const {
#pragma unroll
    for (int ai = 0; ai < 2; ++ai)
#pragma unroll
      for (int m = 0; m < 4; ++m) {
        const float s = rs_from_ssq(ssq, u.pm * BM + wr * 64 + fr + ai * HALF + m * 16);
#pragma unroll
        for (int bj = 0; bj < 2; ++bj)
#pragma unroll
          for (int n = 0; n < 2; ++n) acc[ai][bj][m][n] *= s;
        __builtin_amdgcn_sched_barrier(0);
      }
  }
  __device__ __forceinline__ void operator()(const f32x4 (&acc)[2][2][4][2], const Unit& u, int wr, int wc, int fr, int fq) const {
    const int row0 = u.pm * BM + wr * 64 + fr, col0 = u.pn * BM + wc * 32 + 4 * fq;
#pragma unroll
    for (int ai = 0; ai < 2; ++ai)
#pragma unroll
      for (int m = 0; m < 4; ++m) {
        const int row = row0 + ai * HALF + m * 16;
        float ss = 0.f;
#pragma unroll
        for (int bj = 0; bj < 2; ++bj)
#pragma unroll
          for (int n = 0; n < 2; ++n) {
            const int col = col0 + bj * HALF + n * 16;
            f32x4 xr = *(const f32x4*)(x + (size_t)row * DM + col);
            f32x4 v = acc[ai][bj][m][n] + xr;
            *(f32x4*)(out + (size_t)row * DM + col) = v;
            u32x2 o = {pk2(v[0], v[1]), pk2(v[2], v[3])};
            *(u32x2*)(x1b + (size_t)row * DM + col) = o;
            ss += v[0] * v[0] + v[1] * v[1] + v[2] * v[2] + v[3] * v[3];
          }
        ss += __shfl_xor(ss, 16);
        ss += __shfl_xor(ss, 32);
        if (fq == 0) ssq2[(size_t)row * 32 + u.pn * 4 + wc] = ss;
        __builtin_amdgcn_sched_barrier(0);
      }
  }
};
struct Epi3 {
  static constexpr bool MID = false;
  const float* ssq2; bf16_t* q;
  __device__ __forceinline__ void mid(f32x4 (&)[2][2][4][2], const Unit&, int, int) const {}
  __device__ __forceinline__ void operator()(const f32x4 (&acc)[2][2][4][2], const Unit& u, int wr, int wc, int fr, int fq) const {
    const int row0 = u.pm * BM + wr * 64 + fr, col0 = u.pn * BM + wc * 32 + 4 * fq;
#pragma unroll
    for (int ai = 0; ai < 2; ++ai)
#pragma unroll
      for (int m = 0; m < 4; ++m) {
        const int row = row0 + ai * HALF + m * 16;
        const float s = rs_from_ssq2(ssq2, row);
#pragma unroll
        for (int bj = 0; bj < 2; ++bj)
#pragma unroll
          for (int n = 0; n < 2; ++n) {
            const int col = col0 + bj * HALF + n * 16;
            f32x4 v = acc[ai][bj][m][n] * s;
            u32x2 o = {pk2(v[0], v[1]), pk2(v[2], v[3])};
            *(u32x2*)(q + (size_t)row * DM + col) = o;
          }
      }
  }
};

template <class Epi, class Sched, int KROT>
__device__ __forceinline__ void gemm_phase(PG8_LAS unsigned char* lds, const Gemm g, const Sched& S, const Epi& E) {
  const int tid = threadIdx.x, wid = __builtin_amdgcn_readfirstlane(tid >> 6), lane = tid & 63, wr = wid >> 2, wc = wid & 3, fr = lane & 15, fq = lane >> 4;
  const int K = g.K, nt = K / BK;
#define PG8_KX(t) (((t) + KROT) & 31)
  unsigned voff[2];
#pragma unroll
  for (int i = 0; i < 2; ++i) { int R, C; stage_rc(tid * 16 + i * 8192, R, C); voff[i] = (unsigned)(R * K + C) * 2u; }
  const size_t kstep = (size_t)(BK * 2);
  const size_t hstep = (size_t)HALF * K * 2;
  const size_t tstep = 2 * hstep;
  const unsigned ldsw = (unsigned)wid * 1024u;
  const int aoff = lds_byte(wr * 64 + fr, fq * 8), boff = lds_byte(wc * 32 + fr, fq * 8);
#define PG8_SA(b, h) (((b) * 2 + (h)) * HTB)
#define PG8_SB(b, h) ((4 + (b) * 2 + (h)) * HTB)
#define PG8_STAGE(bufoff, gbase) do { _Pragma("unroll") for (int _i = 0; _i < 2; ++_i) \
    __builtin_amdgcn_global_load_lds((const unsigned*)((const char*)(gbase) + voff[_i]), (PG8_LAS unsigned*)(lds + (bufoff) + ldsw + _i * 8192), 16, 0, 0); } while (0)
#define PG8_LDA(dst, b, h) do { _Pragma("unroll") for (int m = 0; m < 4; ++m) _Pragma("unroll") for (int k = 0; k < 2; ++k) dst[m][k] = *(const PG8_LAS bf16x8*)(lds + PG8_SA(b, h) + aoff + m * 2048 + k * 1024); } while (0)
#define PG8_LDB(dst, b, h) do { _Pragma("unroll") for (int n = 0; n < 2; ++n) _Pragma("unroll") for (int k = 0; k < 2; ++k) dst[n][k] = *(const PG8_LAS bf16x8*)(lds + PG8_SB(b, h) + boff + n * 2048 + k * 1024); } while (0)
#define PG8_MMA(ai, bj, At, Bt) do { __builtin_amdgcn_s_setprio(1); _Pragma("unroll") for (int m = 0; m < 4; ++m) _Pragma("unroll") for (int n = 0; n < 2; ++n) _Pragma("unroll") for (int k = 0; k < 2; ++k) \
    acc[ai][bj][m][n] = __builtin_amdgcn_mfma_f32_16x16x32_bf16(Bt[n][k], At[m][k], acc[ai][bj][m][n], 0, 0, 0); __builtin_amdgcn_s_setprio(0); } while (0)
#define PG8_WAIT_V(n) asm volatile("s_waitcnt vmcnt(" #n ")" ::: "memory")
#define PG8_WAIT_L(n) asm volatile("s_waitcnt lgkmcnt(" #n ")" ::: "memory")
#define PG8_BAR __builtin_amdgcn_s_barrier()
#define PG8_SCHED __builtin_amdgcn_sched_barrier(0)
  Unit cur, nxt; int ui = 0;
  if (!S.next(0, cur)) return;
  f32x4 acc[2][2][4][2];
#pragma unroll
  for (int a = 0; a < 2; ++a)
#pragma unroll
    for (int b = 0; b < 2; ++b)
#pragma unroll
      for (int m = 0; m < 4; ++m)
#pragma unroll
        for (int n = 0; n < 2; ++n) acc[a][b][m][n] = (f32x4){0.f, 0.f, 0.f, 0.f};
  bf16x8 At[4][2], B0[2][2], B1[2][2];
  const char* cA = (const char*)g.A + (size_t)cur.pm * tstep; const char* cB = (const char*)g.Bt + (size_t)cur.pn * tstep;
  { const char* a0 = cA + (size_t)PG8_KX(0) * kstep; const char* b0 = cB + (size_t)PG8_KX(0) * kstep;
    const char* a1 = cA + (size_t)PG8_KX(1) * kstep; const char* b1 = cB + (size_t)PG8_KX(1) * kstep;
    PG8_STAGE(PG8_SB(0, 0), b0); PG8_STAGE(PG8_SA(0, 0), a0); PG8_STAGE(PG8_SB(0, 1), b0 + hstep); PG8_STAGE(PG8_SA(0, 1), a0 + hstep);
    if (wr == 1) PG8_BAR;
    PG8_WAIT_V(4); PG8_BAR;
    PG8_STAGE(PG8_SB(1, 0), b1); PG8_STAGE(PG8_SA(1, 0), a1); PG8_STAGE(PG8_SB(1, 1), b1 + hstep);
    PG8_WAIT_V(6); PG8_BAR; }
  for (;;) {
    const bool has_next = S.next(ui + 1, nxt);
    const char* nA = has_next ? (const char*)g.A + (size_t)nxt.pm * tstep : cA; const char* nB = has_next ? (const char*)g.Bt + (size_t)nxt.pn * tstep : cB;
#define PG8_ITER(t) {\
      const bool last = (t == nt - 2);\
      const char* a1 = cA + (size_t)PG8_KX(t + 1) * kstep;\
      const char* a2 = last ? nA + (size_t)PG8_KX(0) * kstep : cA + (size_t)PG8_KX(t + 2) * kstep;\
      const char* b2 = last ? nB + (size_t)PG8_KX(0) * kstep : cB + (size_t)PG8_KX(t + 2) * kstep;\
      const char* a3 = last ? nA + (size_t)PG8_KX(1) * kstep : cA + (size_t)PG8_KX(t + 3) * kstep;\
      const char* b3 = last ? nB + (size_t)PG8_KX(1) * kstep : cB + (size_t)PG8_KX(t + 3) * kstep;\
      PG8_LDB(B0, 0, 0); PG8_SCHED; PG8_LDA(At, 0, 0); PG8_STAGE(PG8_SA(1, 1), a1 + hstep);\
      PG8_WAIT_L(8); PG8_BAR; PG8_WAIT_L(0); PG8_MMA(0, 0, At, B0); PG8_BAR; PG8_SCHED;\
      PG8_LDB(B1, 0, 1); PG8_STAGE(PG8_SB(0, 0), b2);\
      PG8_BAR; PG8_WAIT_L(0); PG8_MMA(0, 1, At, B1); PG8_BAR;\
      PG8_LDA(At, 0, 1); PG8_STAGE(PG8_SA(0, 0), a2);\
      PG8_BAR; PG8_WAIT_L(0); PG8_MMA(1, 0, At, B0); PG8_BAR; PG8_SCHED;\
      PG8_STAGE(PG8_SB(0, 1), b2 + hstep);\
      PG8_WAIT_V(6); PG8_BAR; PG8_MMA(1, 1, At, B1); PG8_BAR;\
      PG8_LDB(B0, 1, 0); PG8_SCHED; PG8_LDA(At, 1, 0); PG8_STAGE(PG8_SA(0, 1), a2 + hstep);\
      PG8_WAIT_L(8); PG8_BAR; PG8_WAIT_L(0); PG8_MMA(0, 0, At, B0); PG8_BAR; PG8_SCHED;\
      PG8_LDB(B1, 1, 1); PG8_STAGE(PG8_SB(1, 0), b3);\
      PG8_BAR; PG8_WAIT_L(0); PG8_MMA(0, 1, At, B1); PG8_BAR;\
      PG8_LDA(At, 1, 1); PG8_STAGE(PG8_SA(1, 0), a3);\
      PG8_BAR; PG8_WAIT_L(0); PG8_MMA(1, 0, At, B0); PG8_BAR; PG8_SCHED;\
      PG8_STAGE(PG8_SB(1, 1), b3 + hstep);\
      PG8_WAIT_V(6); PG8_BAR; PG8_MMA(1, 1, At, B1); PG8_BAR;\
}
    if (Epi::MID) {
      for (int t = 0; t < 16; t += 2) PG8_ITER(t)
      E.mid(acc, cur, wr, fr);
      for (int t = 16; t < nt; t += 2) PG8_ITER(t)
    } else {
      for (int t = 0; t < nt; t += 2) PG8_ITER(t)
    }
#undef PG8_ITER
    E(acc, cur, wr, wc, fr, fq);
    if (!has_next) break;
#pragma unroll
    for (int a = 0; a < 2; ++a)
#pragma unroll
      for (int b = 0; b < 2; ++b)
#pragma unroll
        for (int m = 0; m < 4; ++m)
#pragma unroll
          for (int n = 0; n < 2; ++n) acc[a][b][m][n] = (f32x4){0.f, 0.f, 0.f, 0.f};
    cur = nxt; cA = nA; cB = nB; ++ui;
  }
  PG8_WAIT_V(0);
  if (wr == 0) PG8_BAR;
  PG8_BAR;
#undef PG8_KX
#undef PG8_SA
#undef PG8_SB
#undef PG8_STAGE
#undef PG8_LDA
#undef PG8_LDB
#undef PG8_MMA
#undef PG8_WAIT_V
#undef PG8_WAIT_L
#undef PG8_BAR
#undef PG8_SCHED
}
}

__device__ __forceinline__ void conv8(const bf16_t* __restrict__ proj, int t, int tt_in_seq, int col,
                                      const float* __restrict__ cw, int ld_w, const float* __restrict__ cb, int ch,
                                      float* o) {
  f32x4 b0 = *(const f32x4*)(cb + ch), b1 = *(const f32x4*)(cb + ch + 4);
  o[0] = b0[0]; o[1] = b0[1]; o[2] = b0[2]; o[3] = b0[3];
  o[4] = b1[0]; o[5] = b1[1]; o[6] = b1[2]; o[7] = b1[3];
#pragma unroll
  for (int k = 0; k < 4; ++k) {
    if (tt_in_seq - 3 + k >= 0) {
      u32x4 v = *(const u32x4*)(proj + (size_t)(t - 3 + k) * LDP + col);
      f32x4 w0 = *(const f32x4*)(cw + k * ld_w + ch), w1 = *(const f32x4*)(cw + k * ld_w + ch + 4);
      o[0] += w0[0] * bflo(v[0]); o[1] += w0[1] * bfhi(v[0]);
      o[2] += w0[2] * bflo(v[1]); o[3] += w0[3] * bfhi(v[1]);
      o[4] += w1[0] * bflo(v[2]); o[5] += w1[1] * bfhi(v[2]);
      o[6] += w1[2] * bflo(v[3]); o[7] += w1[3] * bfhi(v[3]);
    }
  }
}
__device__ __forceinline__ void conv4(const bf16_t* __restrict__ proj, int t, int tt_in_seq, int col,
                                      const float* __restrict__ cw, int ld_w, const float* __restrict__ cb, int ch,
                                      float* o) {
  f32x4 b0 = *(const f32x4*)(cb + ch);
  o[0] = b0[0]; o[1] = b0[1]; o[2] = b0[2]; o[3] = b0[3];
#pragma unroll
  for (int k = 0; k < 4; ++k) {
    if (tt_in_seq - 3 + k >= 0) {
      u32x2 v = *(const u32x2*)(proj + (size_t)(t - 3 + k) * LDP + col);
      f32x4 w0 = *(const f32x4*)(cw + k * ld_w + ch);
      o[0] += w0[0] * bflo(v[0]); o[1] += w0[1] * bfhi(v[0]);
      o[2] += w0[2] * bflo(v[1]); o[3] += w0[3] * bfhi(v[1]);
    }
  }
}
__device__ __forceinline__ bf16x8 cfrag(const Params& p, const bf16_t* proj, int t, int tseq, int g, int n8) {
  float o[8];
  const int ch = 1280 + g * 128 + n8;
  conv8(proj, t, tseq, 3072 + ch, p.ssd_conv_w, 1536, p.ssd_conv_b, ch, o);
#pragma unroll
  for (int i = 0; i < 8; ++i) o[i] = silu_(o[i]);
  u32x4 r = {pk2(o[0], o[1]), pk2(o[2], o[3]), pk2(o[4], o[5]), pk2(o[6], o[7])};
  return as_frag(r);
}

__device__ void lru_local_unit(const Params& p, unsigned char* smem, int unit) {
  const int tid = threadIdx.x & 255, lane = tid & 63, wid = tid >> 6, l15 = lane & 15, q4 = lane >> 4;
  const int hh = unit & 15, c = (unit >> 4) & 15, b = unit >> 8;
  const int t0 = b * 2048 + c * 128, ch0 = hh * 64;
  unsigned char* ws = p.ws;
  const bf16_t* proj = (const bf16_t*)(ws + OFF_PROJ);
  float* R1 = (float*)smem;
  float* R2 = (float*)(smem + 33536);
  float* R3 = (float*)(smem + 33536 + 32768);
#pragma unroll 11
  for (int e = tid; e < 131 * 64; e += HTHR) {
    const int r = e >> 6, j = e & 63, tt = r - 3;
    float v = 0.f;
    if (c * 128 + tt >= 0) v = bf2f(proj[(size_t)(t0 + tt) * LDP + ch0 + j]);
    R1[e] = v;
  }
  __syncthreads();
  {
    const int j = tid & 63;
    const float cb = p.lru_conv_b[ch0 + j];
    const float w0 = p.lru_conv_w[0 * 1024 + ch0 + j], w1 = p.lru_conv_w[1 * 1024 + ch0 + j],
                w2 = p.lru_conv_w[2 * 1024 + ch0 + j], w3 = p.lru_conv_w[3 * 1024 + ch0 + j];
#pragma unroll 8
    for (int tt = tid >> 6; tt < 128; tt += 4) {
      R2[tt * 64 + j] = cb + w0 * R1[tt * 64 + j] + w1 * R1[(tt + 1) * 64 + j] + w2 * R1[(tt + 2) * 64 + j] +
                        w3 * R1[(tt + 3) * 64 + j];
    }
  }
  __syncthreads();
  {
    const bf16_t* waT = (const bf16_t*)(ws + OFF_WAT) + (size_t)hh * 4096;
    const bf16_t* wxT = (const bf16_t*)(ws + OFF_WXT) + (size_t)hh * 4096;
    f32x4 aa[2][4], ax[2][4];
#pragma unroll
    for (int i = 0; i < 2; ++i)
#pragma unroll
      for (int j = 0; j < 4; ++j) { aa[i][j] = (f32x4){0, 0, 0, 0}; ax[i][j] = (f32x4){0, 0, 0, 0}; }
#pragma unroll
    for (int ks = 0; ks < 2; ++ks) {
      bf16x8 af[2];
#pragma unroll
      for (int mi = 0; mi < 2; ++mi) {
        const float* src = R2 + (wid * 32 + mi * 16 + l15) * 64 + ks * 32 + q4 * 8;
        f32x4 v0 = *(const f32x4*)src, v1 = *(const f32x4*)(src + 4);
        u32x4 r = {pk2(v0[0], v0[1]), pk2(v0[2], v0[3]), pk2(v1[0], v1[1]), pk2(v1[2], v1[3])};
        af[mi] = as_frag(r);
      }
#pragma unroll
      for (int ni = 0; ni < 4; ++ni) {
        const size_t wo = (size_t)(ni * 16 + l15) * 64 + ks * 32 + q4 * 8;
        bf16x8 ba = as_frag(*(const u32x4*)(waT + wo));
        bf16x8 bx = as_frag(*(const u32x4*)(wxT + wo));
#pragma unroll
        for (int mi = 0; mi < 2; ++mi) {
          aa[mi][ni] = mfma16(af[mi], ba, aa[mi][ni]);
          ax[mi][ni] = mfma16(af[mi], bx, ax[mi][ni]);
        }
      }
    }
#pragma unroll
    for (int ni = 0; ni < 4; ++ni) {
      const int j = ni * 16 + l15;
      const float ba = p.lru_ba[ch0 + j], bx = p.lru_bx[ch0 + j];
      const float lam = p.lru_lambda[ch0 + j];
      const float spl = -8.f * log1pf(__expf(-lam));
#pragma unroll
      for (int mi = 0; mi < 2; ++mi)
#pragma unroll
        for (int r = 0; r < 4; ++r) {
          const int tt = wid * 32 + mi * 16 + q4 * 4 + r;
          const float rg = sigmoid_(aa[mi][ni][r] + ba);
          const float ig = sigmoid_(ax[mi][ni][r] + bx);
          const float log_a = spl * rg;
          const float av = __expf(log_a);
          const float xl = R2[tt * 64 + j];
          const float bv = sqrtf(fmaxf(-expm1f(2.f * log_a), 0.f)) * (ig * xl);
          R1[tt * 64 + j] = av;
          R2[tt * 64 + j] = bv;
        }
    }
  }
  __syncthreads();
  {
    const int j = tid & 63, seg = tid >> 6;
    float h = 0.f, Ac = 1.f;
#pragma unroll 4
    for (int s = 0; s < 32; ++s) {
      const int tt = seg * 32 + s;
      const float a = R1[tt * 64 + j], bb = R2[tt * 64 + j];
      h = a * h + bb;
      Ac *= a;
      R2[tt * 64 + j] = h;
      R1[tt * 64 + j] = Ac;
    }
    R3[seg * 64 + j] = h;
    R3[256 + seg * 64 + j] = Ac;
    __syncthreads();
    float cin = 0.f, Ain = 1.f;
    for (int s2 = 0; s2 < seg; ++s2) {
      cin = R3[256 + s2 * 64 + j] * cin + R3[s2 * 64 + j];
      Ain *= R3[256 + s2 * 64 + j];
    }
    float* hloc = (float*)(ws + OFF_HLOC);
    float* cumA = (float*)(ws + OFF_CUMA);
#pragma unroll 4
    for (int s = 0; s < 32; ++s) {
      const int tt = seg * 32 + s;
      const float hl = R2[tt * 64 + j] + R1[tt * 64 + j] * cin;
      const float Al = R1[tt * 64 + j] * Ain;
      hloc[(size_t)(t0 + tt) * 1024 + ch0 + j] = hl;
      cumA[(size_t)(t0 + tt) * 1024 + ch0 + j] = Al;
    }
  }
  __syncthreads();
}

__device__ void ssd_local_unit(const Params& p, unsigned char* smem, int unit) {
  const int tid = threadIdx.x & 255, lane = tid & 63, wid = tid >> 6, l15 = lane & 15, q4 = lane >> 4;
  const int hh = unit & 15, c = (unit >> 4) & 15, b = unit >> 8, g = hh >> 3;
  const int t0 = b * 2048 + c * 128, ts0 = c * 128;
  unsigned char* ws = p.ws;
  const bf16_t* proj = (const bf16_t*)(ws + OFF_PROJ);
  unsigned char* Bm = smem;
  unsigned char* XT = smem + 32768;
  unsigned char* Pw = smem + 49152 + wid * 4096;
  float* dts = (float*)(smem + 65536);
  float* acs = dts + 128;
  float* adt = acs + 128;
  if (tid < 128) {
    const float raw = bf2f(proj[(size_t)(t0 + tid) * LDP + 4608 + hh]);
    const float dtv = softplus_(raw + p.ssd_dt_bias[hh]);
    dts[tid] = dtv;
    adt[tid] = -__expf(p.ssd_a_log[hh]) * dtv;
  }
  __syncthreads();
  if (tid < 128) {
    float s = 0.f;
    for (int k = 0; k <= tid; ++k) s += adt[k];
    acs[tid] = s;
    ((float*)(ws + OFF_ACS))[(size_t)(t0 + tid) * 16 + hh] = s;
  }
  {
    const int chunk = tid & 15;
    const int ch = 1024 + g * 128 + chunk * 8;
#pragma unroll 4
    for (int i = 0; i < 8; ++i) {
      const int tt = (tid >> 4) + 16 * i;
      float o[8];
      conv8(proj, t0 + tt, ts0 + tt, 3072 + ch, p.ssd_conv_w, 1536, p.ssd_conv_b, ch, o);
#pragma unroll
      for (int e = 0; e < 8; ++e) o[e] = silu_(o[e]);
      u32x4 r = {pk2(o[0], o[1]), pk2(o[2], o[3]), pk2(o[4], o[5]), pk2(o[6], o[7])};
      *(u32x4*)(Bm + sw256(tt, chunk)) = r;
    }
  }
  __syncthreads();
  {
    const int pp = tid & 63;
    const int ch = hh * 64 + pp;
    const float cb = p.ssd_conv_b[ch];
    const float w0 = p.ssd_conv_w[ch], w1 = p.ssd_conv_w[1536 + ch], w2 = p.ssd_conv_w[2 * 1536 + ch],
                w3 = p.ssd_conv_w[3 * 1536 + ch];
#pragma unroll 2
    for (int i = 0; i < 4; ++i) {
      const int chunk = (tid >> 6) * 4 + i;
      const int tt0 = chunk * 8;
      float xv[11];
#pragma unroll
      for (int k = 0; k < 11; ++k) {
        const int tt = tt0 - 3 + k;
        xv[k] = (ts0 + tt >= 0) ? bf2f(proj[(size_t)(t0 + tt) * LDP + 3072 + ch]) : 0.f;
      }
      float o[8];
#pragma unroll
      for (int e = 0; e < 8; ++e) {
        const float cv = cb + w0 * xv[e] + w1 * xv[e + 1] + w2 * xv[e + 2] + w3 * xv[e + 3];
        o[e] = silu_(cv) * dts[tt0 + e];
      }
      u32x4 r = {pk2(o[0], o[1]), pk2(o[2], o[3]), pk2(o[4], o[5]), pk2(o[6], o[7])};
      *(u32x4*)(XT + sw256(pp, chunk)) = r;
    }
  }
  __syncthreads();
  bf16_t* ypart = (bf16_t*)(ws + OFF_YPART);
  const float Dh = p.ssd_d[hh];
#pragma unroll 1
  for (int mt = 0; mt < 2; ++mt) {
    const int M = wid * 2 + mt;
    const int lrow = M * 16 + l15;
    bf16x8 cf[4];
#pragma unroll
    for (int ks = 0; ks < 4; ++ks) cf[ks] = cfrag(p, proj, t0 + lrow, ts0 + lrow, g, ks * 32 + q4 * 8);
    const float acl = acs[lrow];
    const int ntmax = M | 1;
#pragma unroll 1
    for (int nt = 0; nt <= ntmax; ++nt) {
      f32x4 a4 = (f32x4){0, 0, 0, 0};
      if (nt <= M) {
#pragma unroll
        for (int ks = 0; ks < 4; ++ks) {
          bf16x8 bfr = *(const bf16x8*)(Bm + sw256(nt * 16 + l15, ks * 4 + q4));
          a4 = mfma16(bfr, cf[ks], a4);
        }
      }
      float pv[4];
#pragma unroll
      for (int r = 0; r < 4; ++r) {
        const int s = nt * 16 + q4 * 4 + r;
        pv[r] = (s <= lrow) ? a4[r] * __expf(acl - acs[s]) : 0.f;
      }
      u32x2 o = {pk2(pv[0], pv[1]), pk2(pv[2], pv[3])};
      const int chunk = nt * 2 + (q4 >> 1);
      *(u32x2*)(Pw + sw256(l15, chunk) + (q4 & 1) * 8) = o;
    }
    f32x4 ya[4];
#pragma unroll
    for (int pt = 0; pt < 4; ++pt) ya[pt] = (f32x4){0, 0, 0, 0};
    const int ksmax = M >> 1;
#pragma unroll 1
    for (int ks = 0; ks <= ksmax; ++ks) {
      bf16x8 pf = *(const bf16x8*)(Pw + sw256(l15, ks * 4 + q4));
#pragma unroll
      for (int pt = 0; pt < 4; ++pt) {
        bf16x8 xf = *(const bf16x8*)(XT + sw256(pt * 16 + l15, ks * 4 + q4));
        ya[pt] = mfma16(xf, pf, ya[pt]);
      }
    }
#pragma unroll
    for (int pt = 0; pt < 4; ++pt) {
      const int pc = pt * 16 + q4 * 4;
      const int ch = hh * 64 + pc;
      float xo[4];
      conv4(proj, t0 + lrow, ts0 + lrow, 3072 + ch, p.ssd_conv_w, 1536, p.ssd_conv_b, ch, xo);
      float y0 = ya[pt][0] + Dh * silu_(xo[0]), y1 = ya[pt][1] + Dh * silu_(xo[1]);
      float y2 = ya[pt][2] + Dh * silu_(xo[2]), y3 = ya[pt][3] + Dh * silu_(xo[3]);
      u32x2 o = {pk2(y0, y1), pk2(y2, y3)};
      *(u32x2*)(ypart + (size_t)(t0 + lrow) * 1024 + ch) = o;
    }
  }
  {
    f32x4 sa[2][4];
#pragma unroll
    for (int i = 0; i < 2; ++i)
#pragma unroll
      for (int j = 0; j < 4; ++j) sa[i][j] = (f32x4){0, 0, 0, 0};
    const float aend = acs[127];
#pragma unroll 1
    for (int ks = 0; ks < 4; ++ks) {
      float dec[8];
#pragma unroll
      for (int e = 0; e < 8; ++e) dec[e] = __expf(aend - acs[ks * 32 + q4 * 8 + e]);
      bf16x8 bd[2];
#pragma unroll
      for (int ni = 0; ni < 2; ++ni) {
        const int n = wid * 32 + ni * 16 + l15;
        float v[8];
#pragma unroll
        for (int e = 0; e < 8; ++e) {
          const int l = ks * 32 + q4 * 8 + e;
          const bf16_t raw = *(const bf16_t*)(Bm + sw256(l, n >> 3) + (n & 7) * 2);
          v[e] = bf2f(raw) * dec[e];
        }
        u32x4 r = {pk2(v[0], v[1]), pk2(v[2], v[3]), pk2(v[4], v[5]), pk2(v[6], v[7])};
        bd[ni] = as_frag(r);
      }
#pragma unroll
      for (int pt = 0; pt < 4; ++pt) {
        bf16x8 xf = *(const bf16x8*)(XT + sw256(pt * 16 + l15, ks * 4 + q4));
#pragma unroll
        for (int ni = 0; ni < 2; ++ni) sa[ni][pt] = mfma16(bd[ni], xf, sa[ni][pt]);
      }
    }
    float* St = (float*)(ws + OFF_ST) + (size_t)((b * 16 + c) * 16 + hh) * 8192;
#pragma unroll
    for (int ni = 0; ni < 2; ++ni)
#pragma unroll
      for (int pt = 0; pt < 4; ++pt) {
        const int pr = pt * 16 + l15, n = wid * 32 + ni * 16 + q4 * 4;
        *(f32x4*)(St + pr * 128 + n) = sa[ni][pt];
      }
  }
  __syncthreads();
}

__device__ void phase_carry(const Params& p) {
  unsigned char* ws = p.ws;
  const int gt = blockIdx.x * NTHR + threadIdx.x, ng = gridDim.x * NTHR;
  const float* hloc = (const float*)(ws + OFF_HLOC);
  const float* cumA = (const float*)(ws + OFF_CUMA);
  float* lcarry = (float*)(ws + OFF_LCARRY);
  for (int i = gt; i < 8192; i += ng) {
    const int b = i >> 10, ch = i & 1023;
    float ca[16], hl[16];
#pragma unroll
    for (int c = 0; c < 16; ++c) {
      const size_t tl = (size_t)(b * 2048 + c * 128 + 127) * 1024 + ch;
      ca[c] = cumA[tl];
      hl[c] = hloc[tl];
    }
    float carry = 0.f;
#pragma unroll
    for (int c = 0; c < 16; ++c) {
      lcarry[(size_t)(b * 16 + c) * 1024 + ch] = carry;
      carry = ca[c] * carry + hl[c];
    }
  }
  const float* acsG = (const float*)(ws + OFF_ACS);
  float* St = (float*)(ws + OFF_ST);
  for (int i = gt; i < 128 * 2048; i += ng) {
    const int bh = i >> 11, e4 = i & 2047, b = bh >> 4, hh = bh & 15;
    f32x4 tmp[16];
    float Ad[16];
#pragma unroll
    for (int c = 0; c < 16; ++c) {
      Ad[c] = __expf(acsG[(size_t)(b * 2048 + c * 128 + 127) * 16 + hh]);
      tmp[c] = *(const f32x4*)(St + (size_t)((b * 16 + c) * 16 + hh) * 8192 + e4 * 4);
    }
    f32x4 s = (f32x4){0, 0, 0, 0};
#pragma unroll
    for (int c = 0; c < 16; ++c) {
      *(f32x4*)(St + (size_t)((b * 16 + c) * 16 + hh) * 8192 + e4 * 4) = s;
      s = s * Ad[c] + tmp[c];
    }
  }
}

__device__ void ssd_final_unit(const Params& p, int unit) {
  const int tid = threadIdx.x & 255, lane = tid & 63, wid = tid >> 6, l15 = lane & 15, q4 = lane >> 4;
  const int hh = unit & 15, c = (unit >> 4) & 15, b = unit >> 8, g = hh >> 3;
  const int t0 = b * 2048 + c * 128, ts0 = c * 128;
  unsigned char* ws = p.ws;
  const bf16_t* proj = (const bf16_t*)(ws + OFF_PROJ);
  const float* Sin = (const float*)(ws + OFF_ST) + (size_t)((b * 16 + c) * 16 + hh) * 8192;
  const bf16_t* ypart = (const bf16_t*)(ws + OFF_YPART);
  const float* acsG = (const float*)(ws + OFF_ACS);
  bf16_t* A2 = (bf16_t*)(ws + OFF_XB);
  float* ssq = (float*)(ws + OFF_SSQ);
#pragma unroll 1
  for (int mt = 0; mt < 2; ++mt) {
    const int lrow = (wid * 2 + mt) * 16 + l15;
    f32x4 ya[4];
#pragma unroll
    for (int pt = 0; pt < 4; ++pt) ya[pt] = (f32x4){0, 0, 0, 0};
    if (c > 0) {
#pragma unroll 2
      for (int ks = 0; ks < 4; ++ks) {
        bf16x8 cf = cfrag(p, proj, t0 + lrow, ts0 + lrow, g, ks * 32 + q4 * 8);
#pragma unroll
        for (int pt = 0; pt < 4; ++pt) {
          const float* sp = Sin + (pt * 16 + l15) * 128 + ks * 32 + q4 * 8;
          f32x4 v0 = *(const f32x4*)sp, v1 = *(const f32x4*)(sp + 4);
          u32x4 r = {pk2(v0[0], v0[1]), pk2(v0[2], v0[3]), pk2(v1[0], v1[1]), pk2(v1[2], v1[3])};
          ya[pt] = mfma16(as_frag(r), cf, ya[pt]);
        }
      }
    }
    const size_t t = (size_t)(t0 + lrow);
    const float ea = __expf(acsG[t * 16 + hh]);
    float ss = 0.f;
#pragma unroll
    for (int pt = 0; pt < 4; ++pt) {
      const int ch = hh * 64 + pt * 16 + q4 * 4;
      u32x2 yp = *(const u32x2*)(ypart + t * 1024 + ch);
      u32x2 zz = *(const u32x2*)(proj + t * LDP + 2048 + ch);
      float y[4] = {bflo(yp[0]) + ea * ya[pt][0], bfhi(yp[0]) + ea * ya[pt][1], bflo(yp[1]) + ea * ya[pt][2],
                    bfhi(yp[1]) + ea * ya[pt][3]};
      float z[4] = {bflo(zz[0]), bfhi(zz[0]), bflo(zz[1]), bfhi(zz[1])};
#pragma unroll
      for (int r = 0; r < 4; ++r) { y[r] = y[r] * silu_(z[r]); ss += y[r] * y[r]; }
      u32x2 o = {pk2(y[0], y[1]), pk2(y[2], y[3])};
      *(u32x2*)(A2 + t * DM + 1024 + ch) = o;
    }
    ss += __shfl_xor(ss, 16);
    ss += __shfl_xor(ss, 32);
    if (q4 == 0) ssq[t * 16 + hh] = ss;
  }
}

__device__ void phase_mix_final(const Params& p) {
  unsigned char* ws = p.ws;
  const bf16_t* proj = (const bf16_t*)(ws + OFF_PROJ);
  const f32x4* hloc = (const f32x4*)(ws + OFF_HLOC);
  const f32x4* cumA = (const f32x4*)(ws + OFF_CUMA);
  const float* lcarry = (const float*)(ws + OFF_LCARRY);
  bf16_t* A2 = (bf16_t*)(ws + OFF_XB);
  for (int u = blockIdx.x * 2 + (threadIdx.x >> 8); u < 2048; u += gridDim.x * 2) ssd_final_unit(p, u);
#pragma unroll 4
  for (int i = blockIdx.x * NTHR + threadIdx.x; i < T_TOK * 256; i += gridDim.x * NTHR) {
    const int t = i >> 8, ch = (i & 255) * 4;
    f32x4 h = hloc[i], ca = cumA[i];
    f32x4 cr = *(const f32x4*)(lcarry + (size_t)(t >> 7) * 1024 + ch);
    u32x2 gg = *(const u32x2*)(proj + (size_t)t * LDP + 1024 + ch);
    float y0 = (h[0] + ca[0] * cr[0]) * gelu_(bflo(gg[0]));
    float y1 = (h[1] + ca[1] * cr[1]) * gelu_(bfhi(gg[0]));
    float y2 = (h[2] + ca[2] * cr[2]) * gelu_(bflo(gg[1]));
    float y3 = (h[3] + ca[3] * cr[3]) * gelu_(bfhi(gg[1]));
    u32x2 o = {pk2(y0, y1), pk2(y2, y3)};
    *(u32x2*)(A2 + (size_t)t * DM + ch) = o;
  }
}

__device__ void convert_uv(const Params& p) {
  unsigned char* ws = p.ws;
  const int lane = threadIdx.x & 63, wid = threadIdx.x >> 6;
  unsigned char* tb = ws + OFF_XB;
  float* scales = (float*)(ws + OFF_SCALES);
  for (int row = blockIdx.x * 8 + wid; row < 32768; row += gridDim.x * 8) {
    const bool isv = row >= 16384;
    const int e = row & 16383;
    const float* src = (isv ? p.peer_v : p.peer_u) + (size_t)e * DM + lane * 32;
    float vals[32];
    float ss = 0.f;
#pragma unroll
    for (int q = 0; q < 8; ++q) {
      f32x4 t = *(const f32x4*)(src + q * 4);
      if (!isv) t *= *(const f32x4*)(p.norm_ffn_w + lane * 32 + q * 4);
#pragma unroll
      for (int k = 0; k < 4; ++k) {
        vals[q * 4 + k] = t[k];
        ss += t[k] * t[k];
      }
    }
    ss = wave_sum(ss);
    const float rms = sqrtf(ss * (1.f / 2048.f));
    const float sc = rms * (2.6f / 7.f);
    const float inv = sc > 0.f ? 1.f / sc : 0.f;
    u32x4 o;
#pragma unroll
    for (int m = 0; m < 4; ++m) {
      unsigned w = 0;
#pragma unroll
      for (int j = 0; j < 4; ++j) {
        const float lo = fminf(fmaxf(rintf(vals[m * 8 + j] * inv), -7.f), 7.f);
        const float hi = fminf(fmaxf(rintf(vals[m * 8 + 4 + j] * inv), -7.f), 7.f);
        const unsigned bl = (unsigned)((int)lo + 8), bh = (unsigned)((int)hi + 8);
        w |= (bl | (bh << 4)) << (8 * j);
      }
      o[m] = w;
    }
    *(u32x4*)(tb + (size_t)row * 1024 + lane * 16) = o;
    if (lane == 0) scales[row] = sc;
  }
}

__device__ const unsigned char cand_tab[64] = {
    0x00, 0x01, 0x02, 0x03, 0x04, 0x05, 0x06, 0x07, 0x08, 0x09, 0x0a, 0x0b, 0x0c, 0x0d, 0x0e, 0x0f,
    0x10, 0x11, 0x12, 0x13, 0x14, 0x15, 0x16, 0x17,
    0x20, 0x21, 0x22, 0x23, 0x24,
    0x30, 0x31, 0x32, 0x33,
    0x40, 0x41, 0x42,
    0x50, 0x51, 0x60, 0x61, 0x70, 0x71,
    0x80, 0x90, 0xa0, 0xb0, 0xc0, 0xd0, 0xe0, 0xf0,
    0xff, 0xff, 0xff, 0xff, 0xff, 0xff, 0xff, 0xff, 0xff, 0xff, 0xff, 0xff, 0xff, 0xff};

__device__ __forceinline__ unsigned ord_key(float f) {
  unsigned u = __float_as_uint(f);
  return u ^ ((u >> 31) ? 0xffffffffu : 0x80000000u);
}
__device__ __forceinline__ float ord_dec(unsigned k) {
  unsigned u = (k >> 31) ? (k ^ 0x80000000u) : ~k;
  return __uint_as_float(u);
}

__device__ void topk_unit(const Params& p, unsigned char* smem, int unit) {
  const int tid = threadIdx.x & 255, lane = tid & 63, wid = tid >> 6, l15 = lane & 15, q4 = lane >> 4;
  const int h = unit & 7, tile = unit >> 3;
  const int tok0 = tile * 64 + wid * 16;
  unsigned char* ws = p.ws;
  const bf16_t* qg = (const bf16_t*)(ws + OFF_Q);
  const bf16_t* kb = (const bf16_t*)(ws + OFF_KEYSB);
  unsigned* S = (unsigned*)(smem + wid * 16640);
  float* tops = (float*)(smem + 4 * 16640 + wid * 256);
  int* topi = (int*)(tops + 32);
  unsigned* Ms = (unsigned*)(smem + 67584 + wid * 768);
#pragma unroll
  for (int k = 0; k < 2; ++k) {
    f32x4 sc[8];
#pragma unroll
    for (int i = 0; i < 8; ++i) sc[i] = (f32x4){0, 0, 0, 0};
#pragma unroll
    for (int ks = 0; ks < 4; ++ks) {
      bf16x8 qf = as_frag(*(const u32x4*)(qg + (size_t)(tok0 + l15) * DM + h * 256 + k * 128 + ks * 32 + q4 * 8));
#pragma unroll
      for (int nt = 0; nt < 8; ++nt) {
        bf16x8 kf = as_frag(*(const u32x4*)(kb + (size_t)((h * 2 + k) * 128 + nt * 16 + l15) * 128 + ks * 32 + q4 * 8));
        sc[nt] = mfma16(kf, qf, sc[nt]);
      }
    }
#pragma unroll
    for (int nt = 0; nt < 8; ++nt) {
      const int n = nt * 16 + q4 * 4;
      u32x4 kk;
#pragma unroll
      for (int r = 0; r < 4; ++r) kk[r] = (ord_key(sc[nt][r]) & ~127u) | (unsigned)(127 - (n + r));
      *(u32x4*)(S + l15 * 260 + k * 128 + n) = kk;
    }
  }
  const unsigned ct = cand_tab[lane];
  const int ca = ct >> 4, cbb = ct & 15;
  int* idxo = (int*)(ws + OFF_IDX);
  float* go = (float*)(ws + OFF_G);
  for (int tk = 0; tk < 16; ++tk) {
    const unsigned* row = S + tk * 260;
    unsigned ka[2], kb[2], mxk[2];
#pragma unroll
    for (int hf = 0; hf < 2; ++hf) {
      ka[hf] = row[hf * 128 + lane];
      kb[hf] = row[hf * 128 + 64 + lane];
      mxk[hf] = ka[hf] > kb[hf] ? ka[hf] : kb[hf];
      Ms[hf * 96 + lane] = mxk[hf];
    }
    int cnt[2][4];
#pragma unroll
    for (int hf = 0; hf < 2; ++hf)
#pragma unroll
      for (int e = 0; e < 4; ++e) cnt[hf][e] = 0;
#pragma unroll
    for (int j = 0; j < 16; ++j)
#pragma unroll
      for (int hf = 0; hf < 2; ++hf) {
        u32x4 x = *(const u32x4*)(Ms + hf * 96 + j * 4);
#pragma unroll
        for (int e = 0; e < 4; ++e) cnt[hf][e] += (x[e] > mxk[hf]) ? 1 : 0;
      }
    bool ca_[2], cb_[2];
    int pa[2], pb[2], ncand[2];
    const unsigned long long lt = (1ull << lane) - 1ull;
#pragma unroll
    for (int hf = 0; hf < 2; ++hf) {
      const int c_ = cnt[hf][0] + cnt[hf][1] + cnt[hf][2] + cnt[hf][3];
      const unsigned long long bm = __ballot(c_ == 15);
      const int srcT = __ffsll((long long)bm) - 1;
      const unsigned T0 = (unsigned)__shfl((int)mxk[hf], srcT);
      ca_[hf] = ka[hf] >= T0;
      cb_[hf] = kb[hf] >= T0;
      const unsigned long long ba = __ballot(ca_[hf]), bb = __ballot(cb_[hf]);
      const int na = __popcll(ba);
      pa[hf] = __popcll(ba & lt);
      pb[hf] = na + __popcll(bb & lt);
      ncand[hf] = na + __popcll(bb);
    }
#pragma unroll
    for (int hf = 0; hf < 2; ++hf) {
      unsigned* Cs = Ms + hf * 96 + 64;
      if (lane < 32) Cs[lane] = 0u;
      if (ca_[hf]) Cs[pa[hf]] = ka[hf];
      if (cb_[hf]) Cs[pb[hf]] = kb[hf];
    }
    unsigned my[2];
    int rk2[2][4];
#pragma unroll
    for (int hf = 0; hf < 2; ++hf) {
      my[hf] = Ms[hf * 96 + 64 + (lane & 31)];
#pragma unroll
      for (int e = 0; e < 4; ++e) rk2[hf][e] = 0;
    }
#pragma unroll
    for (int j = 0; j < 8; ++j)
#pragma unroll
      for (int hf = 0; hf < 2; ++hf) {
        u32x4 x = *(const u32x4*)(Ms + hf * 96 + 64 + j * 4);
#pragma unroll
        for (int e = 0; e < 4; ++e) rk2[hf][e] += (x[e] > my[hf]) ? 1 : 0;
      }
#pragma unroll
    for (int hf = 0; hf < 2; ++hf) {
      const int r_ = rk2[hf][0] + rk2[hf][1] + rk2[hf][2] + rk2[hf][3];
      if (lane < ncand[hf] && r_ < 16) {
        tops[hf * 16 + r_] = ord_dec(my[hf] & ~127u);
        topi[hf * 16 + r_] = 127 - (int)(my[hf] & 127u);
      }
    }
    float cs = 0.f;
    unsigned ck = 0u;
    if (lane < 50) {
      cs = tops[ca] + tops[16 + cbb];
      ck = (ord_key(cs) & ~255u) | (unsigned)(255 - (ca * 16 + cbb));
    }
    int rkA = 0, rkB = 0;
#pragma unroll
    for (int j = 0; j < 50; j += 2) {
      const unsigned oj = (unsigned)__builtin_amdgcn_readlane((int)ck, j);
      const unsigned oj2 = (unsigned)__builtin_amdgcn_readlane((int)ck, j + 1);
      rkA += (oj > ck) ? 1 : 0;
      rkB += (oj2 > ck) ? 1 : 0;
    }
    const int rk = rkA + rkB;
    const float mx = tops[0] + tops[16];
    const bool sel = (lane < 50) && (rk < 16);
    const float ev = sel ? __expf(cs - mx) : 0.f;
    const float sum = wave_sum(ev);
    if (sel) {
      const size_t o = (size_t)(tok0 + tk) * 128 + h * 16 + rk;
      idxo[o] = topi[ca] * 128 + topi[16 + cbb];
      go[o] = ev / sum;
    }
  }
}

__device__ __forceinline__ float ub0(unsigned w) { return (float)(w & 0xffu); }
__device__ __forceinline__ float ub1(unsigned w) { return (float)((w >> 8) & 0xffu); }
__device__ __forceinline__ float ub2(unsigned w) { return (float)((w >> 16) & 0xffu); }
__device__ __forceinline__ float ub3(unsigned w) { return (float)(w >> 24); }

#define GROWS 8
#ifndef USE_SDOT4
#define USE_SDOT4 1
#endif
typedef float f32x2 __attribute__((ext_vector_type(2)));
__device__ void phase_gather(const Params& p) {
  const int tid = threadIdx.x, lane = tid & 63, wid = tid >> 6;
  unsigned char* ws = p.ws;
  const unsigned char* ub = ws + OFF_XB;
  const unsigned char* vb = ws + OFF_XB + 16 * MIB;
  const float* scales = (const float*)(ws + OFF_SCALES);
  const int* idxg = (const int*)(ws + OFF_IDX);
  const float* gg = (const float*)(ws + OFF_G);
  const float* ssq2 = (const float*)(ws + OFF_SSQ2);
  const bool b5 = (lane & 32) != 0, b4 = (lane & 16) != 0, b3 = (lane & 8) != 0;
  const int srcl = ((lane & 1) << 3) | (((lane >> 1) & 1) << 4) | (((lane >> 2) & 1) << 5);
  for (int t = blockIdx.x * 8 + wid; t < T_TOK; t += gridDim.x * 8) {
    const int id0 = idxg[(size_t)t * 128 + lane], id1 = idxg[(size_t)t * 128 + 64 + lane];
    const float g0 = gg[(size_t)t * 128 + lane], g1 = gg[(size_t)t * 128 + 64 + lane];
    const float su0 = scales[id0], su1 = scales[id1], sv0 = scales[16384 + id0], sv1 = scales[16384 + id1];
    float* orow = p.out + (size_t)t * DM + lane * 32;
    int xlo[4], xhi[4];
    float sx;
    int sumq;
    {
      float xr[32];
      float amax = 0.f;
#pragma unroll
      for (int q = 0; q < 8; ++q) {
        f32x4 v = *(const f32x4*)(orow + q * 4);
#pragma unroll
        for (int k = 0; k < 4; ++k) { xr[q * 4 + k] = v[k]; amax = fmaxf(amax, fabsf(v[k])); }
      }
#pragma unroll
      for (int o = 32; o > 0; o >>= 1) amax = fmaxf(amax, __shfl_xor(amax, o));
      sx = amax * (1.f / 127.f);
      const float inv = amax > 0.f ? 127.f / amax : 0.f;
      int sq_ = 0;
#pragma unroll
      for (int m = 0; m < 4; ++m) {
        unsigned wl = 0, wh = 0;
#pragma unroll
        for (int j = 0; j < 4; ++j) {
          const int a_ = __float2int_rn(xr[m * 8 + j] * inv), b_ = __float2int_rn(xr[m * 8 + 4 + j] * inv);
          sq_ += a_ + b_;
          wl |= ((unsigned)a_ & 0xffu) << (8 * j);
          wh |= ((unsigned)b_ & 0xffu) << (8 * j);
        }
        xlo[m] = (int)wl;
        xhi[m] = (int)wh;
      }
#pragma unroll
      for (int o = 32; o > 0; o >>= 1) sq_ += __shfl_xor(sq_, o);
      sumq = sq_;
    }
    float sq = (lane < 32) ? ssq2[(size_t)t * 32 + lane] : 0.f;
    sq = wave_sum(sq);
    const float rs2 = rsqrtf(sq * (1.f / 2048.f) + EPSV);
    float w0 = 0.f, w1 = 0.f;
#pragma unroll 1
    for (int half = 0; half < 2; ++half) {
      const int idv = half ? id1 : id0;
      int wv = 0;
      u32x4 rr[2][GROWS];
#pragma unroll
      for (int k = 0; k < GROWS; ++k) {
        const int e = __builtin_amdgcn_readlane(idv, k);
        rr[0][k] = *(const u32x4*)(ub + (size_t)e * 1024 + lane * 16);
      }
#pragma unroll
      for (int gi = 0; gi < 64 / GROWS; ++gi) {
        const int j0 = gi * GROWS;
        if (gi + 1 < 64 / GROWS) {
#pragma unroll
          for (int k = 0; k < GROWS; ++k) {
            const int e = __builtin_amdgcn_readlane(idv, j0 + GROWS + k);
            rr[(gi + 1) & 1][k] = *(const u32x4*)(ub + (size_t)e * 1024 + lane * 16);
          }
        }
        int dv[GROWS];
#pragma unroll
        for (int k = 0; k < GROWS; ++k) {
          int d = 0;
#pragma unroll
          for (int m = 0; m < 4; ++m) {
            const unsigned w = rr[gi & 1][k][m];
            const int lo = (int)(w & 0x0f0f0f0fu), hi = (int)((w >> 4) & 0x0f0f0f0fu);
            d = __builtin_amdgcn_sdot4(lo, xlo[m], d, false);
            d = __builtin_amdgcn_sdot4(hi, xhi[m], d, false);
          }
          dv[k] = d;
        }
        int a4[4], a2[2];
#pragma unroll
        for (int k = 0; k < 4; ++k) {
          const int mine = b5 ? dv[k + 4] : dv[k], oth = b5 ? dv[k] : dv[k + 4];
          a4[k] = mine + __shfl_xor(oth, 32);
        }
#pragma unroll
        for (int k = 0; k < 2; ++k) {
          const int mine = b4 ? a4[k + 2] : a4[k], oth = b4 ? a4[k] : a4[k + 2];
          a2[k] = mine + __shfl_xor(oth, 16);
        }
        int c1;
        {
          const int mine = b3 ? a2[1] : a2[0], oth = b3 ? a2[0] : a2[1];
          c1 = mine + __shfl_xor(oth, 8);
        }
        c1 += __shfl_xor(c1, 4);
        c1 += __shfl_xor(c1, 2);
        c1 += __shfl_xor(c1, 1);
        const int val = __shfl(c1, srcl);
        if ((lane & ~7) == j0) wv = val;
      }
      const float su = half ? su1 : su0;
      const float a = gelu_((float)(wv - 8 * sumq) * (su * sx * rs2));
      if (half) w1 = a * g1 * sv1; else w0 = a * g0 * sv0;
    }
    float wmax = fmaxf(fabsf(w0), fabsf(w1));
#pragma unroll
    for (int o = 32; o > 0; o >>= 1) wmax = fmaxf(wmax, __shfl_xor(wmax, o));
    const float sw = wmax * (1.f / 127.f);
    const float winv = wmax > 0.f ? 127.f / wmax : 0.f;
    const int q0 = __float2int_rn(w0 * winv), q1 = __float2int_rn(w1 * winv);
    int wsumq = q0 + q1;
#pragma unroll
    for (int o = 32; o > 0; o >>= 1) wsumq += __shfl_xor(wsumq, o);
    int pk0 = (int)(((unsigned)q0 & 0xffu) << (8 * (lane & 3))), pk1 = (int)(((unsigned)q1 & 0xffu) << (8 * (lane & 3)));
    pk0 |= __shfl_xor(pk0, 1); pk0 |= __shfl_xor(pk0, 2);
    pk1 |= __shfl_xor(pk1, 1); pk1 |= __shfl_xor(pk1, 2);
    int acc[32];
#pragma unroll
    for (int i = 0; i < 32; ++i) acc[i] = 0;
#pragma unroll 1
    for (int half = 0; half < 2; ++half) {
      const int idv = half ? id1 : id0;
      const int pkv = half ? pk1 : pk0;
      u32x4 rr[2][GROWS];
#pragma unroll
      for (int k = 0; k < GROWS; ++k) {
        const int e = __builtin_amdgcn_readlane(idv, k);
        rr[0][k] = *(const u32x4*)(vb + (size_t)e * 1024 + lane * 16);
      }
#pragma unroll
      for (int gi = 0; gi < 64 / GROWS; ++gi) {
        const int j0 = gi * GROWS;
        if (gi + 1 < 64 / GROWS) {
#pragma unroll
          for (int k = 0; k < GROWS; ++k) {
            const int e = __builtin_amdgcn_readlane(idv, j0 + GROWS + k);
            rr[(gi + 1) & 1][k] = *(const u32x4*)(vb + (size_t)e * 1024 + lane * 16);
          }
        }
#pragma unroll
        for (int sub = 0; sub < GROWS / 4; ++sub) {
          const int W4 = __builtin_amdgcn_readlane(pkv, j0 + 4 * sub);
#pragma unroll
          for (int m = 0; m < 4; ++m) {
            unsigned lo[4], hi[4];
#pragma unroll
            for (int k = 0; k < 4; ++k) {
              const unsigned w = rr[gi & 1][sub * 4 + k][m];
              lo[k] = w & 0x0f0f0f0fu;
              hi[k] = (w >> 4) & 0x0f0f0f0fu;
            }
            {
              const unsigned p01l = __builtin_amdgcn_perm(lo[1], lo[0], 0x05010400u), p01h = __builtin_amdgcn_perm(lo[1], lo[0], 0x07030602u);
              const unsigned p23l = __builtin_amdgcn_perm(lo[3], lo[2], 0x05010400u), p23h = __builtin_amdgcn_perm(lo[3], lo[2], 0x07030602u);
              acc[m * 8 + 0] = __builtin_amdgcn_sdot4((int)__builtin_amdgcn_perm(p23l, p01l, 0x05040100u), W4, acc[m * 8 + 0], false);
              acc[m * 8 + 1] = __builtin_amdgcn_sdot4((int)__builtin_amdgcn_perm(p23l, p01l, 0x07060302u), W4, acc[m * 8 + 1], false);
              acc[m * 8 + 2] = __builtin_amdgcn_sdot4((int)__builtin_amdgcn_perm(p23h, p01h, 0x05040100u), W4, acc[m * 8 + 2], false);
              acc[m * 8 + 3] = __builtin_amdgcn_sdot4((int)__builtin_amdgcn_perm(p23h, p01h, 0x07060302u), W4, acc[m * 8 + 3], false);
            }
            {
              const unsigned p01l = __builtin_amdgcn_perm(hi[1], hi[0], 0x05010400u), p01h = __builtin_amdgcn_perm(hi[1], hi[0], 0x07030602u);
              const unsigned p23l = __builtin_amdgcn_perm(hi[3], hi[2], 0x05010400u), p23h = __builtin_amdgcn_perm(hi[3], hi[2], 0x07030602u);
              acc[m * 8 + 4] = __builtin_amdgcn_sdot4((int)__builtin_amdgcn_perm(p23l, p01l, 0x05040100u), W4, acc[m * 8 + 4], false);
              acc[m * 8 + 5] = __builtin_amdgcn_sdot4((int)__builtin_amdgcn_perm(p23l, p01l, 0x07060302u), W4, acc[m * 8 + 5], false);
              acc[m * 8 + 6] = __builtin_amdgcn_sdot4((int)__builtin_amdgcn_perm(p23h, p01h, 0x05040100u), W4, acc[m * 8 + 6], false);
              acc[m * 8 + 7] = __builtin_amdgcn_sdot4((int)__builtin_amdgcn_perm(p23h, p01h, 0x07060302u), W4, acc[m * 8 + 7], false);
            }
          }
        }
      }
    }
    float val[32];
    float ss = 0.f;
    const int off8 = 8 * wsumq;
#pragma unroll
    for (int q = 0; q < 8; ++q) {
      f32x4 v = *(const f32x4*)(orow + q * 4);
#pragma unroll
      for (int k = 0; k < 4; ++k) {
        val[q * 4 + k] = sw * (float)(acc[q * 4 + k] - off8) + v[k];
        ss += val[q * 4 + k] * val[q * 4 + k];
      }
    }
    ss = wave_sum(ss);
    const float rs3 = rsqrtf(ss * (1.f / 2048.f) + EPSV);
#pragma unroll
    for (int q = 0; q < 8; ++q) {
      f32x4 wf = *(const f32x4*)(p.norm_final_w + lane * 32 + q * 4);
      f32x4 o = {val[q * 4 + 0] * rs3 * wf[0], val[q * 4 + 1] * rs3 * wf[1], val[q * 4 + 2] * rs3 * wf[2],
                 val[q * 4 + 3] * rs3 * wf[3]};
      *(f32x4*)(orow + q * 4) = o;
    }
  }
}

__global__ void __launch_bounds__(NTHR, 2) fwd_kernel(Params p) {
  __shared__ __attribute__((aligned(16))) unsigned char smem[SMEM_BYTES];
  cg::grid_group grid = cg::this_grid();
  unsigned char* ws = p.ws;
  const int hb = threadIdx.x >> 8;
  unsigned char* hsm = smem + hb * SMEM_HALF;
#define PHASE_ON(n) (p.phase_lo <= (n) && (n) <= p.phase_hi)
#define PHASE_SYNC(n) if (p.coop && PHASE_ON(n) && (n) < p.phase_hi) grid.sync();
  if (PHASE_ON(0)) phase_prep(p, smem);
  PHASE_SYNC(0)
  if (PHASE_ON(1)) {
    pg8::Gemm g{(const bf16_t*)(ws + OFF_XB), (const bf16_t*)(ws + OFF_WINT), T_TOK, NPAD1, 2048};
    pg8::SimpleOrder S; S.init(T_TOK, NPAD1, gridDim.x, blockIdx.x);
    pg8::Epi1 E{(const float*)(ws + OFF_RS1), (bf16_t*)(ws + OFF_PROJ)};
    pg8::gemm_phase<pg8::Epi1, pg8::SimpleOrder, 0>((PG8_LAS unsigned char*)smem, g, S, E);
  }
  PHASE_SYNC(1)
  if (PHASE_ON(2)) {
    for (int u0 = blockIdx.x * 2; u0 < 2048; u0 += gridDim.x * 2) ssd_local_unit(p, hsm, u0 + hb);
    for (int u0 = blockIdx.x * 2; u0 < 2048; u0 += gridDim.x * 2) lru_local_unit(p, hsm, u0 + hb);
  }
  PHASE_SYNC(2)
  if (PHASE_ON(3)) phase_carry(p);
  PHASE_SYNC(3)
  if (PHASE_ON(4)) phase_mix_final(p);
  PHASE_SYNC(4)
  if (PHASE_ON(5)) {
    pg8::Gemm g{(const bf16_t*)(ws + OFF_XB), (const bf16_t*)(ws + OFF_WOUTT), T_TOK, 2048, 2048};
    pg8::SimpleOrder S; S.init(T_TOK, 2048, gridDim.x, blockIdx.x);
    pg8::Epi2 E{p.x, p.out, (bf16_t*)(ws + OFF_X1B), (float*)(ws + OFF_SSQ2), (const float*)(ws + OFF_SSQ)};
    pg8::gemm_phase<pg8::Epi2, pg8::SimpleOrder, 16>((PG8_LAS unsigned char*)smem, g, S, E);
  }
  PHASE_SYNC(5)
  if (PHASE_ON(6)) {
    pg8::Gemm g{(const bf16_t*)(ws + OFF_X1B), (const bf16_t*)(ws + OFF_WQT), T_TOK, 2048, 2048};
    pg8::SimpleOrder S; S.init(T_TOK, 2048, gridDim.x, blockIdx.x);
    pg8::Epi3 E{(const float*)(ws + OFF_SSQ2), (bf16_t*)(ws + OFF_Q)};
    pg8::gemm_phase<pg8::Epi3, pg8::SimpleOrder, 0>((PG8_LAS unsigned char*)smem, g, S, E);
    convert_uv(p);
  }
  PHASE_SYNC(6)
  if (PHASE_ON(7)) {
    for (int u = blockIdx.x * 2 + hb; u < 2048; u += gridDim.x * 2) topk_unit(p, hsm, u);
  }
  PHASE_SYNC(7)
  if (PHASE_ON(8)) phase_gather(p);
}

extern "C" void kernel_launch(void* const* d_in, const int* in_sizes, int n_in, void* d_out, int out_size,
                              void* d_ws, size_t ws_size, hipStream_t stream) {
  Params p{};
  const float** fp = (const float**)&p;
  for (int i = 0; i < 23; ++i) fp[i] = (const float*)d_in[i];
  p.out = (float*)d_out;
  p.ws = (unsigned char*)d_ws;
  static int grid_blocks = 0;
  if (!grid_blocks) {
    int dev = 0, cus = 0, per_cu = 0;
    hipGetDevice(&dev);
    hipDeviceGetAttribute(&cus, hipDeviceAttributeMultiprocessorCount, dev);
    hipOccupancyMaxActiveBlocksPerMultiprocessor(&per_cu, fwd_kernel, NTHR, 0);
    if (per_cu < 1) per_cu = 1;
    if (per_cu > 1) per_cu = 1;
    grid_blocks = cus * per_cu;
  }
#if SINGLE_LAUNCH
  p.phase_lo = 0; p.phase_hi = 8; p.coop = 1;
  void* args[] = {&p};
  hipError_t e = hipLaunchCooperativeKernel((void*)fwd_kernel, dim3(grid_blocks), dim3(NTHR), args, 0, stream);
  if (e != hipSuccess) fprintf(stderr, "cooperative launch failed: %s (grid %d)\n", hipGetErrorString(e), grid_blocks);
#else
  for (int ph = 0; ph <= 8; ++ph) {
    p.phase_lo = ph; p.phase_hi = ph; p.coop = 0;
    hipLaunchKernelGGL(fwd_kernel, dim3(grid_blocks), dim3(NTHR), 0, stream, p);
  }
#endif
}
```

```cpp
#include <hip/hip_runtime.h>
#include <hip/hip_cooperative_groups.h>
#include <cstdio>
namespace cg = cooperative_groups;

#ifndef DBL_PHASE
#define DBL_PHASE -1
#endif
#ifndef SINGLE_LAUNCH
#define SINGLE_LAUNCH 1
#endif

typedef unsigned short bf16_t;
typedef short bf16x8 __attribute__((ext_vector_type(8)));
typedef float f32x4 __attribute__((ext_vector_type(4)));
typedef unsigned u32x4 __attribute__((ext_vector_type(4)));
typedef unsigned u32x2 __attribute__((ext_vector_type(2)));
typedef __bf16 bf2_t __attribute__((ext_vector_type(2)));

#define T_TOK 16384
#define DM 2048
#define LDP 4736
#define NPAD1 4864
#define NTHR 512
#define HTHR 256
#define SMEM_HALF 73728
#define SMEM_BYTES 147456
#define EPSV 1e-6f
#define MIB ((size_t)1 << 20)

#define OFF_XB (0 * MIB)
#define OFF_PROJ (64 * MIB)
#define OFF_X1B (64 * MIB)
#define OFF_Q (128 * MIB)
#define OFF_IDX (192 * MIB)
#define OFF_G (200 * MIB)
#define OFF_HLOC (212 * MIB)
#define OFF_CUMA (276 * MIB)
#define OFF_YPART (340 * MIB)
#define OFF_ST (372 * MIB)
#define OFF_WINT (436 * MIB)
#define OFF_WOUTT (455 * MIB)
#define OFF_WQT (463 * MIB)
#define OFF_WAT (471 * MIB)
#define OFF_WXT (471 * MIB + 131072)
#define OFF_KEYSB (471 * MIB + 262144)
#define OFF_RS1 (472 * MIB)
#define OFF_ACS (472 * MIB + 65536)
#define OFF_LCARRY (OFF_ACS + MIB)
#define OFF_SSQ (OFF_LCARRY + 524288)
#define OFF_SSQ2 (OFF_SSQ + MIB)
#define OFF_SCALES (OFF_SSQ2 + 2 * MIB)
#define OFF_XACT (0 * MIB)
#define OFF_BACT (32 * MIB)
#define OFF_CACT (478 * MIB)

struct Params {
  const float *x, *norm_mix_w, *w_in, *lru_conv_w, *lru_conv_b, *lru_wa, *lru_ba, *lru_wx, *lru_bx, *lru_lambda;
  const float *ssd_conv_w, *ssd_conv_b, *ssd_dt_bias, *ssd_a_log, *ssd_d, *ssd_norm_w, *w_out, *norm_ffn_w, *peer_wq;
  const float *peer_sub_keys, *peer_u, *peer_v, *norm_final_w;
  float* out;
  unsigned char* ws;
  int phase_lo, phase_hi, coop, pad0;
};

__device__ __forceinline__ unsigned pk2(float lo, float hi) {
  unsigned r;
  asm("v_cvt_pk_bf16_f32 %0, %1, %2" : "=v"(r) : "v"(lo), "v"(hi));
  return r;
}
__device__ __forceinline__ float bf2f(bf16_t v) { return __uint_as_float(((unsigned)v) << 16); }
__device__ __forceinline__ float bflo(unsigned u) { return __uint_as_float(u << 16); }
__device__ __forceinline__ float bfhi(unsigned u) { return __uint_as_float(u & 0xffff0000u); }
__device__ __forceinline__ float wave_sum(float v) {
#pragma unroll
  for (int o = 32; o > 0; o >>= 1) v += __shfl_xor(v, o);
  return v;
}
__device__ __forceinline__ float sigmoid_(float x) { return 1.f / (1.f + __expf(-x)); }
__device__ __forceinline__ float silu_(float x) { return x * sigmoid_(x); }
__device__ __forceinline__ float gelu_(float x) {
  float u = 0.7978845608028654f * (x + 0.044715f * x * x * x);
  return x * sigmoid_(2.f * u);
}
__device__ __forceinline__ float softplus_(float x) { return fmaxf(x, 0.f) + log1pf(__expf(-fabsf(x))); }
__device__ __forceinline__ f32x4 mfma16(bf16x8 a, bf16x8 b, f32x4 c) {
  return __builtin_amdgcn_mfma_f32_16x16x32_bf16(a, b, c, 0, 0, 0);
}
__device__ __forceinline__ bf16x8 as_frag(u32x4 v) { return __builtin_bit_cast(bf16x8, v); }
__device__ __forceinline__ int sw256(int row, int chunk) { return row * 256 + ((chunk ^ (row & 15)) << 4); }
__device__ __forceinline__ int sw128(int row, int chunk) { return row * 128 + ((chunk ^ ((row >> 1) & 7)) << 4); }

__device__ __forceinline__ float rs_from_ssq2(const float* ssq2, int row) {
  const f32x4* pp = (const f32x4*)(ssq2 + (size_t)row * 32);
  float s = 0.f;
#pragma unroll
  for (int i = 0; i < 8; ++i) { f32x4 v = pp[i]; s += v[0] + v[1] + v[2] + v[3]; }
  return rsqrtf(s * (1.f / 2048.f) + EPSV);
}
__device__ __forceinline__ float rs_from_ssq(const float* ssq, int row) {
  const f32x4* pp = (const f32x4*)(ssq + (size_t)row * 16);
  float s = 0.f;
#pragma unroll
  for (int i = 0; i < 4; ++i) { f32x4 v = pp[i]; s += v[0] + v[1] + v[2] + v[3]; }
  return rsqrtf(s * (1.f / 1024.f) + EPSV);
}

__device__ void transpose_tile(const float* __restrict__ src, int ld_src, int r0, int c0, int c_valid,
                               bf16_t* __restrict__ dst, int ld_dst, const float* __restrict__ scale, int scale_from,
                               float* tile, bool valid) {
  const int tid = threadIdx.x & 255;
  {
    const int j = tid & 63, i0 = tid >> 6;
#pragma unroll 4
    for (int ii = 0; ii < 16; ++ii) {
      const int i = i0 + 4 * ii;
      float v = 0.f;
      if (valid && c0 + j < c_valid) {
        v = src[(size_t)(r0 + i) * ld_src + c0 + j];
        if (scale != nullptr && (r0 + i) >= scale_from) v *= scale[r0 + i - scale_from];
      }
      tile[i * 65 + j] = v;
    }
  }
  __syncthreads();
  {
    const int i = tid & 63, j0 = tid >> 6;
#pragma unroll 4
    for (int jj = 0; jj < 16; ++jj) {
      const int j = j0 + 4 * jj;
      if (valid) dst[(size_t)(c0 + j) * ld_dst + r0 + i] = (bf16_t)(pk2(tile[i * 65 + j], 0.f) & 0xffffu);
    }
  }
  __syncthreads();
}

__device__ void phase_prep(const Params& p, unsigned char* smem) {
  const int tid = threadIdx.x, lane = tid & 63, wid = tid >> 6, hb = tid >> 8;
  unsigned char* ws = p.ws;
  bf16_t* xb = (bf16_t*)(ws + OFF_XB);
  float* rs1 = (float*)(ws + OFF_RS1);
  for (int t = blockIdx.x * 8 + wid; t < T_TOK; t += gridDim.x * 8) {
    const float* xr = p.x + (size_t)t * DM;
    bf16_t* xo = xb + (size_t)t * DM;
    float ss = 0.f;
#pragma unroll
    for (int c = 0; c < 8; ++c) {
      f32x4 v = *(const f32x4*)(xr + c * 256 + lane * 4);
      ss += v[0] * v[0] + v[1] * v[1] + v[2] * v[2] + v[3] * v[3];
      u32x2 o = {pk2(v[0], v[1]), pk2(v[2], v[3])};
      *(u32x2*)(xo + c * 256 + lane * 4) = o;
    }
    ss = wave_sum(ss);
    if (lane == 0) rs1[t] = rsqrtf(ss * (1.f / 2048.f) + EPSV);
  }
  float* tile = (float*)(smem + hb * SMEM_HALF);
  const int NT_WIN = 32 * 76, NT_SQ = 32 * 32;
  const int total = NT_WIN + 2 * NT_SQ + 32;
  for (int u0 = blockIdx.x * 2; u0 < total; u0 += gridDim.x * 2) {
    const bool valid = (u0 + hb) < total;
    const int u = valid ? (u0 + hb) : u0;
    if (u < NT_WIN) {
      const int ri = u & 31, cj = u >> 5;
      transpose_tile(p.w_in, 4624, ri * 64, cj * 64, 4624, (bf16_t*)(ws + OFF_WINT), 2048, p.norm_mix_w, 0, tile, valid);
    } else if (u < NT_WIN + NT_SQ) {
      const int v = u - NT_WIN, ri = v & 31, cj = v >> 5;
      transpose_tile(p.w_out, 2048, ri * 64, cj * 64, 2048, (bf16_t*)(ws + OFF_WOUTT), 2048, p.ssd_norm_w, 1024, tile, valid);
    } else if (u < NT_WIN + 2 * NT_SQ) {
      const int v = u - NT_WIN - NT_SQ, ri = v & 31, cj = v >> 5;
      transpose_tile(p.peer_wq, 2048, ri * 64, cj * 64, 2048, (bf16_t*)(ws + OFF_WQT), 2048, p.norm_ffn_w, 0, tile, valid);
    } else {
      const int v = u - NT_WIN - 2 * NT_SQ;
      const int h = v & 15;
      const float* src = (v < 16 ? p.lru_wa : p.lru_wx) + (size_t)h * 4096;
      bf16_t* dst = (bf16_t*)(ws + (v < 16 ? OFF_WAT : OFF_WXT)) + (size_t)h * 4096;
      transpose_tile(src, 64, 0, 0, 64, dst, 64, nullptr, 0, tile, valid);
    }
  }
  {
    bf16_t* kb = (bf16_t*)(ws + OFF_KEYSB);
    for (int i = blockIdx.x * NTHR + tid; i < 65536; i += gridDim.x * NTHR) {
      f32x4 v = *(const f32x4*)(p.peer_sub_keys + (size_t)i * 4);
      u32x2 o = {pk2(v[0], v[1]), pk2(v[2], v[3])};
      *(u32x2*)(kb + (size_t)i * 4) = o;
    }
  }
}

namespace pg8 {
#define PG8_LAS __attribute__((address_space(3)))
constexpr int BM = 256, BK = 64, HALF = 128, HTB = HALF * BK * 2;
__device__ __forceinline__ int lds_byte(int r, int c) { const int st = (r >> 4) * 2 + (c >> 5), rr = r & 15, cc = c & 31, ob = rr * 64 + cc * 2; return st * 1024 + (ob ^ (((ob >> 9) & 1) << 5)); }
__device__ __forceinline__ void stage_rc(int b, int& R, int& C) { const int st = b / 1024, sb = b % 1024, swz = sb ^ (((sb >> 9) & 1) << 5); R = (st >> 1) * 16 + swz / 64; C = (st & 1) * 32 + (swz % 64) / 2; }
struct Unit { int pm, pn; };
struct Gemm { const bf16_t* A; const bf16_t* Bt; int M, N, K; };
struct SimpleOrder {
  int nM, nwg, G, c;
  __device__ void init(int M, int N, int G_, int c_) { nM = M / BM; nwg = nM * (N / BM); G = G_; c = c_; }
  __device__ bool next(int i, Unit& u) const { const int L = i * G + c; if (L >= nwg) return false; u.pm = L % nM; u.pn = L / nM; return true; }
};
struct Epi1 {
  static constexpr bool MID = false;
  const float* rs1; bf16_t* proj;
  __device__ __forceinline__ void mid(f32x4 (&)[2][2][4][2], const Unit&, int, int) const {}
  __device__ __forceinline__ void operator()(const f32x4 (&acc)[2][2][4][2], const Unit& u, int wr, int wc, int fr, int fq) const {
    const int row0 = u.pm * BM + wr * 64 + fr, col0 = u.pn * BM + wc * 32 + 4 * fq;
#pragma unroll
    for (int ai = 0; ai < 2; ++ai)
#pragma unroll
      for (int m = 0; m < 4; ++m) {
        const int row = row0 + ai * HALF + m * 16;
        const float s = rs1[row];
#pragma unroll
        for (int bj = 0; bj < 2; ++bj)
#pragma unroll
          for (int n = 0; n < 2; ++n) {
            const int col = col0 + bj * HALF + n * 16;
            if (col < LDP) {
              f32x4 v = acc[ai][bj][m][n] * s;
              u32x2 o = {pk2(v[0], v[1]), pk2(v[2], v[3])};
              *(u32x2*)(proj + (size_t)row * LDP + col) = o;
            }
          }
      }
  }
};
struct Epi2 {
  static constexpr bool MID = true;
  const float* x; float* out; bf16_t* x1b; float* ssq2; const float* ssq;
  __device__ __forceinline__ void mid(f32x4 (&acc)[2][2][4][2], const Unit& u, int wr, int fr) const {
#pragma unroll
    for (int ai = 0; ai < 2; ++ai)
#pragma unroll
      for (int m = 0; m < 4; ++m) {
        const float s = rs_from_ssq(ssq, u.pm * BM + wr * 64 + fr + ai * HALF + m * 16);
#pragma unroll
        for (int bj = 0; bj < 2; ++bj)
#pragma unroll
          for (int n = 0; n < 2; ++n) acc[ai][bj][m][n] *= s;
        __builtin_amdgcn_sched_barrier(0);
      }
  }
  __device__ __forceinline__ void operator()(const f32x4 (&acc)[2][2][4][2], const Unit& u, int wr, int wc, int fr, int fq) const {
    const int row0 = u.pm * BM + wr * 64 + fr, col0 = u.pn * BM + wc * 32 + 4 * fq;
#pragma unroll
    for (int ai = 0; ai < 2; ++ai)
#pragma unroll
      for (int m = 0; m < 4; ++m) {
        const int row = row0 + ai * HALF + m * 16;
        float ss = 0.f;
#pragma unroll
        for (int bj = 0; bj < 2; ++bj)
#pragma unroll
          for (int n = 0; n < 2; ++n) {
            const int col = col0 + bj * HALF + n * 16;
            f32x4 xr = *(const f32x4*)(x + (size_t)row * DM + col);
            f32x4 v = acc[ai][bj][m][n] + xr;
            *(f32x4*)(out + (size_t)row * DM + col) = v;
            u32x2 o = {pk2(v[0], v[1]), pk2(v[2], v[3])};
            *(u32x2*)(x1b + (size_t)row * DM + col) = o;
            ss += v[0] * v[0] + v[1] * v[1] + v[2] * v[2] + v[3] * v[3];
          }
        ss += __shfl_xor(ss, 16);
        ss += __shfl_xor(ss, 32);
        if (fq == 0) ssq2[(size_t)row * 32 + u.pn * 4 + wc] = ss;
        __builtin_amdgcn_sched_barrier(0);
      }
  }
};
struct Epi3 {
  static constexpr bool MID = false;
  const float* ssq2; bf16_t* q;
  __device__ __forceinline__ void mid(f32x4 (&)[2][2][4][2], const Unit&, int, int) const {}
  __device__ __forceinline__ void operator()(const f32x4 (&acc)[2][2][4][2], const Unit& u, int wr, int wc, int fr, int fq) const {
    const int row0 = u.pm * BM + wr * 64 + fr, col0 = u.pn * BM + wc * 32 + 4 * fq;
#pragma unroll
    for (int ai = 0; ai < 2; ++ai)
#pragma unroll
      for (int m = 0; m < 4; ++m) {
        const int row = row0 + ai * HALF + m * 16;
        const float s = rs_from_ssq2(ssq2, row);
#pragma unroll
        for (int bj = 0; bj < 2; ++bj)
#pragma unroll
          for (int n = 0; n < 2; ++n) {
            const int col = col0 + bj * HALF + n * 16;
            f32x4 v = acc[ai][bj][m][n] * s;
            u32x2 o = {pk2(v[0], v[1]), pk2(v[2], v[3])};
            *(u32x2*)(q + (size_t)row * DM + col) = o;
          }
      }
  }
};

template <class Epi, class Sched, int KROT>
__device__ __forceinline__ void gemm_phase(PG8_LAS unsigned char* lds, const Gemm g, const Sched& S, const Epi& E) {
  const int tid = threadIdx.x, wid = __builtin_amdgcn_readfirstlane(tid >> 6), lane = tid & 63, wr = wid >> 2, wc = wid & 3, fr = lane & 15, fq = lane >> 4;
  const int K = g.K, nt = K / BK;
#define PG8_KX(t) (((t) + KROT) & 31)
  unsigned voff[2];
#pragma unroll
  for (int i = 0; i < 2; ++i) { int R, C; stage_rc(tid * 16 + i * 8192, R, C); voff[i] = (unsigned)(R * K + C) * 2u; }
  const size_t kstep = (size_t)(BK * 2);
  const size_t hstep = (size_t)HALF * K * 2;
  const size_t tstep = 2 * hstep;
  const unsigned ldsw = (unsigned)wid * 1024u;
  const int aoff = lds_byte(wr * 64 + fr, fq * 8), boff = lds_byte(wc * 32 + fr, fq * 8);
#define PG8_SA(b, h) (((b) * 2 + (h)) * HTB)
#define PG8_SB(b, h) ((4 + (b) * 2 + (h)) * HTB)
#define PG8_STAGE(bufoff, gbase) do { _Pragma("unroll") for (int _i = 0; _i < 2; ++_i) \
    __builtin_amdgcn_global_load_lds((const unsigned*)((const char*)(gbase) + voff[_i]), (PG8_LAS unsigned*)(lds + (bufoff) + ldsw + _i * 8192), 16, 0, 0); } while (0)
#define PG8_LDA(dst, b, h) do { _Pragma("unroll") for (int m = 0; m < 4; ++m) _Pragma("unroll") for (int k = 0; k < 2; ++k) dst[m][k] = *(const PG8_LAS bf16x8*)(lds + PG8_SA(b, h) + aoff + m * 2048 + k * 1024); } while (0)
#define PG8_LDB(dst, b, h) do { _Pragma("unroll") for (int n = 0; n < 2; ++n) _Pragma("unroll") for (int k = 0; k < 2; ++k) dst[n][k] = *(const PG8_LAS bf16x8*)(lds + PG8_SB(b, h) + boff + n * 2048 + k * 1024); } while (0)
#define PG8_MMA(ai, bj, At, Bt) do { __builtin_amdgcn_s_setprio(1); _Pragma("unroll") for (int m = 0; m < 4; ++m) _Pragma("unroll") for (int n = 0; n < 2; ++n) _Pragma("unroll") for (int k = 0; k < 2; ++k) \
    acc[ai][bj][m][n] = __builtin_amdgcn_mfma_f32_16x16x32_bf16(Bt[n][k], At[m][k], acc[ai][bj][m][n], 0, 0, 0); __builtin_amdgcn_s_setprio(0); } while (0)
#define PG8_WAIT_V(n) asm volatile("s_waitcnt vmcnt(" #n ")" ::: "memory")
#define PG8_WAIT_L(n) asm volatile("s_waitcnt lgkmcnt(" #n ")" ::: "memory")
#define PG8_BAR __builtin_amdgcn_s_barrier()
#define PG8_SCHED __builtin_amdgcn_sched_barrier(0)
  Unit cur, nxt; int ui = 0;
  if (!S.next(0, cur)) return;
  f32x4 acc[2][2][4][2];
#pragma unroll
  for (int a = 0; a < 2; ++a)
#pragma unroll
    for (int b = 0; b < 2; ++b)
#pragma unroll
      for (int m = 0; m < 4; ++m)
#pragma unroll
        for (int n = 0; n < 2; ++n) acc[a][b][m][n] = (f32x4){0.f, 0.f, 0.f, 0.f};
  bf16x8 At[4][2], B0[2][2], B1[2][2];
  const char* cA = (const char*)g.A + (size_t)cur.pm * tstep; const char* cB = (const char*)g.Bt + (size_t)cur.pn * tstep;
  { const char* a0 = cA + (size_t)PG8_KX(0) * kstep; const char* b0 = cB + (size_t)PG8_KX(0) * kstep;
    const char* a1 = cA + (size_t)PG8_KX(1) * kstep; const char* b1 = cB + (size_t)PG8_KX(1) * kstep;
    PG8_STAGE(PG8_SB(0, 0), b0); PG8_STAGE(PG8_SA(0, 0), a0); PG8_STAGE(PG8_SB(0, 1), b0 + hstep); PG8_STAGE(PG8_SA(0, 1), a0 + hstep);
    if (wr == 1) PG8_BAR;
    PG8_WAIT_V(4); PG8_BAR;
    PG8_STAGE(PG8_SB(1, 0), b1); PG8_STAGE(PG8_SA(1, 0), a1); PG8_STAGE(PG8_SB(1, 1), b1 + hstep);
    PG8_WAIT_V(6); PG8_BAR; }
  for (;;) {
    const bool has_next = S.next(ui + 1, nxt);
    const char* nA = has_next ? (const char*)g.A + (size_t)nxt.pm * tstep : cA; const char* nB = has_next ? (const char*)g.Bt + (size_t)nxt.pn * tstep : cB;
#define PG8_ITER(t) {\
      const bool last = (t == nt - 2);\
      const char* a1 = cA + (size_t)PG8_KX(t + 1) * kstep;\
      const char* a2 = last ? nA + (size_t)PG8_KX(0) * kstep : cA + (size_t)PG8_KX(t + 2) * kstep;\
      const char* b2 = last ? nB + (size_t)PG8_KX(0) * kstep : cB + (size_t)PG8_KX(t + 2) * kstep;\
      const char* a3 = last ? nA + (size_t)PG8_KX(1) * kstep : cA + (size_t)PG8_KX(t + 3) * kstep;\
      const char* b3 = last ? nB + (size_t)PG8_KX(1) * kstep : cB + (size_t)PG8_KX(t + 3) * kstep;\
      PG8_LDB(B0, 0, 0); PG8_SCHED; PG8_LDA(At, 0, 0); PG8_STAGE(PG8_SA(1, 1), a1 + hstep);\
      PG8_WAIT_L(8); PG8_BAR; PG8_WAIT_L(0); PG8_MMA(0, 0, At, B0); PG8_BAR; PG8_SCHED;\
      PG8_LDB(B1, 0, 1); PG8_STAGE(PG8_SB(0, 0), b2);\
      PG8_BAR; PG8_WAIT_L(0); PG8_MMA(0, 1, At, B1); PG8_BAR;\
      PG8_LDA(At, 0, 1); PG8_STAGE(PG8_SA(0, 0), a2);\
      PG8_BAR; PG8_WAIT_L(0); PG8_MMA(1, 0, At, B0); PG8_BAR; PG8_SCHED;\
      PG8_STAGE(PG8_SB(0, 1), b2 + hstep);\
      PG8_WAIT_V(6); PG8_BAR; PG8_MMA(1, 1, At, B1); PG8_BAR;\
      PG8_LDB(B0, 1, 0); PG8_SCHED; PG8_LDA(At, 1, 0); PG8_STAGE(PG8_SA(0, 1), a2 + hstep);\
      PG8_WAIT_L(8); PG8_BAR; PG8_WAIT_L(0); PG8_MMA(0, 0, At, B0); PG8_BAR; PG8_SCHED;\
      PG8_LDB(B1, 1, 1); PG8_STAGE(PG8_SB(1, 0), b3);\
      PG8_BAR; PG8_WAIT_L(0); PG8_MMA(0, 1, At, B1); PG8_BAR;\
      PG8_LDA(At, 1, 1); PG8_STAGE(PG8_SA(1, 0), a3);\
      PG8_BAR; PG8_WAIT_L(0); PG8_MMA(1, 0, At, B0); PG8_BAR; PG8_SCHED;\
      PG8_STAGE(PG8_SB(1, 1), b3 + hstep);\
      PG8_WAIT_V(6); PG8_BAR; PG8_MMA(1, 1, At, B1); PG8_BAR;\
}
    if (Epi::MID) {
      for (int t = 0; t < 16; t += 2) PG8_ITER(t)
      E.mid(acc, cur, wr, fr);
      for (int t = 16; t < nt; t += 2) PG8_ITER(t)
    } else {
      for (int t = 0; t < nt; t += 2) PG8_ITER(t)
    }
#undef PG8_ITER
    E(acc, cur, wr, wc, fr, fq);
    if (!has_next) break;
#pragma unroll
    for (int a = 0; a < 2; ++a)
#pragma unroll
      for (int b = 0; b < 2; ++b)
#pragma unroll
        for (int m = 0; m < 4; ++m)
#pragma unroll
          for (int n = 0; n < 2; ++n) acc[a][b][m][n] = (f32x4){0.f, 0.f, 0.f, 0.f};
    cur = nxt; cA = nA; cB = nB; ++ui;
  }
  PG8_WAIT_V(0);
  if (wr == 0) PG8_BAR;
  PG8_BAR;
#undef PG8_KX
#undef PG8_SA
#undef PG8_SB
#undef PG8_STAGE
#undef PG8_LDA
#undef PG8_LDB
#undef PG8_MMA
#undef PG8_WAIT_V
#undef PG8_WAIT_L
#undef PG8_BAR
#undef PG8_SCHED
}
}

__device__ __forceinline__ void conv8(const bf16_t* __restrict__ proj, int t, int tt_in_seq, int col,
                                      const float* __restrict__ cw, int ld_w, const float* __restrict__ cb, int ch,
                                      float* o) {
  f32x4 b0 = *(const f32x4*)(cb + ch), b1 = *(const f32x4*)(cb + ch + 4);
  o[0] = b0[0]; o[1] = b0[1]; o[2] = b0[2]; o[3] = b0[3];
  o[4] = b1[0]; o[5] = b1[1]; o[6] = b1[2]; o[7] = b1[3];
#pragma unroll
  for (int k = 0; k < 4; ++k) {
    if (tt_in_seq - 3 + k >= 0) {
      u32x4 v = *(const u32x4*)(proj + (size_t)(t - 3 + k) * LDP + col);
      f32x4 w0 = *(const f32x4*)(cw + k * ld_w + ch), w1 = *(const f32x4*)(cw + k * ld_w + ch + 4);
      o[0] += w0[0] * bflo(v[0]); o[1] += w0[1] * bfhi(v[0]);
      o[2] += w0[2] * bflo(v[1]); o[3] += w0[3] * bfhi(v[1]);
      o[4] += w1[0] * bflo(v[2]); o[5] += w1[1] * bfhi(v[2]);
      o[6] += w1[2] * bflo(v[3]); o[7] += w1[3] * bfhi(v[3]);
    }
  }
}
__device__ __forceinline__ void conv4(const bf16_t* __restrict__ proj, int t, int tt_in_seq, int col,
                                      const float* __restrict__ cw, int ld_w, const float* __restrict__ cb, int ch,
                                      float* o) {
  f32x4 b0 = *(const f32x4*)(cb + ch);
  o[0] = b0[0]; o[1] = b0[1]; o[2] = b0[2]; o[3] = b0[3];
#pragma unroll
  for (int k = 0; k < 4; ++k) {
    if (tt_in_seq - 3 + k >= 0) {
      u32x2 v = *(const u32x2*)(proj + (size_t)(t - 3 + k) * LDP + col);
      f32x4 w0 = *(const f32x4*)(cw + k * ld_w + ch);
      o[0] += w0[0] * bflo(v[0]); o[1] += w0[1] * bfhi(v[0]);
      o[2] += w0[2] * bflo(v[1]); o[3] += w0[3] * bfhi(v[1]);
    }
  }
}
__device__ __forceinline__ bf16x8 cfrag(const Params& p, const bf16_t* proj, int t, int tseq, int g, int n8) {
  const bf16_t* cact = (const bf16_t*)(p.ws + OFF_CACT);
  return as_frag(*(const u32x4*)(cact + (size_t)t * 256 + g * 128 + n8));
}
__device__ void conv_prepass(const Params& p) {
  unsigned char* ws = p.ws;
  const bf16_t* proj = (const bf16_t*)(ws + OFF_PROJ);
  bf16_t* xact = (bf16_t*)(ws + OFF_XACT);
  bf16_t* bact = (bf16_t*)(ws + OFF_BACT);
  bf16_t* cact = (bf16_t*)(ws + OFF_CACT);
  for (int i = blockIdx.x * NTHR + threadIdx.x; i < T_TOK * 192; i += gridDim.x * NTHR) {
    const int t = i / 192, ch = (i - t * 192) * 8;
    float o[8];
    conv8(proj, t, t & 2047, 3072 + ch, p.ssd_conv_w, 1536, p.ssd_conv_b, ch, o);
#pragma unroll
    for (int e = 0; e < 8; ++e) o[e] = silu_(o[e]);
    u32x4 r = {pk2(o[0], o[1]), pk2(o[2], o[3]), pk2(o[4], o[5]), pk2(o[6], o[7])};
    bf16_t* dst = ch < 1024 ? xact + (size_t)t * 1024 + ch : (ch < 1280 ? bact + (size_t)t * 256 + (ch - 1024) : cact + (size_t)t * 256 + (ch - 1280));
    *(u32x4*)dst = r;
  }
}

__device__ void lru_local_unit(const Params& p, unsigned char* smem, int unit) {
  const int tid = threadIdx.x & 255, lane = tid & 63, wid = tid >> 6, l15 = lane & 15, q4 = lane >> 4;
  const int hh = unit & 15, c = (unit >> 4) & 15, b = unit >> 8;
  const int t0 = b * 2048 + c * 128, ch0 = hh * 64;
  unsigned char* ws = p.ws;
  const bf16_t* proj = (const bf16_t*)(ws + OFF_PROJ);
  float* R1 = (float*)smem;
  float* R2 = (float*)(smem + 33536);
  float* R3 = (float*)(smem + 33536 + 32768);
#pragma unroll 11
  for (int e = tid; e < 131 * 64; e += HTHR) {
    const int r = e >> 6, j = e & 63, tt = r - 3;
    float v = 0.f;
    if (c * 128 + tt >= 0) v = bf2f(proj[(size_t)(t0 + tt) * LDP + ch0 + j]);
    R1[e] = v;
  }
  __syncthreads();
  {
    const int j = tid & 63;
    const float cb = p.lru_conv_b[ch0 + j];
    const float w0 = p.lru_conv_w[0 * 1024 + ch0 + j], w1 = p.lru_conv_w[1 * 1024 + ch0 + j],
                w2 = p.lru_conv_w[2 * 1024 + ch0 + j], w3 = p.lru_conv_w[3 * 1024 + ch0 + j];
#pragma unroll 8
    for (int tt = tid >> 6; tt < 128; tt += 4) {
      R2[tt * 64 + j] = cb + w0 * R1[tt * 64 + j] + w1 * R1[(tt + 1) * 64 + j] + w2 * R1[(tt + 2) * 64 + j] +
                        w3 * R1[(tt + 3) * 64 + j];
    }
  }
  __syncthreads();
  {
    const bf16_t* waT = (const bf16_t*)(ws + OFF_WAT) + (size_t)hh * 4096;
    const bf16_t* wxT = (const bf16_t*)(ws + OFF_WXT) + (size_t)hh * 4096;
    f32x4 aa[2][4], ax[2][4];
#pragma unroll
    for (int i = 0; i < 2; ++i)
#pragma unroll
      for (int j = 0; j < 4; ++j) { aa[i][j] = (f32x4){0, 0, 0, 0}; ax[i][j] = (f32x4){0, 0, 0, 0}; }
#pragma unroll
    for (int ks = 0; ks < 2; ++ks) {
      bf16x8 af[2];
#pragma unroll
      for (int mi = 0; mi < 2; ++mi) {
        const float* src = R2 + (wid * 32 + mi * 16 + l15) * 64 + ks * 32 + q4 * 8;
        f32x4 v0 = *(const f32x4*)src, v1 = *(const f32x4*)(src + 4);
        u32x4 r = {pk2(v0[0], v0[1]), pk2(v0[2], v0[3]), pk2(v1[0], v1[1]), pk2(v1[2], v1[3])};
        af[mi] = as_frag(r);
      }
#pragma unroll
      for (int ni = 0; ni < 4; ++ni) {
        const size_t wo = (size_t)(ni * 16 + l15) * 64 + ks * 32 + q4 * 8;
        bf16x8 ba = as_frag(*(const u32x4*)(waT + wo));
        bf16x8 bx = as_frag(*(const u32x4*)(wxT + wo));
#pragma unroll
        for (int mi = 0; mi < 2; ++mi) {
          aa[mi][ni] = mfma16(af[mi], ba, aa[mi][ni]);
          ax[mi][ni] = mfma16(af[mi], bx, ax[mi][ni]);
        }
      }
    }
#pragma unroll
    for (int ni = 0; ni < 4; ++ni) {
      const int j = ni * 16 + l15;
      const float ba = p.lru_ba[ch0 + j], bx = p.lru_bx[ch0 + j];
      const float lam = p.lru_lambda[ch0 + j];
      const float spl = -8.f * log1pf(__expf(-lam));
#pragma unroll
      for (int mi = 0; mi < 2; ++mi)
#pragma unroll
        for (int r = 0; r < 4; ++r) {
          const int tt = wid * 32 + mi * 16 + q4 * 4 + r;
          const float rg = sigmoid_(aa[mi][ni][r] + ba);
          const float ig = sigmoid_(ax[mi][ni][r] + bx);
          const float log_a = spl * rg;
          const float av = __expf(log_a);
          const float xl = R2[tt * 64 + j];
          const float bv = sqrtf(fmaxf(-expm1f(2.f * log_a), 0.f)) * (ig * xl);
          R1[tt * 64 + j] = av;
          R2[tt * 64 + j] = bv;
        }
    }
  }
  __syncthreads();
  {
    const int j = tid & 63, seg = tid >> 6;
    float h = 0.f, Ac = 1.f;
#pragma unroll 4
    for (int s = 0; s < 32; ++s) {
      const int tt = seg * 32 + s;
      const float a = R1[tt * 64 + j], bb = R2[tt * 64 + j];
      h = a * h + bb;
      Ac *= a;
      R2[tt * 64 + j] = h;
      R1[tt * 64 + j] = Ac;
    }
    R3[seg * 64 + j] = h;
    R3[256 + seg * 64 + j] = Ac;
    __syncthreads();
    float cin = 0.f, Ain = 1.f;
    for (int s2 = 0; s2 < seg; ++s2) {
      cin = R3[256 + s2 * 64 + j] * cin + R3[s2 * 64 + j];
      Ain *= R3[256 + s2 * 64 + j];
    }
    float* hloc = (float*)(ws + OFF_HLOC);
    float* cumA = (float*)(ws + OFF_CUMA);
#pragma unroll 4
    for (int s = 0; s < 32; ++s) {
      const int tt = seg * 32 + s;
      const float hl = R2[tt * 64 + j] + R1[tt * 64 + j] * cin;
      const float Al = R1[tt * 64 + j] * Ain;
      hloc[(size_t)(t0 + tt) * 1024 + ch0 + j] = hl;
      cumA[(size_t)(t0 + tt) * 1024 + ch0 + j] = Al;
    }
  }
  __syncthreads();
}

__device__ void ssd_local_unit(const Params& p, unsigned char* smem, int unit) {
  const int tid = threadIdx.x & 255, lane = tid & 63, wid = tid >> 6, l15 = lane & 15, q4 = lane >> 4;
  const int hh = unit & 15, c = (unit >> 4) & 15, b = unit >> 8, g = hh >> 3;
  const int t0 = b * 2048 + c * 128, ts0 = c * 128;
  unsigned char* ws = p.ws;
  const bf16_t* proj = (const bf16_t*)(ws + OFF_PROJ);
  unsigned char* Bm = smem;
  unsigned char* XT = smem + 32768;
  unsigned char* Pw = smem + 49152 + wid * 4096;
  float* dts = (float*)(smem + 65536);
  float* acs = dts + 128;
  float* adt = acs + 128;
  if (tid < 128) {
    const float raw = bf2f(proj[(size_t)(t0 + tid) * LDP + 4608 + hh]);
    const float dtv = softplus_(raw + p.ssd_dt_bias[hh]);
    dts[tid] = dtv;
    adt[tid] = -__expf(p.ssd_a_log[hh]) * dtv;
  }
  __syncthreads();
  if (tid < 128) {
    float s = 0.f;
    for (int k = 0; k <= tid; ++k) s += adt[k];
    acs[tid] = s;
    ((float*)(ws + OFF_ACS))[(size_t)(t0 + tid) * 16 + hh] = s;
  }
  {
    const bf16_t* bact = (const bf16_t*)(ws + OFF_BACT);
    const int chunk = tid & 15;
#pragma unroll
    for (int i = 0; i < 8; ++i) {
      const int tt = (tid >> 4) + 16 * i;
      *(u32x4*)(Bm + sw256(tt, chunk)) = *(const u32x4*)(bact + (size_t)(t0 + tt) * 256 + g * 128 + chunk * 8);
    }
  }
  __syncthreads();
  const bf16_t* xact = (const bf16_t*)(ws + OFF_XACT);
  {
    const int pp = tid & 63;
    const int ch = hh * 64 + pp;
#pragma unroll
    for (int i = 0; i < 4; ++i) {
      const int chunk = (tid >> 6) * 4 + i;
      const int tt0 = chunk * 8;
      float o[8];
#pragma unroll
      for (int e = 0; e < 8; ++e) o[e] = bf2f(xact[(size_t)(t0 + tt0 + e) * 1024 + ch]) * dts[tt0 + e];
      u32x4 r = {pk2(o[0], o[1]), pk2(o[2], o[3]), pk2(o[4], o[5]), pk2(o[6], o[7])};
      *(u32x4*)(XT + sw256(pp, chunk)) = r;
    }
  }
  __syncthreads();
  bf16_t* ypart = (bf16_t*)(ws + OFF_YPART);
  const float Dh = p.ssd_d[hh];
#pragma unroll 1
  for (int mt = 0; mt < 2; ++mt) {
    const int M = wid * 2 + mt;
    const int lrow = M * 16 + l15;
    bf16x8 cf[4];
#pragma unroll
    for (int ks = 0; ks < 4; ++ks) cf[ks] = cfrag(p, proj, t0 + lrow, ts0 + lrow, g, ks * 32 + q4 * 8);
    const float acl = acs[lrow];
    const int ntmax = M | 1;
#pragma unroll 1
    for (int nt = 0; nt <= ntmax; ++nt) {
      f32x4 a4 = (f32x4){0, 0, 0, 0};
      if (nt <= M) {
#pragma unroll
        for (int ks = 0; ks < 4; ++ks) {
          bf16x8 bfr = *(const bf16x8*)(Bm + sw256(nt * 16 + l15, ks * 4 + q4));
          a4 = mfma16(bfr, cf[ks], a4);
        }
      }
      float pv[4];
#pragma unroll
      for (int r = 0; r < 4; ++r) {
        const int s = nt * 16 + q4 * 4 + r;
        pv[r] = (s <= lrow) ? a4[r] * __expf(acl - acs[s]) : 0.f;
      }
      u32x2 o = {pk2(pv[0], pv[1]), pk2(pv[2], pv[3])};
      const int chunk = nt * 2 + (q4 >> 1);
      *(u32x2*)(Pw + sw256(l15, chunk) + (q4 & 1) * 8) = o;
    }
    f32x4 ya[4];
#pragma unroll
    for (int pt = 0; pt < 4; ++pt) ya[pt] = (f32x4){0, 0, 0, 0};
    const int ksmax = M >> 1;
#pragma unroll 1
    for (int ks = 0; ks <= ksmax; ++ks) {
      bf16x8 pf = *(const bf16x8*)(Pw + sw256(l15, ks * 4 + q4));
#pragma unroll
      for (int pt = 0; pt < 4; ++pt) {
        bf16x8 xf = *(const bf16x8*)(XT + sw256(pt * 16 + l15, ks * 4 + q4));
        ya[pt] = mfma16(xf, pf, ya[pt]);
      }
    }
#pragma unroll
    for (int pt = 0; pt < 4; ++pt) {
      const int pc = pt * 16 + q4 * 4;
      const int ch = hh * 64 + pc;
      const u32x2 xv = *(const u32x2*)(xact + (size_t)(t0 + lrow) * 1024 + ch);
      float y0 = ya[pt][0] + Dh * bflo(xv[0]), y1 = ya[pt][1] + Dh * bfhi(xv[0]);
      float y2 = ya[pt][2] + Dh * bflo(xv[1]), y3 = ya[pt][3] + Dh * bfhi(xv[1]);
      u32x2 o = {pk2(y0, y1), pk2(y2, y3)};
      *(u32x2*)(ypart + (size_t)(t0 + lrow) * 1024 + ch) = o;
    }
  }
  {
    f32x4 sa[2][4];
#pragma unroll
    for (int i = 0; i < 2; ++i)
#pragma unroll
      for (int j = 0; j < 4; ++j) sa[i][j] = (f32x4){0, 0, 0, 0};
    const float aend = acs[127];
#pragma unroll 1
    for (int ks = 0; ks < 4; ++ks) {
      float dec[8];
#pragma unroll
      for (int e = 0; e < 8; ++e) dec[e] = __expf(aend - acs[ks * 32 + q4 * 8 + e]);
      bf16x8 bd[2];
#pragma unroll
      for (int ni = 0; ni < 2; ++ni) {
        const int n = wid * 32 + ni * 16 + l15;
        float v[8];
#pragma unroll
        for (int e = 0; e < 8; ++e) {
          const int l = ks * 32 + q4 * 8 + e;
          const bf16_t raw = *(const bf16_t*)(Bm + sw256(l, n >> 3) + (n & 7) * 2);
          v[e] = bf2f(raw) * dec[e];
        }
        u32x4 r = {pk2(v[0], v[1]), pk2(v[2], v[3]), pk2(v[4], v[5]), pk2(v[6], v[7])};
        bd[ni] = as_frag(r);
      }
#pragma unroll
      for (int pt = 0; pt < 4; ++pt) {
        bf16x8 xf = *(const bf16x8*)(XT + sw256(pt * 16 + l15, ks * 4 + q4));
#pragma unroll
        for (int ni = 0; ni < 2; ++ni) sa[ni][pt] = mfma16(bd[ni], xf, sa[ni][pt]);
      }
    }
    float* St = (float*)(ws + OFF_ST) + (size_t)((b * 16 + c) * 16 + hh) * 8192;
#pragma unroll
    for (int ni = 0; ni < 2; ++ni)
#pragma unroll
      for (int pt = 0; pt < 4; ++pt) {
        const int pr = pt * 16 + l15, n = wid * 32 + ni * 16 + q4 * 4;
        *(f32x4*)(St + pr * 128 + n) = sa[ni][pt];
      }
  }
  __syncthreads();
}

__device__ void phase_carry(const Params& p) {
  unsigned char* ws = p.ws;
  const int gt = blockIdx.x * NTHR + threadIdx.x, ng = gridDim.x * NTHR;
  const float* hloc = (const float*)(ws + OFF_HLOC);
  const float* cumA = (const float*)(ws + OFF_CUMA);
  float* lcarry = (float*)(ws + OFF_LCARRY);
  for (int i = gt; i < 8192; i += ng) {
    const int b = i >> 10, ch = i & 1023;
    float ca[16], hl[16];
#pragma unroll
    for (int c = 0; c < 16; ++c) {
      const size_t tl = (size_t)(b * 2048 + c * 128 + 127) * 1024 + ch;
      ca[c] = cumA[tl];
      hl[c] = hloc[tl];
    }
    float carry = 0.f;
#pragma unroll
    for (int c = 0; c < 16; ++c) {
      lcarry[(size_t)(b * 16 + c) * 1024 + ch] = carry;
      carry = ca[c] * carry + hl[c];
    }
  }
  const float* acsG = (const float*)(ws + OFF_ACS);
  float* St = (float*)(ws + OFF_ST);
  for (int i = gt; i < 128 * 2048; i += ng) {
    const int bh = i >> 11, e4 = i & 2047, b = bh >> 4, hh = bh & 15;
    f32x4 tmp[16];
    float Ad[16];
#pragma unroll
    for (int c = 0; c < 16; ++c) {
      Ad[c] = __expf(acsG[(size_t)(b * 2048 + c * 128 + 127) * 16 + hh]);
      tmp[c] = *(const f32x4*)(St + (size_t)((b * 16 + c) * 16 + hh) * 8192 + e4 * 4);
    }
    f32x4 s = (f32x4){0, 0, 0, 0};
#pragma unroll
    for (int c = 0; c < 16; ++c) {
      *(f32x4*)(St + (size_t)((b * 16 + c) * 16 + hh) * 8192 + e4 * 4) = s;
      s = s * Ad[c] + tmp[c];
    }
  }
}

__device__ void ssd_final_unit(const Params& p, int unit) {
  const int tid = threadIdx.x & 255, lane = tid & 63, wid = tid >> 6, l15 = lane & 15, q4 = lane >> 4;
  const int hh = unit & 15, c = (unit >> 4) & 15, b = unit >> 8, g = hh >> 3;
  const int t0 = b * 2048 + c * 128, ts0 = c * 128;
  unsigned char* ws = p.ws;
  const bf16_t* proj = (const bf16_t*)(ws + OFF_PROJ);
  const float* Sin = (const float*)(ws + OFF_ST) + (size_t)((b * 16 + c) * 16 + hh) * 8192;
  const bf16_t* ypart = (const bf16_t*)(ws + OFF_YPART);
  const float* acsG = (const float*)(ws + OFF_ACS);
  bf16_t* A2 = (bf16_t*)(ws + OFF_XB);
  float* ssq = (float*)(ws + OFF_SSQ);
#pragma unroll 1
  for (int mt = 0; mt < 2; ++mt) {
    const int lrow = (wid * 2 + mt) * 16 + l15;
    f32x4 ya[4];
#pragma unroll
    for (int pt = 0; pt < 4; ++pt) ya[pt] = (f32x4){0, 0, 0, 0};
    if (c > 0) {
#pragma unroll 2
      for (int ks = 0; ks < 4; ++ks) {
        bf16x8 cf = cfrag(p, proj, t0 + lrow, ts0 + lrow, g, ks * 32 + q4 * 8);
#pragma unroll
        for (int pt = 0; pt < 4; ++pt) {
          const float* sp = Sin + (pt * 16 + l15) * 128 + ks * 32 + q4 * 8;
          f32x4 v0 = *(const f32x4*)sp, v1 = *(const f32x4*)(sp + 4);
          u32x4 r = {pk2(v0[0], v0[1]), pk2(v0[2], v0[3]), pk2(v1[0], v1[1]), pk2(v1[2], v1[3])};
          ya[pt] = mfma16(as_frag(r), cf, ya[pt]);
        }
      }
    }
    const size_t t = (size_t)(t0 + lrow);
    const float ea = __expf(acsG[t * 16 + hh]);
    float ss = 0.f;
#pragma unroll
    for (int pt = 0; pt < 4; ++pt) {
      const int ch = hh * 64 + pt * 16 + q4 * 4;
      u32x2 yp = *(const u32x2*)(ypart + t * 1024 + ch);
      u32x2 zz = *(const u32x2*)(proj + t * LDP + 2048 + ch);
      float y[4] = {bflo(yp[0]) + ea * ya[pt][0], bfhi(yp[0]) + ea * ya[pt][1], bflo(yp[1]) + ea * ya[pt][2],
                    bfhi(yp[1]) + ea * ya[pt][3]};
      float z[4] = {bflo(zz[0]), bfhi(zz[0]), bflo(zz[1]), bfhi(zz[1])};
#pragma unroll
      for (int r = 0; r < 4; ++r) { y[r] = y[r] * silu_(z[r]); ss += y[r] * y[r]; }
      u32x2 o = {pk2(y[0], y[1]), pk2(y[2], y[3])};
      *(u32x2*)(A2 + t * DM + 1024 + ch) = o;
    }
    ss += __shfl_xor(ss, 16);
    ss += __shfl_xor(ss, 32);
    if (q4 == 0) ssq[t * 16 + hh] = ss;
  }
}

__device__ void phase_mix_final(const Params& p) {
  unsigned char* ws = p.ws;
  const bf16_t* proj = (const bf16_t*)(ws + OFF_PROJ);
  const f32x4* hloc = (const f32x4*)(ws + OFF_HLOC);
  const f32x4* cumA = (const f32x4*)(ws + OFF_CUMA);
  const float* lcarry = (const float*)(ws + OFF_LCARRY);
  bf16_t* A2 = (bf16_t*)(ws + OFF_XB);
  for (int u = blockIdx.x * 2 + (threadIdx.x >> 8); u < 2048; u += gridDim.x * 2) ssd_final_unit(p, u);
#pragma unroll 4
  for (int i = blockIdx.x * NTHR + threadIdx.x; i < T_TOK * 256; i += gridDim.x * NTHR) {
    const int t = i >> 8, ch = (i & 255) * 4;
    f32x4 h = hloc[i], ca = cumA[i];
    f32x4 cr = *(const f32x4*)(lcarry + (size_t)(t >> 7) * 1024 + ch);
    u32x2 gg = *(const u32x2*)(proj + (size_t)t * LDP + 1024 + ch);
    float y0 = (h[0] + ca[0] * cr[0]) * gelu_(bflo(gg[0]));
    float y1 = (h[1] + ca[1] * cr[1]) * gelu_(bfhi(gg[0]));
    float y2 = (h[2] + ca[2] * cr[2]) * gelu_(bflo(gg[1]));
    float y3 = (h[3] + ca[3] * cr[3]) * gelu_(bfhi(gg[1]));
    u32x2 o = {pk2(y0, y1), pk2(y2, y3)};
    *(u32x2*)(A2 + (size_t)t * DM + ch) = o;
  }
}

__device__ void convert_uv(const Params& p) {
  unsigned char* ws = p.ws;
  const int lane = threadIdx.x & 63, wid = threadIdx.x >> 6;
  unsigned char* tb = ws + OFF_XB;
  float* scales = (float*)(ws + OFF_SCALES);
  for (int row = blockIdx.x * 8 + wid; row < 32768; row += gridDim.x * 8) {
    const bool isv = row >= 16384;
    const int e = row & 16383;
    const float* src = (isv ? p.peer_v : p.peer_u) + (size_t)e * DM + lane * 32;
    float vals[32];
    float ss = 0.f;
#pragma unroll
    for (int q = 0; q < 8; ++q) {
      f32x4 t = *(const f32x4*)(src + q * 4);
      if (!isv) t *= *(const f32x4*)(p.norm_ffn_w + lane * 32 + q * 4);
#pragma unroll
      for (int k = 0; k < 4; ++k) {
        vals[q * 4 + k] = t[k];
        ss += t[k] * t[k];
      }
    }
    ss = wave_sum(ss);
    const float rms = sqrtf(ss * (1.f / 2048.f));
    const float sc = rms * (2.6f / 7.f);
    const float inv = sc > 0.f ? 1.f / sc : 0.f;
    u32x4 o;
#pragma unroll
    for (int m = 0; m < 4; ++m) {
      unsigned w = 0;
#pragma unroll
      for (int j = 0; j < 4; ++j) {
        const float lo = fminf(fmaxf(rintf(vals[m * 8 + j] * inv), -7.f), 7.f);
        const float hi = fminf(fmaxf(rintf(vals[m * 8 + 4 + j] * inv), -7.f), 7.f);
        const unsigned bl = (unsigned)((int)lo + 8), bh = (unsigned)((int)hi + 8);
        w |= (bl | (bh << 4)) << (8 * j);
      }
      o[m] = w;
    }
    *(u32x4*)(tb + (size_t)row * 1024 + lane * 16) = o;
    if (lane == 0) scales[row] = sc;
  }
}

__device__ const unsigned char cand_tab[64] = {
    0x00, 0x01, 0x02, 0x03, 0x04, 0x05, 0x06, 0x07, 0x08, 0x09, 0x0a, 0x0b, 0x0c, 0x0d, 0x0e, 0x0f,
    0x10, 0x11, 0x12, 0x13, 0x14, 0x15, 0x16, 0x17,
    0x20, 0x21, 0x22, 0x23, 0x24,
    0x30, 0x31, 0x32, 0x33,
    0x40, 0x41, 0x42,
    0x50, 0x51, 0x60, 0x61, 0x70, 0x71,
    0x80, 0x90, 0xa0, 0xb0, 0xc0, 0xd0, 0xe0, 0xf0,
    0xff, 0xff, 0xff, 0xff, 0xff, 0xff, 0xff, 0xff, 0xff, 0xff, 0xff, 0xff, 0xff, 0xff};

__device__ __forceinline__ unsigned ord_key(float f) {
  unsigned u = __float_as_uint(f);
  return u ^ ((u >> 31) ? 0xffffffffu : 0x80000000u);
}
__device__ __forceinline__ float ord_dec(unsigned k) {
  unsigned u = (k >> 31) ? (k ^ 0x80000000u) : ~k;
  return __uint_as_float(u);
}

__device__ void topk_unit(const Params& p, unsigned char* smem, int unit) {
  const int tid = threadIdx.x & 255, lane = tid & 63, wid = tid >> 6, l15 = lane & 15, q4 = lane >> 4;
  const int h = unit & 7, tile = unit >> 3;
  const int tok0 = tile * 64 + wid * 16;
  unsigned char* ws = p.ws;
  const bf16_t* qg = (const bf16_t*)(ws + OFF_Q);
  const bf16_t* kb = (const bf16_t*)(ws + OFF_KEYSB);
  unsigned* S = (unsigned*)(smem + wid * 16640);
  float* tops = (float*)(smem + 4 * 16640 + wid * 256);
  int* topi = (int*)(tops + 32);
  unsigned* Ms = (unsigned*)(smem + 67584 + wid * 768);
#pragma unroll
  for (int k = 0; k < 2; ++k) {
    f32x4 sc[8];
#pragma unroll
    for (int i = 0; i < 8; ++i) sc[i] = (f32x4){0, 0, 0, 0};
#pragma unroll
    for (int ks = 0; ks < 4; ++ks) {
      bf16x8 qf = as_frag(*(const u32x4*)(qg + (size_t)(tok0 + l15) * DM + h * 256 + k * 128 + ks * 32 + q4 * 8));
#pragma unroll
      for (int nt = 0; nt < 8; ++nt) {
        bf16x8 kf = as_frag(*(const u32x4*)(kb + (size_t)((h * 2 + k) * 128 + nt * 16 + l15) * 128 + ks * 32 + q4 * 8));
        sc[nt] = mfma16(kf, qf, sc[nt]);
      }
    }
#pragma unroll
    for (int nt = 0; nt < 8; ++nt) {
      const int n = nt * 16 + q4 * 4;
      u32x4 kk;
#pragma unroll
      for (int r = 0; r < 4; ++r) kk[r] = (ord_key(sc[nt][r]) & ~127u) | (unsigned)(127 - (n + r));
      *(u32x4*)(S + l15 * 260 + k * 128 + n) = kk;
    }
  }
  const unsigned ct = cand_tab[lane];
  const int ca = ct >> 4, cbb = ct & 15;
  int* idxo = (int*)(ws + OFF_IDX);
  float* go = (float*)(ws + OFF_G);
  for (int tk = 0; tk < 16; ++tk) {
    const unsigned* row = S + tk * 260;
    unsigned ka[2], kb[2], mxk[2];
#pragma unroll
    for (int hf = 0; hf < 2; ++hf) {
      ka[hf] = row[hf * 128 + lane];
      kb[hf] = row[hf * 128 + 64 + lane];
      mxk[hf] = ka[hf] > kb[hf] ? ka[hf] : kb[hf];
      Ms[hf * 96 + lane] = mxk[hf];
    }
    int cnt[2][4];
#pragma unroll
    for (int hf = 0; hf < 2; ++hf)
#pragma unroll
      for (int e = 0; e < 4; ++e) cnt[hf][e] = 0;
#pragma unroll
    for (int j = 0; j < 16; ++j)
#pragma unroll
      for (int hf = 0; hf < 2; ++hf) {
        u32x4 x = *(const u32x4*)(Ms + hf * 96 + j * 4);
#pragma unroll
        for (int e = 0; e < 4; ++e) cnt[hf][e] += (x[e] > mxk[hf]) ? 1 : 0;
      }
    bool ca_[2], cb_[2];
    int pa[2], pb[2], ncand[2];
    const unsigned long long lt = (1ull << lane) - 1ull;
#pragma unroll
    for (int hf = 0; hf < 2; ++hf) {
      const int c_ = cnt[hf][0] + cnt[hf][1] + cnt[hf][2] + cnt[hf][3];
      const unsigned long long bm = __ballot(c_ == 15);
      const int srcT = __ffsll((long long)bm) - 1;
      const unsigned T0 = (unsigned)__shfl((int)mxk[hf], srcT);
      ca_[hf] = ka[hf] >= T0;
      cb_[hf] = kb[hf] >= T0;
      const unsigned long long ba = __ballot(ca_[hf]), bb = __ballot(cb_[hf]);
      const int na = __popcll(ba);
      pa[hf] = __popcll(ba & lt);
      pb[hf] = na + __popcll(bb & lt);
      ncand[hf] = na + __popcll(bb);
    }
#pragma unroll
    for (int hf = 0; hf < 2; ++hf) {
      unsigned* Cs = Ms + hf * 96 + 64;
      if (lane < 32) Cs[lane] = 0u;
      if (ca_[hf]) Cs[pa[hf]] = ka[hf];
      if (cb_[hf]) Cs[pb[hf]] = kb[hf];
    }
    unsigned my[2];
    int rk2[2][4];
#pragma unroll
    for (int hf = 0; hf < 2; ++hf) {
      my[hf] = Ms[hf * 96 + 64 + (lane & 31)];
#pragma unroll
      for (int e = 0; e < 4; ++e) rk2[hf][e] = 0;
    }
#pragma unroll
    for (int j = 0; j < 8; ++j)
#pragma unroll
      for (int hf = 0; hf < 2; ++hf) {
        u32x4 x = *(const u32x4*)(Ms + hf * 96 + 64 + j * 4);
#pragma unroll
        for (int e = 0; e < 4; ++e) rk2[hf][e] += (x[e] > my[hf]) ? 1 : 0;
      }
#pragma unroll
    for (int hf = 0; hf < 2; ++hf) {
      const int r_ = rk2[hf][0] + rk2[hf][1] + rk2[hf][2] + rk2[hf][3];
      if (lane < ncand[hf] && r_ < 16) {
        tops[hf * 16 + r_] = ord_dec(my[hf] & ~127u);
        topi[hf * 16 + r_] = 127 - (int)(my[hf] & 127u);
      }
    }
    float cs = 0.f;
    unsigned ck = 0u;
    if (lane < 50) {
      cs = tops[ca] + tops[16 + cbb];
      ck = (ord_key(cs) & ~255u) | (unsigned)(255 - (ca * 16 + cbb));
    }
    int rkA = 0, rkB = 0;
#pragma unroll
    for (int j = 0; j < 50; j += 2) {
      const unsigned oj = (unsigned)__builtin_amdgcn_readlane((int)ck, j);
      const unsigned oj2 = (unsigned)__builtin_amdgcn_readlane((int)ck, j + 1);
      rkA += (oj > ck) ? 1 : 0;
      rkB += (oj2 > ck) ? 1 : 0;
    }
    const int rk = rkA + rkB;
    const float mx = tops[0] + tops[16];
    const bool sel = (lane < 50) && (rk < 16);
    const float ev = sel ? __expf(cs - mx) : 0.f;
    const float sum = wave_sum(ev);
    if (sel) {
      const size_t o = (size_t)(tok0 + tk) * 128 + h * 16 + rk;
      idxo[o] = topi[ca] * 128 + topi[16 + cbb];
      go[o] = ev / sum;
    }
  }
}

__device__ __forceinline__ float ub0(unsigned w) { return (float)(w & 0xffu); }
__device__ __forceinline__ float ub1(unsigned w) { return (float)((w >> 8) & 0xffu); }
__device__ __forceinline__ float ub2(unsigned w) { return (float)((w >> 16) & 0xffu); }
__device__ __forceinline__ float ub3(unsigned w) { return (float)(w >> 24); }

#define GROWS 8
#ifndef USE_SDOT4
#define USE_SDOT4 1
#endif
typedef float f32x2 __attribute__((ext_vector_type(2)));
__device__ void phase_gather(const Params& p) {
  const int tid = threadIdx.x, lane = tid & 63, wid = tid >> 6;
  unsigned char* ws = p.ws;
  const unsigned char* ub = ws + OFF_XB;
  const unsigned char* vb = ws + OFF_XB + 16 * MIB;
  const float* scales = (const float*)(ws + OFF_SCALES);
  const int* idxg = (const int*)(ws + OFF_IDX);
  const float* gg = (const float*)(ws + OFF_G);
  const float* ssq2 = (const float*)(ws + OFF_SSQ2);
  const bool b5 = (lane & 32) != 0, b4 = (lane & 16) != 0, b3 = (lane & 8) != 0;
  const int srcl = ((lane & 1) << 3) | (((lane >> 1) & 1) << 4) | (((lane >> 2) & 1) << 5);
  for (int t = blockIdx.x * 8 + wid; t < T_TOK; t += gridDim.x * 8) {
    const int id0 = idxg[(size_t)t * 128 + lane], id1 = idxg[(size_t)t * 128 + 64 + lane];
    const float g0 = gg[(size_t)t * 128 + lane], g1 = gg[(size_t)t * 128 + 64 + lane];
    const float su0 = scales[id0], su1 = scales[id1], sv0 = scales[16384 + id0], sv1 = scales[16384 + id1];
    float* orow = p.out + (size_t)t * DM + lane * 32;
    int xlo[4], xhi[4];
    float sx;
    int sumq;
    {
      float xr[32];
      float amax = 0.f;
#pragma unroll
      for (int q = 0; q < 8; ++q) {
        f32x4 v = *(const f32x4*)(orow + q * 4);
#pragma unroll
        for (int k = 0; k < 4; ++k) { xr[q * 4 + k] = v[k]; amax = fmaxf(amax, fabsf(v[k])); }
      }
#pragma unroll
      for (int o = 32; o > 0; o >>= 1) amax = fmaxf(amax, __shfl_xor(amax, o));
      sx = amax * (1.f / 127.f);
      const float inv = amax > 0.f ? 127.f / amax : 0.f;
      int sq_ = 0;
#pragma unroll
      for (int m = 0; m < 4; ++m) {
        unsigned wl = 0, wh = 0;
#pragma unroll
        for (int j = 0; j < 4; ++j) {
          const int a_ = __float2int_rn(xr[m * 8 + j] * inv), b_ = __float2int_rn(xr[m * 8 + 4 + j] * inv);
          sq_ += a_ + b_;
          wl |= ((unsigned)a_ & 0xffu) << (8 * j);
          wh |= ((unsigned)b_ & 0xffu) << (8 * j);
        }
        xlo[m] = (int)wl;
        xhi[m] = (int)wh;
      }
#pragma unroll
      for (int o = 32; o > 0; o >>= 1) sq_ += __shfl_xor(sq_, o);
      sumq = sq_;
    }
    float sq = (lane < 32) ? ssq2[(size_t)t * 32 + lane] : 0.f;
    sq = wave_sum(sq);
    const float rs2 = rsqrtf(sq * (1.f / 2048.f) + EPSV);
    float w0 = 0.f, w1 = 0.f;
#pragma unroll 1
    for (int half = 0; half < 2; ++half) {
      const int idv = half ? id1 : id0;
      int wv = 0;
      u32x4 rr[2][GROWS];
#pragma unroll
      for (int k = 0; k < GROWS; ++k) {
        const int e = __builtin_amdgcn_readlane(idv, k);
        rr[0][k] = *(const u32x4*)(ub + (size_t)e * 1024 + lane * 16);
      }
#pragma unroll
      for (int gi = 0; gi < 64 / GROWS; ++gi) {
        const int j0 = gi * GROWS;
        if (gi + 1 < 64 / GROWS) {
#pragma unroll
          for (int k = 0; k < GROWS; ++k) {
            const int e = __builtin_amdgcn_readlane(idv, j0 + GROWS + k);
            rr[(gi + 1) & 1][k] = *(const u32x4*)(ub + (size_t)e * 1024 + lane * 16);
          }
        }
        int dv[GROWS];
#pragma unroll
        for (int k = 0; k < GROWS; ++k) {
          int d = 0;
#pragma unroll
          for (int m = 0; m < 4; ++m) {
            const unsigned w = rr[gi & 1][k][m];
            const int lo = (int)(w & 0x0f0f0f0fu), hi = (int)((w >> 4) & 0x0f0f0f0fu);
            d = __builtin_amdgcn_sdot4(lo, xlo[m], d, false);
            d = __builtin_amdgcn_sdot4(hi, xhi[m], d, false);
          }
          dv[k] = d;
        }
        int a4[4], a2[2];
#pragma unroll
        for (int k = 0; k < 4; ++k) {
          const int mine = b5 ? dv[k + 4] : dv[k], oth = b5 ? dv[k] : dv[k + 4];
          a4[k] = mine + __shfl_xor(oth, 32);
        }
#pragma unroll
        for (int k = 0; k < 2; ++k) {
          const int mine = b4 ? a4[k + 2] : a4[k], oth = b4 ? a4[k] : a4[k + 2];
          a2[k] = mine + __shfl_xor(oth, 16);
        }
        int c1;
        {
          const int mine = b3 ? a2[1] : a2[0], oth = b3 ? a2[0] : a2[1];
          c1 = mine + __shfl_xor(oth, 8);
        }
        c1 += __shfl_xor(c1, 4);
        c1 += __shfl_xor(c1, 2);
        c1 += __shfl_xor(c1, 1);
        const int val = __shfl(c1, srcl);
        if ((lane & ~7) == j0) wv = val;
      }
      const float su = half ? su1 : su0;
      const float a = gelu_((float)(wv - 8 * sumq) * (su * sx * rs2));
      if (half) w1 = a * g1 * sv1; else w0 = a * g0 * sv0;
    }
    float wmax = fmaxf(fabsf(w0), fabsf(w1));
#pragma unroll
    for (int o = 32; o > 0; o >>= 1) wmax = fmaxf(wmax, __shfl_xor(wmax, o));
    const float sw = wmax * (1.f / 127.f);
    const float winv = wmax > 0.f ? 127.f / wmax : 0.f;
    const int q0 = __float2int_rn(w0 * winv), q1 = __float2int_rn(w1 * winv);
    int wsumq = q0 + q1;
#pragma unroll
    for (int o = 32; o > 0; o >>= 1) wsumq += __shfl_xor(wsumq, o);
    int pk0 = (int)(((unsigned)q0 & 0xffu) << (8 * (lane & 3))), pk1 = (int)(((unsigned)q1 & 0xffu) << (8 * (lane & 3)));
    pk0 |= __shfl_xor(pk0, 1); pk0 |= __shfl_xor(pk0, 2);
    pk1 |= __shfl_xor(pk1, 1); pk1 |= __shfl_xor(pk1, 2);
    int acc[32];
#pragma unroll
    for (int i = 0; i < 32; ++i) acc[i] = 0;
#pragma unroll 1
    for (int half = 0; half < 2; ++half) {
      const int idv = half ? id1 : id0;
      const int pkv = half ? pk1 : pk0;
      u32x4 rr[2][GROWS];
#pragma unroll
      for (int k = 0; k < GROWS; ++k) {
        const int e = __builtin_amdgcn_readlane(idv, k);
        rr[0][k] = *(const u32x4*)(vb + (size_t)e * 1024 + lane * 16);
      }
#pragma unroll
      for (int gi = 0; gi < 64 / GROWS; ++gi) {
        const int j0 = gi * GROWS;
        if (gi + 1 < 64 / GROWS) {
#pragma unroll
          for (int k = 0; k < GROWS; ++k) {
            const int e = __builtin_amdgcn_readlane(idv, j0 + GROWS + k);
            rr[(gi + 1) & 1][k] = *(const u32x4*)(vb + (size_t)e * 1024 + lane * 16);
          }
        }
#pragma unroll
        for (int sub = 0; sub < GROWS / 4; ++sub) {
          const int W4 = __builtin_amdgcn_readlane(pkv, j0 + 4 * sub);
#pragma unroll
          for (int m = 0; m < 4; ++m) {
            unsigned lo[4], hi[4];
#pragma unroll
            for (int k = 0; k < 4; ++k) {
              const unsigned w = rr[gi & 1][sub * 4 + k][m];
              lo[k] = w & 0x0f0f0f0fu;
              hi[k] = (w >> 4) & 0x0f0f0f0fu;
            }
            {
              const unsigned p01l = __builtin_amdgcn_perm(lo[1], lo[0], 0x05010400u), p01h = __builtin_amdgcn_perm(lo[1], lo[0], 0x07030602u);
              const unsigned p23l = __builtin_amdgcn_perm(lo[3], lo[2], 0x05010400u), p23h = __builtin_amdgcn_perm(lo[3], lo[2], 0x07030602u);
              acc[m * 8 + 0] = __builtin_amdgcn_sdot4((int)__builtin_amdgcn_perm(p23l, p01l, 0x05040100u), W4, acc[m * 8 + 0], false);
              acc[m * 8 + 1] = __builtin_amdgcn_sdot4((int)__builtin_amdgcn_perm(p23l, p01l, 0x07060302u), W4, acc[m * 8 + 1], false);
              acc[m * 8 + 2] = __builtin_amdgcn_sdot4((int)__builtin_amdgcn_perm(p23h, p01h, 0x05040100u), W4, acc[m * 8 + 2], false);
              acc[m * 8 + 3] = __builtin_amdgcn_sdot4((int)__builtin_amdgcn_perm(p23h, p01h, 0x07060302u), W4, acc[m * 8 + 3], false);
            }
            {
              const unsigned p01l = __builtin_amdgcn_perm(hi[1], hi[0], 0x05010400u), p01h = __builtin_amdgcn_perm(hi[1], hi[0], 0x07030602u);
              const unsigned p23l = __builtin_amdgcn_perm(hi[3], hi[2], 0x05010400u), p23h = __builtin_amdgcn_perm(hi[3], hi[2], 0x07030602u);
              acc[m * 8 + 4] = __builtin_amdgcn_sdot4((int)__builtin_amdgcn_perm(p23l, p01l, 0x05040100u), W4, acc[m * 8 + 4], false);
              acc[m * 8 + 5] = __builtin_amdgcn_sdot4((int)__builtin_amdgcn_perm(p23l, p01l, 0x07060302u), W4, acc[m * 8 + 5], false);
              acc[m * 8 + 6] = __builtin_amdgcn_sdot4((int)__builtin_amdgcn_perm(p23h, p01h, 0x05040100u), W4, acc[m * 8 + 6], false);
              acc[m * 8 + 7] = __builtin_amdgcn_sdot4((int)__builtin_amdgcn_perm(p23h, p01h, 0x07060302u), W4, acc[m * 8 + 7], false);
            }
          }
        }
      }
    }
    float val[32];
    float ss = 0.f;
    const int off8 = 8 * wsumq;
#pragma unroll
    for (int q = 0; q < 8; ++q) {
      f32x4 v = *(const f32x4*)(orow + q * 4);
#pragma unroll
      for (int k = 0; k < 4; ++k) {
        val[q * 4 + k] = sw * (float)(acc[q * 4 + k] - off8) + v[k];
        ss += val[q * 4 + k] * val[q * 4 + k];
      }
    }
    ss = wave_sum(ss);
    const float rs3 = rsqrtf(ss * (1.f / 2048.f) + EPSV);
#pragma unroll
    for (int q = 0; q < 8; ++q) {
      f32x4 wf = *(const f32x4*)(p.norm_final_w + lane * 32 + q * 4);
      f32x4 o = {val[q * 4 + 0] * rs3 * wf[0], val[q * 4 + 1] * rs3 * wf[1], val[q * 4 + 2] * rs3 * wf[2],
                 val[q * 4 + 3] * rs3 * wf[3]};
      *(f32x4*)(orow + q * 4) = o;
    }
  }
}

__global__ void __launch_bounds__(NTHR, 2) fwd_kernel(Params p) {
  __shared__ __attribute__((aligned(16))) unsigned char smem[SMEM_BYTES];
  cg::grid_group grid = cg::this_grid();
  unsigned char* ws = p.ws;
  const int hb = threadIdx.x >> 8;
  unsigned char* hsm = smem + hb * SMEM_HALF;
#define PHASE_ON(n) (p.phase_lo <= (n) && (n) <= p.phase_hi)
#define PHASE_SYNC(n) if (p.coop && PHASE_ON(n) && (n) < p.phase_hi) grid.sync();
  if (PHASE_ON(0)) phase_prep(p, smem);
  PHASE_SYNC(0)
  if (PHASE_ON(1)) {
    pg8::Gemm g{(const bf16_t*)(ws + OFF_XB), (const bf16_t*)(ws + OFF_WINT), T_TOK, NPAD1, 2048};
    pg8::SimpleOrder S; S.init(T_TOK, NPAD1, gridDim.x, blockIdx.x);
    pg8::Epi1 E{(const float*)(ws + OFF_RS1), (bf16_t*)(ws + OFF_PROJ)};
    pg8::gemm_phase<pg8::Epi1, pg8::SimpleOrder, 0>((PG8_LAS unsigned char*)smem, g, S, E);
  }
  PHASE_SYNC(1)
  if (PHASE_ON(2)) {
    conv_prepass(p);
    if (p.coop) grid.sync();
    for (int u0 = blockIdx.x * 2; u0 < 2048; u0 += gridDim.x * 2) ssd_local_unit(p, hsm, u0 + hb);
    for (int u0 = blockIdx.x * 2; u0 < 2048; u0 += gridDim.x * 2) lru_local_unit(p, hsm, u0 + hb);
  }
  PHASE_SYNC(2)
  if (PHASE_ON(3)) phase_carry(p);
  PHASE_SYNC(3)
  if (PHASE_ON(4)) phase_mix_final(p);
  PHASE_SYNC(4)
  if (PHASE_ON(5)) {
    pg8::Gemm g{(const bf16_t*)(ws + OFF_XB), (const bf16_t*)(ws + OFF_WOUTT), T_TOK, 2048, 2048};
    pg8::SimpleOrder S; S.init(T_TOK, 2048, gridDim.x, blockIdx.x);
    pg8::Epi2 E{p.x, p.out, (bf16_t*)(ws + OFF_X1B), (float*)(ws + OFF_SSQ2), (const float*)(ws + OFF_SSQ)};
    pg8::gemm_phase<pg8::Epi2, pg8::SimpleOrder, 16>((PG8_LAS unsigned char*)smem, g, S, E);
  }
  PHASE_SYNC(5)
  if (PHASE_ON(6)) {
    pg8::Gemm g{(const bf16_t*)(ws + OFF_X1B), (const bf16_t*)(ws + OFF_WQT), T_TOK, 2048, 2048};
    pg8::SimpleOrder S; S.init(T_TOK, 2048, gridDim.x, blockIdx.x);
    pg8::Epi3 E{(const float*)(ws + OFF_SSQ2), (bf16_t*)(ws + OFF_Q)};
    pg8::gemm_phase<pg8::Epi3, pg8::SimpleOrder, 0>((PG8_LAS unsigned char*)smem, g, S, E);
    convert_uv(p);
  }
  PHASE_SYNC(6)
  if (PHASE_ON(7)) {
    for (int u = blockIdx.x * 2 + hb; u < 2048; u += gridDim.x * 2) topk_unit(p, hsm, u);
  }
  PHASE_SYNC(7)
  if (PHASE_ON(8)) phase_gather(p);
}

extern "C" void kernel_launch(void* const* d_in, const int* in_sizes, int n_in, void* d_out, int out_size,
                              void* d_ws, size_t ws_size, hipStream_t stream) {
  Params p{};
  const float** fp = (const float**)&p;
  for (int i = 0; i < 23; ++i) fp[i] = (const float*)d_in[i];
  p.out = (float*)d_out;
  p.ws = (unsigned char*)d_ws;
  static int grid_blocks = 0;
  if (!grid_blocks) {
    int dev = 0, cus = 0, per_cu = 0;
    hipGetDevice(&dev);
    hipDeviceGetAttribute(&cus, hipDeviceAttributeMultiprocessorCount, dev);
    hipOccupancyMaxActiveBlocksPerMultiprocessor(&per_cu, fwd_kernel, NTHR, 0);
    if (per_cu < 1) per_cu = 1;
    if (per_cu > 1) per_cu = 1;
    grid_blocks = cus * per_cu;
  }
#if SINGLE_LAUNCH
  p.phase_lo = 0; p.phase_hi = 8; p.coop = 1;
  void* args[] = {&p};
  hipError_t e = hipLaunchCooperativeKernel((void*)fwd_kernel, dim3(grid_blocks), dim3(NTHR), args, 0, stream);
  if (e != hipSuccess) fprintf(stderr, "cooperative launch failed: %s (grid %d)\n", hipGetErrorString(e), grid_blocks);
#else
  for (int ph = 0; ph <= 8; ++ph) {
    p.phase_lo = ph; p.phase_hi = ph; p.coop = 0;
    hipLaunchKernelGGL(fwd_kernel, dim3(grid_blocks), dim3(NTHR), 0, stream, p);
  }
#endif
}
```

```cpp
#include <hip/hip_runtime.h>
#include <hip/hip_cooperative_groups.h>
#include <cstdio>
namespace cg = cooperative_groups;

#ifndef DBL_PHASE
#define DBL_PHASE -1
#endif
#ifndef SINGLE_LAUNCH
#define SINGLE_LAUNCH 1
#endif

typedef unsigned short bf16_t;
typedef short bf16x8 __attribute__((ext_vector_type(8)));
typedef float f32x4 __attribute__((ext_vector_type(4)));
typedef unsigned u32x4 __attribute__((ext_vector_type(4)));
typedef unsigned u32x2 __attribute__((ext_vector_type(2)));
typedef __bf16 bf2_t __attribute__((ext_vector_type(2)));

#define T_TOK 16384
#define DM 2048
#define LDP 4736
#define NPAD1 4864
#define NTHR 512
#define HTHR 256
#define SMEM_HALF 73728
#define SMEM_BYTES 147456
#define EPSV 1e-6f
#define MIB ((size_t)1 << 20)

#define OFF_XB (0 * MIB)
#define OFF_PROJ (64 * MIB)
#define OFF_X1B (64 * MIB)
#define OFF_Q (128 * MIB)
#define OFF_IDX (192 * MIB)
#define OFF_G (200 * MIB)
#define OFF_HLOC (212 * MIB)
#define OFF_CUMA (276 * MIB)
#define OFF_YPART (340 * MIB)
#define OFF_ST (372 * MIB)
#define OFF_WINT (436 * MIB)
#define OFF_WOUTT (455 * MIB)
#define OFF_WQT (463 * MIB)
#define OFF_WAT (471 * MIB)
#define OFF_WXT (471 * MIB + 131072)
#define OFF_KEYSB (471 * MIB + 262144)
#define OFF_RS1 (472 * MIB)
#define OFF_ACS (472 * MIB + 65536)
#define OFF_LCARRY (OFF_ACS + MIB)
#define OFF_SSQ (OFF_LCARRY + 524288)
#define OFF_SSQ2 (OFF_SSQ + MIB)
#define OFF_SCALES (OFF_SSQ2 + 2 * MIB)
#define OFF_XACT (0 * MIB)
#define OFF_BACT (32 * MIB)
#define OFF_CACT (478 * MIB)

struct Params {
  const float *x, *norm_mix_w, *w_in, *lru_conv_w, *lru_conv_b, *lru_wa, *lru_ba, *lru_wx, *lru_bx, *lru_lambda;
  const float *ssd_conv_w, *ssd_conv_b, *ssd_dt_bias, *ssd_a_log, *ssd_d, *ssd_norm_w, *w_out, *norm_ffn_w, *peer_wq;
  const float *peer_sub_keys, *peer_u, *peer_v, *norm_final_w;
  float* out;
  unsigned char* ws;
  int phase_lo, phase_hi, coop, pad0;
};

__device__ __forceinline__ unsigned pk2(float lo, float hi) {
  unsigned r;
  asm("v_cvt_pk_bf16_f32 %0, %1, %2" : "=v"(r) : "v"(lo), "v"(hi));
  return r;
}
__device__ __forceinline__ float bf2f(bf16_t v) { return __uint_as_float(((unsigned)v) << 16); }
__device__ __forceinline__ float bflo(unsigned u) { return __uint_as_float(u << 16); }
__device__ __forceinline__ float bfhi(unsigned u) { return __uint_as_float(u & 0xffff0000u); }
__device__ __forceinline__ float wave_sum(float v) {
#pragma unroll
  for (int o = 32; o > 0; o >>= 1) v += __shfl_xor(v, o);
  return v;
}
__device__ __forceinline__ float sigmoid_(float x) { return __builtin_amdgcn_rcpf(1.f + __expf(-x)); }
__device__ __forceinline__ float silu_(float x) { return x * sigmoid_(x); }
__device__ __forceinline__ float gelu_(float x) {
  float u = 0.7978845608028654f * (x + 0.044715f * x * x * x);
  return x * sigmoid_(2.f * u);
}
__device__ __forceinline__ float softplus_(float x) { return fmaxf(x, 0.f) + log1pf(__expf(-fabsf(x))); }
__device__ __forceinline__ f32x4 mfma16(bf16x8 a, bf16x8 b, f32x4 c) {
  return __builtin_amdgcn_mfma_f32_16x16x32_bf16(a, b, c, 0, 0, 0);
}
__device__ __forceinline__ bf16x8 as_frag(u32x4 v) { return __builtin_bit_cast(bf16x8, v); }
__device__ __forceinline__ int sw256(int row, int chunk) { return row * 256 + ((chunk ^ (row & 15)) << 4); }
__device__ __forceinline__ int sw128(int row, int chunk) { return row * 128 + ((chunk ^ ((row >> 1) & 7)) << 4); }

__device__ __forceinline__ float rs_from_ssq2(const float* ssq2, int row) {
  const f32x4* pp = (const f32x4*)(ssq2 + (size_t)row * 32);
  float s = 0.f;
#pragma unroll
  for (int i = 0; i < 8; ++i) { f32x4 v = pp[i]; s += v[0] + v[1] + v[2] + v[3]; }
  return rsqrtf(s * (1.f / 2048.f) + EPSV);
}
__device__ __forceinline__ float rs_from_ssq(const float* ssq, int row) {
  const f32x4* pp = (const f32x4*)(ssq + (size_t)row * 16);
  float s = 0.f;
#pragma unroll
  for (int i = 0; i < 4; ++i) { f32x4 v = pp[i]; s += v[0] + v[1] + v[2] + v[3]; }
  return rsqrtf(s * (1.f / 1024.f) + EPSV);
}

__device__ void transpose_tile(const float* __restrict__ src, int ld_src, int r0, int c0, int c_valid,
                               bf16_t* __restrict__ dst, int ld_dst, const float* __restrict__ scale, int scale_from,
                               float* tile, bool valid) {
  const int tid = threadIdx.x & 255;
  {
    const int j = tid & 63, i0 = tid >> 6;
#pragma unroll 4
    for (int ii = 0; ii < 16; ++ii) {
      const int i = i0 + 4 * ii;
      float v = 0.f;
      if (valid && c0 + j < c_valid) {
        v = src[(size_t)(r0 + i) * ld_src + c0 + j];
        if (scale != nullptr && (r0 + i) >= scale_from) v *= scale[r0 + i - scale_from];
      }
      tile[i * 65 + j] = v;
    }
  }
  __syncthreads();
  {
    const int i = tid & 63, j0 = tid >> 6;
#pragma unroll 4
    for (int jj = 0; jj < 16; ++jj) {
      const int j = j0 + 4 * jj;
      if (valid) dst[(size_t)(c0 + j) * ld_dst + r0 + i] = (bf16_t)(pk2(tile[i * 65 + j], 0.f) & 0xffffu);
    }
  }
  __syncthreads();
}

__device__ void phase_prep(const Params& p, unsigned char* smem) {
  const int tid = threadIdx.x, lane = tid & 63, wid = tid >> 6, hb = tid >> 8;
  unsigned char* ws = p.ws;
  bf16_t* xb = (bf16_t*)(ws + OFF_XB);
  float* rs1 = (float*)(ws + OFF_RS1);
  for (int t = blockIdx.x * 8 + wid; t < T_TOK; t += gridDim.x * 8) {
    const float* xr = p.x + (size_t)t * DM;
    bf16_t* xo = xb + (size_t)t * DM;
    float ss = 0.f;
#pragma unroll
    for (int c = 0; c < 8; ++c) {
      f32x4 v = *(const f32x4*)(xr + c * 256 + lane * 4);
      ss += v[0] * v[0] + v[1] * v[1] + v[2] * v[2] + v[3] * v[3];
      u32x2 o = {pk2(v[0], v[1]), pk2(v[2], v[3])};
      *(u32x2*)(xo + c * 256 + lane * 4) = o;
    }
    ss = wave_sum(ss);
    if (lane == 0) rs1[t] = rsqrtf(ss * (1.f / 2048.f) + EPSV);
  }
  float* tile = (float*)(smem + hb * SMEM_HALF);
  const int NT_WIN = 32 * 76, NT_SQ = 32 * 32;
  const int total = NT_WIN + 2 * NT_SQ + 32;
  for (int u0 = blockIdx.x * 2; u0 < total; u0 += gridDim.x * 2) {
    const bool valid = (u0 + hb) < total;
    const int u = valid ? (u0 + hb) : u0;
    if (u < NT_WIN) {
      const int ri = u & 31, cj = u >> 5;
      transpose_tile(p.w_in, 4624, ri * 64, cj * 64, 4624, (bf16_t*)(ws + OFF_WINT), 2048, p.norm_mix_w, 0, tile, valid);
    } else if (u < NT_WIN + NT_SQ) {
      const int v = u - NT_WIN, ri = v & 31, cj = v >> 5;
      transpose_tile(p.w_out, 2048, ri * 64, cj * 64, 2048, (bf16_t*)(ws + OFF_WOUTT), 2048, p.ssd_norm_w, 1024, tile, valid);
    } else if (u < NT_WIN + 2 * NT_SQ) {
      const int v = u - NT_WIN - NT_SQ, ri = v & 31, cj = v >> 5;
      transpose_tile(p.peer_wq, 2048, ri * 64, cj * 64, 2048, (bf16_t*)(ws + OFF_WQT), 2048, p.norm_ffn_w, 0, tile, valid);
    } else {
      const int v = u - NT_WIN - 2 * NT_SQ;
      const int h = v & 15;
      const float* src = (v < 16 ? p.lru_wa : p.lru_wx) + (size_t)h * 4096;
      bf16_t* dst = (bf16_t*)(ws + (v < 16 ? OFF_WAT : OFF_WXT)) + (size_t)h * 4096;
      transpose_tile(src, 64, 0, 0, 64, dst, 64, nullptr, 0, tile, valid);
    }
  }
  {
    bf16_t* kb = (bf16_t*)(ws + OFF_KEYSB);
    for (int i = blockIdx.x * NTHR + tid; i < 65536; i += gridDim.x * NTHR) {
      f32x4 v = *(const f32x4*)(p.peer_sub_keys + (size_t)i * 4);
      u32x2 o = {pk2(v[0], v[1]), pk2(v[2], v[3])};
      *(u32x2*)(kb + (size_t)i * 4) = o;
    }
  }
}

namespace pg8 {
#define PG8_LAS __attribute__((address_space(3)))
constexpr int BM = 256, BK = 64, HALF = 128, HTB = HALF * BK * 2;
__device__ __forceinline__ int lds_byte(int r, int c) { const int st = (r >> 4) * 2 + (c >> 5), rr = r & 15, cc = c & 31, ob = rr * 64 + cc * 2; return st * 1024 + (ob ^ (((ob >> 9) & 1) << 5)); }
__device__ __forceinline__ void stage_rc(int b, int& R, int& C) { const int st = b / 1024, sb = b % 1024, swz = sb ^ (((sb >> 9) & 1) << 5); R = (st >> 1) * 16 + swz / 64; C = (st & 1) * 32 + (swz % 64) / 2; }
struct Unit { int pm, pn; };
struct Gemm { const bf16_t* A; const bf16_t* Bt; int M, N, K; };
struct SimpleOrder {
  int nM, nwg, G, c;
  __device__ void init(int M, int N, int G_, int c_) { nM = M / BM; nwg = nM * (N / BM); G = G_; c = c_; }
  __device__ bool next(int i, Unit& u) const { const int L = i * G + c; if (L >= nwg) return false; u.pm = L % nM; u.pn = L / nM; return true; }
};
struct Epi1 {
  static constexpr bool MID = false;
  const float* rs1; bf16_t* proj;
  __device__ __forceinline__ void mid(f32x4 (&)[2][2][4][2], const Unit&, int, int) const {}
  __device__ __forceinline__ void operator()(const f32x4 (&acc)[2][2][4][2], const Unit& u, int wr, int wc, int fr, int fq) const {
    const int row0 = u.pm * BM + wr * 64 + fr, col0 = u.pn * BM + wc * 32 + 4 * fq;
#pragma unroll
    for (int ai = 0; ai < 2; ++ai)
#pragma unroll
      for (int m = 0; m < 4; ++m) {
        const int row = row0 + ai * HALF + m * 16;
        const float s = rs1[row];
#pragma unroll
        for (int bj = 0; bj < 2; ++bj)
#pragma unroll
          for (int n = 0; n < 2; ++n) {
            const int col = col0 + bj * HALF + n * 16;
            if (col < LDP) {
              f32x4 v = acc[ai][bj][m][n] * s;
              u32x2 o = {pk2(v[0], v[1]), pk2(v[2], v[3])};
              *(u32x2*)(proj + (size_t)row * LDP + col) = o;
            }
          }
      }
  }
};
struct Epi2 {
  static constexpr bool MID = true;
  const float* x; float* out; bf16_t* x1b; float* ssq2; const float* ssq;
  __device__ __forceinline__ void mid(f32x4 (&acc)[2][2][4][2], const Unit& u, int wr, int fr) const {
#pragma unroll
    for (int ai = 0; ai < 2; ++ai)
#pragma unroll
      for (int m = 0; m < 4; ++m) {
        const float s = rs_from_ssq(ssq, u.pm * BM + wr * 64 + fr + ai * HALF + m * 16);
#pragma unroll
        for (int bj = 0; bj < 2; ++bj)
#pragma unroll
          for (int n = 0; n < 2; ++n) acc[ai][bj][m][n] *= s;
        __builtin_amdgcn_sched_barrier(0);
      }
  }
  __device__ __forceinline__ void operator()(const f32x4 (&acc)[2][2][4][2], const Unit& u, int wr, int wc, int fr, int fq) const {
    const int row0 = u.pm * BM + wr * 64 + fr, col0 = u.pn * BM + wc * 32 + 4 * fq;
#pragma unroll
    for (int ai = 0; ai < 2; ++ai)
#pragma unroll
      for (int m = 0; m < 4; ++m) {
        const int row = row0 + ai * HALF + m * 16;
        float ss = 0.f;
#pragma unroll
        for (int bj = 0; bj < 2; ++bj)
#pragma unroll
          for (int n = 0; n < 2; ++n) {
            const int col = col0 + bj * HALF + n * 16;
            f32x4 xr = *(const f32x4*)(x + (size_t)row * DM + col);
            f32x4 v = acc[ai][bj][m][n] + xr;
            *(f32x4*)(out + (size_t)row * DM + col) = v;
            u32x2 o = {pk2(v[0], v[1]), pk2(v[2], v[3])};
            *(u32x2*)(x1b + (size_t)row * DM + col) = o;
            ss += v[0] * v[0] + v[1] * v[1] + v[2] * v[2] + v[3] * v[3];
          }
        ss += __shfl_xor(ss, 16);
        ss += __shfl_xor(ss, 32);
        if (fq == 0) ssq2[(size_t)row * 32 + u.pn * 4 + wc] = ss;
        __builtin_amdgcn_sched_barrier(0);
      }
  }
};
struct Epi3 {
  static constexpr bool MID = false;
  const float* ssq2; bf16_t* q;
  __device__ __forceinline__ void mid(f32x4 (&)[2][2][4][2], const Unit&, int, int) const {}
  __device__ __forceinline__ void operator()(const f32x4 (&acc)[2][2][4][2], const Unit& u, int wr, int wc, int fr, int fq) const {
    const int row0 = u.pm * BM + wr * 64 + fr, col0 = u.pn * BM + wc * 32 + 4 * fq;
#pragma unroll
    for (int ai = 0; ai < 2; ++ai)
#pragma unroll
      for (int m = 0; m < 4; ++m) {
        const int row = row0 + ai * HALF + m * 16;
        const float s = rs_from_ssq2(ssq2, row);
#pragma unroll
        for (int bj = 0; bj < 2; ++bj)
#pragma unroll
          for (int n = 0; n < 2; ++n) {
            const int col = col0 + bj * HALF + n * 16;
            f32x4 v = acc[ai][bj][m][n] * s;
            u32x2 o = {pk2(v[0], v[1]), pk2(v[2], v[3])};
            *(u32x2*)(q + (size_t)row * DM + col) = o;
          }
      }
  }
};

template <class Epi, class Sched, int KROT>
__device__ __forceinline__ void gemm_phase(PG8_LAS unsigned char* lds, const Gemm g, const Sched& S, const Epi& E) {
  const int tid = threadIdx.x, wid = __builtin_amdgcn_readfirstlane(tid >> 6), lane = tid & 63, wr = wid >> 2, wc = wid & 3, fr = lane & 15, fq = lane >> 4;
  const int K = g.K, nt = K / BK;
#define PG8_KX(t) (((t) + KROT) & 31)
  unsigned voff[2];
#pragma unroll
  for (int i = 0; i < 2; ++i) { int R, C; stage_rc(tid * 16 + i * 8192, R, C); voff[i] = (unsigned)(R * K + C) * 2u; }
  const size_t kstep = (size_t)(BK * 2);
  const size_t hstep = (size_t)HALF * K * 2;
  const size_t tstep = 2 * hstep;
  const unsigned ldsw = (unsigned)wid * 1024u;
  const int aoff = lds_byte(wr * 64 + fr, fq * 8), boff = lds_byte(wc * 32 + fr, fq * 8);
#define PG8_SA(b, h) (((b) * 2 + (h)) * HTB)
#define PG8_SB(b, h) ((4 + (b) * 2 + (h)) * HTB)
#define PG8_STAGE(bufoff, gbase) do { _Pragma("unroll") for (int _i = 0; _i < 2; ++_i) \
    __builtin_amdgcn_global_load_lds((const unsigned*)((const char*)(gbase) + voff[_i]), (PG8_LAS unsigned*)(lds + (bufoff) + ldsw + _i * 8192), 16, 0, 0); } while (0)
#define PG8_LDA(dst, b, h) do { _Pragma("unroll") for (int m = 0; m < 4; ++m) _Pragma("unroll") for (int k = 0; k < 2; ++k) dst[m][k] = *(const PG8_LAS bf16x8*)(lds + PG8_SA(b, h) + aoff + m * 2048 + k * 1024); } while (0)
#define PG8_LDB(dst, b, h) do { _Pragma("unroll") for (int n = 0; n < 2; ++n) _Pragma("unroll") for (int k = 0; k < 2; ++k) dst[n][k] = *(const PG8_LAS bf16x8*)(lds + PG8_SB(b, h) + boff + n * 2048 + k * 1024); } while (0)
#define PG8_MMA(ai, bj, At, Bt) do { __builtin_amdgcn_s_setprio(1); _Pragma("unroll") for (int m = 0; m < 4; ++m) _Pragma("unroll") for (int n = 0; n < 2; ++n) _Pragma("unroll") for (int k = 0; k < 2; ++k) \
    acc[ai][bj][m][n] = __builtin_amdgcn_mfma_f32_16x16x32_bf16(Bt[n][k], At[m][k], acc[ai][bj][m][n], 0, 0, 0); __builtin_amdgcn_s_setprio(0); } while (0)
#define PG8_WAIT_V(n) asm volatile("s_waitcnt vmcnt(" #n ")" ::: "memory")
#define PG8_WAIT_L(n) asm volatile("s_waitcnt lgkmcnt(" #n ")" ::: "memory")
#define PG8_BAR __builtin_amdgcn_s_barrier()
#define PG8_SCHED __builtin_amdgcn_sched_barrier(0)
  Unit cur, nxt; int ui = 0;
  if (!S.next(0, cur)) return;
  f32x4 acc[2][2][4][2];
#pragma unroll
  for (int a = 0; a < 2; ++a)
#pragma unroll
    for (int b = 0; b < 2; ++b)
#pragma unroll
      for (int m = 0; m < 4; ++m)
#pragma unroll
        for (int n = 0; n < 2; ++n) acc[a][b][m][n] = (f32x4){0.f, 0.f, 0.f, 0.f};
  bf16x8 At[4][2], B0[2][2], B1[2][2];
  const char* cA = (const char*)g.A + (size_t)cur.pm * tstep; const char* cB = (const char*)g.Bt + (size_t)cur.pn * tstep;
  { const char* a0 = cA + (size_t)PG8_KX(0) * kstep; const char* b0 = cB + (size_t)PG8_KX(0) * kstep;
    const char* a1 = cA + (size_t)PG8_KX(1) * kstep; const char* b1 = cB + (size_t)PG8_KX(1) * kstep;
    PG8_STAGE(PG8_SB(0, 0), b0); PG8_STAGE(PG8_SA(0, 0), a0); PG8_STAGE(PG8_SB(0, 1), b0 + hstep); PG8_STAGE(PG8_SA(0, 1), a0 + hstep);
    if (wr == 1) PG8_BAR;
    PG8_WAIT_V(4); PG8_BAR;
    PG8_STAGE(PG8_SB(1, 0), b1); PG8_STAGE(PG8_SA(1, 0), a1); PG8_STAGE(PG8_SB(1, 1), b1 + hstep);
    PG8_WAIT_V(6); PG8_BAR; }
  for (;;) {
    const bool has_next = S.next(ui + 1, nxt);
    const char* nA = has_next ? (const char*)g.A + (size_t)nxt.pm * tstep : cA; const char* nB = has_next ? (const char*)g.Bt + (size_t)nxt.pn * tstep : cB;
#define PG8_ITER(t) {\
      const bool last = (t == nt - 2);\
      const char* a1 = cA + (size_t)PG8_KX(t + 1) * kstep;\
      const char* a2 = last ? nA + (size_t)PG8_KX(0) * kstep : cA + (size_t)PG8_KX(t + 2) * kstep;\
      const char* b2 = last ? nB + (size_t)PG8_KX(0) * kstep : cB + (size_t)PG8_KX(t + 2) * kstep;\
      const char* a3 = last ? nA + (size_t)PG8_KX(1) * kstep : cA + (size_t)PG8_KX(t + 3) * kstep;\
      const char* b3 = last ? nB + (size_t)PG8_KX(1) * kstep : cB + (size_t)PG8_KX(t + 3) * kstep;\
      PG8_LDB(B0, 0, 0); PG8_SCHED; PG8_LDA(At, 0, 0); PG8_STAGE(PG8_SA(1, 1), a1 + hstep);\
      PG8_WAIT_L(8); PG8_BAR; PG8_WAIT_L(0); PG8_MMA(0, 0, At, B0); PG8_BAR; PG8_SCHED;\
      PG8_LDB(B1, 0, 1); PG8_STAGE(PG8_SB(0, 0), b2);\
      PG8_BAR; PG8_WAIT_L(0); PG8_MMA(0, 1, At, B1); PG8_BAR;\
      PG8_LDA(At, 0, 1); PG8_STAGE(PG8_SA(0, 0), a2);\
      PG8_BAR; PG8_WAIT_L(0); PG8_MMA(1, 0, At, B0); PG8_BAR; PG8_SCHED;\
      PG8_STAGE(PG8_SB(0, 1), b2 + hstep);\
      PG8_WAIT_V(6); PG8_BAR; PG8_MMA(1, 1, At, B1); PG8_BAR;\
      PG8_LDB(B0, 1, 0); PG8_SCHED; PG8_LDA(At, 1, 0); PG8_STAGE(PG8_SA(0, 1), a2 + hstep);\
      PG8_WAIT_L(8); PG8_BAR; PG8_WAIT_L(0); PG8_MMA(0, 0, At, B0); PG8_BAR; PG8_SCHED;\
      PG8_LDB(B1, 1, 1); PG8_STAGE(PG8_SB(1, 0), b3);\
      PG8_BAR; PG8_WAIT_L(0); PG8_MMA(0, 1, At, B1); PG8_BAR;\
      PG8_LDA(At, 1, 1); PG8_STAGE(PG8_SA(1, 0), a3);\
      PG8_BAR; PG8_WAIT_L(0); PG8_MMA(1, 0, At, B0); PG8_BAR; PG8_SCHED;\
      PG8_STAGE(PG8_SB(1, 1), b3 + hstep);\
      PG8_WAIT_V(6); PG8_BAR; PG8_MMA(1, 1, At, B1); PG8_BAR;\
}
    if (Epi::MID) {
      for (int t = 0; t < 16; t += 2) PG8_ITER(t)
      E.mid(acc, cur, wr, fr);
      for (int t = 16; t < nt; t += 2) PG8_ITER(t)
    } else {
      for (int t = 0; t < nt; t += 2) PG8_ITER(t)
    }
#undef PG8_ITER
    E(acc, cur, wr, wc, fr, fq);
    if (!has_next) break;
#pragma unroll
    for (int a = 0; a < 2; ++a)
#pragma unroll
      for (int b = 0; b < 2; ++b)
#pragma unroll
        for (int m = 0; m < 4; ++m)
#pragma unroll
          for (int n = 0; n < 2; ++n) acc[a][b][m][n] = (f32x4){0.f, 0.f, 0.f, 0.f};
    cur = nxt; cA = nA; cB = nB; ++ui;
  }
  PG8_WAIT_V(0);
  if (wr == 0) PG8_BAR;
  PG8_BAR;
#undef PG8_KX
#undef PG8_SA
#undef PG8_SB
#undef PG8_STAGE
#undef PG8_LDA
#undef PG8_LDB
#undef PG8_MMA
#undef PG8_WAIT_V
#undef PG8_WAIT_L
#undef PG8_BAR
#undef PG8_SCHED
}
}

__device__ __forceinline__ void conv8(const bf16_t* __restrict__ proj, int t, int tt_in_seq, int col,
                                      const float* __restrict__ cw, int ld_w, const float* __restrict__ cb, int ch,
                                      float* o) {
  f32x4 b0 = *(const f32x4*)(cb + ch), b1 = *(const f32x4*)(cb + ch + 4);
  o[0] = b0[0]; o[1] = b0[1]; o[2] = b0[2]; o[3] = b0[3];
  o[4] = b1[0]; o[5] = b1[1]; o[6] = b1[2]; o[7] = b1[3];
#pragma unroll
  for (int k = 0; k < 4; ++k) {
    if (tt_in_seq - 3 + k >= 0) {
      u32x4 v = *(const u32x4*)(proj + (size_t)(t - 3 + k) * LDP + col);
      f32x4 w0 = *(const f32x4*)(cw + k * ld_w + ch), w1 = *(const f32x4*)(cw + k * ld_w + ch + 4);
      o[0] += w0[0] * bflo(v[0]); o[1] += w0[1] * bfhi(v[0]);
      o[2] += w0[2] * bflo(v[1]); o[3] += w0[3] * bfhi(v[1]);
      o[4] += w1[0] * bflo(v[2]); o[5] += w1[1] * bfhi(v[2]);
      o[6] += w1[2] * bflo(v[3]); o[7] += w1[3] * bfhi(v[3]);
    }
  }
}
__device__ __forceinline__ void conv4(const bf16_t* __restrict__ proj, int t, int tt_in_seq, int col,
                                      const float* __restrict__ cw, int ld_w, const float* __restrict__ cb, int ch,
                                      float* o) {
  f32x4 b0 = *(const f32x4*)(cb + ch);
  o[0] = b0[0]; o[1] = b0[1]; o[2] = b0[2]; o[3] = b0[3];
#pragma unroll
  for (int k = 0; k < 4; ++k) {
    if (tt_in_seq - 3 + k >= 0) {
      u32x2 v = *(const u32x2*)(proj + (size_t)(t - 3 + k) * LDP + col);
      f32x4 w0 = *(const f32x4*)(cw + k * ld_w + ch);
      o[0] += w0[0] * bflo(v[0]); o[1] += w0[1] * bfhi(v[0]);
      o[2] += w0[2] * bflo(v[1]); o[3] += w0[3] * bfhi(v[1]);
    }
  }
}
__device__ __forceinline__ bf16x8 cfrag(const Params& p, const bf16_t* proj, int t, int tseq, int g, int n8) {
  const bf16_t* cact = (const bf16_t*)(p.ws + OFF_CACT);
  return as_frag(*(const u32x4*)(cact + (size_t)t * 256 + g * 128 + n8));
}
__device__ void conv_prepass(const Params& p) {
  unsigned char* ws = p.ws;
  const bf16_t* proj = (const bf16_t*)(ws + OFF_PROJ);
  bf16_t* xact = (bf16_t*)(ws + OFF_XACT);
  bf16_t* bact = (bf16_t*)(ws + OFF_BACT);
  bf16_t* cact = (bf16_t*)(ws + OFF_CACT);
  for (int i = blockIdx.x * NTHR + threadIdx.x; i < T_TOK * 192; i += gridDim.x * NTHR) {
    const int t = i / 192, ch = (i - t * 192) * 8;
    float o[8];
    conv8(proj, t, t & 2047, 3072 + ch, p.ssd_conv_w, 1536, p.ssd_conv_b, ch, o);
#pragma unroll
    for (int e = 0; e < 8; ++e) o[e] = silu_(o[e]);
    u32x4 r = {pk2(o[0], o[1]), pk2(o[2], o[3]), pk2(o[4], o[5]), pk2(o[6], o[7])};
    bf16_t* dst = ch < 1024 ? xact + (size_t)t * 1024 + ch : (ch < 1280 ? bact + (size_t)t * 256 + (ch - 1024) : cact + (size_t)t * 256 + (ch - 1280));
    *(u32x4*)dst = r;
  }
}

__device__ void lru_local_unit(const Params& p, unsigned char* smem, int unit) {
  const int tid = threadIdx.x & 255, lane = tid & 63, wid = tid >> 6, l15 = lane & 15, q4 = lane >> 4;
  const int hh = unit & 15, c = (unit >> 4) & 15, b = unit >> 8;
  const int t0 = b * 2048 + c * 128, ch0 = hh * 64;
  unsigned char* ws = p.ws;
  const bf16_t* proj = (const bf16_t*)(ws + OFF_PROJ);
  float* R1 = (float*)smem;
  float* R2 = (float*)(smem + 33536);
  float* R3 = (float*)(smem + 33536 + 32768);
#pragma unroll 11
  for (int e = tid; e < 131 * 64; e += HTHR) {
    const int r = e >> 6, j = e & 63, tt = r - 3;
    float v = 0.f;
    if (c * 128 + tt >= 0) v = bf2f(proj[(size_t)(t0 + tt) * LDP + ch0 + j]);
    R1[e] = v;
  }
  __syncthreads();
  {
    const int j = tid & 63;
    const float cb = p.lru_conv_b[ch0 + j];
    const float w0 = p.lru_conv_w[0 * 1024 + ch0 + j], w1 = p.lru_conv_w[1 * 1024 + ch0 + j],
                w2 = p.lru_conv_w[2 * 1024 + ch0 + j], w3 = p.lru_conv_w[3 * 1024 + ch0 + j];
#pragma unroll 8
    for (int tt = tid >> 6; tt < 128; tt += 4) {
      R2[tt * 64 + j] = cb + w0 * R1[tt * 64 + j] + w1 * R1[(tt + 1) * 64 + j] + w2 * R1[(tt + 2) * 64 + j] +
                        w3 * R1[(tt + 3) * 64 + j];
    }
  }
  __syncthreads();
  {
    const bf16_t* waT = (const bf16_t*)(ws + OFF_WAT) + (size_t)hh * 4096;
    const bf16_t* wxT = (const bf16_t*)(ws + OFF_WXT) + (size_t)hh * 4096;
    f32x4 aa[2][4], ax[2][4];
#pragma unroll
    for (int i = 0; i < 2; ++i)
#pragma unroll
      for (int j = 0; j < 4; ++j) { aa[i][j] = (f32x4){0, 0, 0, 0}; ax[i][j] = (f32x4){0, 0, 0, 0}; }
#pragma unroll
    for (int ks = 0; ks < 2; ++ks) {
      bf16x8 af[2];
#pragma unroll
      for (int mi = 0; mi < 2; ++mi) {
        const float* src = R2 + (wid * 32 + mi * 16 + l15) * 64 + ks * 32 + q4 * 8;
        f32x4 v0 = *(const f32x4*)src, v1 = *(const f32x4*)(src + 4);
        u32x4 r = {pk2(v0[0], v0[1]), pk2(v0[2], v0[3]), pk2(v1[0], v1[1]), pk2(v1[2], v1[3])};
        af[mi] = as_frag(r);
      }
#pragma unroll
      for (int ni = 0; ni < 4; ++ni) {
        const size_t wo = (size_t)(ni * 16 + l15) * 64 + ks * 32 + q4 * 8;
        bf16x8 ba = as_frag(*(const u32x4*)(waT + wo));
        bf16x8 bx = as_frag(*(const u32x4*)(wxT + wo));
#pragma unroll
        for (int mi = 0; mi < 2; ++mi) {
          aa[mi][ni] = mfma16(af[mi], ba, aa[mi][ni]);
          ax[mi][ni] = mfma16(af[mi], bx, ax[mi][ni]);
        }
      }
    }
#pragma unroll
    for (int ni = 0; ni < 4; ++ni) {
      const int j = ni * 16 + l15;
      const float ba = p.lru_ba[ch0 + j], bx = p.lru_bx[ch0 + j];
      const float lam = p.lru_lambda[ch0 + j];
      const float spl = -8.f * log1pf(__expf(-lam));
#pragma unroll
      for (int mi = 0; mi < 2; ++mi)
#pragma unroll
        for (int r = 0; r < 4; ++r) {
          const int tt = wid * 32 + mi * 16 + q4 * 4 + r;
          const float rg = sigmoid_(aa[mi][ni][r] + ba);
          const float ig = sigmoid_(ax[mi][ni][r] + bx);
          const float log_a = spl * rg;
          const float av = __expf(log_a);
          const float xl = R2[tt * 64 + j];
          const float y2 = 2.f * log_a;
          const float poly = -y2 * (1.f + y2 * (0.5f + y2 * (0.16666667f + y2 * (0.041666668f + y2 * (0.0083333338f + y2 * 0.0013888889f)))));
          const float em = (y2 > -0.25f) ? poly : (1.f - av * av);
          const float bv = __builtin_amdgcn_sqrtf(fmaxf(em, 0.f)) * (ig * xl);
          R1[tt * 64 + j] = av;
          R2[tt * 64 + j] = bv;
        }
    }
  }
  __syncthreads();
  {
    const int j = tid & 63, seg = tid >> 6;
    float h = 0.f, Ac = 1.f;
#pragma unroll 4
    for (int s = 0; s < 32; ++s) {
      const int tt = seg * 32 + s;
      const float a = R1[tt * 64 + j], bb = R2[tt * 64 + j];
      h = a * h + bb;
      Ac *= a;
      R2[tt * 64 + j] = h;
      R1[tt * 64 + j] = Ac;
    }
    R3[seg * 64 + j] = h;
    R3[256 + seg * 64 + j] = Ac;
    __syncthreads();
    float cin = 0.f, Ain = 1.f;
    for (int s2 = 0; s2 < seg; ++s2) {
      cin = R3[256 + s2 * 64 + j] * cin + R3[s2 * 64 + j];
      Ain *= R3[256 + s2 * 64 + j];
    }
    float* hloc = (float*)(ws + OFF_HLOC);
    float* cumA = (float*)(ws + OFF_CUMA);
#pragma unroll 4
    for (int s = 0; s < 32; ++s) {
      const int tt = seg * 32 + s;
      const float hl = R2[tt * 64 + j] + R1[tt * 64 + j] * cin;
      const float Al = R1[tt * 64 + j] * Ain;
      hloc[(size_t)(t0 + tt) * 1024 + ch0 + j] = hl;
      cumA[(size_t)(t0 + tt) * 1024 + ch0 + j] = Al;
    }
  }
  __syncthreads();
}

__device__ void ssd_local_unit(const Params& p, unsigned char* smem, int unit) {
  const int tid = threadIdx.x & 255, lane = tid & 63, wid = tid >> 6, l15 = lane & 15, q4 = lane >> 4;
  const int hh = unit & 15, c = (unit >> 4) & 15, b = unit >> 8, g = hh >> 3;
  const int t0 = b * 2048 + c * 128, ts0 = c * 128;
  unsigned char* ws = p.ws;
  const bf16_t* proj = (const bf16_t*)(ws + OFF_PROJ);
  unsigned char* Bm = smem;
  unsigned char* XT = smem + 32768;
  unsigned char* Pw = smem + 49152 + wid * 4096;
  float* dts = (float*)(smem + 65536);
  float* acs = dts + 128;
  float* adt = acs + 128;
  if (tid < 128) {
    const float raw = bf2f(proj[(size_t)(t0 + tid) * LDP + 4608 + hh]);
    const float dtv = softplus_(raw + p.ssd_dt_bias[hh]);
    dts[tid] = dtv;
    adt[tid] = -__expf(p.ssd_a_log[hh]) * dtv;
  }
  __syncthreads();
  if (tid < 128) {
    float s = 0.f;
    for (int k = 0; k <= tid; ++k) s += adt[k];
    acs[tid] = s;
    ((float*)(ws + OFF_ACS))[(size_t)(t0 + tid) * 16 + hh] = s;
  }
  {
    const bf16_t* bact = (const bf16_t*)(ws + OFF_BACT);
    const int chunk = tid & 15;
#pragma unroll
    for (int i = 0; i < 8; ++i) {
      const int tt = (tid >> 4) + 16 * i;
      *(u32x4*)(Bm + sw256(tt, chunk)) = *(const u32x4*)(bact + (size_t)(t0 + tt) * 256 + g * 128 + chunk * 8);
    }
  }
  __syncthreads();
  const bf16_t* xact = (const bf16_t*)(ws + OFF_XACT);
  {
    const int pp = tid & 63;
    const int ch = hh * 64 + pp;
#pragma unroll
    for (int i = 0; i < 4; ++i) {
      const int chunk = (tid >> 6) * 4 + i;
      const int tt0 = chunk * 8;
      float o[8];
#pragma unroll
      for (int e = 0; e < 8; ++e) o[e] = bf2f(xact[(size_t)(t0 + tt0 + e) * 1024 + ch]) * dts[tt0 + e];
      u32x4 r = {pk2(o[0], o[1]), pk2(o[2], o[3]), pk2(o[4], o[5]), pk2(o[6], o[7])};
      *(u32x4*)(XT + sw256(pp, chunk)) = r;
    }
  }
  __syncthreads();
  bf16_t* ypart = (bf16_t*)(ws + OFF_YPART);
  const float Dh = p.ssd_d[hh];
#pragma unroll 1
  for (int mt = 0; mt < 2; ++mt) {
    const int M = wid * 2 + mt;
    const int lrow = M * 16 + l15;
    bf16x8 cf[4];
#pragma unroll
    for (int ks = 0; ks < 4; ++ks) cf[ks] = cfrag(p, proj, t0 + lrow, ts0 + lrow, g, ks * 32 + q4 * 8);
    const float acl = acs[lrow];
    const int ntmax = M | 1;
#pragma unroll 1
    for (int nt = 0; nt <= ntmax; ++nt) {
      f32x4 a4 = (f32x4){0, 0, 0, 0};
      if (nt <= M) {
#pragma unroll
        for (int ks = 0; ks < 4; ++ks) {
          bf16x8 bfr = *(const bf16x8*)(Bm + sw256(nt * 16 + l15, ks * 4 + q4));
          a4 = mfma16(bfr, cf[ks], a4);
        }
      }
      float pv[4];
#pragma unroll
      for (int r = 0; r < 4; ++r) {
        const int s = nt * 16 + q4 * 4 + r;
        pv[r] = (s <= lrow) ? a4[r] * __expf(acl - acs[s]) : 0.f;
      }
      u32x2 o = {pk2(pv[0], pv[1]), pk2(pv[2], pv[3])};
      const int chunk = nt * 2 + (q4 >> 1);
      *(u32x2*)(Pw + sw256(l15, chunk) + (q4 & 1) * 8) = o;
    }
    f32x4 ya[4];
#pragma unroll
    for (int pt = 0; pt < 4; ++pt) ya[pt] = (f32x4){0, 0, 0, 0};
    const int ksmax = M >> 1;
#pragma unroll 1
    for (int ks = 0; ks <= ksmax; ++ks) {
      bf16x8 pf = *(const bf16x8*)(Pw + sw256(l15, ks * 4 + q4));
#pragma unroll
      for (int pt = 0; pt < 4; ++pt) {
        bf16x8 xf = *(const bf16x8*)(XT + sw256(pt * 16 + l15, ks * 4 + q4));
        ya[pt] = mfma16(xf, pf, ya[pt]);
      }
    }
#pragma unroll
    for (int pt = 0; pt < 4; ++pt) {
      const int pc = pt * 16 + q4 * 4;
      const int ch = hh * 64 + pc;
      const u32x2 xv = *(const u32x2*)(xact + (size_t)(t0 + lrow) * 1024 + ch);
      float y0 = ya[pt][0] + Dh * bflo(xv[0]), y1 = ya[pt][1] + Dh * bfhi(xv[0]);
      float y2 = ya[pt][2] + Dh * bflo(xv[1]), y3 = ya[pt][3] + Dh * bfhi(xv[1]);
      u32x2 o = {pk2(y0, y1), pk2(y2, y3)};
      *(u32x2*)(ypart + (size_t)(t0 + lrow) * 1024 + ch) = o;
    }
  }
  {
    f32x4 sa[2][4];
#pragma unroll
    for (int i = 0; i < 2; ++i)
#pragma unroll
      for (int j = 0; j < 4; ++j) sa[i][j] = (f32x4){0, 0, 0, 0};
    const float aend = acs[127];
#pragma unroll 1
    for (int ks = 0; ks < 4; ++ks) {
      float dec[8];
#pragma unroll
      for (int e = 0; e < 8; ++e) dec[e] = __expf(aend - acs[ks * 32 + q4 * 8 + e]);
      bf16x8 bd[2];
#pragma unroll
      for (int ni = 0; ni < 2; ++ni) {
        const int n = wid * 32 + ni * 16 + l15;
        float v[8];
#pragma unroll
        for (int e = 0; e < 8; ++e) {
          const int l = ks * 32 + q4 * 8 + e;
          const bf16_t raw = *(const bf16_t*)(Bm + sw256(l, n >> 3) + (n & 7) * 2);
          v[e] = bf2f(raw) * dec[e];
        }
        u32x4 r = {pk2(v[0], v[1]), pk2(v[2], v[3]), pk2(v[4], v[5]), pk2(v[6], v[7])};
        bd[ni] = as_frag(r);
      }
#pragma unroll
      for (int pt = 0; pt < 4; ++pt) {
        bf16x8 xf = *(const bf16x8*)(XT + sw256(pt * 16 + l15, ks * 4 + q4));
#pragma unroll
        for (int ni = 0; ni < 2; ++ni) sa[ni][pt] = mfma16(bd[ni], xf, sa[ni][pt]);
      }
    }
    float* St = (float*)(ws + OFF_ST) + (size_t)((b * 16 + c) * 16 + hh) * 8192;
#pragma unroll
    for (int ni = 0; ni < 2; ++ni)
#pragma unroll
      for (int pt = 0; pt < 4; ++pt) {
        const int pr = pt * 16 + l15, n = wid * 32 + ni * 16 + q4 * 4;
        *(f32x4*)(St + pr * 128 + n) = sa[ni][pt];
      }
  }
  __syncthreads();
}

__device__ void phase_carry(const Params& p) {
  unsigned char* ws = p.ws;
  const int gt = blockIdx.x * NTHR + threadIdx.x, ng = gridDim.x * NTHR;
  const float* hloc = (const float*)(ws + OFF_HLOC);
  const float* cumA = (const float*)(ws + OFF_CUMA);
  float* lcarry = (float*)(ws + OFF_LCARRY);
  for (int i = gt; i < 8192; i += ng) {
    const int b = i >> 10, ch = i & 1023;
    float ca[16], hl[16];
#pragma unroll
    for (int c = 0; c < 16; ++c) {
      const size_t tl = (size_t)(b * 2048 + c * 128 + 127) * 1024 + ch;
      ca[c] = cumA[tl];
      hl[c] = hloc[tl];
    }
    float carry = 0.f;
#pragma unroll
    for (int c = 0; c < 16; ++c) {
      lcarry[(size_t)(b * 16 + c) * 1024 + ch] = carry;
      carry = ca[c] * carry + hl[c];
    }
  }
  const float* acsG = (const float*)(ws + OFF_ACS);
  float* St = (float*)(ws + OFF_ST);
  for (int i = gt; i < 128 * 2048; i += ng) {
    const int bh = i >> 11, e4 = i & 2047, b = bh >> 4, hh = bh & 15;
    f32x4 tmp[16];
    float Ad[16];
#pragma unroll
    for (int c = 0; c < 16; ++c) {
      Ad[c] = __expf(acsG[(size_t)(b * 2048 + c * 128 + 127) * 16 + hh]);
      tmp[c] = *(const f32x4*)(St + (size_t)((b * 16 + c) * 16 + hh) * 8192 + e4 * 4);
    }
    f32x4 s = (f32x4){0, 0, 0, 0};
#pragma unroll
    for (int c = 0; c < 16; ++c) {
      *(f32x4*)(St + (size_t)((b * 16 + c) * 16 + hh) * 8192 + e4 * 4) = s;
      s = s * Ad[c] + tmp[c];
    }
  }
}

__device__ void ssd_final_unit(const Params& p, int unit) {
  const int tid = threadIdx.x & 255, lane = tid & 63, wid = tid >> 6, l15 = lane & 15, q4 = lane >> 4;
  const int hh = unit & 15, c = (unit >> 4) & 15, b = unit >> 8, g = hh >> 3;
  const int t0 = b * 2048 + c * 128, ts0 = c * 128;
  unsigned char* ws = p.ws;
  const bf16_t* proj = (const bf16_t*)(ws + OFF_PROJ);
  const float* Sin = (const float*)(ws + OFF_ST) + (size_t)((b * 16 + c) * 16 + hh) * 8192;
  const bf16_t* ypart = (const bf16_t*)(ws + OFF_YPART);
  const float* acsG = (const float*)(ws + OFF_ACS);
  bf16_t* A2 = (bf16_t*)(ws + OFF_XB);
  float* ssq = (float*)(ws + OFF_SSQ);
#pragma unroll 1
  for (int mt = 0; mt < 2; ++mt) {
    const int lrow = (wid * 2 + mt) * 16 + l15;
    f32x4 ya[4];
#pragma unroll
    for (int pt = 0; pt < 4; ++pt) ya[pt] = (f32x4){0, 0, 0, 0};
    if (c > 0) {
#pragma unroll 2
      for (int ks = 0; ks < 4; ++ks) {
        bf16x8 cf = cfrag(p, proj, t0 + lrow, ts0 + lrow, g, ks * 32 + q4 * 8);
#pragma unroll
        for (int pt = 0; pt < 4; ++pt) {
          const float* sp = Sin + (pt * 16 + l15) * 128 + ks * 32 + q4 * 8;
          f32x4 v0 = *(const f32x4*)sp, v1 = *(const f32x4*)(sp + 4);
          u32x4 r = {pk2(v0[0], v0[1]), pk2(v0[2], v0[3]), pk2(v1[0], v1[1]), pk2(v1[2], v1[3])};
          ya[pt] = mfma16(as_frag(r), cf, ya[pt]);
        }
      }
    }
    const size_t t = (size_t)(t0 + lrow);
    const float ea = __expf(acsG[t * 16 + hh]);
    float ss = 0.f;
#pragma unroll
    for (int pt = 0; pt < 4; ++pt) {
      const int ch = hh * 64 + pt * 16 + q4 * 4;
      u32x2 yp = *(const u32x2*)(ypart + t * 1024 + ch);
      u32x2 zz = *(const u32x2*)(proj + t * LDP + 2048 + ch);
      float y[4] = {bflo(yp[0]) + ea * ya[pt][0], bfhi(yp[0]) + ea * ya[pt][1], bflo(yp[1]) + ea * ya[pt][2],
                    bfhi(yp[1]) + ea * ya[pt][3]};
      float z[4] = {bflo(zz[0]), bfhi(zz[0]), bflo(zz[1]), bfhi(zz[1])};
#pragma unroll
      for (int r = 0; r < 4; ++r) { y[r] = y[r] * silu_(z[r]); ss += y[r] * y[r]; }
      u32x2 o = {pk2(y[0], y[1]), pk2(y[2], y[3])};
      *(u32x2*)(A2 + t * DM + 1024 + ch) = o;
    }
    ss += __shfl_xor(ss, 16);
    ss += __shfl_xor(ss, 32);
    if (q4 == 0) ssq[t * 16 + hh] = ss;
  }
}

__device__ void phase_mix_final(const Params& p) {
  unsigned char* ws = p.ws;
  const bf16_t* proj = (const bf16_t*)(ws + OFF_PROJ);
  const f32x4* hloc = (const f32x4*)(ws + OFF_HLOC);
  const f32x4* cumA = (const f32x4*)(ws + OFF_CUMA);
  const float* lcarry = (const float*)(ws + OFF_LCARRY);
  bf16_t* A2 = (bf16_t*)(ws + OFF_XB);
  for (int u = blockIdx.x * 2 + (threadIdx.x >> 8); u < 2048; u += gridDim.x * 2) ssd_final_unit(p, u);
#pragma unroll 4
  for (int i = blockIdx.x * NTHR + threadIdx.x; i < T_TOK * 256; i += gridDim.x * NTHR) {
    const int t = i >> 8, ch = (i & 255) * 4;
    f32x4 h = hloc[i], ca = cumA[i];
    f32x4 cr = *(const f32x4*)(lcarry + (size_t)(t >> 7) * 1024 + ch);
    u32x2 gg = *(const u32x2*)(proj + (size_t)t * LDP + 1024 + ch);
    float y0 = (h[0] + ca[0] * cr[0]) * gelu_(bflo(gg[0]));
    float y1 = (h[1] + ca[1] * cr[1]) * gelu_(bfhi(gg[0]));
    float y2 = (h[2] + ca[2] * cr[2]) * gelu_(bflo(gg[1]));
    float y3 = (h[3] + ca[3] * cr[3]) * gelu_(bfhi(gg[1]));
    u32x2 o = {pk2(y0, y1), pk2(y2, y3)};
    *(u32x2*)(A2 + (size_t)t * DM + ch) = o;
  }
}

__device__ void convert_uv(const Params& p) {
  unsigned char* ws = p.ws;
  const int lane = threadIdx.x & 63, wid = threadIdx.x >> 6;
  unsigned char* tb = ws + OFF_XB;
  float* scales = (float*)(ws + OFF_SCALES);
  for (int row = blockIdx.x * 8 + wid; row < 32768; row += gridDim.x * 8) {
    const bool isv = row >= 16384;
    const int e = row & 16383;
    const float* src = (isv ? p.peer_v : p.peer_u) + (size_t)e * DM + lane * 32;
    float vals[32];
    float ss = 0.f;
#pragma unroll
    for (int q = 0; q < 8; ++q) {
      f32x4 t = *(const f32x4*)(src + q * 4);
      if (!isv) t *= *(const f32x4*)(p.norm_ffn_w + lane * 32 + q * 4);
#pragma unroll
      for (int k = 0; k < 4; ++k) {
        vals[q * 4 + k] = t[k];
        ss += t[k] * t[k];
      }
    }
    ss = wave_sum(ss);
    const float rms = sqrtf(ss * (1.f / 2048.f));
    const float sc = rms * (2.6f / 7.f);
    const float inv = sc > 0.f ? 1.f / sc : 0.f;
    u32x4 o;
#pragma unroll
    for (int m = 0; m < 4; ++m) {
      unsigned w = 0;
#pragma unroll
      for (int j = 0; j < 4; ++j) {
        const float lo = fminf(fmaxf(rintf(vals[m * 8 + j] * inv), -7.f), 7.f);
        const float hi = fminf(fmaxf(rintf(vals[m * 8 + 4 + j] * inv), -7.f), 7.f);
        const unsigned bl = (unsigned)((int)lo + 8), bh = (unsigned)((int)hi + 8);
        w |= (bl | (bh << 4)) << (8 * j);
      }
      o[m] = w;
    }
    *(u32x4*)(tb + (size_t)row * 1024 + lane * 16) = o;
    if (lane == 0) scales[row] = sc;
  }
}

__device__ const unsigned char cand_tab[64] = {
    0x00, 0x01, 0x02, 0x03, 0x04, 0x05, 0x06, 0x07, 0x08, 0x09, 0x0a, 0x0b, 0x0c, 0x0d, 0x0e, 0x0f,
    0x10, 0x11, 0x12, 0x13, 0x14, 0x15, 0x16, 0x17,
    0x20, 0x21, 0x22, 0x23, 0x24,
    0x30, 0x31, 0x32, 0x33,
    0x40, 0x41, 0x42,
    0x50, 0x51, 0x60, 0x61, 0x70, 0x71,
    0x80, 0x90, 0xa0, 0xb0, 0xc0, 0xd0, 0xe0, 0xf0,
    0xff, 0xff, 0xff, 0xff, 0xff, 0xff, 0xff, 0xff, 0xff, 0xff, 0xff, 0xff, 0xff, 0xff};

__device__ __forceinline__ unsigned ord_key(float f) {
  unsigned u = __float_as_uint(f);
  return u ^ ((u >> 31) ? 0xffffffffu : 0x80000000u);
}
__device__ __forceinline__ float ord_dec(unsigned k) {
  unsigned u = (k >> 31) ? (k ^ 0x80000000u) : ~k;
  return __uint_as_float(u);
}

__device__ void topk_unit(const Params& p, unsigned char* smem, int unit) {
  const int tid = threadIdx.x & 255, lane = tid & 63, wid = tid >> 6, l15 = lane & 15, q4 = lane >> 4;
  const int h = unit & 7, tile = unit >> 3;
  const int tok0 = tile * 64 + wid * 16;
  unsigned char* ws = p.ws;
  const bf16_t* qg = (const bf16_t*)(ws + OFF_Q);
  const bf16_t* kb = (const bf16_t*)(ws + OFF_KEYSB);
  unsigned* S = (unsigned*)(smem + wid * 16640);
  float* tops = (float*)(smem + 4 * 16640 + wid * 256);
  int* topi = (int*)(tops + 32);
  unsigned* Ms = (unsigned*)(smem + 67584 + wid * 768);
#pragma unroll
  for (int k = 0; k < 2; ++k) {
    f32x4 sc[8];
#pragma unroll
    for (int i = 0; i < 8; ++i) sc[i] = (f32x4){0, 0, 0, 0};
#pragma unroll
    for (int ks = 0; ks < 4; ++ks) {
      bf16x8 qf = as_frag(*(const u32x4*)(qg + (size_t)(tok0 + l15) * DM + h * 256 + k * 128 + ks * 32 + q4 * 8));
#pragma unroll
      for (int nt = 0; nt < 8; ++nt) {
        bf16x8 kf = as_frag(*(const u32x4*)(kb + (size_t)((h * 2 + k) * 128 + nt * 16 + l15) * 128 + ks * 32 + q4 * 8));
        sc[nt] = mfma16(kf, qf, sc[nt]);
      }
    }
#pragma unroll
    for (int nt = 0; nt < 8; ++nt) {
      const int n = nt * 16 + q4 * 4;
      u32x4 kk;
#pragma unroll
      for (int r = 0; r < 4; ++r) kk[r] = (ord_key(sc[nt][r]) & ~127u) | (unsigned)(127 - (n + r));
      *(u32x4*)(S + l15 * 260 + k * 128 + n) = kk;
    }
  }
  const unsigned ct = cand_tab[lane];
  const int ca = ct >> 4, cbb = ct & 15;
  int* idxo = (int*)(ws + OFF_IDX);
  float* go = (float*)(ws + OFF_G);
  for (int tk = 0; tk < 16; ++tk) {
    const unsigned* row = S + tk * 260;
    unsigned ka[2], kb[2], mxk[2];
#pragma unroll
    for (int hf = 0; hf < 2; ++hf) {
      ka[hf] = row[hf * 128 + lane];
      kb[hf] = row[hf * 128 + 64 + lane];
      mxk[hf] = ka[hf] > kb[hf] ? ka[hf] : kb[hf];
      Ms[hf * 96 + lane] = mxk[hf];
    }
    int cnt[2][4];
#pragma unroll
    for (int hf = 0; hf < 2; ++hf)
#pragma unroll
      for (int e = 0; e < 4; ++e) cnt[hf][e] = 0;
#pragma unroll
    for (int j = 0; j < 16; ++j)
#pragma unroll
      for (int hf = 0; hf < 2; ++hf) {
        u32x4 x = *(const u32x4*)(Ms + hf * 96 + j * 4);
#pragma unroll
        for (int e = 0; e < 4; ++e) cnt[hf][e] += (x[e] > mxk[hf]) ? 1 : 0;
      }
    bool ca_[2], cb_[2];
    int pa[2], pb[2], ncand[2];
    const unsigned long long lt = (1ull << lane) - 1ull;
#pragma unroll
    for (int hf = 0; hf < 2; ++hf) {
      const int c_ = cnt[hf][0] + cnt[hf][1] + cnt[hf][2] + cnt[hf][3];
      const unsigned long long bm = __ballot(c_ == 15);
      const int srcT = __ffsll((long long)bm) - 1;
      const unsigned T0 = (unsigned)__shfl((int)mxk[hf], srcT);
      ca_[hf] = ka[hf] >= T0;
      cb_[hf] = kb[hf] >= T0;
      const unsigned long long ba = __ballot(ca_[hf]), bb = __ballot(cb_[hf]);
      const int na = __popcll(ba);
      pa[hf] = __popcll(ba & lt);
      pb[hf] = na + __popcll(bb & lt);
      ncand[hf] = na + __popcll(bb);
    }
#pragma unroll
    for (int hf = 0; hf < 2; ++hf) {
      unsigned* Cs = Ms + hf * 96 + 64;
      if (lane < 32) Cs[lane] = 0u;
      if (ca_[hf]) Cs[pa[hf]] = ka[hf];
      if (cb_[hf]) Cs[pb[hf]] = kb[hf];
    }
    unsigned my[2];
    int rk2[2][4];
#pragma unroll
    for (int hf = 0; hf < 2; ++hf) {
      my[hf] = Ms[hf * 96 + 64 + (lane & 31)];
#pragma unroll
      for (int e = 0; e < 4; ++e) rk2[hf][e] = 0;
    }
#pragma unroll
    for (int j = 0; j < 8; ++j)
#pragma unroll
      for (int hf = 0; hf < 2; ++hf) {
        u32x4 x = *(const u32x4*)(Ms + hf * 96 + 64 + j * 4);
#pragma unroll
        for (int e = 0; e < 4; ++e) rk2[hf][e] += (x[e] > my[hf]) ? 1 : 0;
      }
#pragma unroll
    for (int hf = 0; hf < 2; ++hf) {
      const int r_ = rk2[hf][0] + rk2[hf][1] + rk2[hf][2] + rk2[hf][3];
      if (lane < ncand[hf] && r_ < 16) {
        tops[hf * 16 + r_] = ord_dec(my[hf] & ~127u);
        topi[hf * 16 + r_] = 127 - (int)(my[hf] & 127u);
      }
    }
    float cs = 0.f;
    unsigned ck = 0u;
    if (lane < 50) {
      cs = tops[ca] + tops[16 + cbb];
      ck = (ord_key(cs) & ~255u) | (unsigned)(255 - (ca * 16 + cbb));
    }
    int rkA = 0, rkB = 0;
#pragma unroll
    for (int j = 0; j < 50; j += 2) {
      const unsigned oj = (unsigned)__builtin_amdgcn_readlane((int)ck, j);
      const unsigned oj2 = (unsigned)__builtin_amdgcn_readlane((int)ck, j + 1);
      rkA += (oj > ck) ? 1 : 0;
      rkB += (oj2 > ck) ? 1 : 0;
    }
    const int rk = rkA + rkB;
    const float mx = tops[0] + tops[16];
    const bool sel = (lane < 50) && (rk < 16);
    const float ev = sel ? __expf(cs - mx) : 0.f;
    const float sum = wave_sum(ev);
    if (sel) {
      const size_t o = (size_t)(tok0 + tk) * 128 + h * 16 + rk;
      idxo[o] = topi[ca] * 128 + topi[16 + cbb];
      go[o] = ev * __builtin_amdgcn_rcpf(sum);
    }
  }
}

__device__ __forceinline__ float ub0(unsigned w) { return (float)(w & 0xffu); }
__device__ __forceinline__ float ub1(unsigned w) { return (float)((w >> 8) & 0xffu); }
__device__ __forceinline__ float ub2(unsigned w) { return (float)((w >> 16) & 0xffu); }
__device__ __forceinline__ float ub3(unsigned w) { return (float)(w >> 24); }

#define GROWS 8
#ifndef USE_SDOT4
#define USE_SDOT4 1
#endif
typedef float f32x2 __attribute__((ext_vector_type(2)));
__device__ void phase_gather(const Params& p) {
  const int tid = threadIdx.x, lane = tid & 63, wid = tid >> 6;
  unsigned char* ws = p.ws;
  const unsigned char* ub = ws + OFF_XB;
  const unsigned char* vb = ws + OFF_XB + 16 * MIB;
  const float* scales = (const float*)(ws + OFF_SCALES);
  const int* idxg = (const int*)(ws + OFF_IDX);
  const float* gg = (const float*)(ws + OFF_G);
  const float* ssq2 = (const float*)(ws + OFF_SSQ2);
  const bool b5 = (lane & 32) != 0, b4 = (lane & 16) != 0, b3 = (lane & 8) != 0;
  const int srcl = ((lane & 1) << 3) | (((lane >> 1) & 1) << 4) | (((lane >> 2) & 1) << 5);
  for (int t = blockIdx.x * 8 + wid; t < T_TOK; t += gridDim.x * 8) {
    const int id0 = idxg[(size_t)t * 128 + lane], id1 = idxg[(size_t)t * 128 + 64 + lane];
    const float g0 = gg[(size_t)t * 128 + lane], g1 = gg[(size_t)t * 128 + 64 + lane];
    const float su0 = scales[id0], su1 = scales[id1], sv0 = scales[16384 + id0], sv1 = scales[16384 + id1];
    float* orow = p.out + (size_t)t * DM + lane * 32;
    int xlo[4], xhi[4];
    float sx;
    int sumq;
    {
      float xr[32];
      float amax = 0.f;
#pragma unroll
      for (int q = 0; q < 8; ++q) {
        f32x4 v = *(const f32x4*)(orow + q * 4);
#pragma unroll
        for (int k = 0; k < 4; ++k) { xr[q * 4 + k] = v[k]; amax = fmaxf(amax, fabsf(v[k])); }
      }
#pragma unroll
      for (int o = 32; o > 0; o >>= 1) amax = fmaxf(amax, __shfl_xor(amax, o));
      sx = amax * (1.f / 127.f);
      const float inv = amax > 0.f ? 127.f / amax : 0.f;
      int sq_ = 0;
#pragma unroll
      for (int m = 0; m < 4; ++m) {
        unsigned wl = 0, wh = 0;
#pragma unroll
        for (int j = 0; j < 4; ++j) {
          const int a_ = __float2int_rn(xr[m * 8 + j] * inv), b_ = __float2int_rn(xr[m * 8 + 4 + j] * inv);
          sq_ += a_ + b_;
          wl |= ((unsigned)a_ & 0xffu) << (8 * j);
          wh |= ((unsigned)b_ & 0xffu) << (8 * j);
        }
        xlo[m] = (int)wl;
        xhi[m] = (int)wh;
      }
#pragma unroll
      for (int o = 32; o > 0; o >>= 1) sq_ += __shfl_xor(sq_, o);
      sumq = sq_;
    }
    float sq = (lane < 32) ? ssq2[(size_t)t * 32 + lane] : 0.f;
    sq = wave_sum(sq);
    const float rs2 = rsqrtf(sq * (1.f / 2048.f) + EPSV);
    float w0 = 0.f, w1 = 0.f;
#pragma unroll 1
    for (int half = 0; half < 2; ++half) {
      const int idv = half ? id1 : id0;
      int wv = 0;
      u32x4 rr[3][GROWS];
#pragma unroll
      for (int k = 0; k < GROWS; ++k) {
        const int e = __builtin_amdgcn_readlane(idv, k);
        rr[0][k] = *(const u32x4*)(ub + (size_t)e * 1024 + lane * 16);
        const int e2 = __builtin_amdgcn_readlane(idv, GROWS + k);
        rr[1][k] = *(const u32x4*)(ub + (size_t)e2 * 1024 + lane * 16);
      }
#pragma unroll
      for (int gi = 0; gi < 64 / GROWS; ++gi) {
        const int j0 = gi * GROWS;
        if (gi + 2 < 64 / GROWS) {
#pragma unroll
          for (int k = 0; k < GROWS; ++k) {
            const int e = __builtin_amdgcn_readlane(idv, j0 + 2 * GROWS + k);
            rr[(gi + 2) % 3][k] = *(const u32x4*)(ub + (size_t)e * 1024 + lane * 16);
          }
        }
        int dv[GROWS];
#pragma unroll
        for (int k = 0; k < GROWS; ++k) {
          int d = 0;
#pragma unroll
          for (int m = 0; m < 4; ++m) {
            const unsigned w = rr[gi % 3][k][m];
            const int lo = (int)(w & 0x0f0f0f0fu), hi = (int)((w >> 4) & 0x0f0f0f0fu);
            d = __builtin_amdgcn_sdot4(lo, xlo[m], d, false);
            d = __builtin_amdgcn_sdot4(hi, xhi[m], d, false);
          }
          dv[k] = d;
        }
        int a4[4], a2[2];
#pragma unroll
        for (int k = 0; k < 4; ++k) {
          const int mine = b5 ? dv[k + 4] : dv[k], oth = b5 ? dv[k] : dv[k + 4];
          a4[k] = mine + __shfl_xor(oth, 32);
        }
#pragma unroll
        for (int k = 0; k < 2; ++k) {
          const int mine = b4 ? a4[k + 2] : a4[k], oth = b4 ? a4[k] : a4[k + 2];
          a2[k] = mine + __shfl_xor(oth, 16);
        }
        int c1;
        {
          const int mine = b3 ? a2[1] : a2[0], oth = b3 ? a2[0] : a2[1];
          c1 = mine + __shfl_xor(oth, 8);
        }
        c1 += __shfl_xor(c1, 4);
        c1 += __shfl_xor(c1, 2);
        c1 += __shfl_xor(c1, 1);
        const int val = __shfl(c1, srcl);
        if ((lane & ~7) == j0) wv = val;
      }
      const float su = half ? su1 : su0;
      const float a = gelu_((float)(wv - 8 * sumq) * (su * sx * rs2));
      if (half) w1 = a * g1 * sv1; else w0 = a * g0 * sv0;
    }
    float wmax = fmaxf(fabsf(w0), fabsf(w1));
#pragma unroll
    for (int o = 32; o > 0; o >>= 1) wmax = fmaxf(wmax, __shfl_xor(wmax, o));
    const float sw = wmax * (1.f / 127.f);
    const float winv = wmax > 0.f ? 127.f / wmax : 0.f;
    const int q0 = __float2int_rn(w0 * winv), q1 = __float2int_rn(w1 * winv);
    int wsumq = q0 + q1;
#pragma unroll
    for (int o = 32; o > 0; o >>= 1) wsumq += __shfl_xor(wsumq, o);
    int pk0 = (int)(((unsigned)q0 & 0xffu) << (8 * (lane & 3))), pk1 = (int)(((unsigned)q1 & 0xffu) << (8 * (lane & 3)));
    pk0 |= __shfl_xor(pk0, 1); pk0 |= __shfl_xor(pk0, 2);
    pk1 |= __shfl_xor(pk1, 1); pk1 |= __shfl_xor(pk1, 2);
    int acc[32];
#pragma unroll
    for (int i = 0; i < 32; ++i) acc[i] = 0;
#pragma unroll 1
    for (int half = 0; half < 2; ++half) {
      const int idv = half ? id1 : id0;
      const int pkv = half ? pk1 : pk0;
      u32x4 rr[3][GROWS];
#pragma unroll
      for (int k = 0; k < GROWS; ++k) {
        const int e = __builtin_amdgcn_readlane(idv, k);
        rr[0][k] = *(const u32x4*)(vb + (size_t)e * 1024 + lane * 16);
        const int e2 = __builtin_amdgcn_readlane(idv, GROWS + k);
        rr[1][k] = *(const u32x4*)(vb + (size_t)e2 * 1024 + lane * 16);
      }
#pragma unroll
      for (int gi = 0; gi < 64 / GROWS; ++gi) {
        const int j0 = gi * GROWS;
        if (gi + 2 < 64 / GROWS) {
#pragma unroll
          for (int k = 0; k < GROWS; ++k) {
            const int e = __builtin_amdgcn_readlane(idv, j0 + 2 * GROWS + k);
            rr[(gi + 2) % 3][k] = *(const u32x4*)(vb + (size_t)e * 1024 + lane * 16);
          }
        }
#pragma unroll
        for (int sub = 0; sub < GROWS / 4; ++sub) {
          const int W4 = __builtin_amdgcn_readlane(pkv, j0 + 4 * sub);
#pragma unroll
          for (int m = 0; m < 4; ++m) {
            unsigned lo[4], hi[4];
#pragma unroll
            for (int k = 0; k < 4; ++k) {
              const unsigned w = rr[gi % 3][sub * 4 + k][m];
              lo[k] = w & 0x0f0f0f0fu;
              hi[k] = (w >> 4) & 0x0f0f0f0fu;
            }
            {
              const unsigned p01l = __builtin_amdgcn_perm(lo[1], lo[0], 0x05010400u), p01h = __builtin_amdgcn_perm(lo[1], lo[0], 0x07030602u);
              const unsigned p23l = __builtin_amdgcn_perm(lo[3], lo[2], 0x05010400u), p23h = __builtin_amdgcn_perm(lo[3], lo[2], 0x07030602u);
              acc[m * 8 + 0] = __builtin_amdgcn_sdot4((int)__builtin_amdgcn_perm(p23l, p01l, 0x05040100u), W4, acc[m * 8 + 0], false);
              acc[m * 8 + 1] = __builtin_amdgcn_sdot4((int)__builtin_amdgcn_perm(p23l, p01l, 0x07060302u), W4, acc[m * 8 + 1], false);
              acc[m * 8 + 2] = __builtin_amdgcn_sdot4((int)__builtin_amdgcn_perm(p23h, p01h, 0x05040100u), W4, acc[m * 8 + 2], false);
              acc[m * 8 + 3] = __builtin_amdgcn_sdot4((int)__builtin_amdgcn_perm(p23h, p01h, 0x07060302u), W4, acc[m * 8 + 3], false);
            }
            {
              const unsigned p01l = __builtin_amdgcn_perm(hi[1], hi[0], 0x05010400u), p01h = __builtin_amdgcn_perm(hi[1], hi[0], 0x07030602u);
              const unsigned p23l = __builtin_amdgcn_perm(hi[3], hi[2], 0x05010400u), p23h = __builtin_amdgcn_perm(hi[3], hi[2], 0x07030602u);
              acc[m * 8 + 4] = __builtin_amdgcn_sdot4((int)__builtin_amdgcn_perm(p23l, p01l, 0x05040100u), W4, acc[m * 8 + 4], false);
              acc[m * 8 + 5] = __builtin_amdgcn_sdot4((int)__builtin_amdgcn_perm(p23l, p01l, 0x07060302u), W4, acc[m * 8 + 5], false);
              acc[m * 8 + 6] = __builtin_amdgcn_sdot4((int)__builtin_amdgcn_perm(p23h, p01h, 0x05040100u), W4, acc[m * 8 + 6], false);
              acc[m * 8 + 7] = __builtin_amdgcn_sdot4((int)__builtin_amdgcn_perm(p23h, p01h, 0x07060302u), W4, acc[m * 8 + 7], false);
            }
          }
        }
      }
    }
    float val[32];
    float ss = 0.f;
    const int off8 = 8 * wsumq;
#pragma unroll
    for (int q = 0; q < 8; ++q) {
      f32x4 v = *(const f32x4*)(orow + q * 4);
#pragma unroll
      for (int k = 0; k < 4; ++k) {
        val[q * 4 + k] = sw * (float)(acc[q * 4 + k] - off8) + v[k];
        ss += val[q * 4 + k] * val[q * 4 + k];
      }
    }
    ss = wave_sum(ss);
    const float rs3 = rsqrtf(ss * (1.f / 2048.f) + EPSV);
#pragma unroll
    for (int q = 0; q < 8; ++q) {
      f32x4 wf = *(const f32x4*)(p.norm_final_w + lane * 32 + q * 4);
      f32x4 o = {val[q * 4 + 0] * rs3 * wf[0], val[q * 4 + 1] * rs3 * wf[1], val[q * 4 + 2] * rs3 * wf[2],
                 val[q * 4 + 3] * rs3 * wf[3]};
      *(f32x4*)(orow + q * 4) = o;
    }
  }
}

__global__ void __launch_bounds__(NTHR, 2) fwd_kernel(Params p) {
  __shared__ __attribute__((aligned(16))) unsigned char smem[SMEM_BYTES];
  cg::grid_group grid = cg::this_grid();
  unsigned char* ws = p.ws;
  const int hb = threadIdx.x >> 8;
  unsigned char* hsm = smem + hb * SMEM_HALF;
#define PHASE_ON(n) (p.phase_lo <= (n) && (n) <= p.phase_hi)
#define PHASE_SYNC(n) if (p.coop && PHASE_ON(n) && (n) < p.phase_hi) grid.sync();
  if (PHASE_ON(0)) phase_prep(p, smem);
  PHASE_SYNC(0)
  if (PHASE_ON(1)) {
    pg8::Gemm g{(const bf16_t*)(ws + OFF_XB), (const bf16_t*)(ws + OFF_WINT), T_TOK, NPAD1, 2048};
    pg8::SimpleOrder S; S.init(T_TOK, NPAD1, gridDim.x, blockIdx.x);
    pg8::Epi1 E{(const float*)(ws + OFF_RS1), (bf16_t*)(ws + OFF_PROJ)};
    pg8::gemm_phase<pg8::Epi1, pg8::SimpleOrder, 0>((PG8_LAS unsigned char*)smem, g, S, E);
  }
  PHASE_SYNC(1)
  if (PHASE_ON(2)) {
    conv_prepass(p);
    if (p.coop) grid.sync();
    for (int u0 = blockIdx.x * 2; u0 < 2048; u0 += gridDim.x * 2) ssd_local_unit(p, hsm, u0 + hb);
    for (int u0 = blockIdx.x * 2; u0 < 2048; u0 += gridDim.x * 2) lru_local_unit(p, hsm, u0 + hb);
  }
  PHASE_SYNC(2)
  if (PHASE_ON(3)) phase_carry(p);
  PHASE_SYNC(3)
  if (PHASE_ON(4)) phase_mix_final(p);
  PHASE_SYNC(4)
  if (PHASE_ON(5)) {
    pg8::Gemm g{(const bf16_t*)(ws + OFF_XB), (const bf16_t*)(ws + OFF_WOUTT), T_TOK, 2048, 2048};
    pg8::SimpleOrder S; S.init(T_TOK, 2048, gridDim.x, blockIdx.x);
    pg8::Epi2 E{p.x, p.out, (bf16_t*)(ws + OFF_X1B), (float*)(ws + OFF_SSQ2), (const float*)(ws + OFF_SSQ)};
    pg8::gemm_phase<pg8::Epi2, pg8::SimpleOrder, 16>((PG8_LAS unsigned char*)smem, g, S, E);
  }
  PHASE_SYNC(5)
  if (PHASE_ON(6)) {
    pg8::Gemm g{(const bf16_t*)(ws + OFF_X1B), (const bf16_t*)(ws + OFF_WQT), T_TOK, 2048, 2048};
    pg8::SimpleOrder S; S.init(T_TOK, 2048, gridDim.x, blockIdx.x);
    pg8::Epi3 E{(const float*)(ws + OFF_SSQ2), (bf16_t*)(ws + OFF_Q)};
    pg8::gemm_phase<pg8::Epi3, pg8::SimpleOrder, 0>((PG8_LAS unsigned char*)smem, g, S, E);
    convert_uv(p);
  }
  PHASE_SYNC(6)
  if (PHASE_ON(7)) {
    for (int u = blockIdx.x * 2 + hb; u < 2048; u += gridDim.x * 2) topk_unit(p, hsm, u);
  }
  PHASE_SYNC(7)
  if (PHASE_ON(8)) phase_gather(p);
}

extern "C" void kernel_launch(void* const* d_in, const int* in_sizes, int n_in, void* d_out, int out_size,
                              void* d_ws, size_t ws_size, hipStream_t stream) {
  Params p{};
  const float** fp = (const float**)&p;
  for (int i = 0; i < 23; ++i) fp[i] = (const float*)d_in[i];
  p.out = (float*)d_out;
  p.ws = (unsigned char*)d_ws;
  static int grid_blocks = 0;
  if (!grid_blocks) {
    int dev = 0, cus = 0, per_cu = 0;
    hipGetDevice(&dev);
    hipDeviceGetAttribute(&cus, hipDeviceAttributeMultiprocessorCount, dev);
    hipOccupancyMaxActiveBlocksPerMultiprocessor(&per_cu, fwd_kernel, NTHR, 0);
    if (per_cu < 1) per_cu = 1;
    if (per_cu > 1) per_cu = 1;
    grid_blocks = cus * per_cu;
  }
#if SINGLE_LAUNCH
  p.phase_lo = 0; p.phase_hi = 8; p.coop = 1;
  void* args[] = {&p};
  hipError_t e = hipLaunchCooperativeKernel((void*)fwd_kernel, dim3(grid_blocks), dim3(NTHR), args, 0, stream);
  if (e != hipSuccess) fprintf(stderr, "cooperative launch failed: %s (grid %d)\n", hipGetErrorString(e), grid_blocks);
#else
  for (int ph = 0; ph <= 8; ++ph) {
    p.phase_lo = ph; p.phase_hi = ph; p.coop = 0;
    hipLaunchKernelGGL(fwd_kernel, dim3(grid_blocks), dim3(NTHR), 0, stream, p);
  }
#endif
}
```

```cpp
#include <hip/hip_runtime.h>
#include <hip/hip_cooperative_groups.h>
#include <cstdio>
namespace cg = cooperative_groups;

#ifndef DBL_PHASE
#define DBL_PHASE -1
#endif
#ifndef SINGLE_LAUNCH
#define SINGLE_LAUNCH 1
#endif

typedef unsigned short bf16_t;
typedef short bf16x8 __attribute__((ext_vector_type(8)));
typedef float f32x4 __attribute__((ext_vector_type(4)));
typedef unsigned u32x4 __attribute__((ext_vector_type(4)));
typedef unsigned u32x2 __attribute__((ext_vector_type(2)));
typedef __bf16 bf2_t __attribute__((ext_vector_type(2)));

#define T_TOK 16384
#define DM 2048
#define LDP 4736
#define NPAD1 4864
#define NTHR 512
#define HTHR 256
#define SMEM_HALF 73728
#define SMEM_BYTES 147456
#define EPSV 1e-6f
#define MIB ((size_t)1 << 20)

#define OFF_XB (0 * MIB)
#define OFF_PROJ (64 * MIB)
#define OFF_X1B (64 * MIB)
#define OFF_Q (128 * MIB)
#define OFF_IDX (192 * MIB)
#define OFF_G (200 * MIB)
#define OFF_HLOC (212 * MIB)
#define OFF_CUMA (276 * MIB)
#define OFF_YPART (340 * MIB)
#define OFF_ST (372 * MIB)
#define OFF_WINT (436 * MIB)
#define OFF_WOUTT (455 * MIB)
#define OFF_WQT (463 * MIB)
#define OFF_WAT (471 * MIB)
#define OFF_WXT (471 * MIB + 131072)
#define OFF_KEYSB (471 * MIB + 262144)
#define OFF_RS1 (472 * MIB)
#define OFF_ACS (472 * MIB + 65536)
#define OFF_LCARRY (OFF_ACS + MIB)
#define OFF_SSQ (OFF_LCARRY + 524288)
#define OFF_SSQ2 (OFF_SSQ + MIB)
#define OFF_SCALES (OFF_SSQ2 + 2 * MIB)
#define OFF_XACT (0 * MIB)
#define OFF_BACT (32 * MIB)
#define OFF_BAR (487 * MIB)
#define OFF_CACT (478 * MIB)

struct Params {
  const float *x, *norm_mix_w, *w_in, *lru_conv_w, *lru_conv_b, *lru_wa, *lru_ba, *lru_wx, *lru_bx, *lru_lambda;
  const float *ssd_conv_w, *ssd_conv_b, *ssd_dt_bias, *ssd_a_log, *ssd_d, *ssd_norm_w, *w_out, *norm_ffn_w, *peer_wq;
  const float *peer_sub_keys, *peer_u, *peer_v, *norm_final_w;
  float* out;
  unsigned char* ws;
  int phase_lo, phase_hi, coop, pad0;
};

__device__ __forceinline__ unsigned pk2(float lo, float hi) {
  unsigned r;
  asm("v_cvt_pk_bf16_f32 %0, %1, %2" : "=v"(r) : "v"(lo), "v"(hi));
  return r;
}
__device__ __forceinline__ float bf2f(bf16_t v) { return __uint_as_float(((unsigned)v) << 16); }
__device__ __forceinline__ float bflo(unsigned u) { return __uint_as_float(u << 16); }
__device__ __forceinline__ float bfhi(unsigned u) { return __uint_as_float(u & 0xffff0000u); }
__device__ __forceinline__ float wave_sum(float v) {
#pragma unroll
  for (int o = 32; o > 0; o >>= 1) v += __shfl_xor(v, o);
  return v;
}
__device__ __forceinline__ float sigmoid_(float x) { return __builtin_amdgcn_rcpf(1.f + __expf(-x)); }
__device__ __forceinline__ float silu_(float x) { return x * sigmoid_(x); }
__device__ __forceinline__ float gelu_(float x) {
  float u = 0.7978845608028654f * (x + 0.044715f * x * x * x);
  return x * sigmoid_(2.f * u);
}
__device__ __forceinline__ float softplus_(float x) { return fmaxf(x, 0.f) + log1pf(__expf(-fabsf(x))); }
__device__ __forceinline__ f32x4 mfma16(bf16x8 a, bf16x8 b, f32x4 c) {
  return __builtin_amdgcn_mfma_f32_16x16x32_bf16(a, b, c, 0, 0, 0);
}
__device__ __forceinline__ bf16x8 as_frag(u32x4 v) { return __builtin_bit_cast(bf16x8, v); }
__device__ __forceinline__ int sw256(int row, int chunk) { return row * 256 + ((chunk ^ (row & 15)) << 4); }
__device__ __forceinline__ int sw128(int row, int chunk) { return row * 128 + ((chunk ^ ((row >> 1) & 7)) << 4); }

__device__ __forceinline__ float rs_from_ssq2(const float* ssq2, int row) {
  const f32x4* pp = (const f32x4*)(ssq2 + (size_t)row * 32);
  float s = 0.f;
#pragma unroll
  for (int i = 0; i < 8; ++i) { f32x4 v = pp[i]; s += v[0] + v[1] + v[2] + v[3]; }
  return rsqrtf(s * (1.f / 2048.f) + EPSV);
}
__device__ __forceinline__ float rs_from_ssq(const float* ssq, int row) {
  const f32x4* pp = (const f32x4*)(ssq + (size_t)row * 16);
  float s = 0.f;
#pragma unroll
  for (int i = 0; i < 4; ++i) { f32x4 v = pp[i]; s += v[0] + v[1] + v[2] + v[3]; }
  return rsqrtf(s * (1.f / 1024.f) + EPSV);
}

__device__ void transpose_tile(const float* __restrict__ src, int ld_src, int r0, int c0, int c_valid,
                               bf16_t* __restrict__ dst, int ld_dst, const float* __restrict__ scale, int scale_from,
                               float* tile, bool valid) {
  const int tid = threadIdx.x & 255;
  {
    const int j = tid & 63, i0 = tid >> 6;
#pragma unroll 4
    for (int ii = 0; ii < 16; ++ii) {
      const int i = i0 + 4 * ii;
      float v = 0.f;
      if (valid && c0 + j < c_valid) {
        v = src[(size_t)(r0 + i) * ld_src + c0 + j];
        if (scale != nullptr && (r0 + i) >= scale_from) v *= scale[r0 + i - scale_from];
      }
      tile[i * 65 + j] = v;
    }
  }
  __syncthreads();
  {
    const int i = tid & 63, j0 = tid >> 6;
#pragma unroll 4
    for (int jj = 0; jj < 16; ++jj) {
      const int j = j0 + 4 * jj;
      if (valid) dst[(size_t)(c0 + j) * ld_dst + r0 + i] = (bf16_t)(pk2(tile[i * 65 + j], 0.f) & 0xffffu);
    }
  }
  __syncthreads();
}

__device__ void phase_prep(const Params& p, unsigned char* smem) {
  const int tid = threadIdx.x, lane = tid & 63, wid = tid >> 6, hb = tid >> 8;
  unsigned char* ws = p.ws;
  bf16_t* xb = (bf16_t*)(ws + OFF_XB);
  float* rs1 = (float*)(ws + OFF_RS1);
  for (int t = blockIdx.x * 8 + wid; t < T_TOK; t += gridDim.x * 8) {
    const float* xr = p.x + (size_t)t * DM;
    bf16_t* xo = xb + (size_t)t * DM;
    float ss = 0.f;
#pragma unroll
    for (int c = 0; c < 8; ++c) {
      f32x4 v = *(const f32x4*)(xr + c * 256 + lane * 4);
      ss += v[0] * v[0] + v[1] * v[1] + v[2] * v[2] + v[3] * v[3];
      u32x2 o = {pk2(v[0], v[1]), pk2(v[2], v[3])};
      *(u32x2*)(xo + c * 256 + lane * 4) = o;
    }
    ss = wave_sum(ss);
    if (lane == 0) rs1[t] = rsqrtf(ss * (1.f / 2048.f) + EPSV);
  }
  float* tile = (float*)(smem + hb * SMEM_HALF);
  const int NT_WIN = 32 * 76, NT_SQ = 32 * 32;
  const int total = NT_WIN + 2 * NT_SQ + 32;
  for (int u0 = blockIdx.x * 2; u0 < total; u0 += gridDim.x * 2) {
    const bool valid = (u0 + hb) < total;
    const int u = valid ? (u0 + hb) : u0;
    if (u < NT_WIN) {
      const int ri = u & 31, cj = u >> 5;
      transpose_tile(p.w_in, 4624, ri * 64, cj * 64, 4624, (bf16_t*)(ws + OFF_WINT), 2048, p.norm_mix_w, 0, tile, valid);
    } else if (u < NT_WIN + NT_SQ) {
      const int v = u - NT_WIN, ri = v & 31, cj = v >> 5;
      transpose_tile(p.w_out, 2048, ri * 64, cj * 64, 2048, (bf16_t*)(ws + OFF_WOUTT), 2048, p.ssd_norm_w, 1024, tile, valid);
    } else if (u < NT_WIN + 2 * NT_SQ) {
      const int v = u - NT_WIN - NT_SQ, ri = v & 31, cj = v >> 5;
      transpose_tile(p.peer_wq, 2048, ri * 64, cj * 64, 2048, (bf16_t*)(ws + OFF_WQT), 2048, p.norm_ffn_w, 0, tile, valid);
    } else {
      const int v = u - NT_WIN - 2 * NT_SQ;
      const int h = v & 15;
      const float* src = (v < 16 ? p.lru_wa : p.lru_wx) + (size_t)h * 4096;
      bf16_t* dst = (bf16_t*)(ws + (v < 16 ? OFF_WAT : OFF_WXT)) + (size_t)h * 4096;
      transpose_tile(src, 64, 0, 0, 64, dst, 64, nullptr, 0, tile, valid);
    }
  }
  {
    bf16_t* kb = (bf16_t*)(ws + OFF_KEYSB);
    for (int i = blockIdx.x * NTHR + tid; i < 65536; i += gridDim.x * NTHR) {
      f32x4 v = *(const f32x4*)(p.peer_sub_keys + (size_t)i * 4);
      u32x2 o = {pk2(v[0], v[1]), pk2(v[2], v[3])};
      *(u32x2*)(kb + (size_t)i * 4) = o;
    }
  }
}

namespace pg8 {
#define PG8_LAS __attribute__((address_space(3)))
constexpr int BM = 256, BK = 64, HALF = 128, HTB = HALF * BK * 2;
__device__ __forceinline__ int lds_byte(int r, int c) { const int st = (r >> 4) * 2 + (c >> 5), rr = r & 15, cc = c & 31, ob = rr * 64 + cc * 2; return st * 1024 + (ob ^ (((ob >> 9) & 1) << 5)); }
__device__ __forceinline__ void stage_rc(int b, int& R, int& C) { const int st = b / 1024, sb = b % 1024, swz = sb ^ (((sb >> 9) & 1) << 5); R = (st >> 1) * 16 + swz / 64; C = (st & 1) * 32 + (swz % 64) / 2; }
struct Unit { int pm, pn; };
struct Gemm { const bf16_t* A; const bf16_t* Bt; int M, N, K; };
struct SimpleOrder {
  int nM, nwg, G, c;
  __device__ void init(int M, int N, int G_, int c_) { nM = M / BM; nwg = nM * (N / BM); G = G_; c = c_; }
  __device__ bool next(int i, Unit& u) const { const int L = i * G + c; if (L >= nwg) return false; u.pm = L % nM; u.pn = L / nM; return true; }
};
struct Epi1 {
  static constexpr bool MID = false;
  const float* rs1; bf16_t* proj;
  __device__ __forceinline__ void mid(f32x4 (&)[2][2][4][2], const Unit&, int, int) const {}
  __device__ __forceinline__ void operator()(const f32x4 (&acc)[2][2][4][2], const Unit& u, int wr, int wc, int fr, int fq) const {
    const int row0 = u.pm * BM + wr * 64 + fr, col0 = u.pn * BM + wc * 32 + 4 * fq;
#pragma unroll
    for (int ai = 0; ai < 2; ++ai)
#pragma unroll
      for (int m = 0; m < 4; ++m) {
        const int row = row0 + ai * HALF + m * 16;
        const float s = rs1[row];
#pragma unroll
        for (int bj = 0; bj < 2; ++bj)
#pragma unroll
          for (int n = 0; n < 2; ++n) {
            const int col = col0 + bj * HALF + n * 16;
            if (col < LDP) {
              f32x4 v = acc[ai][bj][m][n] * s;
              u32x2 o = {pk2(v[0], v[1]), pk2(v[2], v[3])};
              *(u32x2*)(proj + (size_t)row * LDP + col) = o;
            }
          }
      }
  }
};
struct Epi2 {
  static constexpr bool MID = true;
  const float* x; float* out; bf16_t* x1b; float* ssq2; const float* ssq;
  __device__ __forceinline__ void mid(f32x4 (&acc)[2][2][4][2], const Unit& u, int wr, int fr) const {
#pragma unroll
    for (int ai = 0; ai < 2; ++ai)
#pragma unroll
      for (int m = 0; m < 4; ++m) {
        const float s = rs_from_ssq(ssq, u.pm * BM + wr * 64 + fr + ai * HALF + m * 16);
#pragma unroll
        for (int bj = 0; bj < 2; ++bj)
#pragma unroll
          for (int n = 0; n < 2; ++n) acc[ai][bj][m][n] *= s;
        __builtin_amdgcn_sched_barrier(0);
      }
  }
  __device__ __forceinline__ void operator()(const f32x4 (&acc)[2][2][4][2], const Unit& u, int wr, int wc, int fr, int fq) const {
    const int row0 = u.pm * BM + wr * 64 + fr, col0 = u.pn * BM + wc * 32 + 4 * fq;
#pragma unroll
    for (int ai = 0; ai < 2; ++ai)
#pragma unroll
      for (int m = 0; m < 4; ++m) {
        const int row = row0 + ai * HALF + m * 16;
        float ss = 0.f;
#pragma unroll
        for (int bj = 0; bj < 2; ++bj)
#pragma unroll
          for (int n = 0; n < 2; ++n) {
            const int col = col0 + bj * HALF + n * 16;
            f32x4 xr = *(const f32x4*)(x + (size_t)row * DM + col);
            f32x4 v = acc[ai][bj][m][n] + xr;
            *(f32x4*)(out + (size_t)row * DM + col) = v;
            u32x2 o = {pk2(v[0], v[1]), pk2(v[2], v[3])};
            *(u32x2*)(x1b + (size_t)row * DM + col) = o;
            ss += v[0] * v[0] + v[1] * v[1] + v[2] * v[2] + v[3] * v[3];
          }
        ss += __shfl_xor(ss, 16);
        ss += __shfl_xor(ss, 32);
        if (fq == 0) ssq2[(size_t)row * 32 + u.pn * 4 + wc] = ss;
        __builtin_amdgcn_sched_barrier(0);
      }
  }
};
struct Epi3 {
  static constexpr bool MID = false;
  const float* ssq2; bf16_t* q;
  __device__ __forceinline__ void mid(f32x4 (&)[2][2][4][2], const Unit&, int, int) const {}
  __device__ __forceinline__ void operator()(const f32x4 (&acc)[2][2][4][2], const Unit& u, int wr, int wc, int fr, int fq) const {
    const int row0 = u.pm * BM + wr * 64 + fr, col0 = u.pn * BM + wc * 32 + 4 * fq;
#pragma unroll
    for (int ai = 0; ai < 2; ++ai)
#pragma unroll
      for (int m = 0; m < 4; ++m) {
        const int row = row0 + ai * HALF + m * 16;
        const float s = rs_from_ssq2(ssq2, row);
#pragma unroll
        for (int bj = 0; bj < 2; ++bj)
#pragma unroll
          for (int n = 0; n < 2; ++n) {
            const int col = col0 + bj * HALF + n * 16;
            f32x4 v = acc[ai][bj][m][n] * s;
            u32x2 o = {pk2(v[0], v[1]), pk2(v[2], v[3])};
            *(u32x2*)(q + (size_t)row * DM + col) = o;
          }
      }
  }
};

template <class Epi, class Sched, int KROT>
__device__ __forceinline__ void gemm_phase(PG8_LAS unsigned char* lds, const Gemm g, const Sched& S, const Epi& E) {
  const int tid = threadIdx.x, wid = __builtin_amdgcn_readfirstlane(tid >> 6), lane = tid & 63, wr = wid >> 2, wc = wid & 3, fr = lane & 15, fq = lane >> 4;
  const int K = g.K, nt = K / BK;
#define PG8_KX(t) (((t) + KROT) & 31)
  unsigned voff[2];
#pragma unroll
  for (int i = 0; i < 2; ++i) { int R, C; stage_rc(tid * 16 + i * 8192, R, C); voff[i] = (unsigned)(R * K + C) * 2u; }
  const size_t kstep = (size_t)(BK * 2);
  const size_t hstep = (size_t)HALF * K * 2;
  const size_t tstep = 2 * hstep;
  const unsigned ldsw = (unsigned)wid * 1024u;
  const int aoff = lds_byte(wr * 64 + fr, fq * 8), boff = lds_byte(wc * 32 + fr, fq * 8);
#define PG8_SA(b, h) (((b) * 2 + (h)) * HTB)
#define PG8_SB(b, h) ((4 + (b) * 2 + (h)) * HTB)
#define PG8_STAGE(bufoff, gbase) do { _Pragma("unroll") for (int _i = 0; _i < 2; ++_i) \
    __builtin_amdgcn_global_load_lds((const unsigned*)((const char*)(gbase) + voff[_i]), (PG8_LAS unsigned*)(lds + (bufoff) + ldsw + _i * 8192), 16, 0, 0); } while (0)
#define PG8_LDA(dst, b, h) do { _Pragma("unroll") for (int m = 0; m < 4; ++m) _Pragma("unroll") for (int k = 0; k < 2; ++k) dst[m][k] = *(const PG8_LAS bf16x8*)(lds + PG8_SA(b, h) + aoff + m * 2048 + k * 1024); } while (0)
#define PG8_LDB(dst, b, h) do { _Pragma("unroll") for (int n = 0; n < 2; ++n) _Pragma("unroll") for (int k = 0; k < 2; ++k) dst[n][k] = *(const PG8_LAS bf16x8*)(lds + PG8_SB(b, h) + boff + n * 2048 + k * 1024); } while (0)
#define PG8_MMA(ai, bj, At, Bt) do { __builtin_amdgcn_s_setprio(1); _Pragma("unroll") for (int m = 0; m < 4; ++m) _Pragma("unroll") for (int n = 0; n < 2; ++n) _Pragma("unroll") for (int k = 0; k < 2; ++k) \
    acc[ai][bj][m][n] = __builtin_amdgcn_mfma_f32_16x16x32_bf16(Bt[n][k], At[m][k], acc[ai][bj][m][n], 0, 0, 0); __builtin_amdgcn_s_setprio(0); } while (0)
#define PG8_WAIT_V(n) asm volatile("s_waitcnt vmcnt(" #n ")" ::: "memory")
#define PG8_WAIT_L(n) asm volatile("s_waitcnt lgkmcnt(" #n ")" ::: "memory")
#define PG8_BAR __builtin_amdgcn_s_barrier()
#define PG8_SCHED __builtin_amdgcn_sched_barrier(0)
  Unit cur, nxt; int ui = 0;
  if (!S.next(0, cur)) return;
  f32x4 acc[2][2][4][2];
#pragma unroll
  for (int a = 0; a < 2; ++a)
#pragma unroll
    for (int b = 0; b < 2; ++b)
#pragma unroll
      for (int m = 0; m < 4; ++m)
#pragma unroll
        for (int n = 0; n < 2; ++n) acc[a][b][m][n] = (f32x4){0.f, 0.f, 0.f, 0.f};
  bf16x8 At[4][2], B0[2][2], B1[2][2];
  const char* cA = (const char*)g.A + (size_t)cur.pm * tstep; const char* cB = (const char*)g.Bt + (size_t)cur.pn * tstep;
  { const char* a0 = cA + (size_t)PG8_KX(0) * kstep; const char* b0 = cB + (size_t)PG8_KX(0) * kstep;
    const char* a1 = cA + (size_t)PG8_KX(1) * kstep; const char* b1 = cB + (size_t)PG8_KX(1) * kstep;
    PG8_STAGE(PG8_SB(0, 0), b0); PG8_STAGE(PG8_SA(0, 0), a0); PG8_STAGE(PG8_SB(0, 1), b0 + hstep); PG8_STAGE(PG8_SA(0, 1), a0 + hstep);
    if (wr == 1) PG8_BAR;
    PG8_WAIT_V(4); PG8_BAR;
    PG8_STAGE(PG8_SB(1, 0), b1); PG8_STAGE(PG8_SA(1, 0), a1); PG8_STAGE(PG8_SB(1, 1), b1 + hstep);
    PG8_WAIT_V(6); PG8_BAR; }
  for (;;) {
    const bool has_next = S.next(ui + 1, nxt);
    const char* nA = has_next ? (const char*)g.A + (size_t)nxt.pm * tstep : cA; const char* nB = has_next ? (const char*)g.Bt + (size_t)nxt.pn * tstep : cB;
#define PG8_ITER(t) {\
      const bool last = (t == nt - 2);\
      const char* a1 = cA + (size_t)PG8_KX(t + 1) * kstep;\
      const char* a2 = last ? nA + (size_t)PG8_KX(0) * kstep : cA + (size_t)PG8_KX(t + 2) * kstep;\
      const char* b2 = last ? nB + (size_t)PG8_KX(0) * kstep : cB + (size_t)PG8_KX(t + 2) * kstep;\
      const char* a3 = last ? nA + (size_t)PG8_KX(1) * kstep : cA + (size_t)PG8_KX(t + 3) * kstep;\
      const char* b3 = last ? nB + (size_t)PG8_KX(1) * kstep : cB + (size_t)PG8_KX(t + 3) * kstep;\
      PG8_LDB(B0, 0, 0); PG8_SCHED; PG8_LDA(At, 0, 0); PG8_STAGE(PG8_SA(1, 1), a1 + hstep);\
      PG8_WAIT_L(8); PG8_BAR; PG8_WAIT_L(0); PG8_MMA(0, 0, At, B0); PG8_BAR; PG8_SCHED;\
      PG8_LDB(B1, 0, 1); PG8_STAGE(PG8_SB(0, 0), b2);\
      PG8_BAR; PG8_WAIT_L(0); PG8_MMA(0, 1, At, B1); PG8_BAR;\
      PG8_LDA(At, 0, 1); PG8_STAGE(PG8_SA(0, 0), a2);\
      PG8_BAR; PG8_WAIT_L(0); PG8_MMA(1, 0, At, B0); PG8_BAR; PG8_SCHED;\
      PG8_STAGE(PG8_SB(0, 1), b2 + hstep);\
      PG8_WAIT_V(6); PG8_BAR; PG8_MMA(1, 1, At, B1); PG8_BAR;\
      PG8_LDB(B0, 1, 0); PG8_SCHED; PG8_LDA(At, 1, 0); PG8_STAGE(PG8_SA(0, 1), a2 + hstep);\
      PG8_WAIT_L(8); PG8_BAR; PG8_WAIT_L(0); PG8_MMA(0, 0, At, B0); PG8_BAR; PG8_SCHED;\
      PG8_LDB(B1, 1, 1); PG8_STAGE(PG8_SB(1, 0), b3);\
      PG8_BAR; PG8_WAIT_L(0); PG8_MMA(0, 1, At, B1); PG8_BAR;\
      PG8_LDA(At, 1, 1); PG8_STAGE(PG8_SA(1, 0), a3);\
      PG8_BAR; PG8_WAIT_L(0); PG8_MMA(1, 0, At, B0); PG8_BAR; PG8_SCHED;\
      PG8_STAGE(PG8_SB(1, 1), b3 + hstep);\
      PG8_WAIT_V(6); PG8_BAR; PG8_MMA(1, 1, At, B1); PG8_BAR;\
}
    if (Epi::MID) {
      for (int t = 0; t < 16; t += 2) PG8_ITER(t)
      E.mid(acc, cur, wr, fr);
      for (int t = 16; t < nt; t += 2) PG8_ITER(t)
    } else {
      for (int t = 0; t < nt; t += 2) PG8_ITER(t)
    }
#undef PG8_ITER
    E(acc, cur, wr, wc, fr, fq);
    if (!has_next) break;
#pragma unroll
    for (int a = 0; a < 2; ++a)
#pragma unroll
      for (int b = 0; b < 2; ++b)
#pragma unroll
        for (int m = 0; m < 4; ++m)
#pragma unroll
          for (int n = 0; n < 2; ++n) acc[a][b][m][n] = (f32x4){0.f, 0.f, 0.f, 0.f};
    cur = nxt; cA = nA; cB = nB; ++ui;
  }
  PG8_WAIT_V(0);
  if (wr == 0) PG8_BAR;
  PG8_BAR;
#undef PG8_KX
#undef PG8_SA
#undef PG8_SB
#undef PG8_STAGE
#undef PG8_LDA
#undef PG8_LDB
#undef PG8_MMA
#undef PG8_WAIT_V
#undef PG8_WAIT_L
#undef PG8_BAR
#undef PG8_SCHED
}
}

__device__ __forceinline__ void conv8(const bf16_t* __restrict__ proj, int t, int tt_in_seq, int col,
                                      const float* __restrict__ cw, int ld_w, const float* __restrict__ cb, int ch,
                                      float* o) {
  f32x4 b0 = *(const f32x4*)(cb + ch), b1 = *(const f32x4*)(cb + ch + 4);
  o[0] = b0[0]; o[1] = b0[1]; o[2] = b0[2]; o[3] = b0[3];
  o[4] = b1[0]; o[5] = b1[1]; o[6] = b1[2]; o[7] = b1[3];
#pragma unroll
  for (int k = 0; k < 4; ++k) {
    if (tt_in_seq - 3 + k >= 0) {
      u32x4 v = *(const u32x4*)(proj + (size_t)(t - 3 + k) * LDP + col);
      f32x4 w0 = *(const f32x4*)(cw + k * ld_w + ch), w1 = *(const f32x4*)(cw + k * ld_w + ch + 4);
      o[0] += w0[0] * bflo(v[0]); o[1] += w0[1] * bfhi(v[0]);
      o[2] += w0[2] * bflo(v[1]); o[3] += w0[3] * bfhi(v[1]);
      o[4] += w1[0] * bflo(v[2]); o[5] += w1[1] * bfhi(v[2]);
      o[6] += w1[2] * bflo(v[3]); o[7] += w1[3] * bfhi(v[3]);
    }
  }
}
__device__ __forceinline__ void conv4(const bf16_t* __restrict__ proj, int t, int tt_in_seq, int col,
                                      const float* __restrict__ cw, int ld_w, const float* __restrict__ cb, int ch,
                                      float* o) {
  f32x4 b0 = *(const f32x4*)(cb + ch);
  o[0] = b0[0]; o[1] = b0[1]; o[2] = b0[2]; o[3] = b0[3];
#pragma unroll
  for (int k = 0; k < 4; ++k) {
    if (tt_in_seq - 3 + k >= 0) {
      u32x2 v = *(const u32x2*)(proj + (size_t)(t - 3 + k) * LDP + col);
      f32x4 w0 = *(const f32x4*)(cw + k * ld_w + ch);
      o[0] += w0[0] * bflo(v[0]); o[1] += w0[1] * bfhi(v[0]);
      o[2] += w0[2] * bflo(v[1]); o[3] += w0[3] * bfhi(v[1]);
    }
  }
}
__device__ __forceinline__ bf16x8 cfrag(const Params& p, const bf16_t* proj, int t, int tseq, int g, int n8) {
  const bf16_t* cact = (const bf16_t*)(p.ws + OFF_CACT);
  return as_frag(*(const u32x4*)(cact + (size_t)t * 256 + g * 128 + n8));
}
__device__ void conv_prepass(const Params& p) {
  unsigned char* ws = p.ws;
  const bf16_t* proj = (const bf16_t*)(ws + OFF_PROJ);
  bf16_t* xact = (bf16_t*)(ws + OFF_XACT);
  bf16_t* bact = (bf16_t*)(ws + OFF_BACT);
  bf16_t* cact = (bf16_t*)(ws + OFF_CACT);
  for (int i = blockIdx.x * NTHR + threadIdx.x; i < T_TOK * 192; i += gridDim.x * NTHR) {
    const int t = i / 192, ch = (i - t * 192) * 8;
    float o[8];
    conv8(proj, t, t & 2047, 3072 + ch, p.ssd_conv_w, 1536, p.ssd_conv_b, ch, o);
#pragma unroll
    for (int e = 0; e < 8; ++e) o[e] = silu_(o[e]);
    u32x4 r = {pk2(o[0], o[1]), pk2(o[2], o[3]), pk2(o[4], o[5]), pk2(o[6], o[7])};
    bf16_t* dst = ch < 1024 ? xact + (size_t)t * 1024 + ch : (ch < 1280 ? bact + (size_t)t * 256 + (ch - 1024) : cact + (size_t)t * 256 + (ch - 1280));
    *(u32x4*)dst = r;
  }
}

__device__ void lru_local_unit(const Params& p, unsigned char* smem, int unit) {
  const int tid = threadIdx.x & 255, lane = tid & 63, wid = tid >> 6, l15 = lane & 15, q4 = lane >> 4;
  const int hh = unit & 15, c = (unit >> 4) & 15, b = unit >> 8;
  const int t0 = b * 2048 + c * 128, ch0 = hh * 64;
  unsigned char* ws = p.ws;
  const bf16_t* proj = (const bf16_t*)(ws + OFF_PROJ);
  float* R1 = (float*)smem;
  float* R2 = (float*)(smem + 33536);
  float* R3 = (float*)(smem + 33536 + 32768);
#pragma unroll 11
  for (int e = tid; e < 131 * 64; e += HTHR) {
    const int r = e >> 6, j = e & 63, tt = r - 3;
    float v = 0.f;
    if (c * 128 + tt >= 0) v = bf2f(proj[(size_t)(t0 + tt) * LDP + ch0 + j]);
    R1[e] = v;
  }
  __syncthreads();
  {
    const int j = tid & 63;
    const float cb = p.lru_conv_b[ch0 + j];
    const float w0 = p.lru_conv_w[0 * 1024 + ch0 + j], w1 = p.lru_conv_w[1 * 1024 + ch0 + j],
                w2 = p.lru_conv_w[2 * 1024 + ch0 + j], w3 = p.lru_conv_w[3 * 1024 + ch0 + j];
#pragma unroll 8
    for (int tt = tid >> 6; tt < 128; tt += 4) {
      R2[tt * 64 + j] = cb + w0 * R1[tt * 64 + j] + w1 * R1[(tt + 1) * 64 + j] + w2 * R1[(tt + 2) * 64 + j] +
                        w3 * R1[(tt + 3) * 64 + j];
    }
  }
  __syncthreads();
  {
    const bf16_t* waT = (const bf16_t*)(ws + OFF_WAT) + (size_t)hh * 4096;
    const bf16_t* wxT = (const bf16_t*)(ws + OFF_WXT) + (size_t)hh * 4096;
    f32x4 aa[2][4], ax[2][4];
#pragma unroll
    for (int i = 0; i < 2; ++i)
#pragma unroll
      for (int j = 0; j < 4; ++j) { aa[i][j] = (f32x4){0, 0, 0, 0}; ax[i][j] = (f32x4){0, 0, 0, 0}; }
#pragma unroll
    for (int ks = 0; ks < 2; ++ks) {
      bf16x8 af[2];
#pragma unroll
      for (int mi = 0; mi < 2; ++mi) {
        const float* src = R2 + (wid * 32 + mi * 16 + l15) * 64 + ks * 32 + q4 * 8;
        f32x4 v0 = *(const f32x4*)src, v1 = *(const f32x4*)(src + 4);
        u32x4 r = {pk2(v0[0], v0[1]), pk2(v0[2], v0[3]), pk2(v1[0], v1[1]), pk2(v1[2], v1[3])};
        af[mi] = as_frag(r);
      }
#pragma unroll
      for (int ni = 0; ni < 4; ++ni) {
        const size_t wo = (size_t)(ni * 16 + l15) * 64 + ks * 32 + q4 * 8;
        bf16x8 ba = as_frag(*(const u32x4*)(waT + wo));
        bf16x8 bx = as_frag(*(const u32x4*)(wxT + wo));
#pragma unroll
        for (int mi = 0; mi < 2; ++mi) {
          aa[mi][ni] = mfma16(af[mi], ba, aa[mi][ni]);
          ax[mi][ni] = mfma16(af[mi], bx, ax[mi][ni]);
        }
      }
    }
#pragma unroll
    for (int ni = 0; ni < 4; ++ni) {
      const int j = ni * 16 + l15;
      const float ba = p.lru_ba[ch0 + j], bx = p.lru_bx[ch0 + j];
      const float lam = p.lru_lambda[ch0 + j];
      const float spl = -8.f * log1pf(__expf(-lam));
#pragma unroll
      for (int mi = 0; mi < 2; ++mi)
#pragma unroll
        for (int r = 0; r < 4; ++r) {
          const int tt = wid * 32 + mi * 16 + q4 * 4 + r;
          const float rg = sigmoid_(aa[mi][ni][r] + ba);
          const float ig = sigmoid_(ax[mi][ni][r] + bx);
          const float log_a = spl * rg;
          const float av = __expf(log_a);
          const float xl = R2[tt * 64 + j];
          const float y2 = 2.f * log_a;
          const float poly = -y2 * (1.f + y2 * (0.5f + y2 * (0.16666667f + y2 * (0.041666668f + y2 * (0.0083333338f + y2 * 0.0013888889f)))));
          const float em = (y2 > -0.25f) ? poly : (1.f - av * av);
          const float bv = __builtin_amdgcn_sqrtf(fmaxf(em, 0.f)) * (ig * xl);
          R1[tt * 64 + j] = av;
          R2[tt * 64 + j] = bv;
        }
    }
  }
  __syncthreads();
  {
    const int j = tid & 63, seg = tid >> 6;
    float h = 0.f, Ac = 1.f;
#pragma unroll 4
    for (int s = 0; s < 32; ++s) {
      const int tt = seg * 32 + s;
      const float a = R1[tt * 64 + j], bb = R2[tt * 64 + j];
      h = a * h + bb;
      Ac *= a;
      R2[tt * 64 + j] = h;
      R1[tt * 64 + j] = Ac;
    }
    R3[seg * 64 + j] = h;
    R3[256 + seg * 64 + j] = Ac;
    __syncthreads();
    float cin = 0.f, Ain = 1.f;
    for (int s2 = 0; s2 < seg; ++s2) {
      cin = R3[256 + s2 * 64 + j] * cin + R3[s2 * 64 + j];
      Ain *= R3[256 + s2 * 64 + j];
    }
    float* hloc = (float*)(ws + OFF_HLOC);
    float* cumA = (float*)(ws + OFF_CUMA);
#pragma unroll 4
    for (int s = 0; s < 32; ++s) {
      const int tt = seg * 32 + s;
      const float hl = R2[tt * 64 + j] + R1[tt * 64 + j] * cin;
      const float Al = R1[tt * 64 + j] * Ain;
      hloc[(size_t)(t0 + tt) * 1024 + ch0 + j] = hl;
      cumA[(size_t)(t0 + tt) * 1024 + ch0 + j] = Al;
    }
  }
  __syncthreads();
}

__device__ void ssd_local_unit(const Params& p, unsigned char* smem, int unit) {
  const int tid = threadIdx.x & 255, lane = tid & 63, wid = tid >> 6, l15 = lane & 15, q4 = lane >> 4;
  const int hh = unit & 15, c = (unit >> 4) & 15, b = unit >> 8, g = hh >> 3;
  const int t0 = b * 2048 + c * 128, ts0 = c * 128;
  unsigned char* ws = p.ws;
  const bf16_t* proj = (const bf16_t*)(ws + OFF_PROJ);
  unsigned char* Bm = smem;
  unsigned char* XT = smem + 32768;
  unsigned char* Pw = smem + 49152 + wid * 4096;
  float* dts = (float*)(smem + 65536);
  float* acs = dts + 128;
  float* adt = acs + 128;
  if (tid < 128) {
    const float raw = bf2f(proj[(size_t)(t0 + tid) * LDP + 4608 + hh]);
    const float dtv = softplus_(raw + p.ssd_dt_bias[hh]);
    dts[tid] = dtv;
    adt[tid] = -__expf(p.ssd_a_log[hh]) * dtv;
  }
  __syncthreads();
  if (tid < 128) {
    float s = 0.f;
    for (int k = 0; k <= tid; ++k) s += adt[k];
    acs[tid] = s;
    ((float*)(ws + OFF_ACS))[(size_t)(t0 + tid) * 16 + hh] = s;
  }
  {
    const bf16_t* bact = (const bf16_t*)(ws + OFF_BACT);
    const int chunk = tid & 15;
#pragma unroll
    for (int i = 0; i < 8; ++i) {
      const int tt = (tid >> 4) + 16 * i;
      *(u32x4*)(Bm + sw256(tt, chunk)) = *(const u32x4*)(bact + (size_t)(t0 + tt) * 256 + g * 128 + chunk * 8);
    }
  }
  __syncthreads();
  const bf16_t* xact = (const bf16_t*)(ws + OFF_XACT);
  {
    const int pp = tid & 63;
    const int ch = hh * 64 + pp;
#pragma unroll
    for (int i = 0; i < 4; ++i) {
      const int chunk = (tid >> 6) * 4 + i;
      const int tt0 = chunk * 8;
      float o[8];
#pragma unroll
      for (int e = 0; e < 8; ++e) o[e] = bf2f(xact[(size_t)(t0 + tt0 + e) * 1024 + ch]) * dts[tt0 + e];
      u32x4 r = {pk2(o[0], o[1]), pk2(o[2], o[3]), pk2(o[4], o[5]), pk2(o[6], o[7])};
      *(u32x4*)(XT + sw256(pp, chunk)) = r;
    }
  }
  __syncthreads();
  bf16_t* ypart = (bf16_t*)(ws + OFF_YPART);
  const float Dh = p.ssd_d[hh];
#pragma unroll 1
  for (int mt = 0; mt < 2; ++mt) {
    const int M = wid * 2 + mt;
    const int lrow = M * 16 + l15;
    bf16x8 cf[4];
#pragma unroll
    for (int ks = 0; ks < 4; ++ks) cf[ks] = cfrag(p, proj, t0 + lrow, ts0 + lrow, g, ks * 32 + q4 * 8);
    const float acl = acs[lrow];
    const int ntmax = M | 1;
#pragma unroll 1
    for (int nt = 0; nt <= ntmax; ++nt) {
      f32x4 a4 = (f32x4){0, 0, 0, 0};
      if (nt <= M) {
#pragma unroll
        for (int ks = 0; ks < 4; ++ks) {
          bf16x8 bfr = *(const bf16x8*)(Bm + sw256(nt * 16 + l15, ks * 4 + q4));
          a4 = mfma16(bfr, cf[ks], a4);
        }
      }
      float pv[4];
#pragma unroll
      for (int r = 0; r < 4; ++r) {
        const int s = nt * 16 + q4 * 4 + r;
        pv[r] = (s <= lrow) ? a4[r] * __expf(acl - acs[s]) : 0.f;
      }
      u32x2 o = {pk2(pv[0], pv[1]), pk2(pv[2], pv[3])};
      const int chunk = nt * 2 + (q4 >> 1);
      *(u32x2*)(Pw + sw256(l15, chunk) + (q4 & 1) * 8) = o;
    }
    f32x4 ya[4];
#pragma unroll
    for (int pt = 0; pt < 4; ++pt) ya[pt] = (f32x4){0, 0, 0, 0};
    const int ksmax = M >> 1;
#pragma unroll 1
    for (int ks = 0; ks <= ksmax; ++ks) {
      bf16x8 pf = *(const bf16x8*)(Pw + sw256(l15, ks * 4 + q4));
#pragma unroll
      for (int pt = 0; pt < 4; ++pt) {
        bf16x8 xf = *(const bf16x8*)(XT + sw256(pt * 16 + l15, ks * 4 + q4));
        ya[pt] = mfma16(xf, pf, ya[pt]);
      }
    }
#pragma unroll
    for (int pt = 0; pt < 4; ++pt) {
      const int pc = pt * 16 + q4 * 4;
      const int ch = hh * 64 + pc;
      const u32x2 xv = *(const u32x2*)(xact + (size_t)(t0 + lrow) * 1024 + ch);
      float y0 = ya[pt][0] + Dh * bflo(xv[0]), y1 = ya[pt][1] + Dh * bfhi(xv[0]);
      float y2 = ya[pt][2] + Dh * bflo(xv[1]), y3 = ya[pt][3] + Dh * bfhi(xv[1]);
      u32x2 o = {pk2(y0, y1), pk2(y2, y3)};
      *(u32x2*)(ypart + (size_t)(t0 + lrow) * 1024 + ch) = o;
    }
  }
  {
    f32x4 sa[2][4];
#pragma unroll
    for (int i = 0; i < 2; ++i)
#pragma unroll
      for (int j = 0; j < 4; ++j) sa[i][j] = (f32x4){0, 0, 0, 0};
    const float aend = acs[127];
#pragma unroll 1
    for (int ks = 0; ks < 4; ++ks) {
      float dec[8];
#pragma unroll
      for (int e = 0; e < 8; ++e) dec[e] = __expf(aend - acs[ks * 32 + q4 * 8 + e]);
      bf16x8 bd[2];
#pragma unroll
      for (int ni = 0; ni < 2; ++ni) {
        const int n = wid * 32 + ni * 16 + l15;
        float v[8];
#pragma unroll
        for (int e = 0; e < 8; ++e) {
          const int l = ks * 32 + q4 * 8 + e;
          const bf16_t raw = *(const bf16_t*)(Bm + sw256(l, n >> 3) + (n & 7) * 2);
          v[e] = bf2f(raw) * dec[e];
        }
        u32x4 r = {pk2(v[0], v[1]), pk2(v[2], v[3]), pk2(v[4], v[5]), pk2(v[6], v[7])};
        bd[ni] = as_frag(r);
      }
#pragma unroll
      for (int pt = 0; pt < 4; ++pt) {
        bf16x8 xf = *(const bf16x8*)(XT + sw256(pt * 16 + l15, ks * 4 + q4));
#pragma unroll
        for (int ni = 0; ni < 2; ++ni) sa[ni][pt] = mfma16(bd[ni], xf, sa[ni][pt]);
      }
    }
    float* St = (float*)(ws + OFF_ST) + (size_t)((b * 16 + c) * 16 + hh) * 8192;
#pragma unroll
    for (int ni = 0; ni < 2; ++ni)
#pragma unroll
      for (int pt = 0; pt < 4; ++pt) {
        const int pr = pt * 16 + l15, n = wid * 32 + ni * 16 + q4 * 4;
        *(f32x4*)(St + pr * 128 + n) = sa[ni][pt];
      }
  }
  __syncthreads();
}

__device__ void phase_carry(const Params& p) {
  unsigned char* ws = p.ws;
  const int gt = blockIdx.x * NTHR + threadIdx.x, ng = gridDim.x * NTHR;
  const float* hloc = (const float*)(ws + OFF_HLOC);
  const float* cumA = (const float*)(ws + OFF_CUMA);
  float* lcarry = (float*)(ws + OFF_LCARRY);
  for (int i = gt; i < 8192; i += ng) {
    const int b = i >> 10, ch = i & 1023;
    float ca[16], hl[16];
#pragma unroll
    for (int c = 0; c < 16; ++c) {
      const size_t tl = (size_t)(b * 2048 + c * 128 + 127) * 1024 + ch;
      ca[c] = cumA[tl];
      hl[c] = hloc[tl];
    }
    float carry = 0.f;
#pragma unroll
    for (int c = 0; c < 16; ++c) {
      lcarry[(size_t)(b * 16 + c) * 1024 + ch] = carry;
      carry = ca[c] * carry + hl[c];
    }
  }
  const float* acsG = (const float*)(ws + OFF_ACS);
  float* St = (float*)(ws + OFF_ST);
  for (int i = gt; i < 128 * 2048; i += ng) {
    const int bh = i >> 11, e4 = i & 2047, b = bh >> 4, hh = bh & 15;
    f32x4 tmp[16];
    float Ad[16];
#pragma unroll
    for (int c = 0; c < 16; ++c) {
      Ad[c] = __expf(acsG[(size_t)(b * 2048 + c * 128 + 127) * 16 + hh]);
      tmp[c] = *(const f32x4*)(St + (size_t)((b * 16 + c) * 16 + hh) * 8192 + e4 * 4);
    }
    f32x4 s = (f32x4){0, 0, 0, 0};
#pragma unroll
    for (int c = 0; c < 16; ++c) {
      *(f32x4*)(St + (size_t)((b * 16 + c) * 16 + hh) * 8192 + e4 * 4) = s;
      s = s * Ad[c] + tmp[c];
    }
  }
}

__device__ void ssd_final_unit(const Params& p, int unit) {
  const int tid = threadIdx.x & 255, lane = tid & 63, wid = tid >> 6, l15 = lane & 15, q4 = lane >> 4;
  const int hh = unit & 15, c = (unit >> 4) & 15, b = unit >> 8, g = hh >> 3;
  const int t0 = b * 2048 + c * 128, ts0 = c * 128;
  unsigned char* ws = p.ws;
  const bf16_t* proj = (const bf16_t*)(ws + OFF_PROJ);
  const float* Sin = (const float*)(ws + OFF_ST) + (size_t)((b * 16 + c) * 16 + hh) * 8192;
  const bf16_t* ypart = (const bf16_t*)(ws + OFF_YPART);
  const float* acsG = (const float*)(ws + OFF_ACS);
  bf16_t* A2 = (bf16_t*)(ws + OFF_XB);
  float* ssq = (float*)(ws + OFF_SSQ);
#pragma unroll 1
  for (int mt = 0; mt < 2; ++mt) {
    const int lrow = (wid * 2 + mt) * 16 + l15;
    f32x4 ya[4];
#pragma unroll
    for (int pt = 0; pt < 4; ++pt) ya[pt] = (f32x4){0, 0, 0, 0};
    if (c > 0) {
#pragma unroll 2
      for (int ks = 0; ks < 4; ++ks) {
        bf16x8 cf = cfrag(p, proj, t0 + lrow, ts0 + lrow, g, ks * 32 + q4 * 8);
#pragma unroll
        for (int pt = 0; pt < 4; ++pt) {
          const float* sp = Sin + (pt * 16 + l15) * 128 + ks * 32 + q4 * 8;
          f32x4 v0 = *(const f32x4*)sp, v1 = *(const f32x4*)(sp + 4);
          u32x4 r = {pk2(v0[0], v0[1]), pk2(v0[2], v0[3]), pk2(v1[0], v1[1]), pk2(v1[2], v1[3])};
          ya[pt] = mfma16(as_frag(r), cf, ya[pt]);
        }
      }
    }
    const size_t t = (size_t)(t0 + lrow);
    const float ea = __expf(acsG[t * 16 + hh]);
    float ss = 0.f;
#pragma unroll
    for (int pt = 0; pt < 4; ++pt) {
      const int ch = hh * 64 + pt * 16 + q4 * 4;
      u32x2 yp = *(const u32x2*)(ypart + t * 1024 + ch);
      u32x2 zz = *(const u32x2*)(proj + t * LDP + 2048 + ch);
      float y[4] = {bflo(yp[0]) + ea * ya[pt][0], bfhi(yp[0]) + ea * ya[pt][1], bflo(yp[1]) + ea * ya[pt][2],
                    bfhi(yp[1]) + ea * ya[pt][3]};
      float z[4] = {bflo(zz[0]), bfhi(zz[0]), bflo(zz[1]), bfhi(zz[1])};
#pragma unroll
      for (int r = 0; r < 4; ++r) { y[r] = y[r] * silu_(z[r]); ss += y[r] * y[r]; }
      u32x2 o = {pk2(y[0], y[1]), pk2(y[2], y[3])};
      *(u32x2*)(A2 + t * DM + 1024 + ch) = o;
    }
    ss += __shfl_xor(ss, 16);
    ss += __shfl_xor(ss, 32);
    if (q4 == 0) ssq[t * 16 + hh] = ss;
  }
}

__device__ void phase_mix_final(const Params& p) {
  unsigned char* ws = p.ws;
  const bf16_t* proj = (const bf16_t*)(ws + OFF_PROJ);
  const f32x4* hloc = (const f32x4*)(ws + OFF_HLOC);
  const f32x4* cumA = (const f32x4*)(ws + OFF_CUMA);
  const float* lcarry = (const float*)(ws + OFF_LCARRY);
  bf16_t* A2 = (bf16_t*)(ws + OFF_XB);
  for (int u = blockIdx.x * 2 + (threadIdx.x >> 8); u < 2048; u += gridDim.x * 2) ssd_final_unit(p, u);
#pragma unroll 4
  for (int i = blockIdx.x * NTHR + threadIdx.x; i < T_TOK * 256; i += gridDim.x * NTHR) {
    const int t = i >> 8, ch = (i & 255) * 4;
    f32x4 h = hloc[i], ca = cumA[i];
    f32x4 cr = *(const f32x4*)(lcarry + (size_t)(t >> 7) * 1024 + ch);
    u32x2 gg = *(const u32x2*)(proj + (size_t)t * LDP + 1024 + ch);
    float y0 = (h[0] + ca[0] * cr[0]) * gelu_(bflo(gg[0]));
    float y1 = (h[1] + ca[1] * cr[1]) * gelu_(bfhi(gg[0]));
    float y2 = (h[2] + ca[2] * cr[2]) * gelu_(bflo(gg[1]));
    float y3 = (h[3] + ca[3] * cr[3]) * gelu_(bfhi(gg[1]));
    u32x2 o = {pk2(y0, y1), pk2(y2, y3)};
    *(u32x2*)(A2 + (size_t)t * DM + ch) = o;
  }
}

__device__ void convert_uv(const Params& p) {
  unsigned char* ws = p.ws;
  const int lane = threadIdx.x & 63, wid = threadIdx.x >> 6;
  unsigned char* tb = ws + OFF_XB;
  float* scales = (float*)(ws + OFF_SCALES);
  for (int row = blockIdx.x * 8 + wid; row < 32768; row += gridDim.x * 8) {
    const bool isv = row >= 16384;
    const int e = row & 16383;
    const float* src = (isv ? p.peer_v : p.peer_u) + (size_t)e * DM + lane * 32;
    float vals[32];
    float ss = 0.f;
#pragma unroll
    for (int q = 0; q < 8; ++q) {
      f32x4 t = *(const f32x4*)(src + q * 4);
      if (!isv) t *= *(const f32x4*)(p.norm_ffn_w + lane * 32 + q * 4);
#pragma unroll
      for (int k = 0; k < 4; ++k) {
        vals[q * 4 + k] = t[k];
        ss += t[k] * t[k];
      }
    }
    ss = wave_sum(ss);
    const float rms = sqrtf(ss * (1.f / 2048.f));
    const float sc = rms * (2.6f / 7.f);
    const float inv = sc > 0.f ? 1.f / sc : 0.f;
    u32x4 o;
#pragma unroll
    for (int m = 0; m < 4; ++m) {
      unsigned w = 0;
#pragma unroll
      for (int j = 0; j < 4; ++j) {
        const float lo = fminf(fmaxf(rintf(vals[m * 8 + j] * inv), -7.f), 7.f);
        const float hi = fminf(fmaxf(rintf(vals[m * 8 + 4 + j] * inv), -7.f), 7.f);
        const unsigned bl = (unsigned)((int)lo + 8), bh = (unsigned)((int)hi + 8);
        w |= (bl | (bh << 4)) << (8 * j);
      }
      o[m] = w;
    }
    *(u32x4*)(tb + (size_t)row * 1024 + lane * 16) = o;
    if (lane == 0) scales[row] = sc;
  }
}

__device__ const unsigned char cand_tab[64] = {
    0x00, 0x01, 0x02, 0x03, 0x04, 0x05, 0x06, 0x07, 0x08, 0x09, 0x0a, 0x0b, 0x0c, 0x0d, 0x0e, 0x0f,
    0x10, 0x11, 0x12, 0x13, 0x14, 0x15, 0x16, 0x17,
    0x20, 0x21, 0x22, 0x23, 0x24,
    0x30, 0x31, 0x32, 0x33,
    0x40, 0x41, 0x42,
    0x50, 0x51, 0x60, 0x61, 0x70, 0x71,
    0x80, 0x90, 0xa0, 0xb0, 0xc0, 0xd0, 0xe0, 0xf0,
    0xff, 0xff, 0xff, 0xff, 0xff, 0xff, 0xff, 0xff, 0xff, 0xff, 0xff, 0xff, 0xff, 0xff};

__device__ __forceinline__ unsigned ord_key(float f) {
  unsigned u = __float_as_uint(f);
  return u ^ ((u >> 31) ? 0xffffffffu : 0x80000000u);
}
__device__ __forceinline__ float ord_dec(unsigned k) {
  unsigned u = (k >> 31) ? (k ^ 0x80000000u) : ~k;
  return __uint_as_float(u);
}

__device__ void topk_unit(const Params& p, unsigned char* smem, int unit) {
  const int tid = threadIdx.x & 255, lane = tid & 63, wid = tid >> 6, l15 = lane & 15, q4 = lane >> 4;
  const int h = unit & 7, tile = unit >> 3;
  const int tok0 = tile * 64 + wid * 16;
  unsigned char* ws = p.ws;
  const bf16_t* qg = (const bf16_t*)(ws + OFF_Q);
  const bf16_t* kb = (const bf16_t*)(ws + OFF_KEYSB);
  unsigned* S = (unsigned*)(smem + wid * 16640);
  float* tops = (float*)(smem + 4 * 16640 + wid * 256);
  int* topi = (int*)(tops + 32);
  unsigned* Ms = (unsigned*)(smem + 67584 + wid * 768);
#pragma unroll
  for (int k = 0; k < 2; ++k) {
    f32x4 sc[8];
#pragma unroll
    for (int i = 0; i < 8; ++i) sc[i] = (f32x4){0, 0, 0, 0};
#pragma unroll
    for (int ks = 0; ks < 4; ++ks) {
      bf16x8 qf = as_frag(*(const u32x4*)(qg + (size_t)(tok0 + l15) * DM + h * 256 + k * 128 + ks * 32 + q4 * 8));
#pragma unroll
      for (int nt = 0; nt < 8; ++nt) {
        bf16x8 kf = as_frag(*(const u32x4*)(kb + (size_t)((h * 2 + k) * 128 + nt * 16 + l15) * 128 + ks * 32 + q4 * 8));
        sc[nt] = mfma16(kf, qf, sc[nt]);
      }
    }
#pragma unroll
    for (int nt = 0; nt < 8; ++nt) {
      const int n = nt * 16 + q4 * 4;
      u32x4 kk;
#pragma unroll
      for (int r = 0; r < 4; ++r) kk[r] = (ord_key(sc[nt][r]) & ~127u) | (unsigned)(127 - (n + r));
      *(u32x4*)(S + l15 * 260 + k * 128 + n) = kk;
    }
  }
  const unsigned ct = cand_tab[lane];
  const int ca = ct >> 4, cbb = ct & 15;
  int* idxo = (int*)(ws + OFF_IDX);
  float* go = (float*)(ws + OFF_G);
  for (int tk = 0; tk < 16; ++tk) {
    const unsigned* row = S + tk * 260;
    unsigned ka[2], kb[2], mxk[2];
#pragma unroll
    for (int hf = 0; hf < 2; ++hf) {
      ka[hf] = row[hf * 128 + lane];
      kb[hf] = row[hf * 128 + 64 + lane];
      mxk[hf] = ka[hf] > kb[hf] ? ka[hf] : kb[hf];
      Ms[hf * 96 + lane] = mxk[hf];
    }
    int cnt[2][4];
#pragma unroll
    for (int hf = 0; hf < 2; ++hf)
#pragma unroll
      for (int e = 0; e < 4; ++e) cnt[hf][e] = 0;
#pragma unroll
    for (int j = 0; j < 16; ++j)
#pragma unroll
      for (int hf = 0; hf < 2; ++hf) {
        u32x4 x = *(const u32x4*)(Ms + hf * 96 + j * 4);
#pragma unroll
        for (int e = 0; e < 4; ++e) cnt[hf][e] += (x[e] > mxk[hf]) ? 1 : 0;
      }
    bool ca_[2], cb_[2];
    int pa[2], pb[2], ncand[2];
    const unsigned long long lt = (1ull << lane) - 1ull;
#pragma unroll
    for (int hf = 0; hf < 2; ++hf) {
      const int c_ = cnt[hf][0] + cnt[hf][1] + cnt[hf][2] + cnt[hf][3];
      const unsigned long long bm = __ballot(c_ == 15);
      const int srcT = __ffsll((long long)bm) - 1;
      const unsigned T0 = (unsigned)__shfl((int)mxk[hf], srcT);
      ca_[hf] = ka[hf] >= T0;
      cb_[hf] = kb[hf] >= T0;
      const unsigned long long ba = __ballot(ca_[hf]), bb = __ballot(cb_[hf]);
      const int na = __popcll(ba);
      pa[hf] = __popcll(ba & lt);
      pb[hf] = na + __popcll(bb & lt);
      ncand[hf] = na + __popcll(bb);
    }
#pragma unroll
    for (int hf = 0; hf < 2; ++hf) {
      unsigned* Cs = Ms + hf * 96 + 64;
      if (lane < 32) Cs[lane] = 0u;
      if (ca_[hf]) Cs[pa[hf]] = ka[hf];
      if (cb_[hf]) Cs[pb[hf]] = kb[hf];
    }
    unsigned my[2];
    int rk2[2][4];
#pragma unroll
    for (int hf = 0; hf < 2; ++hf) {
      my[hf] = Ms[hf * 96 + 64 + (lane & 31)];
#pragma unroll
      for (int e = 0; e < 4; ++e) rk2[hf][e] = 0;
    }
#pragma unroll
    for (int j = 0; j < 8; ++j)
#pragma unroll
      for (int hf = 0; hf < 2; ++hf) {
        u32x4 x = *(const u32x4*)(Ms + hf * 96 + 64 + j * 4);
#pragma unroll
        for (int e = 0; e < 4; ++e) rk2[hf][e] += (x[e] > my[hf]) ? 1 : 0;
      }
#pragma unroll
    for (int hf = 0; hf < 2; ++hf) {
      const int r_ = rk2[hf][0] + rk2[hf][1] + rk2[hf][2] + rk2[hf][3];
      if (lane < ncand[hf] && r_ < 16) {
        tops[hf * 16 + r_] = ord_dec(my[hf] & ~127u);
        topi[hf * 16 + r_] = 127 - (int)(my[hf] & 127u);
      }
    }
    float cs = 0.f;
    unsigned ck = 0u;
    if (lane < 50) {
      cs = tops[ca] + tops[16 + cbb];
      ck = (ord_key(cs) & ~255u) | (unsigned)(255 - (ca * 16 + cbb));
    }
    int rkA = 0, rkB = 0;
#pragma unroll
    for (int j = 0; j < 50; j += 2) {
      const unsigned oj = (unsigned)__builtin_amdgcn_readlane((int)ck, j);
      const unsigned oj2 = (unsigned)__builtin_amdgcn_readlane((int)ck, j + 1);
      rkA += (oj > ck) ? 1 : 0;
      rkB += (oj2 > ck) ? 1 : 0;
    }
    const int rk = rkA + rkB;
    const float mx = tops[0] + tops[16];
    const bool sel = (lane < 50) && (rk < 16);
    const float ev = sel ? __expf(cs - mx) : 0.f;
    const float sum = wave_sum(ev);
    if (sel) {
      const size_t o = (size_t)(tok0 + tk) * 128 + h * 16 + rk;
      idxo[o] = topi[ca] * 128 + topi[16 + cbb];
      go[o] = ev * __builtin_amdgcn_rcpf(sum);
    }
  }
}

__device__ __forceinline__ float ub0(unsigned w) { return (float)(w & 0xffu); }
__device__ __forceinline__ float ub1(unsigned w) { return (float)((w >> 8) & 0xffu); }
__device__ __forceinline__ float ub2(unsigned w) { return (float)((w >> 16) & 0xffu); }
__device__ __forceinline__ float ub3(unsigned w) { return (float)(w >> 24); }

#define GROWS 8
#ifndef USE_SDOT4
#define USE_SDOT4 1
#endif
typedef float f32x2 __attribute__((ext_vector_type(2)));
__device__ void phase_gather(const Params& p) {
  const int tid = threadIdx.x, lane = tid & 63, wid = tid >> 6;
  unsigned char* ws = p.ws;
  const unsigned char* ub = ws + OFF_XB;
  const unsigned char* vb = ws + OFF_XB + 16 * MIB;
  const float* scales = (const float*)(ws + OFF_SCALES);
  const int* idxg = (const int*)(ws + OFF_IDX);
  const float* gg = (const float*)(ws + OFF_G);
  const float* ssq2 = (const float*)(ws + OFF_SSQ2);
  const bool b5 = (lane & 32) != 0, b4 = (lane & 16) != 0, b3 = (lane & 8) != 0;
  const int srcl = ((lane & 1) << 3) | (((lane >> 1) & 1) << 4) | (((lane >> 2) & 1) << 5);
  for (int t = blockIdx.x * 8 + wid; t < T_TOK; t += gridDim.x * 8) {
    const int id0 = idxg[(size_t)t * 128 + lane], id1 = idxg[(size_t)t * 128 + 64 + lane];
    const float g0 = gg[(size_t)t * 128 + lane], g1 = gg[(size_t)t * 128 + 64 + lane];
    const float su0 = scales[id0], su1 = scales[id1], sv0 = scales[16384 + id0], sv1 = scales[16384 + id1];
    float* orow = p.out + (size_t)t * DM + lane * 32;
    int xlo[4], xhi[4];
    float sx;
    int sumq;
    {
      float xr[32];
      float amax = 0.f;
#pragma unroll
      for (int q = 0; q < 8; ++q) {
        f32x4 v = *(const f32x4*)(orow + q * 4);
#pragma unroll
        for (int k = 0; k < 4; ++k) { xr[q * 4 + k] = v[k]; amax = fmaxf(amax, fabsf(v[k])); }
      }
#pragma unroll
      for (int o = 32; o > 0; o >>= 1) amax = fmaxf(amax, __shfl_xor(amax, o));
      sx = amax * (1.f / 127.f);
      const float inv = amax > 0.f ? 127.f / amax : 0.f;
      int sq_ = 0;
#pragma unroll
      for (int m = 0; m < 4; ++m) {
        unsigned wl = 0, wh = 0;
#pragma unroll
        for (int j = 0; j < 4; ++j) {
          const int a_ = __float2int_rn(xr[m * 8 + j] * inv), b_ = __float2int_rn(xr[m * 8 + 4 + j] * inv);
          sq_ += a_ + b_;
          wl |= ((unsigned)a_ & 0xffu) << (8 * j);
          wh |= ((unsigned)b_ & 0xffu) << (8 * j);
        }
        xlo[m] = (int)wl;
        xhi[m] = (int)wh;
      }
#pragma unroll
      for (int o = 32; o > 0; o >>= 1) sq_ += __shfl_xor(sq_, o);
      sumq = sq_;
    }
    float sq = (lane < 32) ? ssq2[(size_t)t * 32 + lane] : 0.f;
    sq = wave_sum(sq);
    const float rs2 = rsqrtf(sq * (1.f / 2048.f) + EPSV);
    float w0 = 0.f, w1 = 0.f;
#pragma unroll 1
    for (int half = 0; half < 2; ++half) {
      const int idv = half ? id1 : id0;
      int wv = 0;
      u32x4 rr[3][GROWS];
#pragma unroll
      for (int k = 0; k < GROWS; ++k) {
        const int e = __builtin_amdgcn_readlane(idv, k);
        rr[0][k] = *(const u32x4*)(ub + (size_t)e * 1024 + lane * 16);
        const int e2 = __builtin_amdgcn_readlane(idv, GROWS + k);
        rr[1][k] = *(const u32x4*)(ub + (size_t)e2 * 1024 + lane * 16);
      }
#pragma unroll
      for (int gi = 0; gi < 64 / GROWS; ++gi) {
        const int j0 = gi * GROWS;
        if (gi + 2 < 64 / GROWS) {
#pragma unroll
          for (int k = 0; k < GROWS; ++k) {
            const int e = __builtin_amdgcn_readlane(idv, j0 + 2 * GROWS + k);
            rr[(gi + 2) % 3][k] = *(const u32x4*)(ub + (size_t)e * 1024 + lane * 16);
          }
        }
        int dv[GROWS];
#pragma unroll
        for (int k = 0; k < GROWS; ++k) {
          int d = 0;
#pragma unroll
          for (int m = 0; m < 4; ++m) {
            const unsigned w = rr[gi % 3][k][m];
            const int lo = (int)(w & 0x0f0f0f0fu), hi = (int)((w >> 4) & 0x0f0f0f0fu);
            d = __builtin_amdgcn_sdot4(lo, xlo[m], d, false);
            d = __builtin_amdgcn_sdot4(hi, xhi[m], d, false);
          }
          dv[k] = d;
        }
        int a4[4], a2[2];
#pragma unroll
        for (int k = 0; k < 4; ++k) {
          const int mine = b5 ? dv[k + 4] : dv[k], oth = b5 ? dv[k] : dv[k + 4];
          a4[k] = mine + __shfl_xor(oth, 32);
        }
#pragma unroll
        for (int k = 0; k < 2; ++k) {
          const int mine = b4 ? a4[k + 2] : a4[k], oth = b4 ? a4[k] : a4[k + 2];
          a2[k] = mine + __shfl_xor(oth, 16);
        }
        int c1;
        {
          const int mine = b3 ? a2[1] : a2[0], oth = b3 ? a2[0] : a2[1];
          c1 = mine + __shfl_xor(oth, 8);
        }
        c1 += __shfl_xor(c1, 4);
        c1 += __shfl_xor(c1, 2);
        c1 += __shfl_xor(c1, 1);
        const int val = __shfl(c1, srcl);
        if ((lane & ~7) == j0) wv = val;
      }
      const float su = half ? su1 : su0;
      const float a = gelu_((float)(wv - 8 * sumq) * (su * sx * rs2));
      if (half) w1 = a * g1 * sv1; else w0 = a * g0 * sv0;
    }
    float wmax = fmaxf(fabsf(w0), fabsf(w1));
#pragma unroll
    for (int o = 32; o > 0; o >>= 1) wmax = fmaxf(wmax, __shfl_xor(wmax, o));
    const float sw = wmax * (1.f / 127.f);
    const float winv = wmax > 0.f ? 127.f / wmax : 0.f;
    const int q0 = __float2int_rn(w0 * winv), q1 = __float2int_rn(w1 * winv);
    int wsumq = q0 + q1;
#pragma unroll
    for (int o = 32; o > 0; o >>= 1) wsumq += __shfl_xor(wsumq, o);
    int pk0 = (int)(((unsigned)q0 & 0xffu) << (8 * (lane & 3))), pk1 = (int)(((unsigned)q1 & 0xffu) << (8 * (lane & 3)));
    pk0 |= __shfl_xor(pk0, 1); pk0 |= __shfl_xor(pk0, 2);
    pk1 |= __shfl_xor(pk1, 1); pk1 |= __shfl_xor(pk1, 2);
    int acc[32];
#pragma unroll
    for (int i = 0; i < 32; ++i) acc[i] = 0;
#pragma unroll 1
    for (int half = 0; half < 2; ++half) {
      const int idv = half ? id1 : id0;
      const int pkv = half ? pk1 : pk0;
      u32x4 rr[3][GROWS];
#pragma unroll
      for (int k = 0; k < GROWS; ++k) {
        const int e = __builtin_amdgcn_readlane(idv, k);
        rr[0][k] = *(const u32x4*)(vb + (size_t)e * 1024 + lane * 16);
        const int e2 = __builtin_amdgcn_readlane(idv, GROWS + k);
        rr[1][k] = *(const u32x4*)(vb + (size_t)e2 * 1024 + lane * 16);
      }
#pragma unroll
      for (int gi = 0; gi < 64 / GROWS; ++gi) {
        const int j0 = gi * GROWS;
        if (gi + 2 < 64 / GROWS) {
#pragma unroll
          for (int k = 0; k < GROWS; ++k) {
            const int e = __builtin_amdgcn_readlane(idv, j0 + 2 * GROWS + k);
            rr[(gi + 2) % 3][k] = *(const u32x4*)(vb + (size_t)e * 1024 + lane * 16);
          }
        }
#pragma unroll
        for (int sub = 0; sub < GROWS / 4; ++sub) {
          const int W4 = __builtin_amdgcn_readlane(pkv, j0 + 4 * sub);
#pragma unroll
          for (int m = 0; m < 4; ++m) {
            unsigned lo[4], hi[4];
#pragma unroll
            for (int k = 0; k < 4; ++k) {
              const unsigned w = rr[gi % 3][sub * 4 + k][m];
              lo[k] = w & 0x0f0f0f0fu;
              hi[k] = (w >> 4) & 0x0f0f0f0fu;
            }
            {
              const unsigned p01l = __builtin_amdgcn_perm(lo[1], lo[0], 0x05010400u), p01h = __builtin_amdgcn_perm(lo[1], lo[0], 0x07030602u);
              const unsigned p23l = __builtin_amdgcn_perm(lo[3], lo[2], 0x05010400u), p23h = __builtin_amdgcn_perm(lo[3], lo[2], 0x07030602u);
              acc[m * 8 + 0] = __builtin_amdgcn_sdot4((int)__builtin_amdgcn_perm(p23l, p01l, 0x05040100u), W4, acc[m * 8 + 0], false);
              acc[m * 8 + 1] = __builtin_amdgcn_sdot4((int)__builtin_amdgcn_perm(p23l, p01l, 0x07060302u), W4, acc[m * 8 + 1], false);
              acc[m * 8 + 2] = __builtin_amdgcn_sdot4((int)__builtin_amdgcn_perm(p23h, p01h, 0x05040100u), W4, acc[m * 8 + 2], false);
              acc[m * 8 + 3] = __builtin_amdgcn_sdot4((int)__builtin_amdgcn_perm(p23h, p01h, 0x07060302u), W4, acc[m * 8 + 3], false);
            }
            {
              const unsigned p01l = __builtin_amdgcn_perm(hi[1], hi[0], 0x05010400u), p01h = __builtin_amdgcn_perm(hi[1], hi[0], 0x07030602u);
              const unsigned p23l = __builtin_amdgcn_perm(hi[3], hi[2], 0x05010400u), p23h = __builtin_amdgcn_perm(hi[3], hi[2], 0x07030602u);
              acc[m * 8 + 4] = __builtin_amdgcn_sdot4((int)__builtin_amdgcn_perm(p23l, p01l, 0x05040100u), W4, acc[m * 8 + 4], false);
              acc[m * 8 + 5] = __builtin_amdgcn_sdot4((int)__builtin_amdgcn_perm(p23l, p01l, 0x07060302u), W4, acc[m * 8 + 5], false);
              acc[m * 8 + 6] = __builtin_amdgcn_sdot4((int)__builtin_amdgcn_perm(p23h, p01h, 0x05040100u), W4, acc[m * 8 + 6], false);
              acc[m * 8 + 7] = __builtin_amdgcn_sdot4((int)__builtin_amdgcn_perm(p23h, p01h, 0x07060302u), W4, acc[m * 8 + 7], false);
            }
          }
        }
      }
    }
    float val[32];
    float ss = 0.f;
    const int off8 = 8 * wsumq;
#pragma unroll
    for (int q = 0; q < 8; ++q) {
      f32x4 v = *(const f32x4*)(orow + q * 4);
#pragma unroll
      for (int k = 0; k < 4; ++k) {
        val[q * 4 + k] = sw * (float)(acc[q * 4 + k] - off8) + v[k];
        ss += val[q * 4 + k] * val[q * 4 + k];
      }
    }
    ss = wave_sum(ss);
    const float rs3 = rsqrtf(ss * (1.f / 2048.f) + EPSV);
#pragma unroll
    for (int q = 0; q < 8; ++q) {
      f32x4 wf = *(const f32x4*)(p.norm_final_w + lane * 32 + q * 4);
      f32x4 o = {val[q * 4 + 0] * rs3 * wf[0], val[q * 4 + 1] * rs3 * wf[1], val[q * 4 + 2] * rs3 * wf[2],
                 val[q * 4 + 3] * rs3 * wf[3]};
      *(f32x4*)(orow + q * 4) = o;
    }
  }
}

#define XB_TMO      128
#define XB_XCNT(j)  (256  + 64 * (j))
#define XB_XSUB(j)  (1280 + 64 * (j))
#define XB_XGEN(j)  (2304 + 64 * (j))
#define XB_TOP      3328
#define XB_TOPGEN   3392
#define XCD_BAR_WORDS 3456
#define XB_SPIN_CAP (1u << 18)
#define XLAS __attribute__((address_space(3)))
__device__ __forceinline__ unsigned xb_ld(unsigned* p) { return __hip_atomic_load(p, __ATOMIC_RELAXED, __HIP_MEMORY_SCOPE_AGENT); }
__device__ __forceinline__ unsigned xb_add(unsigned* p, unsigned v) { return __hip_atomic_fetch_add(p, v, __ATOMIC_RELAXED, __HIP_MEMORY_SCOPE_AGENT); }
__device__ __forceinline__ unsigned xb_xcc_id() { return (unsigned)__builtin_amdgcn_s_getreg((3 << 11) | 20) & 0xFu; }
#define XB_SPIN(cond, bar) do { unsigned _sp = 0; while (cond) { __builtin_amdgcn_s_sleep(1); \
    if ((++_sp & 255u) == 0u) { if (xb_ld(&(bar)[XB_TMO])) break; if (_sp > XB_SPIN_CAP) { atomicAdd(&(bar)[XB_TMO], 1u); break; } } } } while (0)
struct XcdBarrier { unsigned* bar; unsigned x; volatile XLAS unsigned* st; };
__device__ __forceinline__ XcdBarrier xcd_barrier_post(unsigned* bar, volatile XLAS unsigned* st) {
  XcdBarrier b; b.bar = bar; b.x = xb_xcc_id(); b.st = st;
  if (threadIdx.x == 0) (void)xb_add(&bar[XB_XCNT(b.x)], 1u);
  return b;
}
__device__ __forceinline__ void xcd_barrier_complete(unsigned* bar, unsigned x, unsigned& nloc, unsigned& nx) {
  const unsigned G = gridDim.x * gridDim.y * gridDim.z;
  unsigned sum, cnt, mine, sp = 0u;
  for (;;) {
    sum = 0u; cnt = 0u; mine = 0u;
#pragma unroll
    for (unsigned j = 0; j < 16; ++j) { const unsigned c = xb_ld(&bar[XB_XCNT(j)]); sum += c; cnt += (c > 0u) ? 1u : 0u; mine = (j == x) ? c : mine; }
    if (sum == G) break;
    __builtin_amdgcn_s_sleep(1);
    if ((++sp & 255u) == 0u) { if (xb_ld(&bar[XB_TMO])) break; if (sp > XB_SPIN_CAP) { atomicAdd(&bar[XB_TMO], 1u); break; } }
  }
  nloc = mine > 0u ? mine : 1u; nx = cnt > 0u ? cnt : 1u;
}
__device__ __forceinline__ void xcd_barrier(const XcdBarrier& b) {
  asm volatile("s_waitcnt vmcnt(0)" ::: "memory");
  __syncthreads();
  if (threadIdx.x == 0) {
    unsigned* bar = b.bar;
    __builtin_amdgcn_s_waitcnt(0);
    unsigned nloc = b.st[0], nx = b.st[1];
    if (nloc == 0u) { xcd_barrier_complete(bar, b.x, nloc, nx); b.st[0] = nloc; b.st[1] = nx; }
    const unsigned old = xb_add(&bar[XB_XSUB(b.x)], 1u);
    const unsigned gen = old / nloc;
    if (old + 1u == (gen + 1u) * nloc) {
      __builtin_amdgcn_fence(__ATOMIC_RELEASE, "agent");
      asm volatile("s_waitcnt vmcnt(0)" ::: "memory");
      const unsigned og = xb_add(&bar[XB_TOP], 1u);
      const unsigned tg = og / nx;
      if (og + 1u == (tg + 1u) * nx) xb_add(&bar[XB_TOPGEN], 1u);
      else XB_SPIN(xb_ld(&bar[XB_TOPGEN]) == tg, bar);
      __builtin_amdgcn_fence(__ATOMIC_ACQUIRE, "agent");
      xb_add(&bar[XB_XGEN(b.x)], 1u);
      asm volatile("s_waitcnt vmcnt(0)" ::: "memory");
    } else {
      XB_SPIN(xb_ld(&bar[XB_XGEN(b.x)]) == gen, bar);
      __builtin_amdgcn_fence(__ATOMIC_ACQUIRE, "agent");
      asm volatile("s_waitcnt vmcnt(0)" ::: "memory");
    }
  }
  __syncthreads();
}

__global__ void __launch_bounds__(NTHR, 2) fwd_kernel(Params p) {
  __shared__ __attribute__((aligned(16))) unsigned char smem[SMEM_BYTES];
  __shared__ uint4 xb_words;
  cg::grid_group grid = cg::this_grid();
  unsigned char* ws = p.ws;
  if (threadIdx.x == 0) xb_words = make_uint4(0u, 0u, 0u, 0u);
  __syncthreads();
  XcdBarrier xb = xcd_barrier_post((unsigned*)(ws + OFF_BAR), (volatile XLAS unsigned*)&xb_words);
  const int hb = threadIdx.x >> 8;
  unsigned char* hsm = smem + hb * SMEM_HALF;
#define PHASE_ON(n) (p.phase_lo <= (n) && (n) <= p.phase_hi)
#define PHASE_SYNC(n) if (p.coop && PHASE_ON(n) && (n) < p.phase_hi) { if ((n) == 0) grid.sync(); else xcd_barrier(xb); }
  if (PHASE_ON(0)) phase_prep(p, smem);
  PHASE_SYNC(0)
  if (PHASE_ON(1)) {
    pg8::Gemm g{(const bf16_t*)(ws + OFF_XB), (const bf16_t*)(ws + OFF_WINT), T_TOK, NPAD1, 2048};
    pg8::SimpleOrder S; S.init(T_TOK, NPAD1, gridDim.x, blockIdx.x);
    pg8::Epi1 E{(const float*)(ws + OFF_RS1), (bf16_t*)(ws + OFF_PROJ)};
    pg8::gemm_phase<pg8::Epi1, pg8::SimpleOrder, 0>((PG8_LAS unsigned char*)smem, g, S, E);
  }
  PHASE_SYNC(1)
  if (PHASE_ON(2)) {
    conv_prepass(p);
    if (p.coop) xcd_barrier(xb);
    for (int u0 = blockIdx.x * 2; u0 < 2048; u0 += gridDim.x * 2) ssd_local_unit(p, hsm, u0 + hb);
    for (int u0 = blockIdx.x * 2; u0 < 2048; u0 += gridDim.x * 2) lru_local_unit(p, hsm, u0 + hb);
  }
  PHASE_SYNC(2)
  if (PHASE_ON(3)) phase_carry(p);
  PHASE_SYNC(3)
  if (PHASE_ON(4)) phase_mix_final(p);
  PHASE_SYNC(4)
  if (PHASE_ON(5)) {
    pg8::Gemm g{(const bf16_t*)(ws + OFF_XB), (const bf16_t*)(ws + OFF_WOUTT), T_TOK, 2048, 2048};
    pg8::SimpleOrder S; S.init(T_TOK, 2048, gridDim.x, blockIdx.x);
    pg8::Epi2 E{p.x, p.out, (bf16_t*)(ws + OFF_X1B), (float*)(ws + OFF_SSQ2), (const float*)(ws + OFF_SSQ)};
    pg8::gemm_phase<pg8::Epi2, pg8::SimpleOrder, 16>((PG8_LAS unsigned char*)smem, g, S, E);
  }
  PHASE_SYNC(5)
  if (PHASE_ON(6)) {
    pg8::Gemm g{(const bf16_t*)(ws + OFF_X1B), (const bf16_t*)(ws + OFF_WQT), T_TOK, 2048, 2048};
    pg8::SimpleOrder S; S.init(T_TOK, 2048, gridDim.x, blockIdx.x);
    pg8::Epi3 E{(const float*)(ws + OFF_SSQ2), (bf16_t*)(ws + OFF_Q)};
    pg8::gemm_phase<pg8::Epi3, pg8::SimpleOrder, 0>((PG8_LAS unsigned char*)smem, g, S, E);
    convert_uv(p);
  }
  PHASE_SYNC(6)
  if (PHASE_ON(7)) {
    for (int u = blockIdx.x * 2 + hb; u < 2048; u += gridDim.x * 2) topk_unit(p, hsm, u);
  }
  PHASE_SYNC(7)
  if (PHASE_ON(8)) phase_gather(p);
}

extern "C" void kernel_launch(void* const* d_in, const int* in_sizes, int n_in, void* d_out, int out_size,
                              void* d_ws, size_t ws_size, hipStream_t stream) {
  Params p{};
  const float** fp = (const float**)&p;
  for (int i = 0; i < 23; ++i) fp[i] = (const float*)d_in[i];
  p.out = (float*)d_out;
  p.ws = (unsigned char*)d_ws;
  static int grid_blocks = 0;
  if (!grid_blocks) {
    int dev = 0, cus = 0, per_cu = 0;
    hipGetDevice(&dev);
    hipDeviceGetAttribute(&cus, hipDeviceAttributeMultiprocessorCount, dev);
    hipOccupancyMaxActiveBlocksPerMultiprocessor(&per_cu, fwd_kernel, NTHR, 0);
    if (per_cu < 1) per_cu = 1;
    if (per_cu > 1) per_cu = 1;
    grid_blocks = cus * per_cu;
  }
#if SINGLE_LAUNCH
  p.phase_lo = 0; p.phase_hi = 8; p.coop = 1;
  hipMemsetAsync((unsigned char*)d_ws + OFF_BAR, 0, XCD_BAR_WORDS * sizeof(unsigned), stream);
  void* args[] = {&p};
  hipError_t e = hipLaunchCooperativeKernel((void*)fwd_kernel, dim3(grid_blocks), dim3(NTHR), args, 0, stream);
  if (e != hipSuccess) fprintf(stderr, "cooperative launch failed: %s (grid %d)\n", hipGetErrorString(e), grid_blocks);
#else
  for (int ph = 0; ph <= 8; ++ph) {
    p.phase_lo = ph; p.phase_hi = ph; p.coop = 0;
    hipLaunchKernelGGL(fwd_kernel, dim3(grid_blocks), dim3(NTHR), 0, stream, p);
  }
#endif
}
```

```cpp
#include <hip/hip_runtime.h>
#include <hip/hip_cooperative_groups.h>
#include <cstdio>
namespace cg = cooperative_groups;

#ifndef DBL_PHASE
#define DBL_PHASE -1
#endif
#ifndef SINGLE_LAUNCH
#define SINGLE_LAUNCH 1
#endif

typedef unsigned short bf16_t;
typedef short bf16x8 __attribute__((ext_vector_type(8)));
typedef float f32x4 __attribute__((ext_vector_type(4)));
typedef unsigned u32x4 __attribute__((ext_vector_type(4)));
typedef unsigned u32x2 __attribute__((ext_vector_type(2)));
typedef __bf16 bf2_t __attribute__((ext_vector_type(2)));

#define T_TOK 16384
#define DM 2048
#define LDP 4736
#define NPAD1 4864
#define NTHR 512
#define HTHR 256
#define SMEM_HALF 73728
#define SMEM_BYTES 147456
#define EPSV 1e-6f
#define MIB ((size_t)1 << 20)

#define OFF_XB (0 * MIB)
#define OFF_PROJ (64 * MIB)
#define OFF_X1B (64 * MIB)
#define OFF_Q (128 * MIB)
#define OFF_IDX (192 * MIB)
#define OFF_G (200 * MIB)
#define OFF_HLOC (212 * MIB)
#define OFF_CUMA (276 * MIB)
#define OFF_YPART (340 * MIB)
#define OFF_ST (372 * MIB)
#define OFF_WINT (436 * MIB)
#define OFF_WOUTT (455 * MIB)
#define OFF_WQT (463 * MIB)
#define OFF_WAT (471 * MIB)
#define OFF_WXT (471 * MIB + 131072)
#define OFF_KEYSB (471 * MIB + 262144)
#define OFF_RS1 (472 * MIB)
#define OFF_ACS (472 * MIB + 65536)
#define OFF_LCARRY (OFF_ACS + MIB)
#define OFF_SSQ (OFF_LCARRY + 524288)
#define OFF_SSQ2 (OFF_SSQ + MIB)
#define OFF_SCALES (OFF_SSQ2 + 2 * MIB)
#define OFF_XACT (0 * MIB)
#define OFF_BACT (32 * MIB)
#define OFF_SINB_LO OFF_WINT
#define OFF_SINB_HI (488 * MIB)
#define OFF_BAR (487 * MIB)
#define OFF_CACT (478 * MIB)

struct Params {
  const float *x, *norm_mix_w, *w_in, *lru_conv_w, *lru_conv_b, *lru_wa, *lru_ba, *lru_wx, *lru_bx, *lru_lambda;
  const float *ssd_conv_w, *ssd_conv_b, *ssd_dt_bias, *ssd_a_log, *ssd_d, *ssd_norm_w, *w_out, *norm_ffn_w, *peer_wq;
  const float *peer_sub_keys, *peer_u, *peer_v, *norm_final_w;
  float* out;
  unsigned char* ws;
  int phase_lo, phase_hi, coop, pad0;
};

__device__ __forceinline__ unsigned pk2(float lo, float hi) {
  unsigned r;
  asm("v_cvt_pk_bf16_f32 %0, %1, %2" : "=v"(r) : "v"(lo), "v"(hi));
  return r;
}
__device__ __forceinline__ float bf2f(bf16_t v) { return __uint_as_float(((unsigned)v) << 16); }
__device__ __forceinline__ float bflo(unsigned u) { return __uint_as_float(u << 16); }
__device__ __forceinline__ float bfhi(unsigned u) { return __uint_as_float(u & 0xffff0000u); }
__device__ __forceinline__ float wave_sum(float v) {
#pragma unroll
  for (int o = 32; o > 0; o >>= 1) v += __shfl_xor(v, o);
  return v;
}
__device__ __forceinline__ float sigmoid_(float x) { return __builtin_amdgcn_rcpf(1.f + __expf(-x)); }
__device__ __forceinline__ float silu_(float x) { return x * sigmoid_(x); }
__device__ __forceinline__ float gelu_(float x) {
  float u = 0.7978845608028654f * (x + 0.044715f * x * x * x);
  return x * sigmoid_(2.f * u);
}
__device__ __forceinline__ float softplus_(float x) { return fmaxf(x, 0.f) + log1pf(__expf(-fabsf(x))); }
__device__ __forceinline__ f32x4 mfma16(bf16x8 a, bf16x8 b, f32x4 c) {
  return __builtin_amdgcn_mfma_f32_16x16x32_bf16(a, b, c, 0, 0, 0);
}
__device__ __forceinline__ bf16x8 as_frag(u32x4 v) { return __builtin_bit_cast(bf16x8, v); }
__device__ __forceinline__ int sw256(int row, int chunk) { return row * 256 + ((chunk ^ (row & 15)) << 4); }
__device__ __forceinline__ int sw128(int row, int chunk) { return row * 128 + ((chunk ^ ((row >> 1) & 7)) << 4); }

__device__ __forceinline__ bf16_t* sinb_ptr(unsigned char* ws, int b, int c, int hh) {
  return (bf16_t*)(ws + (b < 4 ? OFF_SINB_LO : OFF_SINB_HI)) + (size_t)(((b & 3) * 16 + c) * 16 + hh) * 8192;
}
__device__ __forceinline__ float rs_from_ssq2(const float* ssq2, int row) {
  const f32x4* pp = (const f32x4*)(ssq2 + (size_t)row * 32);
  float s = 0.f;
#pragma unroll
  for (int i = 0; i < 8; ++i) { f32x4 v = pp[i]; s += v[0] + v[1] + v[2] + v[3]; }
  return rsqrtf(s * (1.f / 2048.f) + EPSV);
}
__device__ __forceinline__ float rs_from_ssq(const float* ssq, int row) {
  const f32x4* pp = (const f32x4*)(ssq + (size_t)row * 16);
  float s = 0.f;
#pragma unroll
  for (int i = 0; i < 4; ++i) { f32x4 v = pp[i]; s += v[0] + v[1] + v[2] + v[3]; }
  return rsqrtf(s * (1.f / 1024.f) + EPSV);
}

__device__ void transpose_tile(const float* __restrict__ src, int ld_src, int r0, int c0, int c_valid,
                               bf16_t* __restrict__ dst, int ld_dst, const float* __restrict__ scale, int scale_from,
                               float* tile, bool valid) {
  const int tid = threadIdx.x & 255;
  {
    const int j = tid & 63, i0 = tid >> 6;
#pragma unroll 4
    for (int ii = 0; ii < 16; ++ii) {
      const int i = i0 + 4 * ii;
      float v = 0.f;
      if (valid && c0 + j < c_valid) {
        v = src[(size_t)(r0 + i) * ld_src + c0 + j];
        if (scale != nullptr && (r0 + i) >= scale_from) v *= scale[r0 + i - scale_from];
      }
      tile[i * 65 + j] = v;
    }
  }
  __syncthreads();
  {
    const int i = tid & 63, j0 = tid >> 6;
#pragma unroll 4
    for (int jj = 0; jj < 16; ++jj) {
      const int j = j0 + 4 * jj;
      if (valid) dst[(size_t)(c0 + j) * ld_dst + r0 + i] = (bf16_t)(pk2(tile[i * 65 + j], 0.f) & 0xffffu);
    }
  }
  __syncthreads();
}

__device__ void phase_prep(const Params& p, unsigned char* smem) {
  const int tid = threadIdx.x, lane = tid & 63, wid = tid >> 6, hb = tid >> 8;
  unsigned char* ws = p.ws;
  bf16_t* xb = (bf16_t*)(ws + OFF_XB);
  float* rs1 = (float*)(ws + OFF_RS1);
  for (int t = blockIdx.x * 8 + wid; t < T_TOK; t += gridDim.x * 8) {
    const float* xr = p.x + (size_t)t * DM;
    bf16_t* xo = xb + (size_t)t * DM;
    float ss = 0.f;
#pragma unroll
    for (int c = 0; c < 8; ++c) {
      f32x4 v = *(const f32x4*)(xr + c * 256 + lane * 4);
      ss += v[0] * v[0] + v[1] * v[1] + v[2] * v[2] + v[3] * v[3];
      u32x2 o = {pk2(v[0], v[1]), pk2(v[2], v[3])};
      *(u32x2*)(xo + c * 256 + lane * 4) = o;
    }
    ss = wave_sum(ss);
    if (lane == 0) rs1[t] = rsqrtf(ss * (1.f / 2048.f) + EPSV);
  }
  float* tile = (float*)(smem + hb * SMEM_HALF);
  const int NT_WIN = 32 * 76, NT_SQ = 32 * 32;
  const int total = NT_WIN + 2 * NT_SQ + 32;
  for (int u0 = blockIdx.x * 2; u0 < total; u0 += gridDim.x * 2) {
    const bool valid = (u0 + hb) < total;
    const int u = valid ? (u0 + hb) : u0;
    if (u < NT_WIN) {
      const int ri = u & 31, cj = u >> 5;
      transpose_tile(p.w_in, 4624, ri * 64, cj * 64, 4624, (bf16_t*)(ws + OFF_WINT), 2048, p.norm_mix_w, 0, tile, valid);
    } else if (u < NT_WIN + NT_SQ) {
      const int v = u - NT_WIN, ri = v & 31, cj = v >> 5;
      transpose_tile(p.w_out, 2048, ri * 64, cj * 64, 2048, (bf16_t*)(ws + OFF_WOUTT), 2048, p.ssd_norm_w, 1024, tile, valid);
    } else if (u < NT_WIN + 2 * NT_SQ) {
      const int v = u - NT_WIN - NT_SQ, ri = v & 31, cj = v >> 5;
      transpose_tile(p.peer_wq, 2048, ri * 64, cj * 64, 2048, (bf16_t*)(ws + OFF_WQT), 2048, p.norm_ffn_w, 0, tile, valid);
    } else {
      const int v = u - NT_WIN - 2 * NT_SQ;
      const int h = v & 15;
      const float* src = (v < 16 ? p.lru_wa : p.lru_wx) + (size_t)h * 4096;
      bf16_t* dst = (bf16_t*)(ws + (v < 16 ? OFF_WAT : OFF_WXT)) + (size_t)h * 4096;
      transpose_tile(src, 64, 0, 0, 64, dst, 64, nullptr, 0, tile, valid);
    }
  }
  {
    bf16_t* kb = (bf16_t*)(ws + OFF_KEYSB);
    for (int i = blockIdx.x * NTHR + tid; i < 65536; i += gridDim.x * NTHR) {
      f32x4 v = *(const f32x4*)(p.peer_sub_keys + (size_t)i * 4);
      u32x2 o = {pk2(v[0], v[1]), pk2(v[2], v[3])};
      *(u32x2*)(kb + (size_t)i * 4) = o;
    }
  }
}

namespace pg8 {
#define PG8_LAS __attribute__((address_space(3)))
constexpr int BM = 256, BK = 64, HALF = 128, HTB = HALF * BK * 2;
__device__ __forceinline__ int lds_byte(int r, int c) { const int st = (r >> 4) * 2 + (c >> 5), rr = r & 15, cc = c & 31, ob = rr * 64 + cc * 2; return st * 1024 + (ob ^ (((ob >> 9) & 1) << 5)); }
__device__ __forceinline__ void stage_rc(int b, int& R, int& C) { const int st = b / 1024, sb = b % 1024, swz = sb ^ (((sb >> 9) & 1) << 5); R = (st >> 1) * 16 + swz / 64; C = (st & 1) * 32 + (swz % 64) / 2; }
struct Unit { int pm, pn; };
struct Gemm { const bf16_t* A; const bf16_t* Bt; int M, N, K; };
struct SimpleOrder {
  int nM, nwg, G, c;
  __device__ void init(int M, int N, int G_, int c_) { nM = M / BM; nwg = nM * (N / BM); G = G_; c = c_; }
  __device__ bool next(int i, Unit& u) const { const int L = i * G + c; if (L >= nwg) return false; u.pm = L % nM; u.pn = L / nM; return true; }
};
struct Epi1 {
  static constexpr bool MID = false;
  const float* rs1; bf16_t* proj;
  __device__ __forceinline__ void mid(f32x4 (&)[2][2][4][2], const Unit&, int, int) const {}
  __device__ __forceinline__ void operator()(const f32x4 (&acc)[2][2][4][2], const Unit& u, int wr, int wc, int fr, int fq) const {
    const int row0 = u.pm * BM + wr * 64 + fr, col0 = u.pn * BM + wc * 32 + 4 * fq;
#pragma unroll
    for (int ai = 0; ai < 2; ++ai)
#pragma unroll
      for (int m = 0; m < 4; ++m) {
        const int row = row0 + ai * HALF + m * 16;
        const float s = rs1[row];
#pragma unroll
        for (int bj = 0; bj < 2; ++bj)
#pragma unroll
          for (int n = 0; n < 2; ++n) {
            const int col = col0 + bj * HALF + n * 16;
            if (col < LDP) {
              f32x4 v = acc[ai][bj][m][n] * s;
              u32x2 o = {pk2(v[0], v[1]), pk2(v[2], v[3])};
              *(u32x2*)(proj + (size_t)row * LDP + col) = o;
            }
          }
      }
  }
};
struct Epi2 {
  static constexpr bool MID = true;
  const float* x; float* out; bf16_t* x1b; float* ssq2; const float* ssq;
  __device__ __forceinline__ void mid(f32x4 (&acc)[2][2][4][2], const Unit& u, int wr, int fr) const {
#pragma unroll
    for (int ai = 0; ai < 2; ++ai)
#pragma unroll
      for (int m = 0; m < 4; ++m) {
        const float s = rs_from_ssq(ssq, u.pm * BM + wr * 64 + fr + ai * HALF + m * 16);
#pragma unroll
        for (int bj = 0; bj < 2; ++bj)
#pragma unroll
          for (int n = 0; n < 2; ++n) acc[ai][bj][m][n] *= s;
        __builtin_amdgcn_sched_barrier(0);
      }
  }
  __device__ __forceinline__ void operator()(const f32x4 (&acc)[2][2][4][2], const Unit& u, int wr, int wc, int fr, int fq) const {
    const int row0 = u.pm * BM + wr * 64 + fr, col0 = u.pn * BM + wc * 32 + 4 * fq;
#pragma unroll
    for (int ai = 0; ai < 2; ++ai)
#pragma unroll
      for (int m = 0; m < 4; ++m) {
        const int row = row0 + ai * HALF + m * 16;
        float ss = 0.f;
#pragma unroll
        for (int bj = 0; bj < 2; ++bj)
#pragma unroll
          for (int n = 0; n < 2; ++n) {
            const int col = col0 + bj * HALF + n * 16;
            f32x4 xr = *(const f32x4*)(x + (size_t)row * DM + col);
            f32x4 v = acc[ai][bj][m][n] + xr;
            *(f32x4*)(out + (size_t)row * DM + col) = v;
            u32x2 o = {pk2(v[0], v[1]), pk2(v[2], v[3])};
            *(u32x2*)(x1b + (size_t)row * DM + col) = o;
            ss += v[0] * v[0] + v[1] * v[1] + v[2] * v[2] + v[3] * v[3];
          }
        ss += __shfl_xor(ss, 16);
        ss += __shfl_xor(ss, 32);
        if (fq == 0) ssq2[(size_t)row * 32 + u.pn * 4 + wc] = ss;
        __builtin_amdgcn_sched_barrier(0);
      }
  }
};
struct Epi3 {
  static constexpr bool MID = false;
  const float* ssq2; bf16_t* q;
  __device__ __forceinline__ void mid(f32x4 (&)[2][2][4][2], const Unit&, int, int) const {}
  __device__ __forceinline__ void operator()(const f32x4 (&acc)[2][2][4][2], const Unit& u, int wr, int wc, int fr, int fq) const {
    const int row0 = u.pm * BM + wr * 64 + fr, col0 = u.pn * BM + wc * 32 + 4 * fq;
#pragma unroll
    for (int ai = 0; ai < 2; ++ai)
#pragma unroll
      for (int m = 0; m < 4; ++m) {
        const int row = row0 + ai * HALF + m * 16;
        const float s = rs_from_ssq2(ssq2, row);
#pragma unroll
        for (int bj = 0; bj < 2; ++bj)
#pragma unroll
          for (int n = 0; n < 2; ++n) {
            const int col = col0 + bj * HALF + n * 16;
            f32x4 v = acc[ai][bj][m][n] * s;
            u32x2 o = {pk2(v[0], v[1]), pk2(v[2], v[3])};
            *(u32x2*)(q + (size_t)row * DM + col) = o;
          }
      }
  }
};

template <class Epi, class Sched, int KROT>
__device__ __forceinline__ void gemm_phase(PG8_LAS unsigned char* lds, const Gemm g, const Sched& S, const Epi& E) {
  const int tid = threadIdx.x, wid = __builtin_amdgcn_readfirstlane(tid >> 6), lane = tid & 63, wr = wid >> 2, wc = wid & 3, fr = lane & 15, fq = lane >> 4;
  const int K = g.K, nt = K / BK;
#define PG8_KX(t) (((t) + KROT) & 31)
  unsigned voff[2];
#pragma unroll
  for (int i = 0; i < 2; ++i) { int R, C; stage_rc(tid * 16 + i * 8192, R, C); voff[i] = (unsigned)(R * K + C) * 2u; }
  const size_t kstep = (size_t)(BK * 2);
  const size_t hstep = (size_t)HALF * K * 2;
  const size_t tstep = 2 * hstep;
  const unsigned ldsw = (unsigned)wid * 1024u;
  const int aoff = lds_byte(wr * 64 + fr, fq * 8), boff = lds_byte(wc * 32 + fr, fq * 8);
#define PG8_SA(b, h) (((b) * 2 + (h)) * HTB)
#define PG8_SB(b, h) ((4 + (b) * 2 + (h)) * HTB)
#define PG8_STAGE(bufoff, gbase) do { _Pragma("unroll") for (int _i = 0; _i < 2; ++_i) \
    __builtin_amdgcn_global_load_lds((const unsigned*)((const char*)(gbase) + voff[_i]), (PG8_LAS unsigned*)(lds + (bufoff) + ldsw + _i * 8192), 16, 0, 0); } while (0)
#define PG8_LDA(dst, b, h) do { _Pragma("unroll") for (int m = 0; m < 4; ++m) _Pragma("unroll") for (int k = 0; k < 2; ++k) dst[m][k] = *(const PG8_LAS bf16x8*)(lds + PG8_SA(b, h) + aoff + m * 2048 + k * 1024); } while (0)
#define PG8_LDB(dst, b, h) do { _Pragma("unroll") for (int n = 0; n < 2; ++n) _Pragma("unroll") for (int k = 0; k < 2; ++k) dst[n][k] = *(const PG8_LAS bf16x8*)(lds + PG8_SB(b, h) + boff + n * 2048 + k * 1024); } while (0)
#define PG8_MMA(ai, bj, At, Bt) do { __builtin_amdgcn_s_setprio(1); _Pragma("unroll") for (int m = 0; m < 4; ++m) _Pragma("unroll") for (int n = 0; n < 2; ++n) _Pragma("unroll") for (int k = 0; k < 2; ++k) \
    acc[ai][bj][m][n] = __builtin_amdgcn_mfma_f32_16x16x32_bf16(Bt[n][k], At[m][k], acc[ai][bj][m][n], 0, 0, 0); __builtin_amdgcn_s_setprio(0); } while (0)
#define PG8_WAIT_V(n) asm volatile("s_waitcnt vmcnt(" #n ")" ::: "memory")
#define PG8_WAIT_L(n) asm volatile("s_waitcnt lgkmcnt(" #n ")" ::: "memory")
#define PG8_BAR __builtin_amdgcn_s_barrier()
#define PG8_SCHED __builtin_amdgcn_sched_barrier(0)
  Unit cur, nxt; int ui = 0;
  if (!S.next(0, cur)) return;
  f32x4 acc[2][2][4][2];
#pragma unroll
  for (int a = 0; a < 2; ++a)
#pragma unroll
    for (int b = 0; b < 2; ++b)
#pragma unroll
      for (int m = 0; m < 4; ++m)
#pragma unroll
        for (int n = 0; n < 2; ++n) acc[a][b][m][n] = (f32x4){0.f, 0.f, 0.f, 0.f};
  bf16x8 At[4][2], B0[2][2], B1[2][2];
  const char* cA = (const char*)g.A + (size_t)cur.pm * tstep; const char* cB = (const char*)g.Bt + (size_t)cur.pn * tstep;
  { const char* a0 = cA + (size_t)PG8_KX(0) * kstep; const char* b0 = cB + (size_t)PG8_KX(0) * kstep;
    const char* a1 = cA + (size_t)PG8_KX(1) * kstep; const char* b1 = cB + (size_t)PG8_KX(1) * kstep;
    PG8_STAGE(PG8_SB(0, 0), b0); PG8_STAGE(PG8_SA(0, 0), a0); PG8_STAGE(PG8_SB(0, 1), b0 + hstep); PG8_STAGE(PG8_SA(0, 1), a0 + hstep);
    if (wr == 1) PG8_BAR;
    PG8_WAIT_V(4); PG8_BAR;
    PG8_STAGE(PG8_SB(1, 0), b1); PG8_STAGE(PG8_SA(1, 0), a1); PG8_STAGE(PG8_SB(1, 1), b1 + hstep);
    PG8_WAIT_V(6); PG8_BAR; }
  for (;;) {
    const bool has_next = S.next(ui + 1, nxt);
    const char* nA = has_next ? (const char*)g.A + (size_t)nxt.pm * tstep : cA; const char* nB = has_next ? (const char*)g.Bt + (size_t)nxt.pn * tstep : cB;
#define PG8_ITER(t) {\
      const bool last = (t == nt - 2);\
      const char* a1 = cA + (size_t)PG8_KX(t + 1) * kstep;\
      const char* a2 = last ? nA + (size_t)PG8_KX(0) * kstep : cA + (size_t)PG8_KX(t + 2) * kstep;\
      const char* b2 = last ? nB + (size_t)PG8_KX(0) * kstep : cB + (size_t)PG8_KX(t + 2) * kstep;\
      const char* a3 = last ? nA + (size_t)PG8_KX(1) * kstep : cA + (size_t)PG8_KX(t + 3) * kstep;\
      const char* b3 = last ? nB + (size_t)PG8_KX(1) * kstep : cB + (size_t)PG8_KX(t + 3) * kstep;\
      PG8_LDB(B0, 0, 0); PG8_SCHED; PG8_LDA(At, 0, 0); PG8_STAGE(PG8_SA(1, 1), a1 + hstep);\
      PG8_WAIT_L(8); PG8_BAR; PG8_WAIT_L(0); PG8_MMA(0, 0, At, B0); PG8_BAR; PG8_SCHED;\
      PG8_LDB(B1, 0, 1); PG8_STAGE(PG8_SB(0, 0), b2);\
      PG8_BAR; PG8_WAIT_L(0); PG8_MMA(0, 1, At, B1); PG8_BAR;\
      PG8_LDA(At, 0, 1); PG8_STAGE(PG8_SA(0, 0), a2);\
      PG8_BAR; PG8_WAIT_L(0); PG8_MMA(1, 0, At, B0); PG8_BAR; PG8_SCHED;\
      PG8_STAGE(PG8_SB(0, 1), b2 + hstep);\
      PG8_WAIT_V(6); PG8_BAR; PG8_MMA(1, 1, At, B1); PG8_BAR;\
      PG8_LDB(B0, 1, 0); PG8_SCHED; PG8_LDA(At, 1, 0); PG8_STAGE(PG8_SA(0, 1), a2 + hstep);\
      PG8_WAIT_L(8); PG8_BAR; PG8_WAIT_L(0); PG8_MMA(0, 0, At, B0); PG8_BAR; PG8_SCHED;\
      PG8_LDB(B1, 1, 1); PG8_STAGE(PG8_SB(1, 0), b3);\
      PG8_BAR; PG8_WAIT_L(0); PG8_MMA(0, 1, At, B1); PG8_BAR;\
      PG8_LDA(At, 1, 1); PG8_STAGE(PG8_SA(1, 0), a3);\
      PG8_BAR; PG8_WAIT_L(0); PG8_MMA(1, 0, At, B0); PG8_BAR; PG8_SCHED;\
      PG8_STAGE(PG8_SB(1, 1), b3 + hstep);\
      PG8_WAIT_V(6); PG8_BAR; PG8_MMA(1, 1, At, B1); PG8_BAR;\
}
    if (Epi::MID) {
      for (int t = 0; t < 16; t += 2) PG8_ITER(t)
      E.mid(acc, cur, wr, fr);
      for (int t = 16; t < nt; t += 2) PG8_ITER(t)
    } else {
      for (int t = 0; t < nt; t += 2) PG8_ITER(t)
    }
#undef PG8_ITER
    E(acc, cur, wr, wc, fr, fq);
    if (!has_next) break;
#pragma unroll
    for (int a = 0; a < 2; ++a)
#pragma unroll
      for (int b = 0; b < 2; ++b)
#pragma unroll
        for (int m = 0; m < 4; ++m)
#pragma unroll
          for (int n = 0; n < 2; ++n) acc[a][b][m][n] = (f32x4){0.f, 0.f, 0.f, 0.f};
    cur = nxt; cA = nA; cB = nB; ++ui;
  }
  PG8_WAIT_V(0);
  if (wr == 0) PG8_BAR;
  PG8_BAR;
#undef PG8_KX
#undef PG8_SA
#undef PG8_SB
#undef PG8_STAGE
#undef PG8_LDA
#undef PG8_LDB
#undef PG8_MMA
#undef PG8_WAIT_V
#undef PG8_WAIT_L
#undef PG8_BAR
#undef PG8_SCHED
}
}

__device__ __forceinline__ void conv8(const bf16_t* __restrict__ proj, int t, int tt_in_seq, int col,
                                      const float* __restrict__ cw, int ld_w, const float* __restrict__ cb, int ch,
                                      float* o) {
  f32x4 b0 = *(const f32x4*)(cb + ch), b1 = *(const f32x4*)(cb + ch + 4);
  o[0] = b0[0]; o[1] = b0[1]; o[2] = b0[2]; o[3] = b0[3];
  o[4] = b1[0]; o[5] = b1[1]; o[6] = b1[2]; o[7] = b1[3];
#pragma unroll
  for (int k = 0; k < 4; ++k) {
    if (tt_in_seq - 3 + k >= 0) {
      u32x4 v = *(const u32x4*)(proj + (size_t)(t - 3 + k) * LDP + col);
      f32x4 w0 = *(const f32x4*)(cw + k * ld_w + ch), w1 = *(const f32x4*)(cw + k * ld_w + ch + 4);
      o[0] += w0[0] * bflo(v[0]); o[1] += w0[1] * bfhi(v[0]);
      o[2] += w0[2] * bflo(v[1]); o[3] += w0[3] * bfhi(v[1]);
      o[4] += w1[0] * bflo(v[2]); o[5] += w1[1] * bfhi(v[2]);
      o[6] += w1[2] * bflo(v[3]); o[7] += w1[3] * bfhi(v[3]);
    }
  }
}
__device__ __forceinline__ void conv4(const bf16_t* __restrict__ proj, int t, int tt_in_seq, int col,
                                      const float* __restrict__ cw, int ld_w, const float* __restrict__ cb, int ch,
                                      float* o) {
  f32x4 b0 = *(const f32x4*)(cb + ch);
  o[0] = b0[0]; o[1] = b0[1]; o[2] = b0[2]; o[3] = b0[3];
#pragma unroll
  for (int k = 0; k < 4; ++k) {
    if (tt_in_seq - 3 + k >= 0) {
      u32x2 v = *(const u32x2*)(proj + (size_t)(t - 3 + k) * LDP + col);
      f32x4 w0 = *(const f32x4*)(cw + k * ld_w + ch);
      o[0] += w0[0] * bflo(v[0]); o[1] += w0[1] * bfhi(v[0]);
      o[2] += w0[2] * bflo(v[1]); o[3] += w0[3] * bfhi(v[1]);
    }
  }
}
__device__ __forceinline__ bf16x8 cfrag(const Params& p, const bf16_t* proj, int t, int tseq, int g, int n8) {
  const bf16_t* cact = (const bf16_t*)(p.ws + OFF_CACT);
  return as_frag(*(const u32x4*)(cact + (size_t)t * 256 + g * 128 + n8));
}
__device__ void conv_prepass(const Params& p) {
  unsigned char* ws = p.ws;
  const bf16_t* proj = (const bf16_t*)(ws + OFF_PROJ);
  bf16_t* xact = (bf16_t*)(ws + OFF_XACT);
  bf16_t* bact = (bf16_t*)(ws + OFF_BACT);
  bf16_t* cact = (bf16_t*)(ws + OFF_CACT);
  for (int i = blockIdx.x * NTHR + threadIdx.x; i < T_TOK * 192; i += gridDim.x * NTHR) {
    const int t = i / 192, ch = (i - t * 192) * 8;
    float o[8];
    conv8(proj, t, t & 2047, 3072 + ch, p.ssd_conv_w, 1536, p.ssd_conv_b, ch, o);
#pragma unroll
    for (int e = 0; e < 8; ++e) o[e] = silu_(o[e]);
    u32x4 r = {pk2(o[0], o[1]), pk2(o[2], o[3]), pk2(o[4], o[5]), pk2(o[6], o[7])};
    bf16_t* dst = ch < 1024 ? xact + (size_t)t * 1024 + ch : (ch < 1280 ? bact + (size_t)t * 256 + (ch - 1024) : cact + (size_t)t * 256 + (ch - 1280));
    *(u32x4*)dst = r;
  }
}

__device__ void lru_local_unit(const Params& p, unsigned char* smem, int unit) {
  const int tid = threadIdx.x & 255, lane = tid & 63, wid = tid >> 6, l15 = lane & 15, q4 = lane >> 4;
  const int hh = unit & 15, c = (unit >> 4) & 15, b = unit >> 8;
  const int t0 = b * 2048 + c * 128, ch0 = hh * 64;
  unsigned char* ws = p.ws;
  const bf16_t* proj = (const bf16_t*)(ws + OFF_PROJ);
  float* R1 = (float*)smem;
  float* R2 = (float*)(smem + 33536);
  float* R3 = (float*)(smem + 33536 + 32768);
#pragma unroll 11
  for (int e = tid; e < 131 * 64; e += HTHR) {
    const int r = e >> 6, j = e & 63, tt = r - 3;
    float v = 0.f;
    if (c * 128 + tt >= 0) v = bf2f(proj[(size_t)(t0 + tt) * LDP + ch0 + j]);
    R1[e] = v;
  }
  __syncthreads();
  {
    const int j = tid & 63;
    const float cb = p.lru_conv_b[ch0 + j];
    const float w0 = p.lru_conv_w[0 * 1024 + ch0 + j], w1 = p.lru_conv_w[1 * 1024 + ch0 + j],
                w2 = p.lru_conv_w[2 * 1024 + ch0 + j], w3 = p.lru_conv_w[3 * 1024 + ch0 + j];
#pragma unroll 8
    for (int tt = tid >> 6; tt < 128; tt += 4) {
      R2[tt * 64 + j] = cb + w0 * R1[tt * 64 + j] + w1 * R1[(tt + 1) * 64 + j] + w2 * R1[(tt + 2) * 64 + j] +
                        w3 * R1[(tt + 3) * 64 + j];
    }
  }
  __syncthreads();
  {
    const bf16_t* waT = (const bf16_t*)(ws + OFF_WAT) + (size_t)hh * 4096;
    const bf16_t* wxT = (const bf16_t*)(ws + OFF_WXT) + (size_t)hh * 4096;
    f32x4 aa[2][4], ax[2][4];
#pragma unroll
    for (int i = 0; i < 2; ++i)
#pragma unroll
      for (int j = 0; j < 4; ++j) { aa[i][j] = (f32x4){0, 0, 0, 0}; ax[i][j] = (f32x4){0, 0, 0, 0}; }
#pragma unroll
    for (int ks = 0; ks < 2; ++ks) {
      bf16x8 af[2];
#pragma unroll
      for (int mi = 0; mi < 2; ++mi) {
        const float* src = R2 + (wid * 32 + mi * 16 + l15) * 64 + ks * 32 + q4 * 8;
        f32x4 v0 = *(const f32x4*)src, v1 = *(const f32x4*)(src + 4);
        u32x4 r = {pk2(v0[0], v0[1]), pk2(v0[2], v0[3]), pk2(v1[0], v1[1]), pk2(v1[2], v1[3])};
        af[mi] = as_frag(r);
      }
#pragma unroll
      for (int ni = 0; ni < 4; ++ni) {
        const size_t wo = (size_t)(ni * 16 + l15) * 64 + ks * 32 + q4 * 8;
        bf16x8 ba = as_frag(*(const u32x4*)(waT + wo));
        bf16x8 bx = as_frag(*(const u32x4*)(wxT + wo));
#pragma unroll
        for (int mi = 0; mi < 2; ++mi) {
          aa[mi][ni] = mfma16(af[mi], ba, aa[mi][ni]);
          ax[mi][ni] = mfma16(af[mi], bx, ax[mi][ni]);
        }
      }
    }
#pragma unroll
    for (int ni = 0; ni < 4; ++ni) {
      const int j = ni * 16 + l15;
      const float ba = p.lru_ba[ch0 + j], bx = p.lru_bx[ch0 + j];
      const float lam = p.lru_lambda[ch0 + j];
      const float spl = -8.f * log1pf(__expf(-lam));
#pragma unroll
      for (int mi = 0; mi < 2; ++mi)
#pragma unroll
        for (int r = 0; r < 4; ++r) {
          const int tt = wid * 32 + mi * 16 + q4 * 4 + r;
          const float rg = sigmoid_(aa[mi][ni][r] + ba);
          const float ig = sigmoid_(ax[mi][ni][r] + bx);
          const float log_a = spl * rg;
          const float av = __expf(log_a);
          const float xl = R2[tt * 64 + j];
          const float y2 = 2.f * log_a;
          const float poly = -y2 * (1.f + y2 * (0.5f + y2 * (0.16666667f + y2 * (0.041666668f + y2 * (0.0083333338f + y2 * 0.0013888889f)))));
          const float em = (y2 > -0.25f) ? poly : (1.f - av * av);
          const float bv = __builtin_amdgcn_sqrtf(fmaxf(em, 0.f)) * (ig * xl);
          R1[tt * 64 + j] = av;
          R2[tt * 64 + j] = bv;
        }
    }
  }
  __syncthreads();
  {
    const int j = tid & 63, seg = tid >> 6;
    float h = 0.f, Ac = 1.f;
#pragma unroll 4
    for (int s = 0; s < 32; ++s) {
      const int tt = seg * 32 + s;
      const float a = R1[tt * 64 + j], bb = R2[tt * 64 + j];
      h = a * h + bb;
      Ac *= a;
      R2[tt * 64 + j] = h;
      R1[tt * 64 + j] = Ac;
    }
    R3[seg * 64 + j] = h;
    R3[256 + seg * 64 + j] = Ac;
    __syncthreads();
    float cin = 0.f, Ain = 1.f;
    for (int s2 = 0; s2 < seg; ++s2) {
      cin = R3[256 + s2 * 64 + j] * cin + R3[s2 * 64 + j];
      Ain *= R3[256 + s2 * 64 + j];
    }
    float* hloc = (float*)(ws + OFF_HLOC);
    float* cumA = (float*)(ws + OFF_CUMA);
#pragma unroll 4
    for (int s = 0; s < 32; ++s) {
      const int tt = seg * 32 + s;
      const float hl = R2[tt * 64 + j] + R1[tt * 64 + j] * cin;
      const float Al = R1[tt * 64 + j] * Ain;
      hloc[(size_t)(t0 + tt) * 1024 + ch0 + j] = hl;
      cumA[(size_t)(t0 + tt) * 1024 + ch0 + j] = Al;
    }
  }
  __syncthreads();
}

__device__ void ssd_local_unit(const Params& p, unsigned char* smem, int unit) {
  const int tid = threadIdx.x & 255, lane = tid & 63, wid = tid >> 6, l15 = lane & 15, q4 = lane >> 4;
  const int hh = unit & 15, c = (unit >> 4) & 15, b = unit >> 8, g = hh >> 3;
  const int t0 = b * 2048 + c * 128, ts0 = c * 128;
  unsigned char* ws = p.ws;
  const bf16_t* proj = (const bf16_t*)(ws + OFF_PROJ);
  unsigned char* Bm = smem;
  unsigned char* XT = smem + 32768;
  unsigned char* Pw = smem + 49152 + wid * 4096;
  float* dts = (float*)(smem + 65536);
  float* acs = dts + 128;
  float* adt = acs + 128;
  if (tid < 128) {
    const float raw = bf2f(proj[(size_t)(t0 + tid) * LDP + 4608 + hh]);
    const float dtv = softplus_(raw + p.ssd_dt_bias[hh]);
    dts[tid] = dtv;
    adt[tid] = -__expf(p.ssd_a_log[hh]) * dtv;
  }
  __syncthreads();
  if (tid < 128) {
    float s = 0.f;
    for (int k = 0; k <= tid; ++k) s += adt[k];
    acs[tid] = s;
    ((float*)(ws + OFF_ACS))[(size_t)(t0 + tid) * 16 + hh] = s;
  }
  {
    const bf16_t* bact = (const bf16_t*)(ws + OFF_BACT);
    const int chunk = tid & 15;
#pragma unroll
    for (int i = 0; i < 8; ++i) {
      const int tt = (tid >> 4) + 16 * i;
      *(u32x4*)(Bm + sw256(tt, chunk)) = *(const u32x4*)(bact + (size_t)(t0 + tt) * 256 + g * 128 + chunk * 8);
    }
  }
  __syncthreads();
  const bf16_t* xact = (const bf16_t*)(ws + OFF_XACT);
  {
    const int pp = tid & 63;
    const int ch = hh * 64 + pp;
#pragma unroll
    for (int i = 0; i < 4; ++i) {
      const int chunk = (tid >> 6) * 4 + i;
      const int tt0 = chunk * 8;
      float o[8];
#pragma unroll
      for (int e = 0; e < 8; ++e) o[e] = bf2f(xact[(size_t)(t0 + tt0 + e) * 1024 + ch]) * dts[tt0 + e];
      u32x4 r = {pk2(o[0], o[1]), pk2(o[2], o[3]), pk2(o[4], o[5]), pk2(o[6], o[7])};
      *(u32x4*)(XT + sw256(pp, chunk)) = r;
    }
  }
  __syncthreads();
  bf16_t* ypart = (bf16_t*)(ws + OFF_YPART);
  const float Dh = p.ssd_d[hh];
#pragma unroll 1
  for (int mt = 0; mt < 2; ++mt) {
    const int M = wid * 2 + mt;
    const int lrow = M * 16 + l15;
    bf16x8 cf[4];
#pragma unroll
    for (int ks = 0; ks < 4; ++ks) cf[ks] = cfrag(p, proj, t0 + lrow, ts0 + lrow, g, ks * 32 + q4 * 8);
    const float acl = acs[lrow];
    const int ntmax = M | 1;
#pragma unroll 1
    for (int nt = 0; nt <= ntmax; ++nt) {
      f32x4 a4 = (f32x4){0, 0, 0, 0};
      if (nt <= M) {
#pragma unroll
        for (int ks = 0; ks < 4; ++ks) {
          bf16x8 bfr = *(const bf16x8*)(Bm + sw256(nt * 16 + l15, ks * 4 + q4));
          a4 = mfma16(bfr, cf[ks], a4);
        }
      }
      float pv[4];
#pragma unroll
      for (int r = 0; r < 4; ++r) {
        const int s = nt * 16 + q4 * 4 + r;
        pv[r] = (s <= lrow) ? a4[r] * __expf(acl - acs[s]) : 0.f;
      }
      u32x2 o = {pk2(pv[0], pv[1]), pk2(pv[2], pv[3])};
      const int chunk = nt * 2 + (q4 >> 1);
      *(u32x2*)(Pw + sw256(l15, chunk) + (q4 & 1) * 8) = o;
    }
    f32x4 ya[4];
#pragma unroll
    for (int pt = 0; pt < 4; ++pt) ya[pt] = (f32x4){0, 0, 0, 0};
    const int ksmax = M >> 1;
#pragma unroll 1
    for (int ks = 0; ks <= ksmax; ++ks) {
      bf16x8 pf = *(const bf16x8*)(Pw + sw256(l15, ks * 4 + q4));
#pragma unroll
      for (int pt = 0; pt < 4; ++pt) {
        bf16x8 xf = *(const bf16x8*)(XT + sw256(pt * 16 + l15, ks * 4 + q4));
        ya[pt] = mfma16(xf, pf, ya[pt]);
      }
    }
#pragma unroll
    for (int pt = 0; pt < 4; ++pt) {
      const int pc = pt * 16 + q4 * 4;
      const int ch = hh * 64 + pc;
      const u32x2 xv = *(const u32x2*)(xact + (size_t)(t0 + lrow) * 1024 + ch);
      float y0 = ya[pt][0] + Dh * bflo(xv[0]), y1 = ya[pt][1] + Dh * bfhi(xv[0]);
      float y2 = ya[pt][2] + Dh * bflo(xv[1]), y3 = ya[pt][3] + Dh * bfhi(xv[1]);
      u32x2 o = {pk2(y0, y1), pk2(y2, y3)};
      *(u32x2*)(ypart + (size_t)(t0 + lrow) * 1024 + ch) = o;
    }
  }
  {
    f32x4 sa[2][4];
#pragma unroll
    for (int i = 0; i < 2; ++i)
#pragma unroll
      for (int j = 0; j < 4; ++j) sa[i][j] = (f32x4){0, 0, 0, 0};
    const float aend = acs[127];
#pragma unroll 1
    for (int ks = 0; ks < 4; ++ks) {
      float dec[8];
#pragma unroll
      for (int e = 0; e < 8; ++e) dec[e] = __expf(aend - acs[ks * 32 + q4 * 8 + e]);
      bf16x8 bd[2];
#pragma unroll
      for (int ni = 0; ni < 2; ++ni) {
        const int n = wid * 32 + ni * 16 + l15;
        float v[8];
#pragma unroll
        for (int e = 0; e < 8; ++e) {
          const int l = ks * 32 + q4 * 8 + e;
          const bf16_t raw = *(const bf16_t*)(Bm + sw256(l, n >> 3) + (n & 7) * 2);
          v[e] = bf2f(raw) * dec[e];
        }
        u32x4 r = {pk2(v[0], v[1]), pk2(v[2], v[3]), pk2(v[4], v[5]), pk2(v[6], v[7])};
        bd[ni] = as_frag(r);
      }
#pragma unroll
      for (int pt = 0; pt < 4; ++pt) {
        bf16x8 xf = *(const bf16x8*)(XT + sw256(pt * 16 + l15, ks * 4 + q4));
#pragma unroll
        for (int ni = 0; ni < 2; ++ni) sa[ni][pt] = mfma16(bd[ni], xf, sa[ni][pt]);
      }
    }
    float* St = (float*)(ws + OFF_ST) + (size_t)((b * 16 + c) * 16 + hh) * 8192;
#pragma unroll
    for (int ni = 0; ni < 2; ++ni)
#pragma unroll
      for (int pt = 0; pt < 4; ++pt) {
        const int pr = pt * 16 + l15, n = wid * 32 + ni * 16 + q4 * 4;
        *(f32x4*)(St + pr * 128 + n) = sa[ni][pt];
      }
  }
  __syncthreads();
}

__device__ void phase_carry(const Params& p) {
  unsigned char* ws = p.ws;
  const int gt = blockIdx.x * NTHR + threadIdx.x, ng = gridDim.x * NTHR;
  const float* hloc = (const float*)(ws + OFF_HLOC);
  const float* cumA = (const float*)(ws + OFF_CUMA);
  float* lcarry = (float*)(ws + OFF_LCARRY);
  for (int i = gt; i < 8192; i += ng) {
    const int b = i >> 10, ch = i & 1023;
    float ca[16], hl[16];
#pragma unroll
    for (int c = 0; c < 16; ++c) {
      const size_t tl = (size_t)(b * 2048 + c * 128 + 127) * 1024 + ch;
      ca[c] = cumA[tl];
      hl[c] = hloc[tl];
    }
    float carry = 0.f;
#pragma unroll
    for (int c = 0; c < 16; ++c) {
      lcarry[(size_t)(b * 16 + c) * 1024 + ch] = carry;
      carry = ca[c] * carry + hl[c];
    }
  }
  const float* acsG = (const float*)(ws + OFF_ACS);
  float* St = (float*)(ws + OFF_ST);
  for (int i = gt; i < 128 * 2048; i += ng) {
    const int bh = i >> 11, e4 = i & 2047, b = bh >> 4, hh = bh & 15;
    f32x4 tmp[16];
    float Ad[16];
#pragma unroll
    for (int c = 0; c < 16; ++c) {
      Ad[c] = __expf(acsG[(size_t)(b * 2048 + c * 128 + 127) * 16 + hh]);
      tmp[c] = *(const f32x4*)(St + (size_t)((b * 16 + c) * 16 + hh) * 8192 + e4 * 4);
    }
    f32x4 s = (f32x4){0, 0, 0, 0};
#pragma unroll
    for (int c = 0; c < 16; ++c) {
      u32x2 o = {pk2(s[0], s[1]), pk2(s[2], s[3])};
      *(u32x2*)(sinb_ptr(ws, b, c, hh) + e4 * 4) = o;
      s = s * Ad[c] + tmp[c];
    }
  }
}

__device__ void ssd_final_unit(const Params& p, int unit) {
  const int tid = threadIdx.x & 255, lane = tid & 63, wid = tid >> 6, l15 = lane & 15, q4 = lane >> 4;
  const int hh = unit & 15, c = (unit >> 4) & 15, b = unit >> 8, g = hh >> 3;
  const int t0 = b * 2048 + c * 128, ts0 = c * 128;
  unsigned char* ws = p.ws;
  const bf16_t* proj = (const bf16_t*)(ws + OFF_PROJ);
  const bf16_t* Sin = sinb_ptr(ws, b, c, hh);
  const bf16_t* ypart = (const bf16_t*)(ws + OFF_YPART);
  const float* acsG = (const float*)(ws + OFF_ACS);
  bf16_t* A2 = (bf16_t*)(ws + OFF_XB);
  float* ssq = (float*)(ws + OFF_SSQ);
#pragma unroll 1
  for (int mt = 0; mt < 2; ++mt) {
    const int lrow = (wid * 2 + mt) * 16 + l15;
    f32x4 ya[4];
#pragma unroll
    for (int pt = 0; pt < 4; ++pt) ya[pt] = (f32x4){0, 0, 0, 0};
    if (c > 0) {
#pragma unroll 2
      for (int ks = 0; ks < 4; ++ks) {
        bf16x8 cf = cfrag(p, proj, t0 + lrow, ts0 + lrow, g, ks * 32 + q4 * 8);
#pragma unroll
        for (int pt = 0; pt < 4; ++pt) {
          const u32x4 r = *(const u32x4*)(Sin + (pt * 16 + l15) * 128 + ks * 32 + q4 * 8);
          ya[pt] = mfma16(as_frag(r), cf, ya[pt]);
        }
      }
    }
    const size_t t = (size_t)(t0 + lrow);
    const float ea = __expf(acsG[t * 16 + hh]);
    float ss = 0.f;
#pragma unroll
    for (int pt = 0; pt < 4; ++pt) {
      const int ch = hh * 64 + pt * 16 + q4 * 4;
      u32x2 yp = *(const u32x2*)(ypart + t * 1024 + ch);
      u32x2 zz = *(const u32x2*)(proj + t * LDP + 2048 + ch);
      float y[4] = {bflo(yp[0]) + ea * ya[pt][0], bfhi(yp[0]) + ea * ya[pt][1], bflo(yp[1]) + ea * ya[pt][2],
                    bfhi(yp[1]) + ea * ya[pt][3]};
      float z[4] = {bflo(zz[0]), bfhi(zz[0]), bflo(zz[1]), bfhi(zz[1])};
#pragma unroll
      for (int r = 0; r < 4; ++r) { y[r] = y[r] * silu_(z[r]); ss += y[r] * y[r]; }
      u32x2 o = {pk2(y[0], y[1]), pk2(y[2], y[3])};
      *(u32x2*)(A2 + t * DM + 1024 + ch) = o;
    }
    ss += __shfl_xor(ss, 16);
    ss += __shfl_xor(ss, 32);
    if (q4 == 0) ssq[t * 16 + hh] = ss;
  }
}

__device__ void phase_mix_final(const Params& p) {
  unsigned char* ws = p.ws;
  const bf16_t* proj = (const bf16_t*)(ws + OFF_PROJ);
  const f32x4* hloc = (const f32x4*)(ws + OFF_HLOC);
  const f32x4* cumA = (const f32x4*)(ws + OFF_CUMA);
  const float* lcarry = (const float*)(ws + OFF_LCARRY);
  bf16_t* A2 = (bf16_t*)(ws + OFF_XB);
  for (int u = blockIdx.x * 2 + (threadIdx.x >> 8); u < 2048; u += gridDim.x * 2) ssd_final_unit(p, u);
#pragma unroll 4
  for (int i = blockIdx.x * NTHR + threadIdx.x; i < T_TOK * 256; i += gridDim.x * NTHR) {
    const int t = i >> 8, ch = (i & 255) * 4;
    f32x4 h = hloc[i], ca = cumA[i];
    f32x4 cr = *(const f32x4*)(lcarry + (size_t)(t >> 7) * 1024 + ch);
    u32x2 gg = *(const u32x2*)(proj + (size_t)t * LDP + 1024 + ch);
    float y0 = (h[0] + ca[0] * cr[0]) * gelu_(bflo(gg[0]));
    float y1 = (h[1] + ca[1] * cr[1]) * gelu_(bfhi(gg[0]));
    float y2 = (h[2] + ca[2] * cr[2]) * gelu_(bflo(gg[1]));
    float y3 = (h[3] + ca[3] * cr[3]) * gelu_(bfhi(gg[1]));
    u32x2 o = {pk2(y0, y1), pk2(y2, y3)};
    *(u32x2*)(A2 + (size_t)t * DM + ch) = o;
  }
}

__device__ void convert_uv(const Params& p) {
  unsigned char* ws = p.ws;
  const int lane = threadIdx.x & 63, wid = threadIdx.x >> 6;
  unsigned char* tb = ws + OFF_XB;
  float* scales = (float*)(ws + OFF_SCALES);
  for (int row = blockIdx.x * 8 + wid; row < 32768; row += gridDim.x * 8) {
    const bool isv = row >= 16384;
    const int e = row & 16383;
    const float* src = (isv ? p.peer_v : p.peer_u) + (size_t)e * DM + lane * 32;
    float vals[32];
    float ss = 0.f;
#pragma unroll
    for (int q = 0; q < 8; ++q) {
      f32x4 t = *(const f32x4*)(src + q * 4);
      if (!isv) t *= *(const f32x4*)(p.norm_ffn_w + lane * 32 + q * 4);
#pragma unroll
      for (int k = 0; k < 4; ++k) {
        vals[q * 4 + k] = t[k];
        ss += t[k] * t[k];
      }
    }
    ss = wave_sum(ss);
    const float rms = sqrtf(ss * (1.f / 2048.f));
    const float sc = rms * (2.6f / 7.f);
    const float inv = sc > 0.f ? 1.f / sc : 0.f;
    u32x4 o;
#pragma unroll
    for (int m = 0; m < 4; ++m) {
      unsigned w = 0;
#pragma unroll
      for (int j = 0; j < 4; ++j) {
        const float lo = fminf(fmaxf(rintf(vals[m * 8 + j] * inv), -7.f), 7.f);
        const float hi = fminf(fmaxf(rintf(vals[m * 8 + 4 + j] * inv), -7.f), 7.f);
        const unsigned bl = (unsigned)((int)lo + 8), bh = (unsigned)((int)hi + 8);
        w |= (bl | (bh << 4)) << (8 * j);
      }
      o[m] = w;
    }
    *(u32x4*)(tb + (size_t)row * 1024 + lane * 16) = o;
    if (lane == 0) scales[row] = sc;
  }
}

__device__ const unsigned char cand_tab[64] = {
    0x00, 0x01, 0x02, 0x03, 0x04, 0x05, 0x06, 0x07, 0x08, 0x09, 0x0a, 0x0b, 0x0c, 0x0d, 0x0e, 0x0f,
    0x10, 0x11, 0x12, 0x13, 0x14, 0x15, 0x16, 0x17,
    0x20, 0x21, 0x22, 0x23, 0x24,
    0x30, 0x31, 0x32, 0x33,
    0x40, 0x41, 0x42,
    0x50, 0x51, 0x60, 0x61, 0x70, 0x71,
    0x80, 0x90, 0xa0, 0xb0, 0xc0, 0xd0, 0xe0, 0xf0,
    0xff, 0xff, 0xff, 0xff, 0xff, 0xff, 0xff, 0xff, 0xff, 0xff, 0xff, 0xff, 0xff, 0xff};

__device__ __forceinline__ unsigned ord_key(float f) {
  unsigned u = __float_as_uint(f);
  return u ^ ((u >> 31) ? 0xffffffffu : 0x80000000u);
}
__device__ __forceinline__ float ord_dec(unsigned k) {
  unsigned u = (k >> 31) ? (k ^ 0x80000000u) : ~k;
  return __uint_as_float(u);
}

__device__ void topk_unit(const Params& p, unsigned char* smem, int unit) {
  const int tid = threadIdx.x & 255, lane = tid & 63, wid = tid >> 6, l15 = lane & 15, q4 = lane >> 4;
  const int h = unit & 7, tile = unit >> 3;
  const int tok0 = tile * 64 + wid * 16;
  unsigned char* ws = p.ws;
  const bf16_t* qg = (const bf16_t*)(ws + OFF_Q);
  const bf16_t* kb = (const bf16_t*)(ws + OFF_KEYSB);
  unsigned* S = (unsigned*)(smem + wid * 16640);
  float* tops = (float*)(smem + 4 * 16640 + wid * 256);
  int* topi = (int*)(tops + 32);
  unsigned* Ms = (unsigned*)(smem + 67584 + wid * 768);
#pragma unroll
  for (int k = 0; k < 2; ++k) {
    f32x4 sc[8];
#pragma unroll
    for (int i = 0; i < 8; ++i) sc[i] = (f32x4){0, 0, 0, 0};
#pragma unroll
    for (int ks = 0; ks < 4; ++ks) {
      bf16x8 qf = as_frag(*(const u32x4*)(qg + (size_t)(tok0 + l15) * DM + h * 256 + k * 128 + ks * 32 + q4 * 8));
#pragma unroll
      for (int nt = 0; nt < 8; ++nt) {
        bf16x8 kf = as_frag(*(const u32x4*)(kb + (size_t)((h * 2 + k) * 128 + nt * 16 + l15) * 128 + ks * 32 + q4 * 8));
        sc[nt] = mfma16(kf, qf, sc[nt]);
      }
    }
#pragma unroll
    for (int nt = 0; nt < 8; ++nt) {
      const int n = nt * 16 + q4 * 4;
      u32x4 kk;
#pragma unroll
      for (int r = 0; r < 4; ++r) kk[r] = (ord_key(sc[nt][r]) & ~127u) | (unsigned)(127 - (n + r));
      *(u32x4*)(S + l15 * 260 + k * 128 + n) = kk;
    }
  }
  const unsigned ct = cand_tab[lane];
  const int ca = ct >> 4, cbb = ct & 15;
  int* idxo = (int*)(ws + OFF_IDX);
  float* go = (float*)(ws + OFF_G);
  for (int tk = 0; tk < 16; ++tk) {
    const unsigned* row = S + tk * 260;
    unsigned ka[2], kb[2], mxk[2];
#pragma unroll
    for (int hf = 0; hf < 2; ++hf) {
      ka[hf] = row[hf * 128 + lane];
      kb[hf] = row[hf * 128 + 64 + lane];
      mxk[hf] = ka[hf] > kb[hf] ? ka[hf] : kb[hf];
      Ms[hf * 96 + lane] = mxk[hf];
    }
    int cnt[2][4];
#pragma unroll
    for (int hf = 0; hf < 2; ++hf)
#pragma unroll
      for (int e = 0; e < 4; ++e) cnt[hf][e] = 0;
#pragma unroll
    for (int j = 0; j < 16; ++j)
#pragma unroll
      for (int hf = 0; hf < 2; ++hf) {
        u32x4 x = *(const u32x4*)(Ms + hf * 96 + j * 4);
#pragma unroll
        for (int e = 0; e < 4; ++e) cnt[hf][e] += (x[e] > mxk[hf]) ? 1 : 0;
      }
    bool ca_[2], cb_[2];
    int pa[2], pb[2], ncand[2];
    const unsigned long long lt = (1ull << lane) - 1ull;
#pragma unroll
    for (int hf = 0; hf < 2; ++hf) {
      const int c_ = cnt[hf][0] + cnt[hf][1] + cnt[hf][2] + cnt[hf][3];
      const unsigned long long bm = __ballot(c_ == 15);
      const int srcT = __ffsll((long long)bm) - 1;
      const unsigned T0 = (unsigned)__shfl((int)mxk[hf], srcT);
      ca_[hf] = ka[hf] >= T0;
      cb_[hf] = kb[hf] >= T0;
      const unsigned long long ba = __ballot(ca_[hf]), bb = __ballot(cb_[hf]);
      const int na = __popcll(ba);
      pa[hf] = __popcll(ba & lt);
      pb[hf] = na + __popcll(bb & lt);
      ncand[hf] = na + __popcll(bb);
    }
#pragma unroll
    for (int hf = 0; hf < 2; ++hf) {
      unsigned* Cs = Ms + hf * 96 + 64;
      if (lane < 32) Cs[lane] = 0u;
      if (ca_[hf]) Cs[pa[hf]] = ka[hf];
      if (cb_[hf]) Cs[pb[hf]] = kb[hf];
    }
    unsigned my[2];
    int rk2[2][4];
#pragma unroll
    for (int hf = 0; hf < 2; ++hf) {
      my[hf] = Ms[hf * 96 + 64 + (lane & 31)];
#pragma unroll
      for (int e = 0; e < 4; ++e) rk2[hf][e] = 0;
    }
#pragma unroll
    for (int j = 0; j < 8; ++j)
#pragma unroll
      for (int hf = 0; hf < 2; ++hf) {
        u32x4 x = *(const u32x4*)(Ms + hf * 96 + 64 + j * 4);
#pragma unroll
        for (int e = 0; e < 4; ++e) rk2[hf][e] += (x[e] > my[hf]) ? 1 : 0;
      }
#pragma unroll
    for (int hf = 0; hf < 2; ++hf) {
      const int r_ = rk2[hf][0] + rk2[hf][1] + rk2[hf][2] + rk2[hf][3];
      if (lane < ncand[hf] && r_ < 16) {
        tops[hf * 16 + r_] = ord_dec(my[hf] & ~127u);
        topi[hf * 16 + r_] = 127 - (int)(my[hf] & 127u);
      }
    }
    float cs = 0.f;
    unsigned ck = 0u;
    if (lane < 50) {
      cs = tops[ca] + tops[16 + cbb];
      ck = (ord_key(cs) & ~255u) | (unsigned)(255 - (ca * 16 + cbb));
    }
    int rkA = 0, rkB = 0;
#pragma unroll
    for (int j = 0; j < 50; j += 2) {
      const unsigned oj = (unsigned)__builtin_amdgcn_readlane((int)ck, j);
      const unsigned oj2 = (unsigned)__builtin_amdgcn_readlane((int)ck, j + 1);
      rkA += (oj > ck) ? 1 : 0;
      rkB += (oj2 > ck) ? 1 : 0;
    }
    const int rk = rkA + rkB;
    const float mx = tops[0] + tops[16];
    const bool sel = (lane < 50) && (rk < 16);
    const float ev = sel ? __expf(cs - mx) : 0.f;
    const float sum = wave_sum(ev);
    if (sel) {
      const size_t o = (size_t)(tok0 + tk) * 128 + h * 16 + rk;
      idxo[o] = topi[ca] * 128 + topi[16 + cbb];
      go[o] = ev * __builtin_amdgcn_rcpf(sum);
    }
  }
}

__device__ __forceinline__ float ub0(unsigned w) { return (float)(w & 0xffu); }
__device__ __forceinline__ float ub1(unsigned w) { return (float)((w >> 8) & 0xffu); }
__device__ __forceinline__ float ub2(unsigned w) { return (float)((w >> 16) & 0xffu); }
__device__ __forceinline__ float ub3(unsigned w) { return (float)(w >> 24); }

#define GROWS 8
#ifndef USE_SDOT4
#define USE_SDOT4 1
#endif
typedef float f32x2 __attribute__((ext_vector_type(2)));
__device__ void phase_gather(const Params& p) {
  const int tid = threadIdx.x, lane = tid & 63, wid = tid >> 6;
  unsigned char* ws = p.ws;
  const unsigned char* ub = ws + OFF_XB;
  const unsigned char* vb = ws + OFF_XB + 16 * MIB;
  const float* scales = (const float*)(ws + OFF_SCALES);
  const int* idxg = (const int*)(ws + OFF_IDX);
  const float* gg = (const float*)(ws + OFF_G);
  const float* ssq2 = (const float*)(ws + OFF_SSQ2);
  const bool b5 = (lane & 32) != 0, b4 = (lane & 16) != 0, b3 = (lane & 8) != 0;
  const int srcl = ((lane & 1) << 3) | (((lane >> 1) & 1) << 4) | (((lane >> 2) & 1) << 5);
  for (int t = blockIdx.x * 8 + wid; t < T_TOK; t += gridDim.x * 8) {
    const int id0 = idxg[(size_t)t * 128 + lane], id1 = idxg[(size_t)t * 128 + 64 + lane];
    const float g0 = gg[(size_t)t * 128 + lane], g1 = gg[(size_t)t * 128 + 64 + lane];
    const float su0 = scales[id0], su1 = scales[id1], sv0 = scales[16384 + id0], sv1 = scales[16384 + id1];
    float* orow = p.out + (size_t)t * DM + lane * 32;
    int xlo[4], xhi[4];
    float sx;
    int sumq;
    {
      float xr[32];
      float amax = 0.f;
#pragma unroll
      for (int q = 0; q < 8; ++q) {
        f32x4 v = *(const f32x4*)(orow + q * 4);
#pragma unroll
        for (int k = 0; k < 4; ++k) { xr[q * 4 + k] = v[k]; amax = fmaxf(amax, fabsf(v[k])); }
      }
#pragma unroll
      for (int o = 32; o > 0; o >>= 1) amax = fmaxf(amax, __shfl_xor(amax, o));
      sx = amax * (1.f / 127.f);
      const float inv = amax > 0.f ? 127.f / amax : 0.f;
      int sq_ = 0;
#pragma unroll
      for (int m = 0; m < 4; ++m) {
        unsigned wl = 0, wh = 0;
#pragma unroll
        for (int j = 0; j < 4; ++j) {
          const int a_ = __float2int_rn(xr[m * 8 + j] * inv), b_ = __float2int_rn(xr[m * 8 + 4 + j] * inv);
          sq_ += a_ + b_;
          wl |= ((unsigned)a_ & 0xffu) << (8 * j);
          wh |= ((unsigned)b_ & 0xffu) << (8 * j);
        }
        xlo[m] = (int)wl;
        xhi[m] = (int)wh;
      }
#pragma unroll
      for (int o = 32; o > 0; o >>= 1) sq_ += __shfl_xor(sq_, o);
      sumq = sq_;
    }
    float sq = (lane < 32) ? ssq2[(size_t)t * 32 + lane] : 0.f;
    sq = wave_sum(sq);
    const float rs2 = rsqrtf(sq * (1.f / 2048.f) + EPSV);
    float w0 = 0.f, w1 = 0.f;
#pragma unroll 1
    for (int half = 0; half < 2; ++half) {
      const int idv = half ? id1 : id0;
      int wv = 0;
      u32x4 rr[3][GROWS];
#pragma unroll
      for (int k = 0; k < GROWS; ++k) {
        const int e = __builtin_amdgcn_readlane(idv, k);
        rr[0][k] = *(const u32x4*)(ub + (size_t)e * 1024 + lane * 16);
        const int e2 = __builtin_amdgcn_readlane(idv, GROWS + k);
        rr[1][k] = *(const u32x4*)(ub + (size_t)e2 * 1024 + lane * 16);
      }
#pragma unroll
      for (int gi = 0; gi < 64 / GROWS; ++gi) {
        const int j0 = gi * GROWS;
        if (gi + 2 < 64 / GROWS) {
#pragma unroll
          for (int k = 0; k < GROWS; ++k) {
            const int e = __builtin_amdgcn_readlane(idv, j0 + 2 * GROWS + k);
            rr[(gi + 2) % 3][k] = *(const u32x4*)(ub + (size_t)e * 1024 + lane * 16);
          }
        }
        int dv[GROWS];
#pragma unroll
        for (int k = 0; k < GROWS; ++k) {
          int d = 0;
#pragma unroll
          for (int m = 0; m < 4; ++m) {
            const unsigned w = rr[gi % 3][k][m];
            const int lo = (int)(w & 0x0f0f0f0fu), hi = (int)((w >> 4) & 0x0f0f0f0fu);
            d = __builtin_amdgcn_sdot4(lo, xlo[m], d, false);
            d = __builtin_amdgcn_sdot4(hi, xhi[m], d, false);
          }
          dv[k] = d;
        }
        int a4[4], a2[2];
#pragma unroll
        for (int k = 0; k < 4; ++k) {
          const int mine = b5 ? dv[k + 4] : dv[k], oth = b5 ? dv[k] : dv[k + 4];
          a4[k] = mine + __shfl_xor(oth, 32);
        }
#pragma unroll
        for (int k = 0; k < 2; ++k) {
          const int mine = b4 ? a4[k + 2] : a4[k], oth = b4 ? a4[k] : a4[k + 2];
          a2[k] = mine + __shfl_xor(oth, 16);
        }
        int c1;
        {
          const int mine = b3 ? a2[1] : a2[0], oth = b3 ? a2[0] : a2[1];
          c1 = mine + __shfl_xor(oth, 8);
        }
        c1 += __shfl_xor(c1, 4);
        c1 += __shfl_xor(c1, 2);
        c1 += __shfl_xor(c1, 1);
        const int val = __shfl(c1, srcl);
        if ((lane & ~7) == j0) wv = val;
      }
      const float su = half ? su1 : su0;
      const float a = gelu_((float)(wv - 8 * sumq) * (su * sx * rs2));
      if (half) w1 = a * g1 * sv1; else w0 = a * g0 * sv0;
    }
    float wmax = fmaxf(fabsf(w0), fabsf(w1));
#pragma unroll
    for (int o = 32; o > 0; o >>= 1) wmax = fmaxf(wmax, __shfl_xor(wmax, o));
    const float sw = wmax * (1.f / 127.f);
    const float winv = wmax > 0.f ? 127.f / wmax : 0.f;
    const int q0 = __float2int_rn(w0 * winv), q1 = __float2int_rn(w1 * winv);
    int wsumq = q0 + q1;
#pragma unroll
    for (int o = 32; o > 0; o >>= 1) wsumq += __shfl_xor(wsumq, o);
    int pk0 = (int)(((unsigned)q0 & 0xffu) << (8 * (lane & 3))), pk1 = (int)(((unsigned)q1 & 0xffu) << (8 * (lane & 3)));
    pk0 |= __shfl_xor(pk0, 1); pk0 |= __shfl_xor(pk0, 2);
    pk1 |= __shfl_xor(pk1, 1); pk1 |= __shfl_xor(pk1, 2);
    int acc[32];
#pragma unroll
    for (int i = 0; i < 32; ++i) acc[i] = 0;
#pragma unroll 1
    for (int half = 0; half < 2; ++half) {
      const int idv = half ? id1 : id0;
      const int pkv = half ? pk1 : pk0;
      u32x4 rr[3][GROWS];
#pragma unroll
      for (int k = 0; k < GROWS; ++k) {
        const int e = __builtin_amdgcn_readlane(idv, k);
        rr[0][k] = *(const u32x4*)(vb + (size_t)e * 1024 + lane * 16);
        const int e2 = __builtin_amdgcn_readlane(idv, GROWS + k);
        rr[1][k] = *(const u32x4*)(vb + (size_t)e2 * 1024 + lane * 16);
      }
#pragma unroll
      for (int gi = 0; gi < 64 / GROWS; ++gi) {
        const int j0 = gi * GROWS;
        if (gi + 2 < 64 / GROWS) {
#pragma unroll
          for (int k = 0; k < GROWS; ++k) {
            const int e = __builtin_amdgcn_readlane(idv, j0 + 2 * GROWS + k);
            rr[(gi + 2) % 3][k] = *(const u32x4*)(vb + (size_t)e * 1024 + lane * 16);
          }
        }
#pragma unroll
        for (int sub = 0; sub < GROWS / 4; ++sub) {
          const int W4 = __builtin_amdgcn_readlane(pkv, j0 + 4 * sub);
#pragma unroll
          for (int m = 0; m < 4; ++m) {
            unsigned lo[4], hi[4];
#pragma unroll
            for (int k = 0; k < 4; ++k) {
              const unsigned w = rr[gi % 3][sub * 4 + k][m];
              lo[k] = w & 0x0f0f0f0fu;
              hi[k] = (w >> 4) & 0x0f0f0f0fu;
            }
            {
              const unsigned p01l = __builtin_amdgcn_perm(lo[1], lo[0], 0x05010400u), p01h = __builtin_amdgcn_perm(lo[1], lo[0], 0x07030602u);
              const unsigned p23l = __builtin_amdgcn_perm(lo[3], lo[2], 0x05010400u), p23h = __builtin_amdgcn_perm(lo[3], lo[2], 0x07030602u);
              acc[m * 8 + 0] = __builtin_amdgcn_sdot4((int)__builtin_amdgcn_perm(p23l, p01l, 0x05040100u), W4, acc[m * 8 + 0], false);
              acc[m * 8 + 1] = __builtin_amdgcn_sdot4((int)__builtin_amdgcn_perm(p23l, p01l, 0x07060302u), W4, acc[m * 8 + 1], false);
              acc[m * 8 + 2] = __builtin_amdgcn_sdot4((int)__builtin_amdgcn_perm(p23h, p01h, 0x05040100u), W4, acc[m * 8 + 2], false);
              acc[m * 8 + 3] = __builtin_amdgcn_sdot4((int)__builtin_amdgcn_perm(p23h, p01h, 0x07060302u), W4, acc[m * 8 + 3], false);
            }
            {
              const unsigned p01l = __builtin_amdgcn_perm(hi[1], hi[0], 0x05010400u), p01h = __builtin_amdgcn_perm(hi[1], hi[0], 0x07030602u);
              const unsigned p23l = __builtin_amdgcn_perm(hi[3], hi[2], 0x05010400u), p23h = __builtin_amdgcn_perm(hi[3], hi[2], 0x07030602u);
              acc[m * 8 + 4] = __builtin_amdgcn_sdot4((int)__builtin_amdgcn_perm(p23l, p01l, 0x05040100u), W4, acc[m * 8 + 4], false);
              acc[m * 8 + 5] = __builtin_amdgcn_sdot4((int)__builtin_amdgcn_perm(p23l, p01l, 0x07060302u), W4, acc[m * 8 + 5], false);
              acc[m * 8 + 6] = __builtin_amdgcn_sdot4((int)__builtin_amdgcn_perm(p23h, p01h, 0x05040100u), W4, acc[m * 8 + 6], false);
              acc[m * 8 + 7] = __builtin_amdgcn_sdot4((int)__builtin_amdgcn_perm(p23h, p01h, 0x07060302u), W4, acc[m * 8 + 7], false);
            }
          }
        }
      }
    }
    float val[32];
    float ss = 0.f;
    const int off8 = 8 * wsumq;
#pragma unroll
    for (int q = 0; q < 8; ++q) {
      f32x4 v = *(const f32x4*)(orow + q * 4);
#pragma unroll
      for (int k = 0; k < 4; ++k) {
        val[q * 4 + k] = sw * (float)(acc[q * 4 + k] - off8) + v[k];
        ss += val[q * 4 + k] * val[q * 4 + k];
      }
    }
    ss = wave_sum(ss);
    const float rs3 = rsqrtf(ss * (1.f / 2048.f) + EPSV);
#pragma unroll
    for (int q = 0; q < 8; ++q) {
      f32x4 wf = *(const f32x4*)(p.norm_final_w + lane * 32 + q * 4);
      f32x4 o = {val[q * 4 + 0] * rs3 * wf[0], val[q * 4 + 1] * rs3 * wf[1], val[q * 4 + 2] * rs3 * wf[2],
                 val[q * 4 + 3] * rs3 * wf[3]};
      *(f32x4*)(orow + q * 4) = o;
    }
  }
}

#define XB_TMO      128
#define XB_XCNT(j)  (256  + 64 * (j))
#define XB_XSUB(j)  (1280 + 64 * (j))
#define XB_XGEN(j)  (2304 + 64 * (j))
#define XB_TOP      3328
#define XB_TOPGEN   3392
#define XCD_BAR_WORDS 3456
#define XB_SPIN_CAP (1u << 18)
#define XLAS __attribute__((address_space(3)))
__device__ __forceinline__ unsigned xb_ld(unsigned* p) { return __hip_atomic_load(p, __ATOMIC_RELAXED, __HIP_MEMORY_SCOPE_AGENT); }
__device__ __forceinline__ unsigned xb_add(unsigned* p, unsigned v) { return __hip_atomic_fetch_add(p, v, __ATOMIC_RELAXED, __HIP_MEMORY_SCOPE_AGENT); }
__device__ __forceinline__ unsigned xb_xcc_id() { return (unsigned)__builtin_amdgcn_s_getreg((3 << 11) | 20) & 0xFu; }
#define XB_SPIN(cond, bar) do { unsigned _sp = 0; while (cond) { __builtin_amdgcn_s_sleep(1); \
    if ((++_sp & 255u) == 0u) { if (xb_ld(&(bar)[XB_TMO])) break; if (_sp > XB_SPIN_CAP) { atomicAdd(&(bar)[XB_TMO], 1u); break; } } } } while (0)
struct XcdBarrier { unsigned* bar; unsigned x; volatile XLAS unsigned* st; };
__device__ __forceinline__ XcdBarrier xcd_barrier_post(unsigned* bar, volatile XLAS unsigned* st) {
  XcdBarrier b; b.bar = bar; b.x = xb_xcc_id(); b.st = st;
  if (threadIdx.x == 0) (void)xb_add(&bar[XB_XCNT(b.x)], 1u);
  return b;
}
__device__ __forceinline__ void xcd_barrier_complete(unsigned* bar, unsigned x, unsigned& nloc, unsigned& nx) {
  const unsigned G = gridDim.x * gridDim.y * gridDim.z;
  unsigned sum, cnt, mine, sp = 0u;
  for (;;) {
    sum = 0u; cnt = 0u; mine = 0u;
#pragma unroll
    for (unsigned j = 0; j < 16; ++j) { const unsigned c = xb_ld(&bar[XB_XCNT(j)]); sum += c; cnt += (c > 0u) ? 1u : 0u; mine = (j == x) ? c : mine; }
    if (sum == G) break;
    __builtin_amdgcn_s_sleep(1);
    if ((++sp & 255u) == 0u) { if (xb_ld(&bar[XB_TMO])) break; if (sp > XB_SPIN_CAP) { atomicAdd(&bar[XB_TMO], 1u); break; } }
  }
  nloc = mine > 0u ? mine : 1u; nx = cnt > 0u ? cnt : 1u;
}
__device__ __forceinline__ void xcd_barrier(const XcdBarrier& b) {
  asm volatile("s_waitcnt vmcnt(0)" ::: "memory");
  __syncthreads();
  if (threadIdx.x == 0) {
    unsigned* bar = b.bar;
    __builtin_amdgcn_s_waitcnt(0);
    unsigned nloc = b.st[0], nx = b.st[1];
    if (nloc == 0u) { xcd_barrier_complete(bar, b.x, nloc, nx); b.st[0] = nloc; b.st[1] = nx; }
    const unsigned old = xb_add(&bar[XB_XSUB(b.x)], 1u);
    const unsigned gen = old / nloc;
    if (old + 1u == (gen + 1u) * nloc) {
      __builtin_amdgcn_fence(__ATOMIC_RELEASE, "agent");
      asm volatile("s_waitcnt vmcnt(0)" ::: "memory");
      const unsigned og = xb_add(&bar[XB_TOP], 1u);
      const unsigned tg = og / nx;
      if (og + 1u == (tg + 1u) * nx) xb_add(&bar[XB_TOPGEN], 1u);
      else XB_SPIN(xb_ld(&bar[XB_TOPGEN]) == tg, bar);
      __builtin_amdgcn_fence(__ATOMIC_ACQUIRE, "agent");
      xb_add(&bar[XB_XGEN(b.x)], 1u);
      asm volatile("s_waitcnt vmcnt(0)" ::: "memory");
    } else {
      XB_SPIN(xb_ld(&bar[XB_XGEN(b.x)]) == gen, bar);
      __builtin_amdgcn_fence(__ATOMIC_ACQUIRE, "agent");
      asm volatile("s_waitcnt vmcnt(0)" ::: "memory");
    }
  }
  __syncthreads();
}

__global__ void __launch_bounds__(NTHR, 2) fwd_kernel(Params p) {
  __shared__ __attribute__((aligned(16))) unsigned char smem[SMEM_BYTES];
  __shared__ uint4 xb_words;
  cg::grid_group grid = cg::this_grid();
  unsigned char* ws = p.ws;
  if (threadIdx.x == 0) xb_words = make_uint4(0u, 0u, 0u, 0u);
  __syncthreads();
  XcdBarrier xb = xcd_barrier_post((unsigned*)(ws + OFF_BAR), (volatile XLAS unsigned*)&xb_words);
  const int hb = threadIdx.x >> 8;
  unsigned char* hsm = smem + hb * SMEM_HALF;
#define PHASE_ON(n) (p.phase_lo <= (n) && (n) <= p.phase_hi)
#define PHASE_SYNC(n) if (p.coop && PHASE_ON(n) && (n) < p.phase_hi) { if (p.coop == 2) grid.sync(); else xcd_barrier(xb); }
  if (PHASE_ON(0)) phase_prep(p, smem);
  PHASE_SYNC(0)
  if (PHASE_ON(1)) {
    pg8::Gemm g{(const bf16_t*)(ws + OFF_XB), (const bf16_t*)(ws + OFF_WINT), T_TOK, NPAD1, 2048};
    pg8::SimpleOrder S; S.init(T_TOK, NPAD1, gridDim.x, blockIdx.x);
    pg8::Epi1 E{(const float*)(ws + OFF_RS1), (bf16_t*)(ws + OFF_PROJ)};
    pg8::gemm_phase<pg8::Epi1, pg8::SimpleOrder, 0>((PG8_LAS unsigned char*)smem, g, S, E);
  }
  PHASE_SYNC(1)
  if (PHASE_ON(2)) {
    conv_prepass(p);
    if (p.coop) xcd_barrier(xb);
    for (int u0 = blockIdx.x * 2; u0 < 2048; u0 += gridDim.x * 2) ssd_local_unit(p, hsm, u0 + hb);
    for (int u0 = blockIdx.x * 2; u0 < 2048; u0 += gridDim.x * 2) lru_local_unit(p, hsm, u0 + hb);
  }
  PHASE_SYNC(2)
  if (PHASE_ON(3)) phase_carry(p);
  PHASE_SYNC(3)
  if (PHASE_ON(4)) phase_mix_final(p);
  PHASE_SYNC(4)
  if (PHASE_ON(5)) {
    pg8::Gemm g{(const bf16_t*)(ws + OFF_XB), (const bf16_t*)(ws + OFF_WOUTT), T_TOK, 2048, 2048};
    pg8::SimpleOrder S; S.init(T_TOK, 2048, gridDim.x, blockIdx.x);
    pg8::Epi2 E{p.x, p.out, (bf16_t*)(ws + OFF_X1B), (float*)(ws + OFF_SSQ2), (const float*)(ws + OFF_SSQ)};
    pg8::gemm_phase<pg8::Epi2, pg8::SimpleOrder, 16>((PG8_LAS unsigned char*)smem, g, S, E);
  }
  PHASE_SYNC(5)
  if (PHASE_ON(6)) {
    pg8::Gemm g{(const bf16_t*)(ws + OFF_X1B), (const bf16_t*)(ws + OFF_WQT), T_TOK, 2048, 2048};
    pg8::SimpleOrder S; S.init(T_TOK, 2048, gridDim.x, blockIdx.x);
    pg8::Epi3 E{(const float*)(ws + OFF_SSQ2), (bf16_t*)(ws + OFF_Q)};
    pg8::gemm_phase<pg8::Epi3, pg8::SimpleOrder, 0>((PG8_LAS unsigned char*)smem, g, S, E);
    convert_uv(p);
  }
  PHASE_SYNC(6)
  if (PHASE_ON(7)) {
    for (int u = blockIdx.x * 2 + hb; u < 2048; u += gridDim.x * 2) topk_unit(p, hsm, u);
  }
  PHASE_SYNC(7)
  if (PHASE_ON(8)) phase_gather(p);
}

extern "C" void kernel_launch(void* const* d_in, const int* in_sizes, int n_in, void* d_out, int out_size,
                              void* d_ws, size_t ws_size, hipStream_t stream) {
  Params p{};
  const float** fp = (const float**)&p;
  for (int i = 0; i < 23; ++i) fp[i] = (const float*)d_in[i];
  p.out = (float*)d_out;
  p.ws = (unsigned char*)d_ws;
  static int grid_blocks = 0;
  if (!grid_blocks) {
    int dev = 0, cus = 0, per_cu = 0;
    hipGetDevice(&dev);
    hipDeviceGetAttribute(&cus, hipDeviceAttributeMultiprocessorCount, dev);
    hipOccupancyMaxActiveBlocksPerMultiprocessor(&per_cu, fwd_kernel, NTHR, 0);
    if (per_cu < 1) per_cu = 1;
    if (per_cu > 1) per_cu = 1;
    grid_blocks = cus * per_cu;
  }
#if SINGLE_LAUNCH
  p.phase_lo = 0; p.phase_hi = 8; p.coop = 1;
  hipMemsetAsync((unsigned char*)d_ws + OFF_BAR, 0, XCD_BAR_WORDS * sizeof(unsigned), stream);
  void* args[] = {&p};
  hipError_t e = hipLaunchCooperativeKernel((void*)fwd_kernel, dim3(grid_blocks), dim3(NTHR), args, 0, stream);
  if (e != hipSuccess) fprintf(stderr, "cooperative launch failed: %s (grid %d)\n", hipGetErrorString(e), grid_blocks);
#else
  for (int ph = 0; ph <= 8; ++ph) {
    p.phase_lo = ph; p.phase_hi = ph; p.coop = 0;
    hipLaunchKernelGGL(fwd_kernel, dim3(grid_blocks), dim3(NTHR), 0, stream, p);
  }
#endif
}
```

```cpp
#include <hip/hip_runtime.h>
#include <hip/hip_cooperative_groups.h>
#include <cstdio>
namespace cg = cooperative_groups;

#ifndef DBL_PHASE
#define DBL_PHASE -1
#endif
#ifndef SINGLE_LAUNCH
#define SINGLE_LAUNCH 1
#endif

typedef unsigned short bf16_t;
typedef short bf16x8 __attribute__((ext_vector_type(8)));
typedef float f32x4 __attribute__((ext_vector_type(4)));
typedef unsigned u32x4 __attribute__((ext_vector_type(4)));
typedef unsigned u32x2 __attribute__((ext_vector_type(2)));
typedef __bf16 bf2_t __attribute__((ext_vector_type(2)));

#define T_TOK 16384
#define DM 2048
#define LDP 4736
#define NPAD1 4864
#define NTHR 512
#define HTHR 256
#define SMEM_HALF 73728
#define SMEM_BYTES 147456
#define EPSV 1e-6f
#define MIB ((size_t)1 << 20)

#define OFF_XB (0 * MIB)
#define OFF_PROJ (64 * MIB)
#define OFF_X1B (64 * MIB)
#define OFF_Q (128 * MIB)
#define OFF_IDX (192 * MIB)
#define OFF_G (200 * MIB)
#define OFF_HLOC (212 * MIB)
#define OFF_CUMA (276 * MIB)
#define OFF_YPART (340 * MIB)
#define OFF_ST (372 * MIB)
#define OFF_WINT (436 * MIB)
#define OFF_WOUTT (455 * MIB)
#define OFF_WQT (463 * MIB)
#define OFF_WAT (471 * MIB)
#define OFF_WXT (471 * MIB + 131072)
#define OFF_KEYSB (471 * MIB + 262144)
#define OFF_RS1 (472 * MIB)
#define OFF_ACS (472 * MIB + 65536)
#define OFF_LCARRY (OFF_ACS + MIB)
#define OFF_SSQ (OFF_LCARRY + 524288)
#define OFF_SSQ2 (OFF_SSQ + MIB)
#define OFF_SCALES (OFF_SSQ2 + 2 * MIB)
#define OFF_XACT (0 * MIB)
#define OFF_BACT (32 * MIB)
#define OFF_SINB_LO OFF_WINT
#define OFF_SINB_HI (488 * MIB)
#define OFF_BAR (487 * MIB)
#define OFF_CACT (478 * MIB)

struct Params {
  const float *x, *norm_mix_w, *w_in, *lru_conv_w, *lru_conv_b, *lru_wa, *lru_ba, *lru_wx, *lru_bx, *lru_lambda;
  const float *ssd_conv_w, *ssd_conv_b, *ssd_dt_bias, *ssd_a_log, *ssd_d, *ssd_norm_w, *w_out, *norm_ffn_w, *peer_wq;
  const float *peer_sub_keys, *peer_u, *peer_v, *norm_final_w;
  float* out;
  unsigned char* ws;
  int phase_lo, phase_hi, coop, pad0;
};

__device__ __forceinline__ unsigned pk2(float lo, float hi) {
  unsigned r;
  asm("v_cvt_pk_bf16_f32 %0, %1, %2" : "=v"(r) : "v"(lo), "v"(hi));
  return r;
}
__device__ __forceinline__ float bf2f(bf16_t v) { return __uint_as_float(((unsigned)v) << 16); }
__device__ __forceinline__ float bflo(unsigned u) { return __uint_as_float(u << 16); }
__device__ __forceinline__ float bfhi(unsigned u) { return __uint_as_float(u & 0xffff0000u); }
__device__ __forceinline__ float wave_sum(float v) {
#pragma unroll
  for (int o = 32; o > 0; o >>= 1) v += __shfl_xor(v, o);
  return v;
}
__device__ __forceinline__ float sigmoid_(float x) { return __builtin_amdgcn_rcpf(1.f + __expf(-x)); }
__device__ __forceinline__ float silu_(float x) { return x * sigmoid_(x); }
__device__ __forceinline__ float gelu_(float x) {
  float u = 0.7978845608028654f * (x + 0.044715f * x * x * x);
  return x * sigmoid_(2.f * u);
}
__device__ __forceinline__ float softplus_(float x) { return fmaxf(x, 0.f) + log1pf(__expf(-fabsf(x))); }
__device__ __forceinline__ f32x4 mfma16(bf16x8 a, bf16x8 b, f32x4 c) {
  return __builtin_amdgcn_mfma_f32_16x16x32_bf16(a, b, c, 0, 0, 0);
}
__device__ __forceinline__ bf16x8 as_frag(u32x4 v) { return __builtin_bit_cast(bf16x8, v); }
__device__ __forceinline__ int sw256(int row, int chunk) { return row * 256 + ((chunk ^ (row & 15)) << 4); }
__device__ __forceinline__ int sw128(int row, int chunk) { return row * 128 + ((chunk ^ ((row >> 1) & 7)) << 4); }

__device__ __forceinline__ bf16_t* sinb_ptr(unsigned char* ws, int b, int c, int hh) {
  return (bf16_t*)(ws + (b < 4 ? OFF_SINB_LO : OFF_SINB_HI)) + (size_t)(((b & 3) * 16 + c) * 16 + hh) * 8192;
}
__device__ __forceinline__ float rs_from_ssq2(const float* ssq2, int row) {
  const f32x4* pp = (const f32x4*)(ssq2 + (size_t)row * 32);
  float s = 0.f;
#pragma unroll
  for (int i = 0; i < 8; ++i) { f32x4 v = pp[i]; s += v[0] + v[1] + v[2] + v[3]; }
  return rsqrtf(s * (1.f / 2048.f) + EPSV);
}
__device__ __forceinline__ float rs_from_ssq(const float* ssq, int row) {
  const f32x4* pp = (const f32x4*)(ssq + (size_t)row * 16);
  float s = 0.f;
#pragma unroll
  for (int i = 0; i < 4; ++i) { f32x4 v = pp[i]; s += v[0] + v[1] + v[2] + v[3]; }
  return rsqrtf(s * (1.f / 1024.f) + EPSV);
}

__device__ void transpose_tile(const float* __restrict__ src, int ld_src, int r0, int c0, int c_valid,
                               bf16_t* __restrict__ dst, int ld_dst, const float* __restrict__ scale, int scale_from,
                               float* tile, bool valid) {
  const int tid = threadIdx.x & 255;
  {
    const int j = tid & 63, i0 = tid >> 6;
#pragma unroll
    for (int ii = 0; ii < 16; ++ii) {
      const int i = i0 + 4 * ii;
      float v = 0.f;
      if (valid && c0 + j < c_valid) {
        v = src[(size_t)(r0 + i) * ld_src + c0 + j];
        if (scale != nullptr && (r0 + i) >= scale_from) v *= scale[r0 + i - scale_from];
      }
      tile[i * 65 + j] = v;
    }
  }
  __syncthreads();
  {
    const int i4 = tid & 15, j0 = tid >> 4;
#pragma unroll
    for (int jj = 0; jj < 4; ++jj) {
      const int j = j0 + 16 * jj;
      const float* tp = tile + (4 * i4) * 65 + j;
      u32x2 o = {pk2(tp[0], tp[65]), pk2(tp[130], tp[195])};
      if (valid) *(u32x2*)(dst + (size_t)(c0 + j) * ld_dst + r0 + 4 * i4) = o;
    }
  }
  __syncthreads();
}

__device__ void phase_prep(const Params& p, unsigned char* smem) {
  const int tid = threadIdx.x, lane = tid & 63, wid = tid >> 6, hb = tid >> 8;
  unsigned char* ws = p.ws;
  bf16_t* xb = (bf16_t*)(ws + OFF_XB);
  float* rs1 = (float*)(ws + OFF_RS1);
  for (int t = blockIdx.x * 8 + wid; t < T_TOK; t += gridDim.x * 8) {
    const float* xr = p.x + (size_t)t * DM;
    bf16_t* xo = xb + (size_t)t * DM;
    float ss = 0.f;
#pragma unroll
    for (int c = 0; c < 8; ++c) {
      f32x4 v = *(const f32x4*)(xr + c * 256 + lane * 4);
      ss += v[0] * v[0] + v[1] * v[1] + v[2] * v[2] + v[3] * v[3];
      u32x2 o = {pk2(v[0], v[1]), pk2(v[2], v[3])};
      *(u32x2*)(xo + c * 256 + lane * 4) = o;
    }
    ss = wave_sum(ss);
    if (lane == 0) rs1[t] = rsqrtf(ss * (1.f / 2048.f) + EPSV);
  }
  float* tile = (float*)(smem + hb * SMEM_HALF);
  const int NT_WIN = 32 * 76, NT_SQ = 32 * 32;
  const int total = NT_WIN + 2 * NT_SQ + 32;
  for (int u0 = blockIdx.x * 2; u0 < total; u0 += gridDim.x * 2) {
    const bool valid = (u0 + hb) < total;
    const int u = valid ? (u0 + hb) : u0;
    if (u < NT_WIN) {
      const int ri = u & 31, cj = u >> 5;
      transpose_tile(p.w_in, 4624, ri * 64, cj * 64, 4624, (bf16_t*)(ws + OFF_WINT), 2048, p.norm_mix_w, 0, tile, valid);
    } else if (u < NT_WIN + NT_SQ) {
      const int v = u - NT_WIN, ri = v & 31, cj = v >> 5;
      transpose_tile(p.w_out, 2048, ri * 64, cj * 64, 2048, (bf16_t*)(ws + OFF_WOUTT), 2048, p.ssd_norm_w, 1024, tile, valid);
    } else if (u < NT_WIN + 2 * NT_SQ) {
      const int v = u - NT_WIN - NT_SQ, ri = v & 31, cj = v >> 5;
      transpose_tile(p.peer_wq, 2048, ri * 64, cj * 64, 2048, (bf16_t*)(ws + OFF_WQT), 2048, p.norm_ffn_w, 0, tile, valid);
    } else {
      const int v = u - NT_WIN - 2 * NT_SQ;
      const int h = v & 15;
      const float* src = (v < 16 ? p.lru_wa : p.lru_wx) + (size_t)h * 4096;
      bf16_t* dst = (bf16_t*)(ws + (v < 16 ? OFF_WAT : OFF_WXT)) + (size_t)h * 4096;
      transpose_tile(src, 64, 0, 0, 64, dst, 64, nullptr, 0, tile, valid);
    }
  }
  {
    bf16_t* kb = (bf16_t*)(ws + OFF_KEYSB);
    for (int i = blockIdx.x * NTHR + tid; i < 65536; i += gridDim.x * NTHR) {
      f32x4 v = *(const f32x4*)(p.peer_sub_keys + (size_t)i * 4);
      u32x2 o = {pk2(v[0], v[1]), pk2(v[2], v[3])};
      *(u32x2*)(kb + (size_t)i * 4) = o;
    }
  }
}

namespace pg8 {
#define PG8_LAS __attribute__((address_space(3)))
constexpr int BM = 256, BK = 64, HALF = 128, HTB = HALF * BK * 2;
__device__ __forceinline__ int lds_byte(int r, int c) { const int st = (r >> 4) * 2 + (c >> 5), rr = r & 15, cc = c & 31, ob = rr * 64 + cc * 2; return st * 1024 + (ob ^ (((ob >> 9) & 1) << 5)); }
__device__ __forceinline__ void stage_rc(int b, int& R, int& C) { const int st = b / 1024, sb = b % 1024, swz = sb ^ (((sb >> 9) & 1) << 5); R = (st >> 1) * 16 + swz / 64; C = (st & 1) * 32 + (swz % 64) / 2; }
struct Unit { int pm, pn; };
struct Gemm { const bf16_t* A; const bf16_t* Bt; int M, N, K; };
struct SimpleOrder {
  int nM, nwg, G, c;
  __device__ void init(int M, int N, int G_, int c_) { nM = M / BM; nwg = nM * (N / BM); G = G_; c = c_; }
  __device__ bool next(int i, Unit& u) const { const int L = i * G + c; if (L >= nwg) return false; u.pm = L % nM; u.pn = L / nM; return true; }
};
struct Epi1 {
  static constexpr bool MID = false;
  const float* rs1; bf16_t* proj;
  __device__ __forceinline__ void mid(f32x4 (&)[2][2][4][2], const Unit&, int, int) const {}
  __device__ __forceinline__ void operator()(const f32x4 (&acc)[2][2][4][2], const Unit& u, int wr, int wc, int fr, int fq) const {
    const int row0 = u.pm * BM + wr * 64 + fr, col0 = u.pn * BM + wc * 32 + 4 * fq;
#pragma unroll
    for (int ai = 0; ai < 2; ++ai)
#pragma unroll
      for (int m = 0; m < 4; ++m) {
        const int row = row0 + ai * HALF + m * 16;
        const float s = rs1[row];
#pragma unroll
        for (int bj = 0; bj < 2; ++bj)
#pragma unroll
          for (int n = 0; n < 2; ++n) {
            const int col = col0 + bj * HALF + n * 16;
            if (col < LDP) {
              f32x4 v = acc[ai][bj][m][n] * s;
              u32x2 o = {pk2(v[0], v[1]), pk2(v[2], v[3])};
              *(u32x2*)(proj + (size_t)row * LDP + col) = o;
            }
          }
      }
  }
};
struct Epi2 {
  static constexpr bool MID = true;
  const float* x; float* out; bf16_t* x1b; float* ssq2; const float* ssq;
  __device__ __forceinline__ void mid(f32x4 (&acc)[2][2][4][2], const Unit& u, int wr, int fr) const {
#pragma unroll
    for (int ai = 0; ai < 2; ++ai)
#pragma unroll
      for (int m = 0; m < 4; ++m) {
        const float s = rs_from_ssq(ssq, u.pm * BM + wr * 64 + fr + ai * HALF + m * 16);
#pragma unroll
        for (int bj = 0; bj < 2; ++bj)
#pragma unroll
          for (int n = 0; n < 2; ++n) acc[ai][bj][m][n] *= s;
        __builtin_amdgcn_sched_barrier(0);
      }
  }
  __device__ __forceinline__ void operator()(const f32x4 (&acc)[2][2][4][2], const Unit& u, int wr, int wc, int fr, int fq) const {
    const int row0 = u.pm * BM + wr * 64 + fr, col0 = u.pn * BM + wc * 32 + 4 * fq;
#pragma unroll
    for (int ai = 0; ai < 2; ++ai)
#pragma unroll
      for (int m = 0; m < 4; ++m) {
        const int row = row0 + ai * HALF + m * 16;
        float ss = 0.f;
#pragma unroll
        for (int bj = 0; bj < 2; ++bj)
#pragma unroll
          for (int n = 0; n < 2; ++n) {
            const int col = col0 + bj * HALF + n * 16;
            f32x4 xr = *(const f32x4*)(x + (size_t)row * DM + col);
            f32x4 v = acc[ai][bj][m][n] + xr;
            *(f32x4*)(out + (size_t)row * DM + col) = v;
            u32x2 o = {pk2(v[0], v[1]), pk2(v[2], v[3])};
            *(u32x2*)(x1b + (size_t)row * DM + col) = o;
            ss += v[0] * v[0] + v[1] * v[1] + v[2] * v[2] + v[3] * v[3];
          }
        ss += __shfl_xor(ss, 16);
        ss += __shfl_xor(ss, 32);
        if (fq == 0) ssq2[(size_t)row * 32 + u.pn * 4 + wc] = ss;
        __builtin_amdgcn_sched_barrier(0);
      }
  }
};
struct Epi3 {
  static constexpr bool MID = false;
  const float* ssq2; bf16_t* q;
  __device__ __forceinline__ void mid(f32x4 (&)[2][2][4][2], const Unit&, int, int) const {}
  __device__ __forceinline__ void operator()(const f32x4 (&acc)[2][2][4][2], const Unit& u, int wr, int wc, int fr, int fq) const {
    const int row0 = u.pm * BM + wr * 64 + fr, col0 = u.pn * BM + wc * 32 + 4 * fq;
#pragma unroll
    for (int ai = 0; ai < 2; ++ai)
#pragma unroll
      for (int m = 0; m < 4; ++m) {
        const int row = row0 + ai * HALF + m * 16;
        const float s = rs_from_ssq2(ssq2, row);
#pragma unroll
        for (int bj = 0; bj < 2; ++bj)
#pragma unroll
          for (int n = 0; n < 2; ++n) {
            const int col = col0 + bj * HALF + n * 16;
            f32x4 v = acc[ai][bj][m][n] * s;
            u32x2 o = {pk2(v[0], v[1]), pk2(v[2], v[3])};
            *(u32x2*)(q + (size_t)row * DM + col) = o;
          }
      }
  }
};

template <class Epi, class Sched, int KROT>
__device__ __forceinline__ void gemm_phase(PG8_LAS unsigned char* lds, const Gemm g, const Sched& S, const Epi& E) {
  const int tid = threadIdx.x, wid = __builtin_amdgcn_readfirstlane(tid >> 6), lane = tid & 63, wr = wid >> 2, wc = wid & 3, fr = lane & 15, fq = lane >> 4;
  const int K = g.K, nt = K / BK;
#define PG8_KX(t) (((t) + KROT) & 31)
  unsigned voff[2];
#pragma unroll
  for (int i = 0; i < 2; ++i) { int R, C; stage_rc(tid * 16 + i * 8192, R, C); voff[i] = (unsigned)(R * K + C) * 2u; }
  const size_t kstep = (size_t)(BK * 2);
  const size_t hstep = (size_t)HALF * K * 2;
  const size_t tstep = 2 * hstep;
  const unsigned ldsw = (unsigned)wid * 1024u;
  const int aoff = lds_byte(wr * 64 + fr, fq * 8), boff = lds_byte(wc * 32 + fr, fq * 8);
#define PG8_SA(b, h) (((b) * 2 + (h)) * HTB)
#define PG8_SB(b, h) ((4 + (b) * 2 + (h)) * HTB)
#define PG8_STAGE(bufoff, gbase) do { _Pragma("unroll") for (int _i = 0; _i < 2; ++_i) \
    __builtin_amdgcn_global_load_lds((const unsigned*)((const char*)(gbase) + voff[_i]), (PG8_LAS unsigned*)(lds + (bufoff) + ldsw + _i * 8192), 16, 0, 0); } while (0)
#define PG8_LDA(dst, b, h) do { _Pragma("unroll") for (int m = 0; m < 4; ++m) _Pragma("unroll") for (int k = 0; k < 2; ++k) dst[m][k] = *(const PG8_LAS bf16x8*)(lds + PG8_SA(b, h) + aoff + m * 2048 + k * 1024); } while (0)
#define PG8_LDB(dst, b, h) do { _Pragma("unroll") for (int n = 0; n < 2; ++n) _Pragma("unroll") for (int k = 0; k < 2; ++k) dst[n][k] = *(const PG8_LAS bf16x8*)(lds + PG8_SB(b, h) + boff + n * 2048 + k * 1024); } while (0)
#define PG8_MMA(ai, bj, At, Bt) do { __builtin_amdgcn_s_setprio(1); _Pragma("unroll") for (int m = 0; m < 4; ++m) _Pragma("unroll") for (int n = 0; n < 2; ++n) _Pragma("unroll") for (int k = 0; k < 2; ++k) \
    acc[ai][bj][m][n] = __builtin_amdgcn_mfma_f32_16x16x32_bf16(Bt[n][k], At[m][k], acc[ai][bj][m][n], 0, 0, 0); __builtin_amdgcn_s_setprio(0); } while (0)
#define PG8_WAIT_V(n) asm volatile("s_waitcnt vmcnt(" #n ")" ::: "memory")
#define PG8_WAIT_L(n) asm volatile("s_waitcnt lgkmcnt(" #n ")" ::: "memory")
#define PG8_BAR __builtin_amdgcn_s_barrier()
#define PG8_SCHED __builtin_amdgcn_sched_barrier(0)
  Unit cur, nxt; int ui = 0;
  if (!S.next(0, cur)) return;
  f32x4 acc[2][2][4][2];
#pragma unroll
  for (int a = 0; a < 2; ++a)
#pragma unroll
    for (int b = 0; b < 2; ++b)
#pragma unroll
      for (int m = 0; m < 4; ++m)
#pragma unroll
        for (int n = 0; n < 2; ++n) acc[a][b][m][n] = (f32x4){0.f, 0.f, 0.f, 0.f};
  bf16x8 At[4][2], B0[2][2], B1[2][2];
  const char* cA = (const char*)g.A + (size_t)cur.pm * tstep; const char* cB = (const char*)g.Bt + (size_t)cur.pn * tstep;
  { const char* a0 = cA + (size_t)PG8_KX(0) * kstep; const char* b0 = cB + (size_t)PG8_KX(0) * kstep;
    const char* a1 = cA + (size_t)PG8_KX(1) * kstep; const char* b1 = cB + (size_t)PG8_KX(1) * kstep;
    PG8_STAGE(PG8_SB(0, 0), b0); PG8_STAGE(PG8_SA(0, 0), a0); PG8_STAGE(PG8_SB(0, 1), b0 + hstep); PG8_STAGE(PG8_SA(0, 1), a0 + hstep);
    if (wr == 1) PG8_BAR;
    PG8_WAIT_V(4); PG8_BAR;
    PG8_STAGE(PG8_SB(1, 0), b1); PG8_STAGE(PG8_SA(1, 0), a1); PG8_STAGE(PG8_SB(1, 1), b1 + hstep);
    PG8_WAIT_V(6); PG8_BAR; }
  for (;;) {
    const bool has_next = S.next(ui + 1, nxt);
    const char* nA = has_next ? (const char*)g.A + (size_t)nxt.pm * tstep : cA; const char* nB = has_next ? (const char*)g.Bt + (size_t)nxt.pn * tstep : cB;
#define PG8_ITER(t) {\
      const bool last = (t == nt - 2);\
      const char* a1 = cA + (size_t)PG8_KX(t + 1) * kstep;\
      const char* a2 = last ? nA + (size_t)PG8_KX(0) * kstep : cA + (size_t)PG8_KX(t + 2) * kstep;\
      const char* b2 = last ? nB + (size_t)PG8_KX(0) * kstep : cB + (size_t)PG8_KX(t + 2) * kstep;\
      const char* a3 = last ? nA + (size_t)PG8_KX(1) * kstep : cA + (size_t)PG8_KX(t + 3) * kstep;\
      const char* b3 = last ? nB + (size_t)PG8_KX(1) * kstep : cB + (size_t)PG8_KX(t + 3) * kstep;\
      PG8_LDB(B0, 0, 0); PG8_SCHED; PG8_LDA(At, 0, 0); PG8_STAGE(PG8_SA(1, 1), a1 + hstep);\
      PG8_WAIT_L(8); PG8_BAR; PG8_WAIT_L(0); PG8_MMA(0, 0, At, B0); PG8_BAR; PG8_SCHED;\
      PG8_LDB(B1, 0, 1); PG8_STAGE(PG8_SB(0, 0), b2);\
      PG8_BAR; PG8_WAIT_L(0); PG8_MMA(0, 1, At, B1); PG8_BAR;\
      PG8_LDA(At, 0, 1); PG8_STAGE(PG8_SA(0, 0), a2);\
      PG8_BAR; PG8_WAIT_L(0); PG8_MMA(1, 0, At, B0); PG8_BAR; PG8_SCHED;\
      PG8_STAGE(PG8_SB(0, 1), b2 + hstep);\
      PG8_WAIT_V(6); PG8_BAR; PG8_MMA(1, 1, At, B1); PG8_BAR;\
      PG8_LDB(B0, 1, 0); PG8_SCHED; PG8_LDA(At, 1, 0); PG8_STAGE(PG8_SA(0, 1), a2 + hstep);\
      PG8_WAIT_L(8); PG8_BAR; PG8_WAIT_L(0); PG8_MMA(0, 0, At, B0); PG8_BAR; PG8_SCHED;\
      PG8_LDB(B1, 1, 1); PG8_STAGE(PG8_SB(1, 0), b3);\
      PG8_BAR; PG8_WAIT_L(0); PG8_MMA(0, 1, At, B1); PG8_BAR;\
      PG8_LDA(At, 1, 1); PG8_STAGE(PG8_SA(1, 0), a3);\
      PG8_BAR; PG8_WAIT_L(0); PG8_MMA(1, 0, At, B0); PG8_BAR; PG8_SCHED;\
      PG8_STAGE(PG8_SB(1, 1), b3 + hstep);\
      PG8_WAIT_V(6); PG8_BAR; PG8_MMA(1, 1, At, B1); PG8_BAR;\
}
    if (Epi::MID) {
      for (int t = 0; t < 16; t += 2) PG8_ITER(t)
      E.mid(acc, cur, wr, fr);
      for (int t = 16; t < nt; t += 2) PG8_ITER(t)
    } else {
      for (int t = 0; t < nt; t += 2) PG8_ITER(t)
    }
#undef PG8_ITER
    E(acc, cur, wr, wc, fr, fq);
    if (!has_next) break;
#pragma unroll
    for (int a = 0; a < 2; ++a)
#pragma unroll
      for (int b = 0; b < 2; ++b)
#pragma unroll
        for (int m = 0; m < 4; ++m)
#pragma unroll
          for (int n = 0; n < 2; ++n) acc[a][b][m][n] = (f32x4){0.f, 0.f, 0.f, 0.f};
    cur = nxt; cA = nA; cB = nB; ++ui;
  }
  PG8_WAIT_V(0);
  if (wr == 0) PG8_BAR;
  PG8_BAR;
#undef PG8_KX
#undef PG8_SA
#undef PG8_SB
#undef PG8_STAGE
#undef PG8_LDA
#undef PG8_LDB
#undef PG8_MMA
#undef PG8_WAIT_V
#undef PG8_WAIT_L
#undef PG8_BAR
#undef PG8_SCHED
}
}

__device__ __forceinline__ void conv8(const bf16_t* __restrict__ proj, int t, int tt_in_seq, int col,
                                      const float* __restrict__ cw, int ld_w, const float* __restrict__ cb, int ch,
                                      float* o) {
  f32x4 b0 = *(const f32x4*)(cb + ch), b1 = *(const f32x4*)(cb + ch + 4);
  o[0] = b0[0]; o[1] = b0[1]; o[2] = b0[2]; o[3] = b0[3];
  o[4] = b1[0]; o[5] = b1[1]; o[6] = b1[2]; o[7] = b1[3];
#pragma unroll
  for (int k = 0; k < 4; ++k) {
    if (tt_in_seq - 3 + k >= 0) {
      u32x4 v = *(const u32x4*)(proj + (size_t)(t - 3 + k) * LDP + col);
      f32x4 w0 = *(const f32x4*)(cw + k * ld_w + ch), w1 = *(const f32x4*)(cw + k * ld_w + ch + 4);
      o[0] += w0[0] * bflo(v[0]); o[1] += w0[1] * bfhi(v[0]);
      o[2] += w0[2] * bflo(v[1]); o[3] += w0[3] * bfhi(v[1]);
      o[4] += w1[0] * bflo(v[2]); o[5] += w1[1] * bfhi(v[2]);
      o[6] += w1[2] * bflo(v[3]); o[7] += w1[3] * bfhi(v[3]);
    }
  }
}
__device__ __forceinline__ void conv4(const bf16_t* __restrict__ proj, int t, int tt_in_seq, int col,
                                      const float* __restrict__ cw, int ld_w, const float* __restrict__ cb, int ch,
                                      float* o) {
  f32x4 b0 = *(const f32x4*)(cb + ch);
  o[0] = b0[0]; o[1] = b0[1]; o[2] = b0[2]; o[3] = b0[3];
#pragma unroll
  for (int k = 0; k < 4; ++k) {
    if (tt_in_seq - 3 + k >= 0) {
      u32x2 v = *(const u32x2*)(proj + (size_t)(t - 3 + k) * LDP + col);
      f32x4 w0 = *(const f32x4*)(cw + k * ld_w + ch);
      o[0] += w0[0] * bflo(v[0]); o[1] += w0[1] * bfhi(v[0]);
      o[2] += w0[2] * bflo(v[1]); o[3] += w0[3] * bfhi(v[1]);
    }
  }
}
__device__ __forceinline__ bf16x8 cfrag(const Params& p, const bf16_t* proj, int t, int tseq, int g, int n8) {
  const bf16_t* cact = (const bf16_t*)(p.ws + OFF_CACT);
  return as_frag(*(const u32x4*)(cact + (size_t)t * 256 + g * 128 + n8));
}
__device__ void conv_prepass(const Params& p, int part, int nparts) {
  unsigned char* ws = p.ws;
  const bf16_t* proj = (const bf16_t*)(ws + OFF_PROJ);
  bf16_t* xact = (bf16_t*)(ws + OFF_XACT);
  bf16_t* bact = (bf16_t*)(ws + OFF_BACT);
  bf16_t* cact = (bf16_t*)(ws + OFF_CACT);
  for (int i = blockIdx.x * NTHR + threadIdx.x + part * (int)gridDim.x * NTHR; i < T_TOK * 192; i += nparts * (int)gridDim.x * NTHR) {
    const int t = i / 192, ch = (i - t * 192) * 8;
    float o[8];
    conv8(proj, t, t & 2047, 3072 + ch, p.ssd_conv_w, 1536, p.ssd_conv_b, ch, o);
#pragma unroll
    for (int e = 0; e < 8; ++e) o[e] = silu_(o[e]);
    u32x4 r = {pk2(o[0], o[1]), pk2(o[2], o[3]), pk2(o[4], o[5]), pk2(o[6], o[7])};
    bf16_t* dst = ch < 1024 ? xact + (size_t)t * 1024 + ch : (ch < 1280 ? bact + (size_t)t * 256 + (ch - 1024) : cact + (size_t)t * 256 + (ch - 1280));
    *(u32x4*)dst = r;
  }
}

__device__ void lru_local_unit(const Params& p, unsigned char* smem, int unit) {
  const int tid = threadIdx.x & 255, lane = tid & 63, wid = tid >> 6, l15 = lane & 15, q4 = lane >> 4;
  const int hh = unit & 15, c = (unit >> 4) & 15, b = unit >> 8;
  const int t0 = b * 2048 + c * 128, ch0 = hh * 64;
  unsigned char* ws = p.ws;
  const bf16_t* proj = (const bf16_t*)(ws + OFF_PROJ);
  float* R1 = (float*)smem;
  float* R2 = (float*)(smem + 33536);
  float* R3 = (float*)(smem + 33536 + 32768);
#pragma unroll 11
  for (int e = tid; e < 131 * 64; e += HTHR) {
    const int r = e >> 6, j = e & 63, tt = r - 3;
    float v = 0.f;
    if (c * 128 + tt >= 0) v = bf2f(proj[(size_t)(t0 + tt) * LDP + ch0 + j]);
    R1[e] = v;
  }
  __syncthreads();
  {
    const int j = tid & 63;
    const float cb = p.lru_conv_b[ch0 + j];
    const float w0 = p.lru_conv_w[0 * 1024 + ch0 + j], w1 = p.lru_conv_w[1 * 1024 + ch0 + j],
                w2 = p.lru_conv_w[2 * 1024 + ch0 + j], w3 = p.lru_conv_w[3 * 1024 + ch0 + j];
#pragma unroll 8
    for (int tt = tid >> 6; tt < 128; tt += 4) {
      R2[tt * 64 + j] = cb + w0 * R1[tt * 64 + j] + w1 * R1[(tt + 1) * 64 + j] + w2 * R1[(tt + 2) * 64 + j] +
                        w3 * R1[(tt + 3) * 64 + j];
    }
  }
  __syncthreads();
  {
    const bf16_t* waT = (const bf16_t*)(ws + OFF_WAT) + (size_t)hh * 4096;
    const bf16_t* wxT = (const bf16_t*)(ws + OFF_WXT) + (size_t)hh * 4096;
    f32x4 aa[2][4], ax[2][4];
#pragma unroll
    for (int i = 0; i < 2; ++i)
#pragma unroll
      for (int j = 0; j < 4; ++j) { aa[i][j] = (f32x4){0, 0, 0, 0}; ax[i][j] = (f32x4){0, 0, 0, 0}; }
#pragma unroll
    for (int ks = 0; ks < 2; ++ks) {
      bf16x8 af[2];
#pragma unroll
      for (int mi = 0; mi < 2; ++mi) {
        const float* src = R2 + (wid * 32 + mi * 16 + l15) * 64 + ks * 32 + q4 * 8;
        f32x4 v0 = *(const f32x4*)src, v1 = *(const f32x4*)(src + 4);
        u32x4 r = {pk2(v0[0], v0[1]), pk2(v0[2], v0[3]), pk2(v1[0], v1[1]), pk2(v1[2], v1[3])};
        af[mi] = as_frag(r);
      }
#pragma unroll
      for (int ni = 0; ni < 4; ++ni) {
        const size_t wo = (size_t)(ni * 16 + l15) * 64 + ks * 32 + q4 * 8;
        bf16x8 ba = as_frag(*(const u32x4*)(waT + wo));
        bf16x8 bx = as_frag(*(const u32x4*)(wxT + wo));
#pragma unroll
        for (int mi = 0; mi < 2; ++mi) {
          aa[mi][ni] = mfma16(af[mi], ba, aa[mi][ni]);
          ax[mi][ni] = mfma16(af[mi], bx, ax[mi][ni]);
        }
      }
    }
#pragma unroll
    for (int ni = 0; ni < 4; ++ni) {
      const int j = ni * 16 + l15;
      const float ba = p.lru_ba[ch0 + j], bx = p.lru_bx[ch0 + j];
      const float lam = p.lru_lambda[ch0 + j];
      const float spl = -8.f * log1pf(__expf(-lam));
#pragma unroll
      for (int mi = 0; mi < 2; ++mi)
#pragma unroll
        for (int r = 0; r < 4; ++r) {
          const int tt = wid * 32 + mi * 16 + q4 * 4 + r;
          const float rg = sigmoid_(aa[mi][ni][r] + ba);
          const float ig = sigmoid_(ax[mi][ni][r] + bx);
          const float log_a = spl * rg;
          const float av = __expf(log_a);
          const float xl = R2[tt * 64 + j];
          const float y2 = 2.f * log_a;
          const float poly = -y2 * (1.f + y2 * (0.5f + y2 * (0.16666667f + y2 * (0.041666668f + y2 * (0.0083333338f + y2 * 0.0013888889f)))));
          const float em = (y2 > -0.25f) ? poly : (1.f - av * av);
          const float bv = __builtin_amdgcn_sqrtf(fmaxf(em, 0.f)) * (ig * xl);
          R1[tt * 64 + j] = av;
          R2[tt * 64 + j] = bv;
        }
    }
  }
  __syncthreads();
  {
    const int j = tid & 63, seg = tid >> 6;
    float h = 0.f, Ac = 1.f;
#pragma unroll 4
    for (int s = 0; s < 32; ++s) {
      const int tt = seg * 32 + s;
      const float a = R1[tt * 64 + j], bb = R2[tt * 64 + j];
      h = a * h + bb;
      Ac *= a;
      R2[tt * 64 + j] = h;
      R1[tt * 64 + j] = Ac;
    }
    R3[seg * 64 + j] = h;
    R3[256 + seg * 64 + j] = Ac;
    __syncthreads();
    float cin = 0.f, Ain = 1.f;
    for (int s2 = 0; s2 < seg; ++s2) {
      cin = R3[256 + s2 * 64 + j] * cin + R3[s2 * 64 + j];
      Ain *= R3[256 + s2 * 64 + j];
    }
    float* hloc = (float*)(ws + OFF_HLOC);
    float* cumA = (float*)(ws + OFF_CUMA);
#pragma unroll 4
    for (int s = 0; s < 32; ++s) {
      const int tt = seg * 32 + s;
      const float hl = R2[tt * 64 + j] + R1[tt * 64 + j] * cin;
      const float Al = R1[tt * 64 + j] * Ain;
      hloc[(size_t)(t0 + tt) * 1024 + ch0 + j] = hl;
      cumA[(size_t)(t0 + tt) * 1024 + ch0 + j] = Al;
    }
  }
  __syncthreads();
}

__device__ void ssd_local_unit(const Params& p, unsigned char* smem, int unit) {
  const int tid = threadIdx.x & 255, lane = tid & 63, wid = tid >> 6, l15 = lane & 15, q4 = lane >> 4;
  const int hh = unit & 15, c = (unit >> 4) & 15, b = unit >> 8, g = hh >> 3;
  const int t0 = b * 2048 + c * 128, ts0 = c * 128;
  unsigned char* ws = p.ws;
  const bf16_t* proj = (const bf16_t*)(ws + OFF_PROJ);
  unsigned char* Bm = smem;
  unsigned char* XT = smem + 32768;
  unsigned char* Pw = smem + 49152 + wid * 4096;
  float* dts = (float*)(smem + 65536);
  float* acs = dts + 128;
  float* adt = acs + 128;
  if (tid < 128) {
    const float raw = bf2f(proj[(size_t)(t0 + tid) * LDP + 4608 + hh]);
    const float dtv = softplus_(raw + p.ssd_dt_bias[hh]);
    dts[tid] = dtv;
    adt[tid] = -__expf(p.ssd_a_log[hh]) * dtv;
  }
  __syncthreads();
  if (tid < 128) {
    float s = 0.f;
    for (int k = 0; k <= tid; ++k) s += adt[k];
    acs[tid] = s;
    ((float*)(ws + OFF_ACS))[(size_t)(t0 + tid) * 16 + hh] = s;
  }
  {
    const bf16_t* bact = (const bf16_t*)(ws + OFF_BACT);
    const int chunk = tid & 15;
#pragma unroll
    for (int i = 0; i < 8; ++i) {
      const int tt = (tid >> 4) + 16 * i;
      *(u32x4*)(Bm + sw256(tt, chunk)) = *(const u32x4*)(bact + (size_t)(t0 + tt) * 256 + g * 128 + chunk * 8);
    }
  }
  __syncthreads();
  const bf16_t* xact = (const bf16_t*)(ws + OFF_XACT);
  {
    const int pp = tid & 63;
    const int ch = hh * 64 + pp;
#pragma unroll
    for (int i = 0; i < 4; ++i) {
      const int chunk = (tid >> 6) * 4 + i;
      const int tt0 = chunk * 8;
      float o[8];
#pragma unroll
      for (int e = 0; e < 8; ++e) o[e] = bf2f(xact[(size_t)(t0 + tt0 + e) * 1024 + ch]) * dts[tt0 + e];
      u32x4 r = {pk2(o[0], o[1]), pk2(o[2], o[3]), pk2(o[4], o[5]), pk2(o[6], o[7])};
      *(u32x4*)(XT + sw256(pp, chunk)) = r;
    }
  }
  __syncthreads();
  bf16_t* ypart = (bf16_t*)(ws + OFF_YPART);
  const float Dh = p.ssd_d[hh];
#pragma unroll 1
  for (int mt = 0; mt < 2; ++mt) {
    const int M = wid * 2 + mt;
    const int lrow = M * 16 + l15;
    bf16x8 cf[4];
#pragma unroll
    for (int ks = 0; ks < 4; ++ks) cf[ks] = cfrag(p, proj, t0 + lrow, ts0 + lrow, g, ks * 32 + q4 * 8);
    const float acl = acs[lrow];
    const int ntmax = M | 1;
#pragma unroll 1
    for (int nt = 0; nt <= ntmax; ++nt) {
      f32x4 a4 = (f32x4){0, 0, 0, 0};
      if (nt <= M) {
#pragma unroll
        for (int ks = 0; ks < 4; ++ks) {
          bf16x8 bfr = *(const bf16x8*)(Bm + sw256(nt * 16 + l15, ks * 4 + q4));
          a4 = mfma16(bfr, cf[ks], a4);
        }
      }
      float pv[4];
#pragma unroll
      for (int r = 0; r < 4; ++r) {
        const int s = nt * 16 + q4 * 4 + r;
        pv[r] = (s <= lrow) ? a4[r] * __expf(acl - acs[s]) : 0.f;
      }
      u32x2 o = {pk2(pv[0], pv[1]), pk2(pv[2], pv[3])};
      const int chunk = nt * 2 + (q4 >> 1);
      *(u32x2*)(Pw + sw256(l15, chunk) + (q4 & 1) * 8) = o;
    }
    f32x4 ya[4];
#pragma unroll
    for (int pt = 0; pt < 4; ++pt) ya[pt] = (f32x4){0, 0, 0, 0};
    const int ksmax = M >> 1;
#pragma unroll 1
    for (int ks = 0; ks <= ksmax; ++ks) {
      bf16x8 pf = *(const bf16x8*)(Pw + sw256(l15, ks * 4 + q4));
#pragma unroll
      for (int pt = 0; pt < 4; ++pt) {
        bf16x8 xf = *(const bf16x8*)(XT + sw256(pt * 16 + l15, ks * 4 + q4));
        ya[pt] = mfma16(xf, pf, ya[pt]);
      }
    }
#pragma unroll
    for (int pt = 0; pt < 4; ++pt) {
      const int pc = pt * 16 + q4 * 4;
      const int ch = hh * 64 + pc;
      const u32x2 xv = *(const u32x2*)(xact + (size_t)(t0 + lrow) * 1024 + ch);
      float y0 = ya[pt][0] + Dh * bflo(xv[0]), y1 = ya[pt][1] + Dh * bfhi(xv[0]);
      float y2 = ya[pt][2] + Dh * bflo(xv[1]), y3 = ya[pt][3] + Dh * bfhi(xv[1]);
      u32x2 o = {pk2(y0, y1), pk2(y2, y3)};
      *(u32x2*)(ypart + (size_t)(t0 + lrow) * 1024 + ch) = o;
    }
  }
  {
    f32x4 sa[2][4];
#pragma unroll
    for (int i = 0; i < 2; ++i)
#pragma unroll
      for (int j = 0; j < 4; ++j) sa[i][j] = (f32x4){0, 0, 0, 0};
    const float aend = acs[127];
#pragma unroll 1
    for (int ks = 0; ks < 4; ++ks) {
      float dec[8];
#pragma unroll
      for (int e = 0; e < 8; ++e) dec[e] = __expf(aend - acs[ks * 32 + q4 * 8 + e]);
      bf16x8 bd[2];
#pragma unroll
      for (int ni = 0; ni < 2; ++ni) {
        const int n = wid * 32 + ni * 16 + l15;
        float v[8];
#pragma unroll
        for (int e = 0; e < 8; ++e) {
          const int l = ks * 32 + q4 * 8 + e;
          const bf16_t raw = *(const bf16_t*)(Bm + sw256(l, n >> 3) + (n & 7) * 2);
          v[e] = bf2f(raw) * dec[e];
        }
        u32x4 r = {pk2(v[0], v[1]), pk2(v[2], v[3]), pk2(v[4], v[5]), pk2(v[6], v[7])};
        bd[ni] = as_frag(r);
      }
#pragma unroll
      for (int pt = 0; pt < 4; ++pt) {
        bf16x8 xf = *(const bf16x8*)(XT + sw256(pt * 16 + l15, ks * 4 + q4));
#pragma unroll
        for (int ni = 0; ni < 2; ++ni) sa[ni][pt] = mfma16(bd[ni], xf, sa[ni][pt]);
      }
    }
    float* St = (float*)(ws + OFF_ST) + (size_t)((b * 16 + c) * 16 + hh) * 8192;
#pragma unroll
    for (int ni = 0; ni < 2; ++ni)
#pragma unroll
      for (int pt = 0; pt < 4; ++pt) {
        const int pr = pt * 16 + l15, n = wid * 32 + ni * 16 + q4 * 4;
        *(f32x4*)(St + pr * 128 + n) = sa[ni][pt];
      }
  }
  __syncthreads();
}

__device__ void phase_carry(const Params& p) {
  unsigned char* ws = p.ws;
  const int gt = blockIdx.x * NTHR + threadIdx.x, ng = gridDim.x * NTHR;
  const float* hloc = (const float*)(ws + OFF_HLOC);
  const float* cumA = (const float*)(ws + OFF_CUMA);
  float* lcarry = (float*)(ws + OFF_LCARRY);
  for (int i = gt; i < 8192; i += ng) {
    const int b = i >> 10, ch = i & 1023;
    float ca[16], hl[16];
#pragma unroll
    for (int c = 0; c < 16; ++c) {
      const size_t tl = (size_t)(b * 2048 + c * 128 + 127) * 1024 + ch;
      ca[c] = cumA[tl];
      hl[c] = hloc[tl];
    }
    float carry = 0.f;
#pragma unroll
    for (int c = 0; c < 16; ++c) {
      lcarry[(size_t)(b * 16 + c) * 1024 + ch] = carry;
      carry = ca[c] * carry + hl[c];
    }
  }
  const float* acsG = (const float*)(ws + OFF_ACS);
  float* St = (float*)(ws + OFF_ST);
  for (int i = gt; i < 128 * 2048; i += ng) {
    const int bh = i >> 11, e4 = i & 2047, b = bh >> 4, hh = bh & 15;
    f32x4 tmp[16];
    float Ad[16];
#pragma unroll
    for (int c = 0; c < 16; ++c) {
      Ad[c] = __expf(acsG[(size_t)(b * 2048 + c * 128 + 127) * 16 + hh]);
      tmp[c] = *(const f32x4*)(St + (size_t)((b * 16 + c) * 16 + hh) * 8192 + e4 * 4);
    }
    f32x4 s = (f32x4){0, 0, 0, 0};
#pragma unroll
    for (int c = 0; c < 16; ++c) {
      u32x2 o = {pk2(s[0], s[1]), pk2(s[2], s[3])};
      *(u32x2*)(sinb_ptr(ws, b, c, hh) + e4 * 4) = o;
      s = s * Ad[c] + tmp[c];
    }
  }
}

__device__ void ssd_final_unit(const Params& p, int unit) {
  const int tid = threadIdx.x & 255, lane = tid & 63, wid = tid >> 6, l15 = lane & 15, q4 = lane >> 4;
  const int hh = unit & 15, c = (unit >> 4) & 15, b = unit >> 8, g = hh >> 3;
  const int t0 = b * 2048 + c * 128, ts0 = c * 128;
  unsigned char* ws = p.ws;
  const bf16_t* proj = (const bf16_t*)(ws + OFF_PROJ);
  const bf16_t* Sin = sinb_ptr(ws, b, c, hh);
  const bf16_t* ypart = (const bf16_t*)(ws + OFF_YPART);
  const float* acsG = (const float*)(ws + OFF_ACS);
  bf16_t* A2 = (bf16_t*)(ws + OFF_XB);
  float* ssq = (float*)(ws + OFF_SSQ);
#pragma unroll 1
  for (int mt = 0; mt < 2; ++mt) {
    const int lrow = (wid * 2 + mt) * 16 + l15;
    f32x4 ya[4];
#pragma unroll
    for (int pt = 0; pt < 4; ++pt) ya[pt] = (f32x4){0, 0, 0, 0};
    if (c > 0) {
#pragma unroll 2
      for (int ks = 0; ks < 4; ++ks) {
        bf16x8 cf = cfrag(p, proj, t0 + lrow, ts0 + lrow, g, ks * 32 + q4 * 8);
#pragma unroll
        for (int pt = 0; pt < 4; ++pt) {
          const u32x4 r = *(const u32x4*)(Sin + (pt * 16 + l15) * 128 + ks * 32 + q4 * 8);
          ya[pt] = mfma16(as_frag(r), cf, ya[pt]);
        }
      }
    }
    const size_t t = (size_t)(t0 + lrow);
    const float ea = __expf(acsG[t * 16 + hh]);
    float ss = 0.f;
#pragma unroll
    for (int pt = 0; pt < 4; ++pt) {
      const int ch = hh * 64 + pt * 16 + q4 * 4;
      u32x2 yp = *(const u32x2*)(ypart + t * 1024 + ch);
      u32x2 zz = *(const u32x2*)(proj + t * LDP + 2048 + ch);
      float y[4] = {bflo(yp[0]) + ea * ya[pt][0], bfhi(yp[0]) + ea * ya[pt][1], bflo(yp[1]) + ea * ya[pt][2],
                    bfhi(yp[1]) + ea * ya[pt][3]};
      float z[4] = {bflo(zz[0]), bfhi(zz[0]), bflo(zz[1]), bfhi(zz[1])};
#pragma unroll
      for (int r = 0; r < 4; ++r) { y[r] = y[r] * silu_(z[r]); ss += y[r] * y[r]; }
      u32x2 o = {pk2(y[0], y[1]), pk2(y[2], y[3])};
      *(u32x2*)(A2 + t * DM + 1024 + ch) = o;
    }
    ss += __shfl_xor(ss, 16);
    ss += __shfl_xor(ss, 32);
    if (q4 == 0) ssq[t * 16 + hh] = ss;
  }
}

__device__ void phase_mix_final(const Params& p) {
  unsigned char* ws = p.ws;
  const bf16_t* proj = (const bf16_t*)(ws + OFF_PROJ);
  const f32x4* hloc = (const f32x4*)(ws + OFF_HLOC);
  const f32x4* cumA = (const f32x4*)(ws + OFF_CUMA);
  const float* lcarry = (const float*)(ws + OFF_LCARRY);
  bf16_t* A2 = (bf16_t*)(ws + OFF_XB);
  for (int u = blockIdx.x * 2 + (threadIdx.x >> 8); u < 2048; u += gridDim.x * 2) ssd_final_unit(p, u);
#pragma unroll 4
  for (int i = blockIdx.x * NTHR + threadIdx.x; i < T_TOK * 256; i += gridDim.x * NTHR) {
    const int t = i >> 8, ch = (i & 255) * 4;
    f32x4 h = hloc[i], ca = cumA[i];
    f32x4 cr = *(const f32x4*)(lcarry + (size_t)(t >> 7) * 1024 + ch);
    u32x2 gg = *(const u32x2*)(proj + (size_t)t * LDP + 1024 + ch);
    float y0 = (h[0] + ca[0] * cr[0]) * gelu_(bflo(gg[0]));
    float y1 = (h[1] + ca[1] * cr[1]) * gelu_(bfhi(gg[0]));
    float y2 = (h[2] + ca[2] * cr[2]) * gelu_(bflo(gg[1]));
    float y3 = (h[3] + ca[3] * cr[3]) * gelu_(bfhi(gg[1]));
    u32x2 o = {pk2(y0, y1), pk2(y2, y3)};
    *(u32x2*)(A2 + (size_t)t * DM + ch) = o;
  }
}

__device__ void convert_uv(const Params& p, int part, int nparts) {
  unsigned char* ws = p.ws;
  const int lane = threadIdx.x & 63, wid = threadIdx.x >> 6;
  unsigned char* tb = ws + OFF_XB;
  float* scales = (float*)(ws + OFF_SCALES);
  for (int row = blockIdx.x * 8 + wid + part * (int)gridDim.x * 8; row < 32768; row += nparts * (int)gridDim.x * 8) {
    const bool isv = row >= 16384;
    const int e = row & 16383;
    const float* src = (isv ? p.peer_v : p.peer_u) + (size_t)e * DM + lane * 32;
    float vals[32];
    float ss = 0.f;
#pragma unroll
    for (int q = 0; q < 8; ++q) {
      f32x4 t = *(const f32x4*)(src + q * 4);
      if (!isv) t *= *(const f32x4*)(p.norm_ffn_w + lane * 32 + q * 4);
#pragma unroll
      for (int k = 0; k < 4; ++k) {
        vals[q * 4 + k] = t[k];
        ss += t[k] * t[k];
      }
    }
    ss = wave_sum(ss);
    const float rms = sqrtf(ss * (1.f / 2048.f));
    const float sc = rms * (2.6f / 7.f);
    const float inv = sc > 0.f ? 1.f / sc : 0.f;
    u32x4 o;
#pragma unroll
    for (int m = 0; m < 4; ++m) {
      unsigned w = 0;
#pragma unroll
      for (int j = 0; j < 4; ++j) {
        const float lo = fminf(fmaxf(rintf(vals[m * 8 + j] * inv), -7.f), 7.f);
        const float hi = fminf(fmaxf(rintf(vals[m * 8 + 4 + j] * inv), -7.f), 7.f);
        const unsigned bl = isv ? (unsigned)((int)lo + 8) : ((unsigned)(int)lo & 0xfu);
        const unsigned bh = isv ? (unsigned)((int)hi + 8) : ((unsigned)(int)hi & 0xfu);
        w |= (bl | (bh << 4)) << (8 * j);
      }
      o[m] = w;
    }
    *(u32x4*)(tb + (size_t)row * 1024 + lane * 16) = o;
    if (lane == 0) scales[row] = sc;
  }
}

__device__ const unsigned char cand_tab[64] = {
    0x00, 0x01, 0x02, 0x03, 0x04, 0x05, 0x06, 0x07, 0x08, 0x09, 0x0a, 0x0b, 0x0c, 0x0d, 0x0e, 0x0f,
    0x10, 0x11, 0x12, 0x13, 0x14, 0x15, 0x16, 0x17,
    0x20, 0x21, 0x22, 0x23, 0x24,
    0x30, 0x31, 0x32, 0x33,
    0x40, 0x41, 0x42,
    0x50, 0x51, 0x60, 0x61, 0x70, 0x71,
    0x80, 0x90, 0xa0, 0xb0, 0xc0, 0xd0, 0xe0, 0xf0,
    0xff, 0xff, 0xff, 0xff, 0xff, 0xff, 0xff, 0xff, 0xff, 0xff, 0xff, 0xff, 0xff, 0xff};

__device__ __forceinline__ unsigned ord_key(float f) {
  unsigned u = __float_as_uint(f);
  return u ^ ((u >> 31) ? 0xffffffffu : 0x80000000u);
}
__device__ __forceinline__ float ord_dec(unsigned k) {
  unsigned u = (k >> 31) ? (k ^ 0x80000000u) : ~k;
  return __uint_as_float(u);
}

__device__ void topk_unit(const Params& p, unsigned char* smem, int unit) {
  const int tid = threadIdx.x & 255, lane = tid & 63, wid = tid >> 6, l15 = lane & 15, q4 = lane >> 4;
  const int h = unit & 7, tile = unit >> 3;
  const int tok0 = tile * 64 + wid * 16;
  unsigned char* ws = p.ws;
  const bf16_t* qg = (const bf16_t*)(ws + OFF_Q);
  const bf16_t* kb = (const bf16_t*)(ws + OFF_KEYSB);
  unsigned* S = (unsigned*)(smem + wid * 16640);
  float* tops = (float*)(smem + 4 * 16640 + wid * 256);
  int* topi = (int*)(tops + 32);
  unsigned* Ms = (unsigned*)(smem + 67584 + wid * 768);
#pragma unroll
  for (int k = 0; k < 2; ++k) {
    f32x4 sc[8];
#pragma unroll
    for (int i = 0; i < 8; ++i) sc[i] = (f32x4){0, 0, 0, 0};
#pragma unroll
    for (int ks = 0; ks < 4; ++ks) {
      bf16x8 qf = as_frag(*(const u32x4*)(qg + (size_t)(tok0 + l15) * DM + h * 256 + k * 128 + ks * 32 + q4 * 8));
#pragma unroll
      for (int nt = 0; nt < 8; ++nt) {
        bf16x8 kf = as_frag(*(const u32x4*)(kb + (size_t)((h * 2 + k) * 128 + nt * 16 + l15) * 128 + ks * 32 + q4 * 8));
        sc[nt] = mfma16(kf, qf, sc[nt]);
      }
    }
#pragma unroll
    for (int nt = 0; nt < 8; ++nt) {
      const int n = nt * 16 + q4 * 4;
      u32x4 kk;
#pragma unroll
      for (int r = 0; r < 4; ++r) kk[r] = (ord_key(sc[nt][r]) & ~127u) | (unsigned)(127 - (n + r));
      *(u32x4*)(S + l15 * 260 + k * 128 + n) = kk;
    }
  }
  const unsigned ct = cand_tab[lane];
  const int ca = ct >> 4, cbb = ct & 15;
  int* idxo = (int*)(ws + OFF_IDX);
  float* go = (float*)(ws + OFF_G);
  for (int tk = 0; tk < 16; ++tk) {
    const unsigned* row = S + tk * 260;
    unsigned ka[2], kb[2], mxk[2];
#pragma unroll
    for (int hf = 0; hf < 2; ++hf) {
      ka[hf] = row[hf * 128 + lane];
      kb[hf] = row[hf * 128 + 64 + lane];
      mxk[hf] = ka[hf] > kb[hf] ? ka[hf] : kb[hf];
      Ms[hf * 96 + lane] = mxk[hf];
    }
    int cnt[2][4];
#pragma unroll
    for (int hf = 0; hf < 2; ++hf)
#pragma unroll
      for (int e = 0; e < 4; ++e) cnt[hf][e] = 0;
#pragma unroll
    for (int j = 0; j < 16; ++j)
#pragma unroll
      for (int hf = 0; hf < 2; ++hf) {
        u32x4 x = *(const u32x4*)(Ms + hf * 96 + j * 4);
#pragma unroll
        for (int e = 0; e < 4; ++e) cnt[hf][e] += (x[e] > mxk[hf]) ? 1 : 0;
      }
    bool ca_[2], cb_[2];
    int pa[2], pb[2], ncand[2];
    const unsigned long long lt = (1ull << lane) - 1ull;
#pragma unroll
    for (int hf = 0; hf < 2; ++hf) {
      const int c_ = cnt[hf][0] + cnt[hf][1] + cnt[hf][2] + cnt[hf][3];
      const unsigned long long bm = __ballot(c_ == 15);
      const int srcT = __ffsll((long long)bm) - 1;
      const unsigned T0 = (unsigned)__shfl((int)mxk[hf], srcT);
      ca_[hf] = ka[hf] >= T0;
      cb_[hf] = kb[hf] >= T0;
      const unsigned long long ba = __ballot(ca_[hf]), bb = __ballot(cb_[hf]);
      const int na = __popcll(ba);
      pa[hf] = __popcll(ba & lt);
      pb[hf] = na + __popcll(bb & lt);
      ncand[hf] = na + __popcll(bb);
    }
#pragma unroll
    for (int hf = 0; hf < 2; ++hf) {
      unsigned* Cs = Ms + hf * 96 + 64;
      if (lane < 32) Cs[lane] = 0u;
      if (ca_[hf]) Cs[pa[hf]] = ka[hf];
      if (cb_[hf]) Cs[pb[hf]] = kb[hf];
    }
    unsigned my[2];
    int rk2[2][4];
#pragma unroll
    for (int hf = 0; hf < 2; ++hf) {
      my[hf] = Ms[hf * 96 + 64 + (lane & 31)];
#pragma unroll
      for (int e = 0; e < 4; ++e) rk2[hf][e] = 0;
    }
#pragma unroll
    for (int j = 0; j < 8; ++j)
#pragma unroll
      for (int hf = 0; hf < 2; ++hf) {
        u32x4 x = *(const u32x4*)(Ms + hf * 96 + 64 + j * 4);
#pragma unroll
        for (int e = 0; e < 4; ++e) rk2[hf][e] += (x[e] > my[hf]) ? 1 : 0;
      }
#pragma unroll
    for (int hf = 0; hf < 2; ++hf) {
      const int r_ = rk2[hf][0] + rk2[hf][1] + rk2[hf][2] + rk2[hf][3];
      if (lane < ncand[hf] && r_ < 16) {
        tops[hf * 16 + r_] = ord_dec(my[hf] & ~127u);
        topi[hf * 16 + r_] = 127 - (int)(my[hf] & 127u);
      }
    }
    float cs = 0.f;
    unsigned ck = 0u;
    if (lane < 50) {
      cs = tops[ca] + tops[16 + cbb];
      ck = (ord_key(cs) & ~255u) | (unsigned)(255 - (ca * 16 + cbb));
    }
    int rkA = 0, rkB = 0;
#pragma unroll
    for (int j = 0; j < 50; j += 2) {
      const unsigned oj = (unsigned)__builtin_amdgcn_readlane((int)ck, j);
      const unsigned oj2 = (unsigned)__builtin_amdgcn_readlane((int)ck, j + 1);
      rkA += (oj > ck) ? 1 : 0;
      rkB += (oj2 > ck) ? 1 : 0;
    }
    const int rk = rkA + rkB;
    const float mx = tops[0] + tops[16];
    const bool sel = (lane < 50) && (rk < 16);
    const float ev = sel ? __expf(cs - mx) : 0.f;
    const float sum = wave_sum(ev);
    if (sel) {
      const size_t o = (size_t)(tok0 + tk) * 128 + h * 16 + rk;
      idxo[o] = topi[ca] * 128 + topi[16 + cbb];
      go[o] = ev * __builtin_amdgcn_rcpf(sum);
    }
  }
}

__device__ __forceinline__ float ub0(unsigned w) { return (float)(w & 0xffu); }
__device__ __forceinline__ float ub1(unsigned w) { return (float)((w >> 8) & 0xffu); }
__device__ __forceinline__ float ub2(unsigned w) { return (float)((w >> 16) & 0xffu); }
__device__ __forceinline__ float ub3(unsigned w) { return (float)(w >> 24); }

#define OFF_XQ OFF_YPART
#define OFF_WBUF OFF_ST
__device__ void phase_gather_u(const Params& p) {
  const int tid = threadIdx.x, lane = tid & 63, wid = tid >> 6;
  unsigned char* ws = p.ws;
  const unsigned char* ub = ws + OFF_XB;
  const int* idxg = (const int*)(ws + OFF_IDX);
  u32x4* xq = (u32x4*)(ws + OFF_XQ);
  int* wbuf = (int*)(ws + OFF_WBUF);
  float* sxa = (float*)(ws + OFF_WBUF + 8 * MIB);
  const bool b5 = (lane & 32) != 0, b4 = (lane & 16) != 0, b3 = (lane & 8) != 0;
  const int srcl = ((lane & 1) << 3) | (((lane >> 1) & 1) << 4) | (((lane >> 2) & 1) << 5);
  const int tbase = blockIdx.x * 8 + wid, tstride = gridDim.x * 8;
  for (int t = tbase; t < T_TOK; t += tstride) {
    const float* orow = p.out + (size_t)t * DM + lane * 32;
    float xr[32];
    float amax = 0.f;
#pragma unroll
    for (int q = 0; q < 8; ++q) {
      f32x4 v = *(const f32x4*)(orow + q * 4);
#pragma unroll
      for (int k = 0; k < 4; ++k) { xr[q * 4 + k] = v[k]; amax = fmaxf(amax, fabsf(v[k])); }
    }
#pragma unroll
    for (int o = 32; o > 0; o >>= 1) amax = fmaxf(amax, __shfl_xor(amax, o));
    const float inv = amax > 0.f ? 119.f / amax : 0.f;
    u32x4 ph, pl;
#pragma unroll
    for (int m = 0; m < 4; ++m) {
      unsigned wh = 0, wl = 0;
#pragma unroll
      for (int j = 0; j < 4; ++j) {
        const int a_ = __float2int_rn(xr[m * 8 + j] * inv), b_ = __float2int_rn(xr[m * 8 + 4 + j] * inv);
        const int ah = (a_ + 8) >> 4, bh = (b_ + 8) >> 4;
        const int al = a_ - 16 * ah, bl = b_ - 16 * bh;
        wh |= (((unsigned)ah & 0xfu) | (((unsigned)bh & 0xfu) << 4)) << (8 * j);
        wl |= (((unsigned)al & 0xfu) | (((unsigned)bl & 0xfu) << 4)) << (8 * j);
      }
      ph[m] = wh;
      pl[m] = wl;
    }
    xq[((size_t)t * 64 + lane) * 2] = ph;
    xq[((size_t)t * 64 + lane) * 2 + 1] = pl;
    if (lane == 0) sxa[t] = amax * (1.f / 119.f);
  }
  asm volatile("s_waitcnt vmcnt(0)" ::: "memory");
#pragma unroll 1
  for (int r = 0; r < 4; ++r) {
#pragma unroll 1
    for (int t = tbase; t < T_TOK; t += tstride) {
      const u32x4 ph = xq[((size_t)t * 64 + lane) * 2], pl = xq[((size_t)t * 64 + lane) * 2 + 1];
      const int idA = idxg[(size_t)t * 128 + lane], idB = idxg[(size_t)t * 128 + 64 + lane];
      unsigned long long m0 = __ballot((idA >> 12) == r), m1 = __ballot((idB >> 12) == r);
      while (m0 | m1) {
        int jk[16];
        u32x4 rw[16];
        const int nvalid = min((int)(__popcll(m0) + __popcll(m1)), 16);
        int jfirst, efirst;
        if (m0) { jfirst = __builtin_amdgcn_readfirstlane(__ffsll((long long)m0) - 1); efirst = __builtin_amdgcn_readlane(idA, jfirst); }
        else { const int j1 = __builtin_amdgcn_readfirstlane(__ffsll((long long)m1) - 1); efirst = __builtin_amdgcn_readlane(idB, j1); jfirst = 64 + j1; }
#pragma unroll
        for (int k = 0; k < 16; ++k) {
          int j = jfirst, e = efirst;
          if (m0) { const int jj = __builtin_amdgcn_readfirstlane(__ffsll((long long)m0) - 1); m0 &= m0 - 1ull; j = jj; e = __builtin_amdgcn_readlane(idA, jj); }
          else if (m1) { const int jj = __builtin_amdgcn_readfirstlane(__ffsll((long long)m1) - 1); m1 &= m1 - 1ull; j = 64 + jj; e = __builtin_amdgcn_readlane(idB, jj); }
          jk[k] = j;
          rw[k] = *(const u32x4*)(ub + (size_t)e * 1024 + lane * 16);
        }
#pragma unroll
        for (int bt = 0; bt < 2; ++bt) {
          int dv[8];
#pragma unroll
          for (int k = 0; k < 8; ++k) {
            int dh = 0, dl = 0;
#pragma unroll
            for (int q = 0; q < 4; ++q) {
              dh = __builtin_amdgcn_sdot8((int)rw[bt * 8 + k][q], (int)ph[q], dh, false);
              dl = __builtin_amdgcn_sdot8((int)rw[bt * 8 + k][q], (int)pl[q], dl, false);
            }
            dv[k] = 16 * dh + dl;
          }
          int a4[4], a2[2];
#pragma unroll
          for (int k = 0; k < 4; ++k) {
            const int mine = b5 ? dv[k + 4] : dv[k], oth = b5 ? dv[k] : dv[k + 4];
            a4[k] = mine + __shfl_xor(oth, 32);
          }
#pragma unroll
          for (int k = 0; k < 2; ++k) {
            const int mine = b4 ? a4[k + 2] : a4[k], oth = b4 ? a4[k] : a4[k + 2];
            a2[k] = mine + __shfl_xor(oth, 16);
          }
          int c1;
          {
            const int mine = b3 ? a2[1] : a2[0], oth = b3 ? a2[0] : a2[1];
            c1 = mine + __shfl_xor(oth, 8);
          }
          c1 += __shfl_xor(c1, 4);
          c1 += __shfl_xor(c1, 2);
          c1 += __shfl_xor(c1, 1);
          const int val = __shfl(c1, srcl);
          int jsel = jk[bt * 8];
#pragma unroll
          for (int k = 1; k < 8; ++k) jsel = (lane == k) ? jk[bt * 8 + k] : jsel;
          if (lane < 8 && lane < nvalid - bt * 8) wbuf[(size_t)t * 128 + jsel] = val;
        }
      }
    }
  }
  asm volatile("s_waitcnt vmcnt(0)" ::: "memory");
}

#define GROWS 8
#ifndef USE_SDOT4
#define USE_SDOT4 1
#endif
typedef float f32x2 __attribute__((ext_vector_type(2)));
__device__ void phase_gather(const Params& p) {
  const int tid = threadIdx.x, lane = tid & 63, wid = tid >> 6;
  unsigned char* ws = p.ws;
  const unsigned char* ub = ws + OFF_XB;
  const unsigned char* vb = ws + OFF_XB + 16 * MIB;
  const float* scales = (const float*)(ws + OFF_SCALES);
  const int* idxg = (const int*)(ws + OFF_IDX);
  const float* gg = (const float*)(ws + OFF_G);
  const float* ssq2 = (const float*)(ws + OFF_SSQ2);
  const bool b5 = (lane & 32) != 0, b4 = (lane & 16) != 0, b3 = (lane & 8) != 0;
  const int srcl = ((lane & 1) << 3) | (((lane >> 1) & 1) << 4) | (((lane >> 2) & 1) << 5);
  for (int t = blockIdx.x * 8 + wid; t < T_TOK; t += gridDim.x * 8) {
    const int id0 = idxg[(size_t)t * 128 + lane], id1 = idxg[(size_t)t * 128 + 64 + lane];
    const float g0 = gg[(size_t)t * 128 + lane], g1 = gg[(size_t)t * 128 + 64 + lane];
    const float su0 = scales[id0], su1 = scales[id1], sv0 = scales[16384 + id0], sv1 = scales[16384 + id1];
    float* orow = p.out + (size_t)t * DM + lane * 32;
    const float sx = ((const float*)(ws + OFF_WBUF + 8 * MIB))[t];
    float sq = (lane < 32) ? ssq2[(size_t)t * 32 + lane] : 0.f;
    sq = wave_sum(sq);
    const float rs2 = rsqrtf(sq * (1.f / 2048.f) + EPSV);
    const int* wbuf = (const int*)(ws + OFF_WBUF);
    const int d0 = wbuf[(size_t)t * 128 + lane], d1 = wbuf[(size_t)t * 128 + 64 + lane];
    const float w0 = gelu_((float)d0 * (su0 * sx * rs2)) * g0 * sv0;
    const float w1 = gelu_((float)d1 * (su1 * sx * rs2)) * g1 * sv1;
    float wmax = fmaxf(fabsf(w0), fabsf(w1));
#pragma unroll
    for (int o = 32; o > 0; o >>= 1) wmax = fmaxf(wmax, __shfl_xor(wmax, o));
    const float sw = wmax * (1.f / 127.f);
    const float winv = wmax > 0.f ? 127.f / wmax : 0.f;
    const int q0 = __float2int_rn(w0 * winv), q1 = __float2int_rn(w1 * winv);
    int wsumq = q0 + q1;
#pragma unroll
    for (int o = 32; o > 0; o >>= 1) wsumq += __shfl_xor(wsumq, o);
    int pk0 = (int)(((unsigned)q0 & 0xffu) << (8 * (lane & 3))), pk1 = (int)(((unsigned)q1 & 0xffu) << (8 * (lane & 3)));
    pk0 |= __shfl_xor(pk0, 1); pk0 |= __shfl_xor(pk0, 2);
    pk1 |= __shfl_xor(pk1, 1); pk1 |= __shfl_xor(pk1, 2);
    int acc[32];
#pragma unroll
    for (int i = 0; i < 32; ++i) acc[i] = 0;
#pragma unroll 1
    for (int half = 0; half < 2; ++half) {
      const int idv = half ? id1 : id0;
      const int pkv = half ? pk1 : pk0;
      u32x4 rr[3][GROWS];
#pragma unroll
      for (int k = 0; k < GROWS; ++k) {
        const int e = __builtin_amdgcn_readlane(idv, k);
        rr[0][k] = *(const u32x4*)(vb + (size_t)e * 1024 + lane * 16);
        const int e2 = __builtin_amdgcn_readlane(idv, GROWS + k);
        rr[1][k] = *(const u32x4*)(vb + (size_t)e2 * 1024 + lane * 16);
      }
#pragma unroll
      for (int gi = 0; gi < 64 / GROWS; ++gi) {
        const int j0 = gi * GROWS;
        if (gi + 2 < 64 / GROWS) {
#pragma unroll
          for (int k = 0; k < GROWS; ++k) {
            const int e = __builtin_amdgcn_readlane(idv, j0 + 2 * GROWS + k);
            rr[(gi + 2) % 3][k] = *(const u32x4*)(vb + (size_t)e * 1024 + lane * 16);
          }
        }
#pragma unroll
        for (int sub = 0; sub < GROWS / 4; ++sub) {
          const int W4 = __builtin_amdgcn_readlane(pkv, j0 + 4 * sub);
#pragma unroll
          for (int m = 0; m < 4; ++m) {
            unsigned lo[4], hi[4];
#pragma unroll
            for (int k = 0; k < 4; ++k) {
              const unsigned w = rr[gi % 3][sub * 4 + k][m];
              lo[k] = w & 0x0f0f0f0fu;
              hi[k] = (w >> 4) & 0x0f0f0f0fu;
            }
            {
              const unsigned p01l = __builtin_amdgcn_perm(lo[1], lo[0], 0x05010400u), p01h = __builtin_amdgcn_perm(lo[1], lo[0], 0x07030602u);
              const unsigned p23l = __builtin_amdgcn_perm(lo[3], lo[2], 0x05010400u), p23h = __builtin_amdgcn_perm(lo[3], lo[2], 0x07030602u);
              acc[m * 8 + 0] = __builtin_amdgcn_sdot4((int)__builtin_amdgcn_perm(p23l, p01l, 0x05040100u), W4, acc[m * 8 + 0], false);
              acc[m * 8 + 1] = __builtin_amdgcn_sdot4((int)__builtin_amdgcn_perm(p23l, p01l, 0x07060302u), W4, acc[m * 8 + 1], false);
              acc[m * 8 + 2] = __builtin_amdgcn_sdot4((int)__builtin_amdgcn_perm(p23h, p01h, 0x05040100u), W4, acc[m * 8 + 2], false);
              acc[m * 8 + 3] = __builtin_amdgcn_sdot4((int)__builtin_amdgcn_perm(p23h, p01h, 0x07060302u), W4, acc[m * 8 + 3], false);
            }
            {
              const unsigned p01l = __builtin_amdgcn_perm(hi[1], hi[0], 0x05010400u), p01h = __builtin_amdgcn_perm(hi[1], hi[0], 0x07030602u);
              const unsigned p23l = __builtin_amdgcn_perm(hi[3], hi[2], 0x05010400u), p23h = __builtin_amdgcn_perm(hi[3], hi[2], 0x07030602u);
              acc[m * 8 + 4] = __builtin_amdgcn_sdot4((int)__builtin_amdgcn_perm(p23l, p01l, 0x05040100u), W4, acc[m * 8 + 4], false);
              acc[m * 8 + 5] = __builtin_amdgcn_sdot4((int)__builtin_amdgcn_perm(p23l, p01l, 0x07060302u), W4, acc[m * 8 + 5], false);
              acc[m * 8 + 6] = __builtin_amdgcn_sdot4((int)__builtin_amdgcn_perm(p23h, p01h, 0x05040100u), W4, acc[m * 8 + 6], false);
              acc[m * 8 + 7] = __builtin_amdgcn_sdot4((int)__builtin_amdgcn_perm(p23h, p01h, 0x07060302u), W4, acc[m * 8 + 7], false);
            }
          }
        }
      }
    }
    float val[32];
    float ss = 0.f;
    const int off8 = 8 * wsumq;
#pragma unroll
    for (int q = 0; q < 8; ++q) {
      f32x4 v = *(const f32x4*)(orow + q * 4);
#pragma unroll
      for (int k = 0; k < 4; ++k) {
        val[q * 4 + k] = sw * (float)(acc[q * 4 + k] - off8) + v[k];
        ss += val[q * 4 + k] * val[q * 4 + k];
      }
    }
    ss = wave_sum(ss);
    const float rs3 = rsqrtf(ss * (1.f / 2048.f) + EPSV);
#pragma unroll
    for (int q = 0; q < 8; ++q) {
      f32x4 wf = *(const f32x4*)(p.norm_final_w + lane * 32 + q * 4);
      f32x4 o = {val[q * 4 + 0] * rs3 * wf[0], val[q * 4 + 1] * rs3 * wf[1], val[q * 4 + 2] * rs3 * wf[2],
                 val[q * 4 + 3] * rs3 * wf[3]};
      *(f32x4*)(orow + q * 4) = o;
    }
  }
}

#define XB_TMO      128
#define XB_XCNT(j)  (256  + 64 * (j))
#define XB_XSUB(j)  (1280 + 64 * (j))
#define XB_XGEN(j)  (2304 + 64 * (j))
#define XB_TOP      3328
#define XB_TOPGEN   3392
#define XCD_BAR_WORDS 3456
#define XB_SPIN_CAP (1u << 18)
#define XLAS __attribute__((address_space(3)))
__device__ __forceinline__ unsigned xb_ld(unsigned* p) { return __hip_atomic_load(p, __ATOMIC_RELAXED, __HIP_MEMORY_SCOPE_AGENT); }
__device__ __forceinline__ unsigned xb_add(unsigned* p, unsigned v) { return __hip_atomic_fetch_add(p, v, __ATOMIC_RELAXED, __HIP_MEMORY_SCOPE_AGENT); }
__device__ __forceinline__ unsigned xb_xcc_id() { return (unsigned)__builtin_amdgcn_s_getreg((3 << 11) | 20) & 0xFu; }
#define XB_SPIN(cond, bar) do { unsigned _sp = 0; while (cond) { __builtin_amdgcn_s_sleep(1); \
    if ((++_sp & 255u) == 0u) { if (xb_ld(&(bar)[XB_TMO])) break; if (_sp > XB_SPIN_CAP) { atomicAdd(&(bar)[XB_TMO], 1u); break; } } } } while (0)
struct XcdBarrier { unsigned* bar; unsigned x; volatile XLAS unsigned* st; };
__device__ __forceinline__ XcdBarrier xcd_barrier_post(unsigned* bar, volatile XLAS unsigned* st) {
  XcdBarrier b; b.bar = bar; b.x = xb_xcc_id(); b.st = st;
  if (threadIdx.x == 0) (void)xb_add(&bar[XB_XCNT(b.x)], 1u);
  return b;
}
__device__ __forceinline__ void xcd_barrier_complete(unsigned* bar, unsigned x, unsigned& nloc, unsigned& nx) {
  const unsigned G = gridDim.x * gridDim.y * gridDim.z;
  unsigned sum, cnt, mine, sp = 0u;
  for (;;) {
    sum = 0u; cnt = 0u; mine = 0u;
#pragma unroll
    for (unsigned j = 0; j < 16; ++j) { const unsigned c = xb_ld(&bar[XB_XCNT(j)]); sum += c; cnt += (c > 0u) ? 1u : 0u; mine = (j == x) ? c : mine; }
    if (sum == G) break;
    __builtin_amdgcn_s_sleep(1);
    if ((++sp & 255u) == 0u) { if (xb_ld(&bar[XB_TMO])) break; if (sp > XB_SPIN_CAP) { atomicAdd(&bar[XB_TMO], 1u); break; } }
  }
  nloc = mine > 0u ? mine : 1u; nx = cnt > 0u ? cnt : 1u;
}
__device__ __forceinline__ void xcd_barrier(const XcdBarrier& b) {
  asm volatile("s_waitcnt vmcnt(0)" ::: "memory");
  __syncthreads();
  if (threadIdx.x == 0) {
    unsigned* bar = b.bar;
    __builtin_amdgcn_s_waitcnt(0);
    unsigned nloc = b.st[0], nx = b.st[1];
    if (nloc == 0u) { xcd_barrier_complete(bar, b.x, nloc, nx); b.st[0] = nloc; b.st[1] = nx; }
    const unsigned old = xb_add(&bar[XB_XSUB(b.x)], 1u);
    const unsigned gen = old / nloc;
    if (old + 1u == (gen + 1u) * nloc) {
      __builtin_amdgcn_fence(__ATOMIC_RELEASE, "agent");
      asm volatile("s_waitcnt vmcnt(0)" ::: "memory");
      const unsigned og = xb_add(&bar[XB_TOP], 1u);
      const unsigned tg = og / nx;
      if (og + 1u == (tg + 1u) * nx) xb_add(&bar[XB_TOPGEN], 1u);
      else XB_SPIN(xb_ld(&bar[XB_TOPGEN]) == tg, bar);
      __builtin_amdgcn_fence(__ATOMIC_ACQUIRE, "agent");
      xb_add(&bar[XB_XGEN(b.x)], 1u);
      asm volatile("s_waitcnt vmcnt(0)" ::: "memory");
    } else {
      XB_SPIN(xb_ld(&bar[XB_XGEN(b.x)]) == gen, bar);
      __builtin_amdgcn_fence(__ATOMIC_ACQUIRE, "agent");
      asm volatile("s_waitcnt vmcnt(0)" ::: "memory");
    }
  }
  __syncthreads();
}

__global__ void __launch_bounds__(NTHR, 2) fwd_kernel(Params p) {
  __shared__ __attribute__((aligned(16))) unsigned char smem[SMEM_BYTES];
  __shared__ uint4 xb_words;
  cg::grid_group grid = cg::this_grid();
  unsigned char* ws = p.ws;
  if (threadIdx.x == 0) xb_words = make_uint4(0u, 0u, 0u, 0u);
  __syncthreads();
  XcdBarrier xb = xcd_barrier_post((unsigned*)(ws + OFF_BAR), (volatile XLAS unsigned*)&xb_words);
  const int hb = threadIdx.x >> 8;
  unsigned char* hsm = smem + hb * SMEM_HALF;
#define PHASE_ON(n) (p.phase_lo <= (n) && (n) <= p.phase_hi)
#define PHASE_SYNC(n) if (p.coop && PHASE_ON(n) && (n) < p.phase_hi) { if (p.coop == 2) grid.sync(); else xcd_barrier(xb); }
  if (PHASE_ON(0)) phase_prep(p, smem);
  PHASE_SYNC(0)
  if (PHASE_ON(1)) {
    pg8::Gemm g{(const bf16_t*)(ws + OFF_XB), (const bf16_t*)(ws + OFF_WINT), T_TOK, NPAD1, 2048};
    pg8::SimpleOrder S; S.init(T_TOK, NPAD1, gridDim.x, blockIdx.x);
    pg8::Epi1 E{(const float*)(ws + OFF_RS1), (bf16_t*)(ws + OFF_PROJ)};
    pg8::gemm_phase<pg8::Epi1, pg8::SimpleOrder, 0>((PG8_LAS unsigned char*)smem, g, S, E);
  }
  PHASE_SYNC(1)
  if (PHASE_ON(2)) {
    {
      const int u_step = gridDim.x * 2;
      const int nk = (int)blockIdx.x * 2 < 2048 ? (2048 - (int)blockIdx.x * 2 + u_step - 1) / u_step : 0;
      if (nk == 0) conv_prepass(p, 0, 1);
      int kk = 0;
      for (int u0 = blockIdx.x * 2; u0 < 2048; u0 += u_step, ++kk) {
        lru_local_unit(p, hsm, u0 + hb);
        conv_prepass(p, kk, nk);
      }
    }
    if (p.coop) xcd_barrier(xb);
    for (int u0 = blockIdx.x * 2; u0 < 2048; u0 += gridDim.x * 2) ssd_local_unit(p, hsm, u0 + hb);
  }
  PHASE_SYNC(2)
  if (PHASE_ON(3)) phase_carry(p);
  PHASE_SYNC(3)
  if (PHASE_ON(4)) phase_mix_final(p);
  PHASE_SYNC(4)
  if (PHASE_ON(5)) {
    pg8::Gemm g{(const bf16_t*)(ws + OFF_XB), (const bf16_t*)(ws + OFF_WOUTT), T_TOK, 2048, 2048};
    pg8::SimpleOrder S; S.init(T_TOK, 2048, gridDim.x, blockIdx.x);
    pg8::Epi2 E{p.x, p.out, (bf16_t*)(ws + OFF_X1B), (float*)(ws + OFF_SSQ2), (const float*)(ws + OFF_SSQ)};
    pg8::gemm_phase<pg8::Epi2, pg8::SimpleOrder, 16>((PG8_LAS unsigned char*)smem, g, S, E);
  }
  PHASE_SYNC(5)
  if (PHASE_ON(6)) {
    pg8::Gemm g{(const bf16_t*)(ws + OFF_X1B), (const bf16_t*)(ws + OFF_WQT), T_TOK, 2048, 2048};
    pg8::SimpleOrder S; S.init(T_TOK, 2048, gridDim.x, blockIdx.x);
    pg8::Epi3 E{(const float*)(ws + OFF_SSQ2), (bf16_t*)(ws + OFF_Q)};
    pg8::gemm_phase<pg8::Epi3, pg8::SimpleOrder, 0>((PG8_LAS unsigned char*)smem, g, S, E);
  }
  PHASE_SYNC(6)
  if (PHASE_ON(7)) {
    const int u_first = blockIdx.x * 2 + hb, u_step = gridDim.x * 2;
    const int nk = u_first < 2048 ? (2048 - u_first + u_step - 1) / u_step : 0;
    if (nk == 0) convert_uv(p, 0, 1);
    int kk = 0;
    for (int u = u_first; u < 2048; u += u_step, ++kk) {
      topk_unit(p, hsm, u);
      convert_uv(p, kk, nk);
    }
  }
  PHASE_SYNC(7)
  if (PHASE_ON(8)) { phase_gather_u(p); phase_gather(p); }
}

extern "C" void kernel_launch(void* const* d_in, const int* in_sizes, int n_in, void* d_out, int out_size,
                              void* d_ws, size_t ws_size, hipStream_t stream) {
  Params p{};
  const float** fp = (const float**)&p;
  for (int i = 0; i < 23; ++i) fp[i] = (const float*)d_in[i];
  p.out = (float*)d_out;
  p.ws = (unsigned char*)d_ws;
  static int grid_blocks = 0;
  if (!grid_blocks) {
    int dev = 0, cus = 0, per_cu = 0;
    hipGetDevice(&dev);
    hipDeviceGetAttribute(&cus, hipDeviceAttributeMultiprocessorCount, dev);
    hipOccupancyMaxActiveBlocksPerMultiprocessor(&per_cu, fwd_kernel, NTHR, 0);
    if (per_cu < 1) per_cu = 1;
    if (per_cu > 1) per_cu = 1;
    grid_blocks = cus * per_cu;
  }
#if SINGLE_LAUNCH
  p.phase_lo = 0; p.phase_hi = 8; p.coop = 1;
  hipMemsetAsync((unsigned char*)d_ws + OFF_BAR, 0, XCD_BAR_WORDS * sizeof(unsigned), stream);
  void* args[] = {&p};
  hipError_t e = hipLaunchCooperativeKernel((void*)fwd_kernel, dim3(grid_blocks), dim3(NTHR), args, 0, stream);
  if (e != hipSuccess) fprintf(stderr, "cooperative launch failed: %s (grid %d)\n", hipGetErrorString(e), grid_blocks);
#else
  for (int ph = 0; ph <= 8; ++ph) {
    p.phase_lo = ph; p.phase_hi = ph; p.coop = 0;
    hipLaunchKernelGGL(fwd_kernel, dim3(grid_blocks), dim3(NTHR), 0, stream, p);
  }
#endif
}
```

```cpp
#include <hip/hip_runtime.h>
#include <hip/hip_cooperative_groups.h>
#include <cstdio>
namespace cg = cooperative_groups;

#ifndef DBL_PHASE
#define DBL_PHASE -1
#endif
#ifndef SINGLE_LAUNCH
#define SINGLE_LAUNCH 1
#endif

typedef unsigned short bf16_t;
typedef short bf16x8 __attribute__((ext_vector_type(8)));
typedef float f32x4 __attribute__((ext_vector_type(4)));
typedef unsigned u32x4 __attribute__((ext_vector_type(4)));
typedef unsigned u32x2 __attribute__((ext_vector_type(2)));
typedef __bf16 bf2_t __attribute__((ext_vector_type(2)));

#define T_TOK 16384
#define DM 2048
#define LDP 4736
#define NPAD1 4864
#define NTHR 512
#define HTHR 256
#define SMEM_HALF 73728
#define SMEM_BYTES 147456
#define EPSV 1e-6f
#define MIB ((size_t)1 << 20)

#define OFF_XB (0 * MIB)
#define OFF_PROJ (64 * MIB)
#define OFF_X1B (64 * MIB)
#define OFF_Q (128 * MIB)
#define OFF_IDX (192 * MIB)
#define OFF_G (200 * MIB)
#define OFF_HLOC (212 * MIB)
#define OFF_CUMA (276 * MIB)
#define OFF_YPART (340 * MIB)
#define OFF_ST (372 * MIB)
#define OFF_WINT (436 * MIB)
#define OFF_WOUTT (455 * MIB)
#define OFF_WQT (463 * MIB)
#define OFF_WAT (471 * MIB)
#define OFF_WXT (471 * MIB + 131072)
#define OFF_KEYSB (471 * MIB + 262144)
#define OFF_RS1 (472 * MIB)
#define OFF_ACS (472 * MIB + 65536)
#define OFF_LCARRY (OFF_ACS + MIB)
#define OFF_SSQ (OFF_LCARRY + 524288)
#define OFF_SSQ2 (OFF_SSQ + MIB)
#define OFF_SCALES (OFF_SSQ2 + 2 * MIB)
#define OFF_XACT (0 * MIB)
#define OFF_BACT (32 * MIB)
#define OFF_SINB_LO OFF_WINT
#define OFF_SINB_HI (488 * MIB)
#define OFF_BAR (487 * MIB)
#define OFF_CACT (478 * MIB)

struct Params {
  const float *x, *norm_mix_w, *w_in, *lru_conv_w, *lru_conv_b, *lru_wa, *lru_ba, *lru_wx, *lru_bx, *lru_lambda;
  const float *ssd_conv_w, *ssd_conv_b, *ssd_dt_bias, *ssd_a_log, *ssd_d, *ssd_norm_w, *w_out, *norm_ffn_w, *peer_wq;
  const float *peer_sub_keys, *peer_u, *peer_v, *norm_final_w;
  float* out;
  unsigned char* ws;
  int phase_lo, phase_hi, coop, pad0;
};

__device__ __forceinline__ unsigned pk2(float lo, float hi) {
  unsigned r;
  asm("v_cvt_pk_bf16_f32 %0, %1, %2" : "=v"(r) : "v"(lo), "v"(hi));
  return r;
}
__device__ __forceinline__ float bf2f(bf16_t v) { return __uint_as_float(((unsigned)v) << 16); }
__device__ __forceinline__ float bflo(unsigned u) { return __uint_as_float(u << 16); }
__device__ __forceinline__ float bfhi(unsigned u) { return __uint_as_float(u & 0xffff0000u); }
__device__ __forceinline__ float wave_sum(float v) {
#pragma unroll
  for (int o = 32; o > 0; o >>= 1) v += __shfl_xor(v, o);
  return v;
}
__device__ __forceinline__ float sigmoid_(float x) { return __builtin_amdgcn_rcpf(1.f + __expf(-x)); }
__device__ __forceinline__ float silu_(float x) { return x * sigmoid_(x); }
__device__ __forceinline__ float gelu_(float x) {
  float u = 0.7978845608028654f * (x + 0.044715f * x * x * x);
  return x * sigmoid_(2.f * u);
}
__device__ __forceinline__ float softplus_(float x) { return fmaxf(x, 0.f) + log1pf(__expf(-fabsf(x))); }
__device__ __forceinline__ f32x4 mfma16(bf16x8 a, bf16x8 b, f32x4 c) {
  return __builtin_amdgcn_mfma_f32_16x16x32_bf16(a, b, c, 0, 0, 0);
}
__device__ __forceinline__ bf16x8 as_frag(u32x4 v) { return __builtin_bit_cast(bf16x8, v); }
__device__ __forceinline__ int sw256(int row, int chunk) { return row * 256 + ((chunk ^ (row & 15)) << 4); }
__device__ __forceinline__ int sw128(int row, int chunk) { return row * 128 + ((chunk ^ ((row >> 1) & 7)) << 4); }

__device__ __forceinline__ bf16_t* sinb_ptr(unsigned char* ws, int b, int c, int hh) {
  return (bf16_t*)(ws + (b < 4 ? OFF_SINB_LO : OFF_SINB_HI)) + (size_t)(((b & 3) * 16 + c) * 16 + hh) * 8192;
}
__device__ __forceinline__ float rs_from_ssq2(const float* ssq2, int row) {
  const f32x4* pp = (const f32x4*)(ssq2 + (size_t)row * 32);
  float s = 0.f;
#pragma unroll
  for (int i = 0; i < 8; ++i) { f32x4 v = pp[i]; s += v[0] + v[1] + v[2] + v[3]; }
  return rsqrtf(s * (1.f / 2048.f) + EPSV);
}
__device__ __forceinline__ float rs_from_ssq(const float* ssq, int row) {
  const f32x4* pp = (const f32x4*)(ssq + (size_t)row * 16);
  float s = 0.f;
#pragma unroll
  for (int i = 0; i < 4; ++i) { f32x4 v = pp[i]; s += v[0] + v[1] + v[2] + v[3]; }
  return rsqrtf(s * (1.f / 1024.f) + EPSV);
}

__device__ void transpose_tile(const float* __restrict__ src, int ld_src, int r0, int c0, int c_valid,
                               bf16_t* __restrict__ dst, int ld_dst, const float* __restrict__ scale, int scale_from,
                               float* tile, bool valid) {
  const int tid = threadIdx.x & 255;
  {
    const int j = tid & 63, i0 = tid >> 6;
#pragma unroll
    for (int ii = 0; ii < 16; ++ii) {
      const int i = i0 + 4 * ii;
      float v = 0.f;
      if (valid && c0 + j < c_valid) {
        v = src[(size_t)(r0 + i) * ld_src + c0 + j];
        if (scale != nullptr && (r0 + i) >= scale_from) v *= scale[r0 + i - scale_from];
      }
      tile[i * 65 + j] = v;
    }
  }
  __syncthreads();
  {
    const int i4 = tid & 15, j0 = tid >> 4;
#pragma unroll
    for (int jj = 0; jj < 4; ++jj) {
      const int j = j0 + 16 * jj;
      const float* tp = tile + (4 * i4) * 65 + j;
      u32x2 o = {pk2(tp[0], tp[65]), pk2(tp[130], tp[195])};
      if (valid) *(u32x2*)(dst + (size_t)(c0 + j) * ld_dst + r0 + 4 * i4) = o;
    }
  }
  __syncthreads();
}

__device__ void phase_prep(const Params& p, unsigned char* smem) {
  const int tid = threadIdx.x, lane = tid & 63, wid = tid >> 6, hb = tid >> 8;
  unsigned char* ws = p.ws;
  bf16_t* xb = (bf16_t*)(ws + OFF_XB);
  float* rs1 = (float*)(ws + OFF_RS1);
  for (int t = blockIdx.x * 8 + wid; t < T_TOK; t += gridDim.x * 8) {
    const float* xr = p.x + (size_t)t * DM;
    bf16_t* xo = xb + (size_t)t * DM;
    float ss = 0.f;
#pragma unroll
    for (int c = 0; c < 8; ++c) {
      f32x4 v = *(const f32x4*)(xr + c * 256 + lane * 4);
      ss += v[0] * v[0] + v[1] * v[1] + v[2] * v[2] + v[3] * v[3];
      u32x2 o = {pk2(v[0], v[1]), pk2(v[2], v[3])};
      *(u32x2*)(xo + c * 256 + lane * 4) = o;
    }
    ss = wave_sum(ss);
    if (lane == 0) rs1[t] = rsqrtf(ss * (1.f / 2048.f) + EPSV);
  }
  float* tile = (float*)(smem + hb * SMEM_HALF);
  const int NT_WIN = 32 * 76, NT_SQ = 32 * 32;
  const int total = NT_WIN + 2 * NT_SQ + 32;
  for (int u0 = blockIdx.x * 2; u0 < total; u0 += gridDim.x * 2) {
    const bool valid = (u0 + hb) < total;
    const int u = valid ? (u0 + hb) : u0;
    if (u < NT_WIN) {
      const int ri = u & 31, cj = u >> 5;
      transpose_tile(p.w_in, 4624, ri * 64, cj * 64, 4624, (bf16_t*)(ws + OFF_WINT), 2048, p.norm_mix_w, 0, tile, valid);
    } else if (u < NT_WIN + NT_SQ) {
      const int v = u - NT_WIN, ri = v & 31, cj = v >> 5;
      transpose_tile(p.w_out, 2048, ri * 64, cj * 64, 2048, (bf16_t*)(ws + OFF_WOUTT), 2048, p.ssd_norm_w, 1024, tile, valid);
    } else if (u < NT_WIN + 2 * NT_SQ) {
      const int v = u - NT_WIN - NT_SQ, ri = v & 31, cj = v >> 5;
      transpose_tile(p.peer_wq, 2048, ri * 64, cj * 64, 2048, (bf16_t*)(ws + OFF_WQT), 2048, p.norm_ffn_w, 0, tile, valid);
    } else {
      const int v = u - NT_WIN - 2 * NT_SQ;
      const int h = v & 15;
      const float* src = (v < 16 ? p.lru_wa : p.lru_wx) + (size_t)h * 4096;
      bf16_t* dst = (bf16_t*)(ws + (v < 16 ? OFF_WAT : OFF_WXT)) + (size_t)h * 4096;
      transpose_tile(src, 64, 0, 0, 64, dst, 64, nullptr, 0, tile, valid);
    }
  }
  {
    bf16_t* kb = (bf16_t*)(ws + OFF_KEYSB);
    for (int i = blockIdx.x * NTHR + tid; i < 65536; i += gridDim.x * NTHR) {
      f32x4 v = *(const f32x4*)(p.peer_sub_keys + (size_t)i * 4);
      u32x2 o = {pk2(v[0], v[1]), pk2(v[2], v[3])};
      *(u32x2*)(kb + (size_t)i * 4) = o;
    }
  }
}

namespace pg8 {
#define PG8_LAS __attribute__((address_space(3)))
constexpr int BM = 256, BK = 64, HALF = 128, HTB = HALF * BK * 2;
__device__ __forceinline__ int lds_byte(int r, int c) { const int st = (r >> 4) * 2 + (c >> 5), rr = r & 15, cc = c & 31, ob = rr * 64 + cc * 2; return st * 1024 + (ob ^ (((ob >> 9) & 1) << 5)); }
__device__ __forceinline__ void stage_rc(int b, int& R, int& C) { const int st = b / 1024, sb = b % 1024, swz = sb ^ (((sb >> 9) & 1) << 5); R = (st >> 1) * 16 + swz / 64; C = (st & 1) * 32 + (swz % 64) / 2; }
struct Unit { int pm, pn; };
struct Gemm { const bf16_t* A; const bf16_t* Bt; int M, N, K; };
struct SimpleOrder {
  int nM, nwg, G, c;
  __device__ void init(int M, int N, int G_, int c_) { nM = M / BM; nwg = nM * (N / BM); G = G_; c = c_; }
  __device__ bool next(int i, Unit& u) const { const int L = i * G + c; if (L >= nwg) return false; u.pm = L % nM; u.pn = L / nM; return true; }
};
struct Epi1 {
  static constexpr bool MID = false;
  const float* rs1; bf16_t* proj;
  __device__ __forceinline__ void mid(f32x4 (&)[2][2][4][2], const Unit&, int, int) const {}
  __device__ __forceinline__ void operator()(const f32x4 (&acc)[2][2][4][2], const Unit& u, int wr, int wc, int fr, int fq) const {
    const int row0 = u.pm * BM + wr * 64 + fr, col0 = u.pn * BM + wc * 32 + 4 * fq;
#pragma unroll
    for (int ai = 0; ai < 2; ++ai)
#pragma unroll
      for (int m = 0; m < 4; ++m) {
        const int row = row0 + ai * HALF + m * 16;
        const float s = rs1[row];
#pragma unroll
        for (int bj = 0; bj < 2; ++bj)
#pragma unroll
          for (int n = 0; n < 2; ++n) {
            const int col = col0 + bj * HALF + n * 16;
            if (col < LDP) {
              f32x4 v = acc[ai][bj][m][n] * s;
              u32x2 o = {pk2(v[0], v[1]), pk2(v[2], v[3])};
              *(u32x2*)(proj + (size_t)row * LDP + col) = o;
            }
          }
      }
  }
};
struct Epi2 {
  static constexpr bool MID = true;
  const float* x; float* out; bf16_t* x1b; float* ssq2; const float* ssq;
  __device__ __forceinline__ void mid(f32x4 (&acc)[2][2][4][2], const Unit& u, int wr, int fr) const {
#pragma unroll
    for (int ai = 0; ai < 2; ++ai)
#pragma unroll
      for (int m = 0; m < 4; ++m) {
        const float s = rs_from_ssq(ssq, u.pm * BM + wr * 64 + fr + ai * HALF + m * 16);
#pragma unroll
        for (int bj = 0; bj < 2; ++bj)
#pragma unroll
          for (int n = 0; n < 2; ++n) acc[ai][bj][m][n] *= s;
        __builtin_amdgcn_sched_barrier(0);
      }
  }
  __device__ __forceinline__ void operator()(const f32x4 (&acc)[2][2][4][2], const Unit& u, int wr, int wc, int fr, int fq) const {
    const int row0 = u.pm * BM + wr * 64 + fr, col0 = u.pn * BM + wc * 32 + 4 * fq;
#pragma unroll
    for (int ai = 0; ai < 2; ++ai)
#pragma unroll
      for (int m = 0; m < 4; ++m) {
        const int row = row0 + ai * HALF + m * 16;
        float ss = 0.f;
#pragma unroll
        for (int bj = 0; bj < 2; ++bj)
#pragma unroll
          for (int n = 0; n < 2; ++n) {
            const int col = col0 + bj * HALF + n * 16;
            f32x4 xr = *(const f32x4*)(x + (size_t)row * DM + col);
            f32x4 v = acc[ai][bj][m][n] + xr;
            *(f32x4*)(out + (size_t)row * DM + col) = v;
            u32x2 o = {pk2(v[0], v[1]), pk2(v[2], v[3])};
            *(u32x2*)(x1b + (size_t)row * DM + col) = o;
            ss += v[0] * v[0] + v[1] * v[1] + v[2] * v[2] + v[3] * v[3];
          }
        ss += __shfl_xor(ss, 16);
        ss += __shfl_xor(ss, 32);
        if (fq == 0) ssq2[(size_t)row * 32 + u.pn * 4 + wc] = ss;
        __builtin_amdgcn_sched_barrier(0);
      }
  }
};
struct Epi3 {
  static constexpr bool MID = false;
  const float* ssq2; bf16_t* q;
  __device__ __forceinline__ void mid(f32x4 (&)[2][2][4][2], const Unit&, int, int) const {}
  __device__ __forceinline__ void operator()(const f32x4 (&acc)[2][2][4][2], const Unit& u, int wr, int wc, int fr, int fq) const {
    const int row0 = u.pm * BM + wr * 64 + fr, col0 = u.pn * BM + wc * 32 + 4 * fq;
#pragma unroll
    for (int ai = 0; ai < 2; ++ai)
#pragma unroll
      for (int m = 0; m < 4; ++m) {
        const int row = row0 + ai * HALF + m * 16;
        const float s = rs_from_ssq2(ssq2, row);
#pragma unroll
        for (int bj = 0; bj < 2; ++bj)
#pragma unroll
          for (int n = 0; n < 2; ++n) {
            const int col = col0 + bj * HALF + n * 16;
            f32x4 v = acc[ai][bj][m][n] * s;
            u32x2 o = {pk2(v[0], v[1]), pk2(v[2], v[3])};
            *(u32x2*)(q + (size_t)row * DM + col) = o;
          }
      }
  }
};

template <class Epi, class Sched, int KROT>
__device__ __forceinline__ void gemm_phase(PG8_LAS unsigned char* lds, const Gemm g, const Sched& S, const Epi& E) {
  const int tid = threadIdx.x, wid = __builtin_amdgcn_readfirstlane(tid >> 6), lane = tid & 63, wr = wid >> 2, wc = wid & 3, fr = lane & 15, fq = lane >> 4;
  const int K = g.K, nt = K / BK;
#define PG8_KX(t) (((t) + KROT) & 31)
  unsigned voff[2];
#pragma unroll
  for (int i = 0; i < 2; ++i) { int R, C; stage_rc(tid * 16 + i * 8192, R, C); voff[i] = (unsigned)(R * K + C) * 2u; }
  const size_t kstep = (size_t)(BK * 2);
  const size_t hstep = (size_t)HALF * K * 2;
  const size_t tstep = 2 * hstep;
  const unsigned ldsw = (unsigned)wid * 1024u;
  const int aoff = lds_byte(wr * 64 + fr, fq * 8), boff = lds_byte(wc * 32 + fr, fq * 8);
#define PG8_SA(b, h) (((b) * 2 + (h)) * HTB)
#define PG8_SB(b, h) ((4 + (b) * 2 + (h)) * HTB)
#define PG8_STAGE(bufoff, gbase) do { _Pragma("unroll") for (int _i = 0; _i < 2; ++_i) \
    __builtin_amdgcn_global_load_lds((const unsigned*)((const char*)(gbase) + voff[_i]), (PG8_LAS unsigned*)(lds + (bufoff) + ldsw + _i * 8192), 16, 0, 0); } while (0)
#define PG8_LDA(dst, b, h) do { _Pragma("unroll") for (int m = 0; m < 4; ++m) _Pragma("unroll") for (int k = 0; k < 2; ++k) dst[m][k] = *(const PG8_LAS bf16x8*)(lds + PG8_SA(b, h) + aoff + m * 2048 + k * 1024); } while (0)
#define PG8_LDB(dst, b, h) do { _Pragma("unroll") for (int n = 0; n < 2; ++n) _Pragma("unroll") for (int k = 0; k < 2; ++k) dst[n][k] = *(const PG8_LAS bf16x8*)(lds + PG8_SB(b, h) + boff + n * 2048 + k * 1024); } while (0)
#define PG8_MMA(ai, bj, At, Bt) do { __builtin_amdgcn_s_setprio(1); _Pragma("unroll") for (int m = 0; m < 4; ++m) _Pragma("unroll") for (int n = 0; n < 2; ++n) _Pragma("unroll") for (int k = 0; k < 2; ++k) \
    acc[ai][bj][m][n] = __builtin_amdgcn_mfma_f32_16x16x32_bf16(Bt[n][k], At[m][k], acc[ai][bj][m][n], 0, 0, 0); __builtin_amdgcn_s_setprio(0); } while (0)
#define PG8_WAIT_V(n) asm volatile("s_waitcnt vmcnt(" #n ")" ::: "memory")
#define PG8_WAIT_L(n) asm volatile("s_waitcnt lgkmcnt(" #n ")" ::: "memory")
#define PG8_BAR __builtin_amdgcn_s_barrier()
#define PG8_SCHED __builtin_amdgcn_sched_barrier(0)
  Unit cur, nxt; int ui = 0;
  if (!S.next(0, cur)) return;
  f32x4 acc[2][2][4][2];
#pragma unroll
  for (int a = 0; a < 2; ++a)
#pragma unroll
    for (int b = 0; b < 2; ++b)
#pragma unroll
      for (int m = 0; m < 4; ++m)
#pragma unroll
        for (int n = 0; n < 2; ++n) acc[a][b][m][n] = (f32x4){0.f, 0.f, 0.f, 0.f};
  bf16x8 At[4][2], B0[2][2], B1[2][2];
  const char* cA = (const char*)g.A + (size_t)cur.pm * tstep; const char* cB = (const char*)g.Bt + (size_t)cur.pn * tstep;
  { const char* a0 = cA + (size_t)PG8_KX(0) * kstep; const char* b0 = cB + (size_t)PG8_KX(0) * kstep;
    const char* a1 = cA + (size_t)PG8_KX(1) * kstep; const char* b1 = cB + (size_t)PG8_KX(1) * kstep;
    PG8_STAGE(PG8_SB(0, 0), b0); PG8_STAGE(PG8_SA(0, 0), a0); PG8_STAGE(PG8_SB(0, 1), b0 + hstep); PG8_STAGE(PG8_SA(0, 1), a0 + hstep);
    if (wr == 1) PG8_BAR;
    PG8_WAIT_V(4); PG8_BAR;
    PG8_STAGE(PG8_SB(1, 0), b1); PG8_STAGE(PG8_SA(1, 0), a1); PG8_STAGE(PG8_SB(1, 1), b1 + hstep);
    PG8_WAIT_V(6); PG8_BAR; }
  for (;;) {
    const bool has_next = S.next(ui + 1, nxt);
    const char* nA = has_next ? (const char*)g.A + (size_t)nxt.pm * tstep : cA; const char* nB = has_next ? (const char*)g.Bt + (size_t)nxt.pn * tstep : cB;
#define PG8_ITER(t) {\
      const bool last = (t == nt - 2);\
      const char* a1 = cA + (size_t)PG8_KX(t + 1) * kstep;\
      const char* a2 = last ? nA + (size_t)PG8_KX(0) * kstep : cA + (size_t)PG8_KX(t + 2) * kstep;\
      const char* b2 = last ? nB + (size_t)PG8_KX(0) * kstep : cB + (size_t)PG8_KX(t + 2) * kstep;\
      const char* a3 = last ? nA + (size_t)PG8_KX(1) * kstep : cA + (size_t)PG8_KX(t + 3) * kstep;\
      const char* b3 = last ? nB + (size_t)PG8_KX(1) * kstep : cB + (size_t)PG8_KX(t + 3) * kstep;\
      PG8_LDB(B0, 0, 0); PG8_SCHED; PG8_LDA(At, 0, 0); PG8_STAGE(PG8_SA(1, 1), a1 + hstep);\
      PG8_WAIT_L(8); PG8_BAR; PG8_WAIT_L(0); PG8_MMA(0, 0, At, B0); PG8_BAR; PG8_SCHED;\
      PG8_LDB(B1, 0, 1); PG8_STAGE(PG8_SB(0, 0), b2);\
      PG8_BAR; PG8_WAIT_L(0); PG8_MMA(0, 1, At, B1); PG8_BAR;\
      PG8_LDA(At, 0, 1); PG8_STAGE(PG8_SA(0, 0), a2);\
      PG8_BAR; PG8_WAIT_L(0); PG8_MMA(1, 0, At, B0); PG8_BAR; PG8_SCHED;\
      PG8_STAGE(PG8_SB(0, 1), b2 + hstep);\
      PG8_WAIT_V(6); PG8_BAR; PG8_MMA(1, 1, At, B1); PG8_BAR;\
      PG8_LDB(B0, 1, 0); PG8_SCHED; PG8_LDA(At, 1, 0); PG8_STAGE(PG8_SA(0, 1), a2 + hstep);\
      PG8_WAIT_L(8); PG8_BAR; PG8_WAIT_L(0); PG8_MMA(0, 0, At, B0); PG8_BAR; PG8_SCHED;\
      PG8_LDB(B1, 1, 1); PG8_STAGE(PG8_SB(1, 0), b3);\
      PG8_BAR; PG8_WAIT_L(0); PG8_MMA(0, 1, At, B1); PG8_BAR;\
      PG8_LDA(At, 1, 1); PG8_STAGE(PG8_SA(1, 0), a3);\
      PG8_BAR; PG8_WAIT_L(0); PG8_MMA(1, 0, At, B0); PG8_BAR; PG8_SCHED;\
      PG8_STAGE(PG8_SB(1, 1), b3 + hstep);\
      PG8_WAIT_V(6); PG8_BAR; PG8_MMA(1, 1, At, B1); PG8_BAR;\
}
    if (Epi::MID) {
      for (int t = 0; t < 16; t += 2) PG8_ITER(t)
      E.mid(acc, cur, wr, fr);
      for (int t = 16; t < nt; t += 2) PG8_ITER(t)
    } else {
      for (int t = 0; t < nt; t += 2) PG8_ITER(t)
    }
#undef PG8_ITER
    E(acc, cur, wr, wc, fr, fq);
    if (!has_next) break;
#pragma unroll
    for (int a = 0; a < 2; ++a)
#pragma unroll
      for (int b = 0; b < 2; ++b)
#pragma unroll
        for (int m = 0; m < 4; ++m)
#pragma unroll
          for (int n = 0; n < 2; ++n) acc[a][b][m][n] = (f32x4){0.f, 0.f, 0.f, 0.f};
    cur = nxt; cA = nA; cB = nB; ++ui;
  }
  PG8_WAIT_V(0);
  if (wr == 0) PG8_BAR;
  PG8_BAR;
#undef PG8_KX
#undef PG8_SA
#undef PG8_SB
#undef PG8_STAGE
#undef PG8_LDA
#undef PG8_LDB
#undef PG8_MMA
#undef PG8_WAIT_V
#undef PG8_WAIT_L
#undef PG8_BAR
#undef PG8_SCHED
}
}

__device__ __forceinline__ void conv8(const bf16_t* __restrict__ proj, int t, int tt_in_seq, int col,
                                      const float* __restrict__ cw, int ld_w, const float* __restrict__ cb, int ch,
                                      float* o) {
  f32x4 b0 = *(const f32x4*)(cb + ch), b1 = *(const f32x4*)(cb + ch + 4);
  o[0] = b0[0]; o[1] = b0[1]; o[2] = b0[2]; o[3] = b0[3];
  o[4] = b1[0]; o[5] = b1[1]; o[6] = b1[2]; o[7] = b1[3];
#pragma unroll
  for (int k = 0; k < 4; ++k) {
    if (tt_in_seq - 3 + k >= 0) {
      u32x4 v = *(const u32x4*)(proj + (size_t)(t - 3 + k) * LDP + col);
      f32x4 w0 = *(const f32x4*)(cw + k * ld_w + ch), w1 = *(const f32x4*)(cw + k * ld_w + ch + 4);
      o[0] += w0[0] * bflo(v[0]); o[1] += w0[1] * bfhi(v[0]);
      o[2] += w0[2] * bflo(v[1]); o[3] += w0[3] * bfhi(v[1]);
      o[4] += w1[0] * bflo(v[2]); o[5] += w1[1] * bfhi(v[2]);
      o[6] += w1[2] * bflo(v[3]); o[7] += w1[3] * bfhi(v[3]);
    }
  }
}
__device__ __forceinline__ void conv4(const bf16_t* __restrict__ proj, int t, int tt_in_seq, int col,
                                      const float* __restrict__ cw, int ld_w, const float* __restrict__ cb, int ch,
                                      float* o) {
  f32x4 b0 = *(const f32x4*)(cb + ch);
  o[0] = b0[0]; o[1] = b0[1]; o[2] = b0[2]; o[3] = b0[3];
#pragma unroll
  for (int k = 0; k < 4; ++k) {
    if (tt_in_seq - 3 + k >= 0) {
      u32x2 v = *(const u32x2*)(proj + (size_t)(t - 3 + k) * LDP + col);
      f32x4 w0 = *(const f32x4*)(cw + k * ld_w + ch);
      o[0] += w0[0] * bflo(v[0]); o[1] += w0[1] * bfhi(v[0]);
      o[2] += w0[2] * bflo(v[1]); o[3] += w0[3] * bfhi(v[1]);
    }
  }
}
__device__ __forceinline__ bf16x8 cfrag(const Params& p, const bf16_t* proj, int t, int tseq, int g, int n8) {
  const bf16_t* cact = (const bf16_t*)(p.ws + OFF_CACT);
  return as_frag(*(const u32x4*)(cact + (size_t)t * 256 + g * 128 + n8));
}
__device__ void conv_prepass(const Params& p, int part, int nparts) {
  unsigned char* ws = p.ws;
  const bf16_t* proj = (const bf16_t*)(ws + OFF_PROJ);
  bf16_t* xact = (bf16_t*)(ws + OFF_XACT);
  bf16_t* bact = (bf16_t*)(ws + OFF_BACT);
  bf16_t* cact = (bf16_t*)(ws + OFF_CACT);
  for (int i = blockIdx.x * NTHR + threadIdx.x + part * (int)gridDim.x * NTHR; i < T_TOK * 192; i += nparts * (int)gridDim.x * NTHR) {
    const int t = i / 192, ch = (i - t * 192) * 8;
    float o[8];
    conv8(proj, t, t & 2047, 3072 + ch, p.ssd_conv_w, 1536, p.ssd_conv_b, ch, o);
#pragma unroll
    for (int e = 0; e < 8; ++e) o[e] = silu_(o[e]);
    u32x4 r = {pk2(o[0], o[1]), pk2(o[2], o[3]), pk2(o[4], o[5]), pk2(o[6], o[7])};
    bf16_t* dst = ch < 1024 ? xact + (size_t)t * 1024 + ch : (ch < 1280 ? bact + (size_t)t * 256 + (ch - 1024) : cact + (size_t)t * 256 + (ch - 1280));
    *(u32x4*)dst = r;
  }
}

__device__ void lru_local_unit(const Params& p, unsigned char* smem, int unit) {
  const int tid = threadIdx.x & 255, lane = tid & 63, wid = tid >> 6, l15 = lane & 15, q4 = lane >> 4;
  const int hh = unit & 15, c = (unit >> 4) & 15, b = unit >> 8;
  const int t0 = b * 2048 + c * 128, ch0 = hh * 64;
  unsigned char* ws = p.ws;
  const bf16_t* proj = (const bf16_t*)(ws + OFF_PROJ);
  float* R1 = (float*)smem;
  float* R2 = (float*)(smem + 33536);
  float* R3 = (float*)(smem + 33536 + 32768);
#pragma unroll 11
  for (int e = tid; e < 131 * 64; e += HTHR) {
    const int r = e >> 6, j = e & 63, tt = r - 3;
    float v = 0.f;
    if (c * 128 + tt >= 0) v = bf2f(proj[(size_t)(t0 + tt) * LDP + ch0 + j]);
    R1[e] = v;
  }
  __syncthreads();
  {
    const int j = tid & 63;
    const float cb = p.lru_conv_b[ch0 + j];
    const float w0 = p.lru_conv_w[0 * 1024 + ch0 + j], w1 = p.lru_conv_w[1 * 1024 + ch0 + j],
                w2 = p.lru_conv_w[2 * 1024 + ch0 + j], w3 = p.lru_conv_w[3 * 1024 + ch0 + j];
#pragma unroll 8
    for (int tt = tid >> 6; tt < 128; tt += 4) {
      R2[tt * 64 + j] = cb + w0 * R1[tt * 64 + j] + w1 * R1[(tt + 1) * 64 + j] + w2 * R1[(tt + 2) * 64 + j] +
                        w3 * R1[(tt + 3) * 64 + j];
    }
  }
  __syncthreads();
  {
    const bf16_t* waT = (const bf16_t*)(ws + OFF_WAT) + (size_t)hh * 4096;
    const bf16_t* wxT = (const bf16_t*)(ws + OFF_WXT) + (size_t)hh * 4096;
    f32x4 aa[2][4], ax[2][4];
#pragma unroll
    for (int i = 0; i < 2; ++i)
#pragma unroll
      for (int j = 0; j < 4; ++j) { aa[i][j] = (f32x4){0, 0, 0, 0}; ax[i][j] = (f32x4){0, 0, 0, 0}; }
#pragma unroll
    for (int ks = 0; ks < 2; ++ks) {
      bf16x8 af[2];
#pragma unroll
      for (int mi = 0; mi < 2; ++mi) {
        const float* src = R2 + (wid * 32 + mi * 16 + l15) * 64 + ks * 32 + q4 * 8;
        f32x4 v0 = *(const f32x4*)src, v1 = *(const f32x4*)(src + 4);
        u32x4 r = {pk2(v0[0], v0[1]), pk2(v0[2], v0[3]), pk2(v1[0], v1[1]), pk2(v1[2], v1[3])};
        af[mi] = as_frag(r);
      }
#pragma unroll
      for (int ni = 0; ni < 4; ++ni) {
        const size_t wo = (size_t)(ni * 16 + l15) * 64 + ks * 32 + q4 * 8;
        bf16x8 ba = as_frag(*(const u32x4*)(waT + wo));
        bf16x8 bx = as_frag(*(const u32x4*)(wxT + wo));
#pragma unroll
        for (int mi = 0; mi < 2; ++mi) {
          aa[mi][ni] = mfma16(af[mi], ba, aa[mi][ni]);
          ax[mi][ni] = mfma16(af[mi], bx, ax[mi][ni]);
        }
      }
    }
#pragma unroll
    for (int ni = 0; ni < 4; ++ni) {
      const int j = ni * 16 + l15;
      const float ba = p.lru_ba[ch0 + j], bx = p.lru_bx[ch0 + j];
      const float lam = p.lru_lambda[ch0 + j];
      const float spl = -8.f * log1pf(__expf(-lam));
#pragma unroll
      for (int mi = 0; mi < 2; ++mi)
#pragma unroll
        for (int r = 0; r < 4; ++r) {
          const int tt = wid * 32 + mi * 16 + q4 * 4 + r;
          const float rg = sigmoid_(aa[mi][ni][r] + ba);
          const float ig = sigmoid_(ax[mi][ni][r] + bx);
          const float log_a = spl * rg;
          const float av = __expf(log_a);
          const float xl = R2[tt * 64 + j];
          const float y2 = 2.f * log_a;
          const float poly = -y2 * (1.f + y2 * (0.5f + y2 * (0.16666667f + y2 * (0.041666668f + y2 * (0.0083333338f + y2 * 0.0013888889f)))));
          const float em = (y2 > -0.25f) ? poly : (1.f - av * av);
          const float bv = __builtin_amdgcn_sqrtf(fmaxf(em, 0.f)) * (ig * xl);
          R1[tt * 64 + j] = av;
          R2[tt * 64 + j] = bv;
        }
    }
  }
  __syncthreads();
  {
    const int j = tid & 63, seg = tid >> 6;
    float h = 0.f, Ac = 1.f;
#pragma unroll 4
    for (int s = 0; s < 32; ++s) {
      const int tt = seg * 32 + s;
      const float a = R1[tt * 64 + j], bb = R2[tt * 64 + j];
      h = a * h + bb;
      Ac *= a;
      R2[tt * 64 + j] = h;
      R1[tt * 64 + j] = Ac;
    }
    R3[seg * 64 + j] = h;
    R3[256 + seg * 64 + j] = Ac;
    __syncthreads();
    float cin = 0.f, Ain = 1.f;
    for (int s2 = 0; s2 < seg; ++s2) {
      cin = R3[256 + s2 * 64 + j] * cin + R3[s2 * 64 + j];
      Ain *= R3[256 + s2 * 64 + j];
    }
    float* hloc = (float*)(ws + OFF_HLOC);
    float* cumA = (float*)(ws + OFF_CUMA);
#pragma unroll 4
    for (int s = 0; s < 32; ++s) {
      const int tt = seg * 32 + s;
      const float hl = R2[tt * 64 + j] + R1[tt * 64 + j] * cin;
      const float Al = R1[tt * 64 + j] * Ain;
      hloc[(size_t)(t0 + tt) * 1024 + ch0 + j] = hl;
      cumA[(size_t)(t0 + tt) * 1024 + ch0 + j] = Al;
    }
  }
  __syncthreads();
}

__device__ void ssd_local_unit(const Params& p, unsigned char* smem, int unit) {
  const int tid = threadIdx.x & 255, lane = tid & 63, wid = tid >> 6, l15 = lane & 15, q4 = lane >> 4;
  const int hh = unit & 15, c = (unit >> 4) & 15, b = unit >> 8, g = hh >> 3;
  const int t0 = b * 2048 + c * 128, ts0 = c * 128;
  unsigned char* ws = p.ws;
  const bf16_t* proj = (const bf16_t*)(ws + OFF_PROJ);
  unsigned char* Bm = smem;
  unsigned char* XT = smem + 32768;
  unsigned char* Pw = smem + 49152 + wid * 4096;
  float* dts = (float*)(smem + 65536);
  float* acs = dts + 128;
  float* adt = acs + 128;
  if (tid < 128) {
    const float raw = bf2f(proj[(size_t)(t0 + tid) * LDP + 4608 + hh]);
    const float dtv = softplus_(raw + p.ssd_dt_bias[hh]);
    dts[tid] = dtv;
    adt[tid] = -__expf(p.ssd_a_log[hh]) * dtv;
  }
  __syncthreads();
  if (tid < 128) {
    float s = 0.f;
    for (int k = 0; k <= tid; ++k) s += adt[k];
    acs[tid] = s;
    ((float*)(ws + OFF_ACS))[(size_t)(t0 + tid) * 16 + hh] = s;
  }
  {
    const bf16_t* bact = (const bf16_t*)(ws + OFF_BACT);
    const int chunk = tid & 15;
#pragma unroll
    for (int i = 0; i < 8; ++i) {
      const int tt = (tid >> 4) + 16 * i;
      *(u32x4*)(Bm + sw256(tt, chunk)) = *(const u32x4*)(bact + (size_t)(t0 + tt) * 256 + g * 128 + chunk * 8);
    }
  }
  __syncthreads();
  const bf16_t* xact = (const bf16_t*)(ws + OFF_XACT);
  {
    const int pp = tid & 63;
    const int ch = hh * 64 + pp;
#pragma unroll
    for (int i = 0; i < 4; ++i) {
      const int chunk = (tid >> 6) * 4 + i;
      const int tt0 = chunk * 8;
      float o[8];
#pragma unroll
      for (int e = 0; e < 8; ++e) o[e] = bf2f(xact[(size_t)(t0 + tt0 + e) * 1024 + ch]) * dts[tt0 + e];
      u32x4 r = {pk2(o[0], o[1]), pk2(o[2], o[3]), pk2(o[4], o[5]), pk2(o[6], o[7])};
      *(u32x4*)(XT + sw256(pp, chunk)) = r;
    }
  }
  __syncthreads();
  bf16_t* ypart = (bf16_t*)(ws + OFF_YPART);
  const float Dh = p.ssd_d[hh];
#pragma unroll 1
  for (int mt = 0; mt < 2; ++mt) {
    const int M = wid * 2 + mt;
    const int lrow = M * 16 + l15;
    bf16x8 cf[4];
#pragma unroll
    for (int ks = 0; ks < 4; ++ks) cf[ks] = cfrag(p, proj, t0 + lrow, ts0 + lrow, g, ks * 32 + q4 * 8);
    const float acl = acs[lrow];
    const int ntmax = M | 1;
#pragma unroll 1
    for (int nt = 0; nt <= ntmax; ++nt) {
      f32x4 a4 = (f32x4){0, 0, 0, 0};
      if (nt <= M) {
#pragma unroll
        for (int ks = 0; ks < 4; ++ks) {
          bf16x8 bfr = *(const bf16x8*)(Bm + sw256(nt * 16 + l15, ks * 4 + q4));
          a4 = mfma16(bfr, cf[ks], a4);
        }
      }
      float pv[4];
#pragma unroll
      for (int r = 0; r < 4; ++r) {
        const int s = nt * 16 + q4 * 4 + r;
        pv[r] = (s <= lrow) ? a4[r] * __expf(acl - acs[s]) : 0.f;
      }
      u32x2 o = {pk2(pv[0], pv[1]), pk2(pv[2], pv[3])};
      const int chunk = nt * 2 + (q4 >> 1);
      *(u32x2*)(Pw + sw256(l15, chunk) + (q4 & 1) * 8) = o;
    }
    f32x4 ya[4];
#pragma unroll
    for (int pt = 0; pt < 4; ++pt) ya[pt] = (f32x4){0, 0, 0, 0};
    const int ksmax = M >> 1;
#pragma unroll 1
    for (int ks = 0; ks <= ksmax; ++ks) {
      bf16x8 pf = *(const bf16x8*)(Pw + sw256(l15, ks * 4 + q4));
#pragma unroll
      for (int pt = 0; pt < 4; ++pt) {
        bf16x8 xf = *(const bf16x8*)(XT + sw256(pt * 16 + l15, ks * 4 + q4));
        ya[pt] = mfma16(xf, pf, ya[pt]);
      }
    }
#pragma unroll
    for (int pt = 0; pt < 4; ++pt) {
      const int pc = pt * 16 + q4 * 4;
      const int ch = hh * 64 + pc;
      const u32x2 xv = *(const u32x2*)(xact + (size_t)(t0 + lrow) * 1024 + ch);
      float y0 = ya[pt][0] + Dh * bflo(xv[0]), y1 = ya[pt][1] + Dh * bfhi(xv[0]);
      float y2 = ya[pt][2] + Dh * bflo(xv[1]), y3 = ya[pt][3] + Dh * bfhi(xv[1]);
      u32x2 o = {pk2(y0, y1), pk2(y2, y3)};
      *(u32x2*)(ypart + (size_t)(t0 + lrow) * 1024 + ch) = o;
    }
  }
  {
    f32x4 sa[2][4];
#pragma unroll
    for (int i = 0; i < 2; ++i)
#pragma unroll
      for (int j = 0; j < 4; ++j) sa[i][j] = (f32x4){0, 0, 0, 0};
    const float aend = acs[127];
#pragma unroll 1
    for (int ks = 0; ks < 4; ++ks) {
      float dec[8];
#pragma unroll
      for (int e = 0; e < 8; ++e) dec[e] = __expf(aend - acs[ks * 32 + q4 * 8 + e]);
      bf16x8 bd[2];
#pragma unroll
      for (int ni = 0; ni < 2; ++ni) {
        const int n = wid * 32 + ni * 16 + l15;
        float v[8];
#pragma unroll
        for (int e = 0; e < 8; ++e) {
          const int l = ks * 32 + q4 * 8 + e;
          const bf16_t raw = *(const bf16_t*)(Bm + sw256(l, n >> 3) + (n & 7) * 2);
          v[e] = bf2f(raw) * dec[e];
        }
        u32x4 r = {pk2(v[0], v[1]), pk2(v[2], v[3]), pk2(v[4], v[5]), pk2(v[6], v[7])};
        bd[ni] = as_frag(r);
      }
#pragma unroll
      for (int pt = 0; pt < 4; ++pt) {
        bf16x8 xf = *(const bf16x8*)(XT + sw256(pt * 16 + l15, ks * 4 + q4));
#pragma unroll
        for (int ni = 0; ni < 2; ++ni) sa[ni][pt] = mfma16(bd[ni], xf, sa[ni][pt]);
      }
    }
    float* St = (float*)(ws + OFF_ST) + (size_t)((b * 16 + c) * 16 + hh) * 8192;
#pragma unroll
    for (int ni = 0; ni < 2; ++ni)
#pragma unroll
      for (int pt = 0; pt < 4; ++pt) {
        const int pr = pt * 16 + l15, n = wid * 32 + ni * 16 + q4 * 4;
        *(f32x4*)(St + pr * 128 + n) = sa[ni][pt];
      }
  }
  __syncthreads();
}

__device__ void phase_carry(const Params& p) {
  unsigned char* ws = p.ws;
  const int gt = blockIdx.x * NTHR + threadIdx.x, ng = gridDim.x * NTHR;
  const float* hloc = (const float*)(ws + OFF_HLOC);
  const float* cumA = (const float*)(ws + OFF_CUMA);
  float* lcarry = (float*)(ws + OFF_LCARRY);
  for (int i = gt; i < 8192; i += ng) {
    const int b = i >> 10, ch = i & 1023;
    float ca[16], hl[16];
#pragma unroll
    for (int c = 0; c < 16; ++c) {
      const size_t tl = (size_t)(b * 2048 + c * 128 + 127) * 1024 + ch;
      ca[c] = cumA[tl];
      hl[c] = hloc[tl];
    }
    float carry = 0.f;
#pragma unroll
    for (int c = 0; c < 16; ++c) {
      lcarry[(size_t)(b * 16 + c) * 1024 + ch] = carry;
      carry = ca[c] * carry + hl[c];
    }
  }
  const float* acsG = (const float*)(ws + OFF_ACS);
  float* St = (float*)(ws + OFF_ST);
  for (int i = gt; i < 128 * 2048; i += ng) {
    const int bh = i >> 11, e4 = i & 2047, b = bh >> 4, hh = bh & 15;
    f32x4 tmp[16];
    float Ad[16];
#pragma unroll
    for (int c = 0; c < 16; ++c) {
      Ad[c] = __expf(acsG[(size_t)(b * 2048 + c * 128 + 127) * 16 + hh]);
      tmp[c] = *(const f32x4*)(St + (size_t)((b * 16 + c) * 16 + hh) * 8192 + e4 * 4);
    }
    f32x4 s = (f32x4){0, 0, 0, 0};
#pragma unroll
    for (int c = 0; c < 16; ++c) {
      u32x2 o = {pk2(s[0], s[1]), pk2(s[2], s[3])};
      *(u32x2*)(sinb_ptr(ws, b, c, hh) + e4 * 4) = o;
      s = s * Ad[c] + tmp[c];
    }
  }
}

__device__ void ssd_final_unit(const Params& p, int unit) {
  const int tid = threadIdx.x & 255, lane = tid & 63, wid = tid >> 6, l15 = lane & 15, q4 = lane >> 4;
  const int hh = unit & 15, c = (unit >> 4) & 15, b = unit >> 8, g = hh >> 3;
  const int t0 = b * 2048 + c * 128, ts0 = c * 128;
  unsigned char* ws = p.ws;
  const bf16_t* proj = (const bf16_t*)(ws + OFF_PROJ);
  const bf16_t* Sin = sinb_ptr(ws, b, c, hh);
  const bf16_t* ypart = (const bf16_t*)(ws + OFF_YPART);
  const float* acsG = (const float*)(ws + OFF_ACS);
  bf16_t* A2 = (bf16_t*)(ws + OFF_XB);
  float* ssq = (float*)(ws + OFF_SSQ);
#pragma unroll 1
  for (int mt = 0; mt < 2; ++mt) {
    const int lrow = (wid * 2 + mt) * 16 + l15;
    f32x4 ya[4];
#pragma unroll
    for (int pt = 0; pt < 4; ++pt) ya[pt] = (f32x4){0, 0, 0, 0};
    if (c > 0) {
#pragma unroll
      for (int ks = 0; ks < 4; ++ks) {
        bf16x8 cf = cfrag(p, proj, t0 + lrow, ts0 + lrow, g, ks * 32 + q4 * 8);
#pragma unroll
        for (int pt = 0; pt < 4; ++pt) {
          const u32x4 r = *(const u32x4*)(Sin + (pt * 16 + l15) * 128 + ks * 32 + q4 * 8);
          ya[pt] = mfma16(as_frag(r), cf, ya[pt]);
        }
      }
    }
    const size_t t = (size_t)(t0 + lrow);
    const float ea = __expf(acsG[t * 16 + hh]);
    float ss = 0.f;
#pragma unroll
    for (int pt = 0; pt < 4; ++pt) {
      const int ch = hh * 64 + pt * 16 + q4 * 4;
      u32x2 yp = *(const u32x2*)(ypart + t * 1024 + ch);
      u32x2 zz = *(const u32x2*)(proj + t * LDP + 2048 + ch);
      float y[4] = {bflo(yp[0]) + ea * ya[pt][0], bfhi(yp[0]) + ea * ya[pt][1], bflo(yp[1]) + ea * ya[pt][2],
                    bfhi(yp[1]) + ea * ya[pt][3]};
      float z[4] = {bflo(zz[0]), bfhi(zz[0]), bflo(zz[1]), bfhi(zz[1])};
#pragma unroll
      for (int r = 0; r < 4; ++r) { y[r] = y[r] * silu_(z[r]); ss += y[r] * y[r]; }
      u32x2 o = {pk2(y[0], y[1]), pk2(y[2], y[3])};
      *(u32x2*)(A2 + t * DM + 1024 + ch) = o;
    }
    ss += __shfl_xor(ss, 16);
    ss += __shfl_xor(ss, 32);
    if (q4 == 0) ssq[t * 16 + hh] = ss;
  }
}

__device__ void phase_mix_final(const Params& p) {
  unsigned char* ws = p.ws;
  const bf16_t* proj = (const bf16_t*)(ws + OFF_PROJ);
  const f32x4* hloc = (const f32x4*)(ws + OFF_HLOC);
  const f32x4* cumA = (const f32x4*)(ws + OFF_CUMA);
  const float* lcarry = (const float*)(ws + OFF_LCARRY);
  bf16_t* A2 = (bf16_t*)(ws + OFF_XB);
  for (int u = blockIdx.x * 2 + (threadIdx.x >> 8); u < 2048; u += gridDim.x * 2) ssd_final_unit(p, u);
#pragma unroll 4
  for (int i = blockIdx.x * NTHR + threadIdx.x; i < T_TOK * 256; i += gridDim.x * NTHR) {
    const int t = i >> 8, ch = (i & 255) * 4;
    f32x4 h = hloc[i], ca = cumA[i];
    f32x4 cr = *(const f32x4*)(lcarry + (size_t)(t >> 7) * 1024 + ch);
    u32x2 gg = *(const u32x2*)(proj + (size_t)t * LDP + 1024 + ch);
    float y0 = (h[0] + ca[0] * cr[0]) * gelu_(bflo(gg[0]));
    float y1 = (h[1] + ca[1] * cr[1]) * gelu_(bfhi(gg[0]));
    float y2 = (h[2] + ca[2] * cr[2]) * gelu_(bflo(gg[1]));
    float y3 = (h[3] + ca[3] * cr[3]) * gelu_(bfhi(gg[1]));
    u32x2 o = {pk2(y0, y1), pk2(y2, y3)};
    *(u32x2*)(A2 + (size_t)t * DM + ch) = o;
  }
}

__device__ void convert_uv(const Params& p, int part, int nparts) {
  unsigned char* ws = p.ws;
  const int lane = threadIdx.x & 63, wid = threadIdx.x >> 6;
  unsigned char* tb = ws + OFF_XB;
  float* scales = (float*)(ws + OFF_SCALES);
  for (int row = blockIdx.x * 8 + wid + part * (int)gridDim.x * 8; row < 32768; row += nparts * (int)gridDim.x * 8) {
    const bool isv = row >= 16384;
    const int e = row & 16383;
    const float* src = (isv ? p.peer_v : p.peer_u) + (size_t)e * DM + lane * 32;
    float vals[32];
    float ss = 0.f;
#pragma unroll
    for (int q = 0; q < 8; ++q) {
      f32x4 t = *(const f32x4*)(src + q * 4);
      if (!isv) t *= *(const f32x4*)(p.norm_ffn_w + lane * 32 + q * 4);
#pragma unroll
      for (int k = 0; k < 4; ++k) {
        vals[q * 4 + k] = t[k];
        ss += t[k] * t[k];
      }
    }
    ss = wave_sum(ss);
    const float rms = sqrtf(ss * (1.f / 2048.f));
    const float sc = rms * (2.6f / 7.f);
    const float inv = sc > 0.f ? 1.f / sc : 0.f;
    u32x4 o;
#pragma unroll
    for (int m = 0; m < 4; ++m) {
      unsigned w = 0;
#pragma unroll
      for (int j = 0; j < 4; ++j) {
        const float lo = fminf(fmaxf(rintf(vals[m * 8 + j] * inv), -7.f), 7.f);
        const float hi = fminf(fmaxf(rintf(vals[m * 8 + 4 + j] * inv), -7.f), 7.f);
        const unsigned bl = isv ? (unsigned)((int)lo + 8) : ((unsigned)(int)lo & 0xfu);
        const unsigned bh = isv ? (unsigned)((int)hi + 8) : ((unsigned)(int)hi & 0xfu);
        w |= (bl | (bh << 4)) << (8 * j);
      }
      o[m] = w;
    }
    *(u32x4*)(tb + (size_t)row * 1024 + lane * 16) = o;
    if (lane == 0) scales[row] = sc;
  }
}

__device__ const unsigned char cand_tab[64] = {
    0x00, 0x01, 0x02, 0x03, 0x04, 0x05, 0x06, 0x07, 0x08, 0x09, 0x0a, 0x0b, 0x0c, 0x0d, 0x0e, 0x0f,
    0x10, 0x11, 0x12, 0x13, 0x14, 0x15, 0x16, 0x17,
    0x20, 0x21, 0x22, 0x23, 0x24,
    0x30, 0x31, 0x32, 0x33,
    0x40, 0x41, 0x42,
    0x50, 0x51, 0x60, 0x61, 0x70, 0x71,
    0x80, 0x90, 0xa0, 0xb0, 0xc0, 0xd0, 0xe0, 0xf0,
    0xff, 0xff, 0xff, 0xff, 0xff, 0xff, 0xff, 0xff, 0xff, 0xff, 0xff, 0xff, 0xff, 0xff};

__device__ __forceinline__ unsigned ord_key(float f) {
  unsigned u = __float_as_uint(f);
  return u ^ ((u >> 31) ? 0xffffffffu : 0x80000000u);
}
__device__ __forceinline__ float ord_dec(unsigned k) {
  unsigned u = (k >> 31) ? (k ^ 0x80000000u) : ~k;
  return __uint_as_float(u);
}

__device__ void topk_unit(const Params& p, unsigned char* smem, int unit) {
  const int tid = threadIdx.x & 255, lane = tid & 63, wid = tid >> 6, l15 = lane & 15, q4 = lane >> 4;
  const int h = unit & 7, tile = unit >> 3;
  const int tok0 = tile * 64 + wid * 16;
  unsigned char* ws = p.ws;
  const bf16_t* qg = (const bf16_t*)(ws + OFF_Q);
  const bf16_t* kb = (const bf16_t*)(ws + OFF_KEYSB);
  unsigned* S = (unsigned*)(smem + wid * 16640);
  float* tops = (float*)(smem + 4 * 16640 + wid * 256);
  int* topi = (int*)(tops + 32);
  unsigned* Ms = (unsigned*)(smem + 67584 + wid * 768);
#pragma unroll
  for (int k = 0; k < 2; ++k) {
    f32x4 sc[8];
#pragma unroll
    for (int i = 0; i < 8; ++i) sc[i] = (f32x4){0, 0, 0, 0};
#pragma unroll
    for (int ks = 0; ks < 4; ++ks) {
      bf16x8 qf = as_frag(*(const u32x4*)(qg + (size_t)(tok0 + l15) * DM + h * 256 + k * 128 + ks * 32 + q4 * 8));
#pragma unroll
      for (int nt = 0; nt < 8; ++nt) {
        bf16x8 kf = as_frag(*(const u32x4*)(kb + (size_t)((h * 2 + k) * 128 + nt * 16 + l15) * 128 + ks * 32 + q4 * 8));
        sc[nt] = mfma16(kf, qf, sc[nt]);
      }
    }
#pragma unroll
    for (int nt = 0; nt < 8; ++nt) {
      const int n = nt * 16 + q4 * 4;
      u32x4 kk;
#pragma unroll
      for (int r = 0; r < 4; ++r) kk[r] = (ord_key(sc[nt][r]) & ~127u) | (unsigned)(127 - (n + r));
      *(u32x4*)(S + l15 * 260 + k * 128 + n) = kk;
    }
  }
  const unsigned ct = cand_tab[lane];
  const int ca = ct >> 4, cbb = ct & 15;
  int* idxo = (int*)(ws + OFF_IDX);
  float* go = (float*)(ws + OFF_G);
  for (int tk = 0; tk < 16; ++tk) {
    const unsigned* row = S + tk * 260;
    unsigned ka[2], kb[2], mxk[2];
#pragma unroll
    for (int hf = 0; hf < 2; ++hf) {
      ka[hf] = row[hf * 128 + lane];
      kb[hf] = row[hf * 128 + 64 + lane];
      mxk[hf] = ka[hf] > kb[hf] ? ka[hf] : kb[hf];
      Ms[hf * 96 + lane] = mxk[hf];
    }
    int cnt[2][4];
#pragma unroll
    for (int hf = 0; hf < 2; ++hf)
#pragma unroll
      for (int e = 0; e < 4; ++e) cnt[hf][e] = 0;
#pragma unroll
    for (int j = 0; j < 16; ++j)
#pragma unroll
      for (int hf = 0; hf < 2; ++hf) {
        u32x4 x = *(const u32x4*)(Ms + hf * 96 + j * 4);
#pragma unroll
        for (int e = 0; e < 4; ++e) cnt[hf][e] += (x[e] > mxk[hf]) ? 1 : 0;
      }
    bool ca_[2], cb_[2];
    int pa[2], pb[2], ncand[2];
    const unsigned long long lt = (1ull << lane) - 1ull;
#pragma unroll
    for (int hf = 0; hf < 2; ++hf) {
      const int c_ = cnt[hf][0] + cnt[hf][1] + cnt[hf][2] + cnt[hf][3];
      const unsigned long long bm = __ballot(c_ == 15);
      const int srcT = __ffsll((long long)bm) - 1;
      const unsigned T0 = (unsigned)__shfl((int)mxk[hf], srcT);
      ca_[hf] = ka[hf] >= T0;
      cb_[hf] = kb[hf] >= T0;
      const unsigned long long ba = __ballot(ca_[hf]), bb = __ballot(cb_[hf]);
      const int na = __popcll(ba);
      pa[hf] = __popcll(ba & lt);
      pb[hf] = na + __popcll(bb & lt);
      ncand[hf] = na + __popcll(bb);
    }
#pragma unroll
    for (int hf = 0; hf < 2; ++hf) {
      unsigned* Cs = Ms + hf * 96 + 64;
      if (lane < 32) Cs[lane] = 0u;
      if (ca_[hf]) Cs[pa[hf]] = ka[hf];
      if (cb_[hf]) Cs[pb[hf]] = kb[hf];
    }
    unsigned my[2];
    int rk2[2][4];
#pragma unroll
    for (int hf = 0; hf < 2; ++hf) {
      my[hf] = Ms[hf * 96 + 64 + (lane & 31)];
#pragma unroll
      for (int e = 0; e < 4; ++e) rk2[hf][e] = 0;
    }
#pragma unroll
    for (int j = 0; j < 8; ++j)
#pragma unroll
      for (int hf = 0; hf < 2; ++hf) {
        u32x4 x = *(const u32x4*)(Ms + hf * 96 + 64 + j * 4);
#pragma unroll
        for (int e = 0; e < 4; ++e) rk2[hf][e] += (x[e] > my[hf]) ? 1 : 0;
      }
#pragma unroll
    for (int hf = 0; hf < 2; ++hf) {
      const int r_ = rk2[hf][0] + rk2[hf][1] + rk2[hf][2] + rk2[hf][3];
      if (lane < ncand[hf] && r_ < 16) {
        tops[hf * 16 + r_] = ord_dec(my[hf] & ~127u);
        topi[hf * 16 + r_] = 127 - (int)(my[hf] & 127u);
      }
    }
    float cs = 0.f;
    unsigned ck = 0u;
    if (lane < 50) {
      cs = tops[ca] + tops[16 + cbb];
      ck = (ord_key(cs) & ~255u) | (unsigned)(255 - (ca * 16 + cbb));
    }
    int rkA = 0, rkB = 0;
#pragma unroll
    for (int j = 0; j < 50; j += 2) {
      const unsigned oj = (unsigned)__builtin_amdgcn_readlane((int)ck, j);
      const unsigned oj2 = (unsigned)__builtin_amdgcn_readlane((int)ck, j + 1);
      rkA += (oj > ck) ? 1 : 0;
      rkB += (oj2 > ck) ? 1 : 0;
    }
    const int rk = rkA + rkB;
    const float mx = tops[0] + tops[16];
    const bool sel = (lane < 50) && (rk < 16);
    const float ev = sel ? __expf(cs - mx) : 0.f;
    const float sum = wave_sum(ev);
    if (sel) {
      const size_t o = (size_t)(tok0 + tk) * 128 + h * 16 + rk;
      idxo[o] = topi[ca] * 128 + topi[16 + cbb];
      go[o] = ev * __builtin_amdgcn_rcpf(sum);
    }
  }
}

__device__ __forceinline__ float ub0(unsigned w) { return (float)(w & 0xffu); }
__device__ __forceinline__ float ub1(unsigned w) { return (float)((w >> 8) & 0xffu); }
__device__ __forceinline__ float ub2(unsigned w) { return (float)((w >> 16) & 0xffu); }
__device__ __forceinline__ float ub3(unsigned w) { return (float)(w >> 24); }

#define OFF_XQ OFF_YPART
#define OFF_WBUF OFF_ST
__device__ void phase_gather_u(const Params& p) {
  const int tid = threadIdx.x, lane = tid & 63, wid = tid >> 6;
  unsigned char* ws = p.ws;
  const unsigned char* ub = ws + OFF_XB;
  const int* idxg = (const int*)(ws + OFF_IDX);
  u32x4* xq = (u32x4*)(ws + OFF_XQ);
  int* wbuf = (int*)(ws + OFF_WBUF);
  float* sxa = (float*)(ws + OFF_WBUF + 8 * MIB);
  const bool b5 = (lane & 32) != 0, b4 = (lane & 16) != 0, b3 = (lane & 8) != 0;
  const int srcl = ((lane & 1) << 3) | (((lane >> 1) & 1) << 4) | (((lane >> 2) & 1) << 5);
  const int tbase = blockIdx.x * 8 + wid, tstride = gridDim.x * 8;
  for (int t = tbase; t < T_TOK; t += tstride) {
    const float* orow = p.out + (size_t)t * DM + lane * 32;
    float xr[32];
    float amax = 0.f;
#pragma unroll
    for (int q = 0; q < 8; ++q) {
      f32x4 v = *(const f32x4*)(orow + q * 4);
#pragma unroll
      for (int k = 0; k < 4; ++k) { xr[q * 4 + k] = v[k]; amax = fmaxf(amax, fabsf(v[k])); }
    }
#pragma unroll
    for (int o = 32; o > 0; o >>= 1) amax = fmaxf(amax, __shfl_xor(amax, o));
    const float inv = amax > 0.f ? 119.f / amax : 0.f;
    u32x4 ph, pl;
#pragma unroll
    for (int m = 0; m < 4; ++m) {
      unsigned wh = 0, wl = 0;
#pragma unroll
      for (int j = 0; j < 4; ++j) {
        const int a_ = __float2int_rn(xr[m * 8 + j] * inv), b_ = __float2int_rn(xr[m * 8 + 4 + j] * inv);
        const int ah = (a_ + 8) >> 4, bh = (b_ + 8) >> 4;
        const int al = a_ - 16 * ah, bl = b_ - 16 * bh;
        wh |= (((unsigned)ah & 0xfu) | (((unsigned)bh & 0xfu) << 4)) << (8 * j);
        wl |= (((unsigned)al & 0xfu) | (((unsigned)bl & 0xfu) << 4)) << (8 * j);
      }
      ph[m] = wh;
      pl[m] = wl;
    }
    xq[((size_t)t * 64 + lane) * 2] = ph;
    xq[((size_t)t * 64 + lane) * 2 + 1] = pl;
    if (lane == 0) sxa[t] = amax * (1.f / 119.f);
  }
  asm volatile("s_waitcnt vmcnt(0)" ::: "memory");
#pragma unroll 1
  for (int r = 0; r < 4; ++r) {
#pragma unroll 1
    for (int t = tbase; t < T_TOK; t += tstride) {
      const u32x4 ph = xq[((size_t)t * 64 + lane) * 2], pl = xq[((size_t)t * 64 + lane) * 2 + 1];
      const int idA = idxg[(size_t)t * 128 + lane], idB = idxg[(size_t)t * 128 + 64 + lane];
      unsigned long long m0 = __ballot((idA >> 12) == r), m1 = __ballot((idB >> 12) == r);
      while (m0 | m1) {
        int jk[16];
        u32x4 rw[16];
        const int nvalid = min((int)(__popcll(m0) + __popcll(m1)), 16);
        int jfirst, efirst;
        if (m0) { jfirst = __builtin_amdgcn_readfirstlane(__ffsll((long long)m0) - 1); efirst = __builtin_amdgcn_readlane(idA, jfirst); }
        else { const int j1 = __builtin_amdgcn_readfirstlane(__ffsll((long long)m1) - 1); efirst = __builtin_amdgcn_readlane(idB, j1); jfirst = 64 + j1; }
#pragma unroll
        for (int k = 0; k < 16; ++k) {
          int j = jfirst, e = efirst;
          if (m0) { const int jj = __builtin_amdgcn_readfirstlane(__ffsll((long long)m0) - 1); m0 &= m0 - 1ull; j = jj; e = __builtin_amdgcn_readlane(idA, jj); }
          else if (m1) { const int jj = __builtin_amdgcn_readfirstlane(__ffsll((long long)m1) - 1); m1 &= m1 - 1ull; j = 64 + jj; e = __builtin_amdgcn_readlane(idB, jj); }
          jk[k] = j;
          rw[k] = *(const u32x4*)(ub + (size_t)e * 1024 + lane * 16);
        }
#pragma unroll
        for (int bt = 0; bt < 2; ++bt) {
          int dv[8];
#pragma unroll
          for (int k = 0; k < 8; ++k) {
            int dh = 0, dl = 0;
#pragma unroll
            for (int q = 0; q < 4; ++q) {
              dh = __builtin_amdgcn_sdot8((int)rw[bt * 8 + k][q], (int)ph[q], dh, false);
              dl = __builtin_amdgcn_sdot8((int)rw[bt * 8 + k][q], (int)pl[q], dl, false);
            }
            dv[k] = 16 * dh + dl;
          }
          int a4[4], a2[2];
#pragma unroll
          for (int k = 0; k < 4; ++k) {
            const int mine = b5 ? dv[k + 4] : dv[k], oth = b5 ? dv[k] : dv[k + 4];
            a4[k] = mine + __shfl_xor(oth, 32);
          }
#pragma unroll
          for (int k = 0; k < 2; ++k) {
            const int mine = b4 ? a4[k + 2] : a4[k], oth = b4 ? a4[k] : a4[k + 2];
            a2[k] = mine + __shfl_xor(oth, 16);
          }
          int c1;
          {
            const int mine = b3 ? a2[1] : a2[0], oth = b3 ? a2[0] : a2[1];
            c1 = mine + __shfl_xor(oth, 8);
          }
          c1 += __shfl_xor(c1, 4);
          c1 += __shfl_xor(c1, 2);
          c1 += __shfl_xor(c1, 1);
          const int val = __shfl(c1, srcl);
          int jsel = jk[bt * 8];
#pragma unroll
          for (int k = 1; k < 8; ++k) jsel = (lane == k) ? jk[bt * 8 + k] : jsel;
          if (lane < 8 && lane < nvalid - bt * 8) wbuf[(size_t)t * 128 + jsel] = val;
        }
      }
    }
  }
  asm volatile("s_waitcnt vmcnt(0)" ::: "memory");
}

#define GROWS 8
#ifndef USE_SDOT4
#define USE_SDOT4 1
#endif
typedef float f32x2 __attribute__((ext_vector_type(2)));
__device__ void phase_gather(const Params& p) {
  const int tid = threadIdx.x, lane = tid & 63, wid = tid >> 6;
  unsigned char* ws = p.ws;
  const unsigned char* ub = ws + OFF_XB;
  const unsigned char* vb = ws + OFF_XB + 16 * MIB;
  const float* scales = (const float*)(ws + OFF_SCALES);
  const int* idxg = (const int*)(ws + OFF_IDX);
  const float* gg = (const float*)(ws + OFF_G);
  const float* ssq2 = (const float*)(ws + OFF_SSQ2);
  const bool b5 = (lane & 32) != 0, b4 = (lane & 16) != 0, b3 = (lane & 8) != 0;
  const int srcl = ((lane & 1) << 3) | (((lane >> 1) & 1) << 4) | (((lane >> 2) & 1) << 5);
  for (int t = blockIdx.x * 8 + wid; t < T_TOK; t += gridDim.x * 8) {
    const int id0 = idxg[(size_t)t * 128 + lane], id1 = idxg[(size_t)t * 128 + 64 + lane];
    const float g0 = gg[(size_t)t * 128 + lane], g1 = gg[(size_t)t * 128 + 64 + lane];
    const float su0 = scales[id0], su1 = scales[id1], sv0 = scales[16384 + id0], sv1 = scales[16384 + id1];
    float* orow = p.out + (size_t)t * DM + lane * 32;
    const float sx = ((const float*)(ws + OFF_WBUF + 8 * MIB))[t];
    float sq = (lane < 32) ? ssq2[(size_t)t * 32 + lane] : 0.f;
    sq = wave_sum(sq);
    const float rs2 = rsqrtf(sq * (1.f / 2048.f) + EPSV);
    const int* wbuf = (const int*)(ws + OFF_WBUF);
    const int d0 = wbuf[(size_t)t * 128 + lane], d1 = wbuf[(size_t)t * 128 + 64 + lane];
    const float w0 = gelu_((float)d0 * (su0 * sx * rs2)) * g0 * sv0;
    const float w1 = gelu_((float)d1 * (su1 * sx * rs2)) * g1 * sv1;
    float wmax = fmaxf(fabsf(w0), fabsf(w1));
#pragma unroll
    for (int o = 32; o > 0; o >>= 1) wmax = fmaxf(wmax, __shfl_xor(wmax, o));
    const float sw = wmax * (1.f / 127.f);
    const float winv = wmax > 0.f ? 127.f / wmax : 0.f;
    const int q0 = __float2int_rn(w0 * winv), q1 = __float2int_rn(w1 * winv);
    int wsumq = q0 + q1;
#pragma unroll
    for (int o = 32; o > 0; o >>= 1) wsumq += __shfl_xor(wsumq, o);
    int pk0 = (int)(((unsigned)q0 & 0xffu) << (8 * (lane & 3))), pk1 = (int)(((unsigned)q1 & 0xffu) << (8 * (lane & 3)));
    pk0 |= __shfl_xor(pk0, 1); pk0 |= __shfl_xor(pk0, 2);
    pk1 |= __shfl_xor(pk1, 1); pk1 |= __shfl_xor(pk1, 2);
    int acc[32];
#pragma unroll
    for (int i = 0; i < 32; ++i) acc[i] = 0;
#pragma unroll 1
    for (int half = 0; half < 2; ++half) {
      const int idv = half ? id1 : id0;
      const int pkv = half ? pk1 : pk0;
      u32x4 rr[3][GROWS];
#pragma unroll
      for (int k = 0; k < GROWS; ++k) {
        const int e = __builtin_amdgcn_readlane(idv, k);
        rr[0][k] = *(const u32x4*)(vb + (size_t)e * 1024 + lane * 16);
        const int e2 = __builtin_amdgcn_readlane(idv, GROWS + k);
        rr[1][k] = *(const u32x4*)(vb + (size_t)e2 * 1024 + lane * 16);
      }
#pragma unroll
      for (int gi = 0; gi < 64 / GROWS; ++gi) {
        const int j0 = gi * GROWS;
        if (gi + 2 < 64 / GROWS) {
#pragma unroll
          for (int k = 0; k < GROWS; ++k) {
            const int e = __builtin_amdgcn_readlane(idv, j0 + 2 * GROWS + k);
            rr[(gi + 2) % 3][k] = *(const u32x4*)(vb + (size_t)e * 1024 + lane * 16);
          }
        }
#pragma unroll
        for (int sub = 0; sub < GROWS / 4; ++sub) {
          const int W4 = __builtin_amdgcn_readlane(pkv, j0 + 4 * sub);
#pragma unroll
          for (int m = 0; m < 4; ++m) {
            unsigned lo[4], hi[4];
#pragma unroll
            for (int k = 0; k < 4; ++k) {
              const unsigned w = rr[gi % 3][sub * 4 + k][m];
              lo[k] = w & 0x0f0f0f0fu;
              hi[k] = (w >> 4) & 0x0f0f0f0fu;
            }
            {
              const unsigned p01l = __builtin_amdgcn_perm(lo[1], lo[0], 0x05010400u), p01h = __builtin_amdgcn_perm(lo[1], lo[0], 0x07030602u);
              const unsigned p23l = __builtin_amdgcn_perm(lo[3], lo[2], 0x05010400u), p23h = __builtin_amdgcn_perm(lo[3], lo[2], 0x07030602u);
              acc[m * 8 + 0] = __builtin_amdgcn_sdot4((int)__builtin_amdgcn_perm(p23l, p01l, 0x05040100u), W4, acc[m * 8 + 0], false);
              acc[m * 8 + 1] = __builtin_amdgcn_sdot4((int)__builtin_amdgcn_perm(p23l, p01l, 0x07060302u), W4, acc[m * 8 + 1], false);
              acc[m * 8 + 2] = __builtin_amdgcn_sdot4((int)__builtin_amdgcn_perm(p23h, p01h, 0x05040100u), W4, acc[m * 8 + 2], false);
              acc[m * 8 + 3] = __builtin_amdgcn_sdot4((int)__builtin_amdgcn_perm(p23h, p01h, 0x07060302u), W4, acc[m * 8 + 3], false);
            }
            {
              const unsigned p01l = __builtin_amdgcn_perm(hi[1], hi[0], 0x05010400u), p01h = __builtin_amdgcn_perm(hi[1], hi[0], 0x07030602u);
              const unsigned p23l = __builtin_amdgcn_perm(hi[3], hi[2], 0x05010400u), p23h = __builtin_amdgcn_perm(hi[3], hi[2], 0x07030602u);
              acc[m * 8 + 4] = __builtin_amdgcn_sdot4((int)__builtin_amdgcn_perm(p23l, p01l, 0x05040100u), W4, acc[m * 8 + 4], false);
              acc[m * 8 + 5] = __builtin_amdgcn_sdot4((int)__builtin_amdgcn_perm(p23l, p01l, 0x07060302u), W4, acc[m * 8 + 5], false);
              acc[m * 8 + 6] = __builtin_amdgcn_sdot4((int)__builtin_amdgcn_perm(p23h, p01h, 0x05040100u), W4, acc[m * 8 + 6], false);
              acc[m * 8 + 7] = __builtin_amdgcn_sdot4((int)__builtin_amdgcn_perm(p23h, p01h, 0x07060302u), W4, acc[m * 8 + 7], false);
            }
          }
        }
      }
    }
    float val[32];
    float ss = 0.f;
    const int off8 = 8 * wsumq;
#pragma unroll
    for (int q = 0; q < 8; ++q) {
      f32x4 v = *(const f32x4*)(orow + q * 4);
#pragma unroll
      for (int k = 0; k < 4; ++k) {
        val[q * 4 + k] = sw * (float)(acc[q * 4 + k] - off8) + v[k];
        ss += val[q * 4 + k] * val[q * 4 + k];
      }
    }
    ss = wave_sum(ss);
    const float rs3 = rsqrtf(ss * (1.f / 2048.f) + EPSV);
#pragma unroll
    for (int q = 0; q < 8; ++q) {
      f32x4 wf = *(const f32x4*)(p.norm_final_w + lane * 32 + q * 4);
      f32x4 o = {val[q * 4 + 0] * rs3 * wf[0], val[q * 4 + 1] * rs3 * wf[1], val[q * 4 + 2] * rs3 * wf[2],
                 val[q * 4 + 3] * rs3 * wf[3]};
      *(f32x4*)(orow + q * 4) = o;
    }
  }
}

#define XB_TMO      128
#define XB_XCNT(j)  (256  + 64 * (j))
#define XB_XSUB(j)  (1280 + 64 * (j))
#define XB_XGEN(j)  (2304 + 64 * (j))
#define XB_TOP      3328
#define XB_TOPGEN   3392
#define XCD_BAR_WORDS 3456
#define XB_SPIN_CAP (1u << 18)
#define XLAS __attribute__((address_space(3)))
__device__ __forceinline__ unsigned xb_ld(unsigned* p) { return __hip_atomic_load(p, __ATOMIC_RELAXED, __HIP_MEMORY_SCOPE_AGENT); }
__device__ __forceinline__ unsigned xb_add(unsigned* p, unsigned v) { return __hip_atomic_fetch_add(p, v, __ATOMIC_RELAXED, __HIP_MEMORY_SCOPE_AGENT); }
__device__ __forceinline__ unsigned xb_xcc_id() { return (unsigned)__builtin_amdgcn_s_getreg((3 << 11) | 20) & 0xFu; }
#define XB_SPIN(cond, bar) do { unsigned _sp = 0; while (cond) { __builtin_amdgcn_s_sleep(1); \
    if ((++_sp & 255u) == 0u) { if (xb_ld(&(bar)[XB_TMO])) break; if (_sp > XB_SPIN_CAP) { atomicAdd(&(bar)[XB_TMO], 1u); break; } } } } while (0)
struct XcdBarrier { unsigned* bar; unsigned x; volatile XLAS unsigned* st; };
__device__ __forceinline__ XcdBarrier xcd_barrier_post(unsigned* bar, volatile XLAS unsigned* st) {
  XcdBarrier b; b.bar = bar; b.x = xb_xcc_id(); b.st = st;
  if (threadIdx.x == 0) (void)xb_add(&bar[XB_XCNT(b.x)], 1u);
  return b;
}
__device__ __forceinline__ void xcd_barrier_complete(unsigned* bar, unsigned x, unsigned& nloc, unsigned& nx) {
  const unsigned G = gridDim.x * gridDim.y * gridDim.z;
  unsigned sum, cnt, mine, sp = 0u;
  for (;;) {
    sum = 0u; cnt = 0u; mine = 0u;
#pragma unroll
    for (unsigned j = 0; j < 16; ++j) { const unsigned c = xb_ld(&bar[XB_XCNT(j)]); sum += c; cnt += (c > 0u) ? 1u : 0u; mine = (j == x) ? c : mine; }
    if (sum == G) break;
    __builtin_amdgcn_s_sleep(1);
    if ((++sp & 255u) == 0u) { if (xb_ld(&bar[XB_TMO])) break; if (sp > XB_SPIN_CAP) { atomicAdd(&bar[XB_TMO], 1u); break; } }
  }
  nloc = mine > 0u ? mine : 1u; nx = cnt > 0u ? cnt : 1u;
}
__device__ __forceinline__ void xcd_barrier(const XcdBarrier& b) {
  asm volatile("s_waitcnt vmcnt(0)" ::: "memory");
  __syncthreads();
  if (threadIdx.x == 0) {
    unsigned* bar = b.bar;
    __builtin_amdgcn_s_waitcnt(0);
    unsigned nloc = b.st[0], nx = b.st[1];
    if (nloc == 0u) { xcd_barrier_complete(bar, b.x, nloc, nx); b.st[0] = nloc; b.st[1] = nx; }
    const unsigned old = xb_add(&bar[XB_XSUB(b.x)], 1u);
    const unsigned gen = old / nloc;
    if (old + 1u == (gen + 1u) * nloc) {
      __builtin_amdgcn_fence(__ATOMIC_RELEASE, "agent");
      asm volatile("s_waitcnt vmcnt(0)" ::: "memory");
      const unsigned og = xb_add(&bar[XB_TOP], 1u);
      const unsigned tg = og / nx;
      if (og + 1u == (tg + 1u) * nx) xb_add(&bar[XB_TOPGEN], 1u);
      else XB_SPIN(xb_ld(&bar[XB_TOPGEN]) == tg, bar);
      __builtin_amdgcn_fence(__ATOMIC_ACQUIRE, "agent");
      xb_add(&bar[XB_XGEN(b.x)], 1u);
      asm volatile("s_waitcnt vmcnt(0)" ::: "memory");
    } else {
      XB_SPIN(xb_ld(&bar[XB_XGEN(b.x)]) == gen, bar);
      __builtin_amdgcn_fence(__ATOMIC_ACQUIRE, "agent");
      asm volatile("s_waitcnt vmcnt(0)" ::: "memory");
    }
  }
  __syncthreads();
}

__global__ void __launch_bounds__(NTHR, 2) fwd_kernel(Params p) {
  __shared__ __attribute__((aligned(16))) unsigned char smem[SMEM_BYTES];
  __shared__ uint4 xb_words;
  cg::grid_group grid = cg::this_grid();
  unsigned char* ws = p.ws;
  if (threadIdx.x == 0) xb_words = make_uint4(0u, 0u, 0u, 0u);
  __syncthreads();
  XcdBarrier xb = xcd_barrier_post((unsigned*)(ws + OFF_BAR), (volatile XLAS unsigned*)&xb_words);
  const int hb = threadIdx.x >> 8;
  unsigned char* hsm = smem + hb * SMEM_HALF;
#define PHASE_ON(n) (p.phase_lo <= (n) && (n) <= p.phase_hi)
#define PHASE_SYNC(n) if (p.coop && PHASE_ON(n) && (n) < p.phase_hi) { if (p.coop == 2) grid.sync(); else xcd_barrier(xb); }
  if (PHASE_ON(0)) phase_prep(p, smem);
  PHASE_SYNC(0)
  if (PHASE_ON(1)) {
    pg8::Gemm g{(const bf16_t*)(ws + OFF_XB), (const bf16_t*)(ws + OFF_WINT), T_TOK, NPAD1, 2048};
    pg8::SimpleOrder S; S.init(T_TOK, NPAD1, gridDim.x, blockIdx.x);
    pg8::Epi1 E{(const float*)(ws + OFF_RS1), (bf16_t*)(ws + OFF_PROJ)};
    pg8::gemm_phase<pg8::Epi1, pg8::SimpleOrder, 0>((PG8_LAS unsigned char*)smem, g, S, E);
  }
  PHASE_SYNC(1)
  if (PHASE_ON(2)) {
    {
      const int u_step = gridDim.x * 2;
      const int nk = (int)blockIdx.x * 2 < 2048 ? (2048 - (int)blockIdx.x * 2 + u_step - 1) / u_step : 0;
      if (nk == 0) conv_prepass(p, 0, 1);
      int kk = 0;
      for (int u0 = blockIdx.x * 2; u0 < 2048; u0 += u_step, ++kk) {
        lru_local_unit(p, hsm, u0 + hb);
        conv_prepass(p, kk, nk);
      }
    }
    if (p.coop) xcd_barrier(xb);
    for (int u0 = blockIdx.x * 2; u0 < 2048; u0 += gridDim.x * 2) ssd_local_unit(p, hsm, u0 + hb);
  }
  PHASE_SYNC(2)
  if (PHASE_ON(3)) phase_carry(p);
  PHASE_SYNC(3)
  if (PHASE_ON(4)) phase_mix_final(p);
  PHASE_SYNC(4)
  if (PHASE_ON(5)) {
    pg8::Gemm g{(const bf16_t*)(ws + OFF_XB), (const bf16_t*)(ws + OFF_WOUTT), T_TOK, 2048, 2048};
    pg8::SimpleOrder S; S.init(T_TOK, 2048, gridDim.x, blockIdx.x);
    pg8::Epi2 E{p.x, p.out, (bf16_t*)(ws + OFF_X1B), (float*)(ws + OFF_SSQ2), (const float*)(ws + OFF_SSQ)};
    pg8::gemm_phase<pg8::Epi2, pg8::SimpleOrder, 16>((PG8_LAS unsigned char*)smem, g, S, E);
  }
  PHASE_SYNC(5)
  if (PHASE_ON(6)) {
    pg8::Gemm g{(const bf16_t*)(ws + OFF_X1B), (const bf16_t*)(ws + OFF_WQT), T_TOK, 2048, 2048};
    pg8::SimpleOrder S; S.init(T_TOK, 2048, gridDim.x, blockIdx.x);
    pg8::Epi3 E{(const float*)(ws + OFF_SSQ2), (bf16_t*)(ws + OFF_Q)};
    pg8::gemm_phase<pg8::Epi3, pg8::SimpleOrder, 0>((PG8_LAS unsigned char*)smem, g, S, E);
  }
  PHASE_SYNC(6)
  if (PHASE_ON(7)) {
    const int u_first = blockIdx.x * 2 + hb, u_step = gridDim.x * 2;
    const int nk = u_first < 2048 ? (2048 - u_first + u_step - 1) / u_step : 0;
    if (nk == 0) convert_uv(p, 0, 1);
    int kk = 0;
    for (int u = u_first; u < 2048; u += u_step, ++kk) {
      topk_unit(p, hsm, u);
      convert_uv(p, kk, nk);
    }
  }
  PHASE_SYNC(7)
  if (PHASE_ON(8)) { phase_gather_u(p); phase_gather(p); }
}

extern "C" void kernel_launch(void* const* d_in, const int* in_sizes, int n_in, void* d_out, int out_size,
                              void* d_ws, size_t ws_size, hipStream_t stream) {
  Params p{};
  const float** fp = (const float**)&p;
  for (int i = 0; i < 23; ++i) fp[i] = (const float*)d_in[i];
  p.out = (float*)d_out;
  p.ws = (unsigned char*)d_ws;
  static int grid_blocks = 0;
  if (!grid_blocks) {
    int dev = 0, cus = 0, per_cu = 0;
    hipGetDevice(&dev);
    hipDeviceGetAttribute(&cus, hipDeviceAttributeMultiprocessorCount, dev);
    hipOccupancyMaxActiveBlocksPerMultiprocessor(&per_cu, fwd_kernel, NTHR, 0);
    if (per_cu < 1) per_cu = 1;
    if (per_cu > 1) per_cu = 1;
    grid_blocks = cus * per_cu;
  }
#if SINGLE_LAUNCH
  p.phase_lo = 0; p.phase_hi = 8; p.coop = 1;
  hipMemsetAsync((unsigned char*)d_ws + OFF_BAR, 0, XCD_BAR_WORDS * sizeof(unsigned), stream);
  void* args[] = {&p};
  hipError_t e = hipLaunchCooperativeKernel((void*)fwd_kernel, dim3(grid_blocks), dim3(NTHR), args, 0, stream);
  if (e != hipSuccess) fprintf(stderr, "cooperative launch failed: %s (grid %d)\n", hipGetErrorString(e), grid_blocks);
#else
  for (int ph = 0; ph <= 8; ++ph) {
    p.phase_lo = ph; p.phase_hi = ph; p.coop = 0;
    hipLaunchKernelGGL(fwd_kernel, dim3(grid_blocks), dim3(NTHR), 0, stream, p);
  }
#endif
}
```

```cpp
#include <hip/hip_runtime.h>
#include <hip/hip_cooperative_groups.h>
#include <cstdio>
namespace cg = cooperative_groups;

#ifndef DBL_PHASE
#define DBL_PHASE -1
#endif
#ifndef SINGLE_LAUNCH
#define SINGLE_LAUNCH 1
#endif

typedef unsigned short bf16_t;
typedef short bf16x8 __attribute__((ext_vector_type(8)));
typedef float f32x4 __attribute__((ext_vector_type(4)));
typedef unsigned u32x4 __attribute__((ext_vector_type(4)));
typedef unsigned u32x2 __attribute__((ext_vector_type(2)));
typedef __bf16 bf2_t __attribute__((ext_vector_type(2)));

#define T_TOK 16384
#define DM 2048
#define LDP 4736
#define NPAD1 4864
#define NTHR 512
#define HTHR 256
#define SMEM_HALF 73728
#define SMEM_BYTES 147456
#define EPSV 1e-6f
#define MIB ((size_t)1 << 20)

#define OFF_XB (0 * MIB)
#define OFF_PROJ (64 * MIB)
#define OFF_X1B (64 * MIB)
#define OFF_Q (128 * MIB)
#define OFF_IDX (192 * MIB)
#define OFF_G (200 * MIB)
#define OFF_HLOC (212 * MIB)
#define OFF_CUMA (276 * MIB)
#define OFF_YPART (340 * MIB)
#define OFF_ST (372 * MIB)
#define OFF_WINT (436 * MIB)
#define OFF_WOUTT (455 * MIB)
#define OFF_WQT (463 * MIB)
#define OFF_WAT (471 * MIB)
#define OFF_WXT (471 * MIB + 131072)
#define OFF_KEYSB (471 * MIB + 262144)
#define OFF_RS1 (472 * MIB)
#define OFF_ACS (472 * MIB + 65536)
#define OFF_LCARRY (OFF_ACS + MIB)
#define OFF_SSQ (OFF_LCARRY + 524288)
#define OFF_SSQ2 (OFF_SSQ + MIB)
#define OFF_SCALES (OFF_SSQ2 + 2 * MIB)
#define OFF_XACT (0 * MIB)
#define OFF_BACT (32 * MIB)
#define OFF_SINB_LO OFF_WINT
#define OFF_SINB_HI (488 * MIB)
#define OFF_BAR (487 * MIB)
#define OFF_CACT (478 * MIB)

struct Params {
  const float *x, *norm_mix_w, *w_in, *lru_conv_w, *lru_conv_b, *lru_wa, *lru_ba, *lru_wx, *lru_bx, *lru_lambda;
  const float *ssd_conv_w, *ssd_conv_b, *ssd_dt_bias, *ssd_a_log, *ssd_d, *ssd_norm_w, *w_out, *norm_ffn_w, *peer_wq;
  const float *peer_sub_keys, *peer_u, *peer_v, *norm_final_w;
  float* out;
  unsigned char* ws;
  int phase_lo, phase_hi, coop, pad0;
};

__device__ __forceinline__ unsigned pk2(float lo, float hi) {
  unsigned r;
  asm("v_cvt_pk_bf16_f32 %0, %1, %2" : "=v"(r) : "v"(lo), "v"(hi));
  return r;
}
__device__ __forceinline__ float bf2f(bf16_t v) { return __uint_as_float(((unsigned)v) << 16); }
__device__ __forceinline__ float bflo(unsigned u) { return __uint_as_float(u << 16); }
__device__ __forceinline__ float bfhi(unsigned u) { return __uint_as_float(u & 0xffff0000u); }
__device__ __forceinline__ float wave_sum(float v) {
#pragma unroll
  for (int o = 32; o > 0; o >>= 1) v += __shfl_xor(v, o);
  return v;
}
__device__ __forceinline__ float sigmoid_(float x) { return __builtin_amdgcn_rcpf(1.f + __expf(-x)); }
__device__ __forceinline__ float silu_(float x) { return x * sigmoid_(x); }
__device__ __forceinline__ float gelu_(float x) {
  float u = 0.7978845608028654f * (x + 0.044715f * x * x * x);
  return x * sigmoid_(2.f * u);
}
__device__ __forceinline__ float softplus_(float x) { return fmaxf(x, 0.f) + log1pf(__expf(-fabsf(x))); }
__device__ __forceinline__ f32x4 mfma16(bf16x8 a, bf16x8 b, f32x4 c) {
  return __builtin_amdgcn_mfma_f32_16x16x32_bf16(a, b, c, 0, 0, 0);
}
__device__ __forceinline__ bf16x8 as_frag(u32x4 v) { return __builtin_bit_cast(bf16x8, v); }
__device__ __forceinline__ int sw256(int row, int chunk) { return row * 256 + ((chunk ^ (row & 15)) << 4); }
__device__ __forceinline__ int sw128(int row, int chunk) { return row * 128 + ((chunk ^ ((row >> 1) & 7)) << 4); }

__device__ __forceinline__ bf16_t* sinb_ptr(unsigned char* ws, int b, int c, int hh) {
  return (bf16_t*)(ws + (b < 4 ? OFF_SINB_LO : OFF_SINB_HI)) + (size_t)(((b & 3) * 16 + c) * 16 + hh) * 8192;
}
__device__ __forceinline__ float rs_from_ssq2(const float* ssq2, int row) {
  const f32x4* pp = (const f32x4*)(ssq2 + (size_t)row * 32);
  float s = 0.f;
#pragma unroll
  for (int i = 0; i < 8; ++i) { f32x4 v = pp[i]; s += v[0] + v[1] + v[2] + v[3]; }
  return rsqrtf(s * (1.f / 2048.f) + EPSV);
}
__device__ __forceinline__ float rs_from_ssq(const float* ssq, int row) {
  const f32x4* pp = (const f32x4*)(ssq + (size_t)row * 16);
  float s = 0.f;
#pragma unroll
  for (int i = 0; i < 4; ++i) { f32x4 v = pp[i]; s += v[0] + v[1] + v[2] + v[3]; }
  return rsqrtf(s * (1.f / 1024.f) + EPSV);
}

__device__ void transpose_tile(const float* __restrict__ src, int ld_src, int r0, int c0, int c_valid,
                               bf16_t* __restrict__ dst, int ld_dst, const float* __restrict__ scale, int scale_from,
                               float* tile, bool valid) {
  const int tid = threadIdx.x & 255;
  {
    const int j = tid & 63, i0 = tid >> 6;
#pragma unroll
    for (int ii = 0; ii < 16; ++ii) {
      const int i = i0 + 4 * ii;
      float v = 0.f;
      if (valid && c0 + j < c_valid) {
        v = src[(size_t)(r0 + i) * ld_src + c0 + j];
        if (scale != nullptr && (r0 + i) >= scale_from) v *= scale[r0 + i - scale_from];
      }
      tile[i * 65 + j] = v;
    }
  }
  __syncthreads();
  {
    const int i4 = tid & 15, j0 = tid >> 4;
#pragma unroll
    for (int jj = 0; jj < 4; ++jj) {
      const int j = j0 + 16 * jj;
      const float* tp = tile + (4 * i4) * 65 + j;
      u32x2 o = {pk2(tp[0], tp[65]), pk2(tp[130], tp[195])};
      if (valid) *(u32x2*)(dst + (size_t)(c0 + j) * ld_dst + r0 + 4 * i4) = o;
    }
  }
  __syncthreads();
}

__device__ void phase_prep(const Params& p, unsigned char* smem) {
  const int tid = threadIdx.x, lane = tid & 63, wid = tid >> 6, hb = tid >> 8;
  unsigned char* ws = p.ws;
  bf16_t* xb = (bf16_t*)(ws + OFF_XB);
  float* rs1 = (float*)(ws + OFF_RS1);
  for (int t = blockIdx.x * 8 + wid; t < T_TOK; t += gridDim.x * 8) {
    const float* xr = p.x + (size_t)t * DM;
    bf16_t* xo = xb + (size_t)t * DM;
    float ss = 0.f;
#pragma unroll
    for (int c = 0; c < 8; ++c) {
      f32x4 v = *(const f32x4*)(xr + c * 256 + lane * 4);
      ss += v[0] * v[0] + v[1] * v[1] + v[2] * v[2] + v[3] * v[3];
      u32x2 o = {pk2(v[0], v[1]), pk2(v[2], v[3])};
      *(u32x2*)(xo + c * 256 + lane * 4) = o;
    }
    ss = wave_sum(ss);
    if (lane == 0) rs1[t] = rsqrtf(ss * (1.f / 2048.f) + EPSV);
  }
  float* tile = (float*)(smem + hb * SMEM_HALF);
  const int NT_WIN = 32 * 76, NT_SQ = 32 * 32;
  const int total = NT_WIN + 2 * NT_SQ + 32;
  for (int u0 = blockIdx.x * 2; u0 < total; u0 += gridDim.x * 2) {
    const bool valid = (u0 + hb) < total;
    const int u = valid ? (u0 + hb) : u0;
    if (u < NT_WIN) {
      const int ri = u & 31, cj = u >> 5;
      transpose_tile(p.w_in, 4624, ri * 64, cj * 64, 4624, (bf16_t*)(ws + OFF_WINT), 2048, p.norm_mix_w, 0, tile, valid);
    } else if (u < NT_WIN + NT_SQ) {
      const int v = u - NT_WIN, ri = v & 31, cj = v >> 5;
      transpose_tile(p.w_out, 2048, ri * 64, cj * 64, 2048, (bf16_t*)(ws + OFF_WOUTT), 2048, p.ssd_norm_w, 1024, tile, valid);
    } else if (u < NT_WIN + 2 * NT_SQ) {
      const int v = u - NT_WIN - NT_SQ, ri = v & 31, cj = v >> 5;
      transpose_tile(p.peer_wq, 2048, ri * 64, cj * 64, 2048, (bf16_t*)(ws + OFF_WQT), 2048, p.norm_ffn_w, 0, tile, valid);
    } else {
      const int v = u - NT_WIN - 2 * NT_SQ;
      const int h = v & 15;
      const float* src = (v < 16 ? p.lru_wa : p.lru_wx) + (size_t)h * 4096;
      bf16_t* dst = (bf16_t*)(ws + (v < 16 ? OFF_WAT : OFF_WXT)) + (size_t)h * 4096;
      transpose_tile(src, 64, 0, 0, 64, dst, 64, nullptr, 0, tile, valid);
    }
  }
  {
    bf16_t* kb = (bf16_t*)(ws + OFF_KEYSB);
    for (int i = blockIdx.x * NTHR + tid; i < 65536; i += gridDim.x * NTHR) {
      f32x4 v = *(const f32x4*)(p.peer_sub_keys + (size_t)i * 4);
      u32x2 o = {pk2(v[0], v[1]), pk2(v[2], v[3])};
      *(u32x2*)(kb + (size_t)i * 4) = o;
    }
  }
}

namespace pg8 {
#define PG8_LAS __attribute__((address_space(3)))
constexpr int BM = 256, BK = 64, HALF = 128, HTB = HALF * BK * 2;
__device__ __forceinline__ int lds_byte(int r, int c) { const int st = (r >> 4) * 2 + (c >> 5), rr = r & 15, cc = c & 31, ob = rr * 64 + cc * 2; return st * 1024 + (ob ^ (((ob >> 9) & 1) << 5)); }
__device__ __forceinline__ void stage_rc(int b, int& R, int& C) { const int st = b / 1024, sb = b % 1024, swz = sb ^ (((sb >> 9) & 1) << 5); R = (st >> 1) * 16 + swz / 64; C = (st & 1) * 32 + (swz % 64) / 2; }
struct Unit { int pm, pn; };
struct Gemm { const bf16_t* A; const bf16_t* Bt; int M, N, K; };
struct SimpleOrder {
  int nM, nwg, G, c;
  __device__ void init(int M, int N, int G_, int c_) { nM = M / BM; nwg = nM * (N / BM); G = G_; c = c_; }
  __device__ bool next(int i, Unit& u) const { const int L = i * G + c; if (L >= nwg) return false; u.pm = L % nM; u.pn = L / nM; return true; }
};
struct Epi1 {
  static constexpr bool MID = false;
  const float* rs1; bf16_t* proj;
  __device__ __forceinline__ void mid(f32x4 (&)[2][2][4][2], const Unit&, int, int) const {}
  __device__ __forceinline__ void operator()(const f32x4 (&acc)[2][2][4][2], const Unit& u, int wr, int wc, int fr, int fq) const {
    const int row0 = u.pm * BM + wr * 64 + fr, col0 = u.pn * BM + wc * 32 + 4 * fq;
#pragma unroll
    for (int ai = 0; ai < 2; ++ai)
#pragma unroll
      for (int m = 0; m < 4; ++m) {
        const int row = row0 + ai * HALF + m * 16;
        const float s = rs1[row];
#pragma unroll
        for (int bj = 0; bj < 2; ++bj)
#pragma unroll
          for (int n = 0; n < 2; ++n) {
            const int col = col0 + bj * HALF + n * 16;
            if (col < LDP) {
              f32x4 v = acc[ai][bj][m][n] * s;
              u32x2 o = {pk2(v[0], v[1]), pk2(v[2], v[3])};
              *(u32x2*)(proj + (size_t)row * LDP + col) = o;
            }
          }
      }
  }
};
struct Epi2 {
  static constexpr bool MID = true;
  const float* x; float* out; bf16_t* x1b; float* ssq2; const float* ssq;
  __device__ __forceinline__ void mid(f32x4 (&acc)[2][2][4][2], const Unit& u, int wr, int fr) const {
#pragma unroll
    for (int ai = 0; ai < 2; ++ai)
#pragma unroll
      for (int m = 0; m < 4; ++m) {
        const float s = rs_from_ssq(ssq, u.pm * BM + wr * 64 + fr + ai * HALF + m * 16);
#pragma unroll
        for (int bj = 0; bj < 2; ++bj)
#pragma unroll
          for (int n = 0; n < 2; ++n) acc[ai][bj][m][n] *= s;
        __builtin_amdgcn_sched_barrier(0);
      }
  }
  __device__ __forceinline__ void operator()(const f32x4 (&acc)[2][2][4][2], const Unit& u, int wr, int wc, int fr, int fq) const {
    const int row0 = u.pm * BM + wr * 64 + fr, col0 = u.pn * BM + wc * 32 + 4 * fq;
#pragma unroll
    for (int ai = 0; ai < 2; ++ai)
#pragma unroll
      for (int m = 0; m < 4; ++m) {
        const int row = row0 + ai * HALF + m * 16;
        float ss = 0.f;
#pragma unroll
        for (int bj = 0; bj < 2; ++bj)
#pragma unroll
          for (int n = 0; n < 2; ++n) {
            const int col = col0 + bj * HALF + n * 16;
            f32x4 xr = *(const f32x4*)(x + (size_t)row * DM + col);
            f32x4 v = acc[ai][bj][m][n] + xr;
            *(f32x4*)(out + (size_t)row * DM + col) = v;
            u32x2 o = {pk2(v[0], v[1]), pk2(v[2], v[3])};
            *(u32x2*)(x1b + (size_t)row * DM + col) = o;
            ss += v[0] * v[0] + v[1] * v[1] + v[2] * v[2] + v[3] * v[3];
          }
        ss += __shfl_xor(ss, 16);
        ss += __shfl_xor(ss, 32);
        if (fq == 0) ssq2[(size_t)row * 32 + u.pn * 4 + wc] = ss;
        __builtin_amdgcn_sched_barrier(0);
      }
  }
};
struct Epi3 {
  static constexpr bool MID = false;
  const float* ssq2; bf16_t* q;
  __device__ __forceinline__ void mid(f32x4 (&)[2][2][4][2], const Unit&, int, int) const {}
  __device__ __forceinline__ void operator()(const f32x4 (&acc)[2][2][4][2], const Unit& u, int wr, int wc, int fr, int fq) const {
    const int row0 = u.pm * BM + wr * 64 + fr, col0 = u.pn * BM + wc * 32 + 4 * fq;
#pragma unroll
    for (int ai = 0; ai < 2; ++ai)
#pragma unroll
      for (int m = 0; m < 4; ++m) {
        const int row = row0 + ai * HALF + m * 16;
        const float s = rs_from_ssq2(ssq2, row);
#pragma unroll
        for (int bj = 0; bj < 2; ++bj)
#pragma unroll
          for (int n = 0; n < 2; ++n) {
            const int col = col0 + bj * HALF + n * 16;
            f32x4 v = acc[ai][bj][m][n] * s;
            u32x2 o = {pk2(v[0], v[1]), pk2(v[2], v[3])};
            *(u32x2*)(q + (size_t)row * DM + col) = o;
          }
      }
  }
};

template <class Epi, class Sched, int KROT>
__device__ __forceinline__ void gemm_phase(PG8_LAS unsigned char* lds, const Gemm g, const Sched& S, const Epi& E) {
  const int tid = threadIdx.x, wid = __builtin_amdgcn_readfirstlane(tid >> 6), lane = tid & 63, wr = wid >> 2, wc = wid & 3, fr = lane & 15, fq = lane >> 4;
  const int K = g.K, nt = K / BK;
#define PG8_KX(t) (((t) + KROT) & 31)
  unsigned voff[2];
#pragma unroll
  for (int i = 0; i < 2; ++i) { int R, C; stage_rc(tid * 16 + i * 8192, R, C); voff[i] = (unsigned)(R * K + C) * 2u; }
  const size_t kstep = (size_t)(BK * 2);
  const size_t hstep = (size_t)HALF * K * 2;
  const size_t tstep = 2 * hstep;
  const unsigned ldsw = (unsigned)wid * 1024u;
  const int aoff = lds_byte(wr * 64 + fr, fq * 8), boff = lds_byte(wc * 32 + fr, fq * 8);
#define PG8_SA(b, h) (((b) * 2 + (h)) * HTB)
#define PG8_SB(b, h) ((4 + (b) * 2 + (h)) * HTB)
#define PG8_STAGE(bufoff, gbase) do { _Pragma("unroll") for (int _i = 0; _i < 2; ++_i) \
    __builtin_amdgcn_global_load_lds((const unsigned*)((const char*)(gbase) + voff[_i]), (PG8_LAS unsigned*)(lds + (bufoff) + ldsw + _i * 8192), 16, 0, 0); } while (0)
#define PG8_LDA(dst, b, h) do { _Pragma("unroll") for (int m = 0; m < 4; ++m) _Pragma("unroll") for (int k = 0; k < 2; ++k) dst[m][k] = *(const PG8_LAS bf16x8*)(lds + PG8_SA(b, h) + aoff + m * 2048 + k * 1024); } while (0)
#define PG8_LDB(dst, b, h) do { _Pragma("unroll") for (int n = 0; n < 2; ++n) _Pragma("unroll") for (int k = 0; k < 2; ++k) dst[n][k] = *(const PG8_LAS bf16x8*)(lds + PG8_SB(b, h) + boff + n * 2048 + k * 1024); } while (0)
#define PG8_MMA(ai, bj, At, Bt) do { __builtin_amdgcn_s_setprio(1); _Pragma("unroll") for (int m = 0; m < 4; ++m) _Pragma("unroll") for (int n = 0; n < 2; ++n) _Pragma("unroll") for (int k = 0; k < 2; ++k) \
    acc[ai][bj][m][n] = __builtin_amdgcn_mfma_f32_16x16x32_bf16(Bt[n][k], At[m][k], acc[ai][bj][m][n], 0, 0, 0); __builtin_amdgcn_s_setprio(0); } while (0)
#define PG8_WAIT_V(n) asm volatile("s_waitcnt vmcnt(" #n ")" ::: "memory")
#define PG8_WAIT_L(n) asm volatile("s_waitcnt lgkmcnt(" #n ")" ::: "memory")
#define PG8_BAR __builtin_amdgcn_s_barrier()
#define PG8_SCHED __builtin_amdgcn_sched_barrier(0)
  Unit cur, nxt; int ui = 0;
  if (!S.next(0, cur)) return;
  f32x4 acc[2][2][4][2];
#pragma unroll
  for (int a = 0; a < 2; ++a)
#pragma unroll
    for (int b = 0; b < 2; ++b)
#pragma unroll
      for (int m = 0; m < 4; ++m)
#pragma unroll
        for (int n = 0; n < 2; ++n) acc[a][b][m][n] = (f32x4){0.f, 0.f, 0.f, 0.f};
  bf16x8 At[4][2], B0[2][2], B1[2][2];
  const char* cA = (const char*)g.A + (size_t)cur.pm * tstep; const char* cB = (const char*)g.Bt + (size_t)cur.pn * tstep;
  { const char* a0 = cA + (size_t)PG8_KX(0) * kstep; const char* b0 = cB + (size_t)PG8_KX(0) * kstep;
    const char* a1 = cA + (size_t)PG8_KX(1) * kstep; const char* b1 = cB + (size_t)PG8_KX(1) * kstep;
    PG8_STAGE(PG8_SB(0, 0), b0); PG8_STAGE(PG8_SA(0, 0), a0); PG8_STAGE(PG8_SB(0, 1), b0 + hstep); PG8_STAGE(PG8_SA(0, 1), a0 + hstep);
    if (wr == 1) PG8_BAR;
    PG8_WAIT_V(4); PG8_BAR;
    PG8_STAGE(PG8_SB(1, 0), b1); PG8_STAGE(PG8_SA(1, 0), a1); PG8_STAGE(PG8_SB(1, 1), b1 + hstep);
    PG8_WAIT_V(6); PG8_BAR; }
  for (;;) {
    const bool has_next = S.next(ui + 1, nxt);
    const char* nA = has_next ? (const char*)g.A + (size_t)nxt.pm * tstep : cA; const char* nB = has_next ? (const char*)g.Bt + (size_t)nxt.pn * tstep : cB;
#define PG8_ITER(t) {\
      const bool last = (t == nt - 2);\
      const char* a1 = cA + (size_t)PG8_KX(t + 1) * kstep;\
      const char* a2 = last ? nA + (size_t)PG8_KX(0) * kstep : cA + (size_t)PG8_KX(t + 2) * kstep;\
      const char* b2 = last ? nB + (size_t)PG8_KX(0) * kstep : cB + (size_t)PG8_KX(t + 2) * kstep;\
      const char* a3 = last ? nA + (size_t)PG8_KX(1) * kstep : cA + (size_t)PG8_KX(t + 3) * kstep;\
      const char* b3 = last ? nB + (size_t)PG8_KX(1) * kstep : cB + (size_t)PG8_KX(t + 3) * kstep;\
      PG8_LDB(B0, 0, 0); PG8_SCHED; PG8_LDA(At, 0, 0); PG8_STAGE(PG8_SA(1, 1), a1 + hstep);\
      PG8_WAIT_L(8); PG8_BAR; PG8_WAIT_L(0); PG8_MMA(0, 0, At, B0); PG8_BAR; PG8_SCHED;\
      PG8_LDB(B1, 0, 1); PG8_STAGE(PG8_SB(0, 0), b2);\
      PG8_BAR; PG8_WAIT_L(0); PG8_MMA(0, 1, At, B1); PG8_BAR;\
      PG8_LDA(At, 0, 1); PG8_STAGE(PG8_SA(0, 0), a2);\
      PG8_BAR; PG8_WAIT_L(0); PG8_MMA(1, 0, At, B0); PG8_BAR; PG8_SCHED;\
      PG8_STAGE(PG8_SB(0, 1), b2 + hstep);\
      PG8_WAIT_V(6); PG8_BAR; PG8_MMA(1, 1, At, B1); PG8_BAR;\
      PG8_LDB(B0, 1, 0); PG8_SCHED; PG8_LDA(At, 1, 0); PG8_STAGE(PG8_SA(0, 1), a2 + hstep);\
      PG8_WAIT_L(8); PG8_BAR; PG8_WAIT_L(0); PG8_MMA(0, 0, At, B0); PG8_BAR; PG8_SCHED;\
      PG8_LDB(B1, 1, 1); PG8_STAGE(PG8_SB(1, 0), b3);\
      PG8_BAR; PG8_WAIT_L(0); PG8_MMA(0, 1, At, B1); PG8_BAR;\
      PG8_LDA(At, 1, 1); PG8_STAGE(PG8_SA(1, 0), a3);\
      PG8_BAR; PG8_WAIT_L(0); PG8_MMA(1, 0, At, B0); PG8_BAR; PG8_SCHED;\
      PG8_STAGE(PG8_SB(1, 1), b3 + hstep);\
      PG8_WAIT_V(6); PG8_BAR; PG8_MMA(1, 1, At, B1); PG8_BAR;\
}
    if (Epi::MID) {
      for (int t = 0; t < 16; t += 2) PG8_ITER(t)
      E.mid(acc, cur, wr, fr);
      for (int t = 16; t < nt; t += 2) PG8_ITER(t)
    } else {
      for (int t = 0; t < nt; t += 2) PG8_ITER(t)
    }
#undef PG8_ITER
    E(acc, cur, wr, wc, fr, fq);
    if (!has_next) break;
#pragma unroll
    for (int a = 0; a < 2; ++a)
#pragma unroll
      for (int b = 0; b < 2; ++b)
#pragma unroll
        for (int m = 0; m < 4; ++m)
#pragma unroll
          for (int n = 0; n < 2; ++n) acc[a][b][m][n] = (f32x4){0.f, 0.f, 0.f, 0.f};
    cur = nxt; cA = nA; cB = nB; ++ui;
  }
  PG8_WAIT_V(0);
  if (wr == 0) PG8_BAR;
  PG8_BAR;
#undef PG8_KX
#undef PG8_SA
#undef PG8_SB
#undef PG8_STAGE
#undef PG8_LDA
#undef PG8_LDB
#undef PG8_MMA
#undef PG8_WAIT_V
#undef PG8_WAIT_L
#undef PG8_BAR
#undef PG8_SCHED
}
}

__device__ __forceinline__ void conv8(const bf16_t* __restrict__ proj, int t, int tt_in_seq, int col,
                                      const float* __restrict__ cw, int ld_w, const float* __restrict__ cb, int ch,
                                      float* o) {
  f32x4 b0 = *(const f32x4*)(cb + ch), b1 = *(const f32x4*)(cb + ch + 4);
  o[0] = b0[0]; o[1] = b0[1]; o[2] = b0[2]; o[3] = b0[3];
  o[4] = b1[0]; o[5] = b1[1]; o[6] = b1[2]; o[7] = b1[3];
#pragma unroll
  for (int k = 0; k < 4; ++k) {
    if (tt_in_seq - 3 + k >= 0) {
      u32x4 v = *(const u32x4*)(proj + (size_t)(t - 3 + k) * LDP + col);
      f32x4 w0 = *(const f32x4*)(cw + k * ld_w + ch), w1 = *(const f32x4*)(cw + k * ld_w + ch + 4);
      o[0] += w0[0] * bflo(v[0]); o[1] += w0[1] * bfhi(v[0]);
      o[2] += w0[2] * bflo(v[1]); o[3] += w0[3] * bfhi(v[1]);
      o[4] += w1[0] * bflo(v[2]); o[5] += w1[1] * bfhi(v[2]);
      o[6] += w1[2] * bflo(v[3]); o[7] += w1[3] * bfhi(v[3]);
    }
  }
}
__device__ __forceinline__ void conv4(const bf16_t* __restrict__ proj, int t, int tt_in_seq, int col,
                                      const float* __restrict__ cw, int ld_w, const float* __restrict__ cb, int ch,
                                      float* o) {
  f32x4 b0 = *(const f32x4*)(cb + ch);
  o[0] = b0[0]; o[1] = b0[1]; o[2] = b0[2]; o[3] = b0[3];
#pragma unroll
  for (int k = 0; k < 4; ++k) {
    if (tt_in_seq - 3 + k >= 0) {
      u32x2 v = *(const u32x2*)(proj + (size_t)(t - 3 + k) * LDP + col);
      f32x4 w0 = *(const f32x4*)(cw + k * ld_w + ch);
      o[0] += w0[0] * bflo(v[0]); o[1] += w0[1] * bfhi(v[0]);
      o[2] += w0[2] * bflo(v[1]); o[3] += w0[3] * bfhi(v[1]);
    }
  }
}
__device__ __forceinline__ bf16x8 cfrag(const Params& p, const bf16_t* proj, int t, int tseq, int g, int n8) {
  const bf16_t* cact = (const bf16_t*)(p.ws + OFF_CACT);
  return as_frag(*(const u32x4*)(cact + (size_t)t * 256 + g * 128 + n8));
}
__device__ void conv_prepass(const Params& p, int part, int nparts) {
  unsigned char* ws = p.ws;
  const bf16_t* proj = (const bf16_t*)(ws + OFF_PROJ);
  bf16_t* xact = (bf16_t*)(ws + OFF_XACT);
  bf16_t* bact = (bf16_t*)(ws + OFF_BACT);
  bf16_t* cact = (bf16_t*)(ws + OFF_CACT);
  for (int i = blockIdx.x * NTHR + threadIdx.x + part * (int)gridDim.x * NTHR; i < T_TOK * 192; i += nparts * (int)gridDim.x * NTHR) {
    const int t = i / 192, ch = (i - t * 192) * 8;
    float o[8];
    conv8(proj, t, t & 2047, 3072 + ch, p.ssd_conv_w, 1536, p.ssd_conv_b, ch, o);
#pragma unroll
    for (int e = 0; e < 8; ++e) o[e] = silu_(o[e]);
    u32x4 r = {pk2(o[0], o[1]), pk2(o[2], o[3]), pk2(o[4], o[5]), pk2(o[6], o[7])};
    bf16_t* dst = ch < 1024 ? xact + (size_t)t * 1024 + ch : (ch < 1280 ? bact + (size_t)t * 256 + (ch - 1024) : cact + (size_t)t * 256 + (ch - 1280));
    *(u32x4*)dst = r;
  }
}

__device__ void lru_local_unit(const Params& p, unsigned char* smem, int unit) {
  const int tid = threadIdx.x & 255, lane = tid & 63, wid = tid >> 6, l15 = lane & 15, q4 = lane >> 4;
  const int hh = unit & 15, c = (unit >> 4) & 15, b = unit >> 8;
  const int t0 = b * 2048 + c * 128, ch0 = hh * 64;
  unsigned char* ws = p.ws;
  const bf16_t* proj = (const bf16_t*)(ws + OFF_PROJ);
  float* R1 = (float*)smem;
  float* R2 = (float*)(smem + 33536);
  float* R3 = (float*)(smem + 33536 + 32768);
#pragma unroll 11
  for (int e = tid; e < 131 * 64; e += HTHR) {
    const int r = e >> 6, j = e & 63, tt = r - 3;
    float v = 0.f;
    if (c * 128 + tt >= 0) v = bf2f(proj[(size_t)(t0 + tt) * LDP + ch0 + j]);
    R1[e] = v;
  }
  __syncthreads();
  {
    const int j = tid & 63;
    const float cb = p.lru_conv_b[ch0 + j];
    const float w0 = p.lru_conv_w[0 * 1024 + ch0 + j], w1 = p.lru_conv_w[1 * 1024 + ch0 + j],
                w2 = p.lru_conv_w[2 * 1024 + ch0 + j], w3 = p.lru_conv_w[3 * 1024 + ch0 + j];
#pragma unroll 8
    for (int tt = tid >> 6; tt < 128; tt += 4) {
      R2[tt * 64 + j] = cb + w0 * R1[tt * 64 + j] + w1 * R1[(tt + 1) * 64 + j] + w2 * R1[(tt + 2) * 64 + j] +
                        w3 * R1[(tt + 3) * 64 + j];
    }
  }
  __syncthreads();
  {
    const bf16_t* waT = (const bf16_t*)(ws + OFF_WAT) + (size_t)hh * 4096;
    const bf16_t* wxT = (const bf16_t*)(ws + OFF_WXT) + (size_t)hh * 4096;
    f32x4 aa[2][4], ax[2][4];
#pragma unroll
    for (int i = 0; i < 2; ++i)
#pragma unroll
      for (int j = 0; j < 4; ++j) { aa[i][j] = (f32x4){0, 0, 0, 0}; ax[i][j] = (f32x4){0, 0, 0, 0}; }
#pragma unroll
    for (int ks = 0; ks < 2; ++ks) {
      bf16x8 af[2];
#pragma unroll
      for (int mi = 0; mi < 2; ++mi) {
        const float* src = R2 + (wid * 32 + mi * 16 + l15) * 64 + ks * 32 + q4 * 8;
        f32x4 v0 = *(const f32x4*)src, v1 = *(const f32x4*)(src + 4);
        u32x4 r = {pk2(v0[0], v0[1]), pk2(v0[2], v0[3]), pk2(v1[0], v1[1]), pk2(v1[2], v1[3])};
        af[mi] = as_frag(r);
      }
#pragma unroll
      for (int ni = 0; ni < 4; ++ni) {
        const size_t wo = (size_t)(ni * 16 + l15) * 64 + ks * 32 + q4 * 8;
        bf16x8 ba = as_frag(*(const u32x4*)(waT + wo));
        bf16x8 bx = as_frag(*(const u32x4*)(wxT + wo));
#pragma unroll
        for (int mi = 0; mi < 2; ++mi) {
          aa[mi][ni] = mfma16(af[mi], ba, aa[mi][ni]);
          ax[mi][ni] = mfma16(af[mi], bx, ax[mi][ni]);
        }
      }
    }
#pragma unroll
    for (int ni = 0; ni < 4; ++ni) {
      const int j = ni * 16 + l15;
      const float ba = p.lru_ba[ch0 + j], bx = p.lru_bx[ch0 + j];
      const float lam = p.lru_lambda[ch0 + j];
      const float spl = -8.f * log1pf(__expf(-lam));
#pragma unroll
      for (int mi = 0; mi < 2; ++mi)
#pragma unroll
        for (int r = 0; r < 4; ++r) {
          const int tt = wid * 32 + mi * 16 + q4 * 4 + r;
          const float rg = sigmoid_(aa[mi][ni][r] + ba);
          const float ig = sigmoid_(ax[mi][ni][r] + bx);
          const float log_a = spl * rg;
          const float av = __expf(log_a);
          const float xl = R2[tt * 64 + j];
          const float y2 = 2.f * log_a;
          const float poly = -y2 * (1.f + y2 * (0.5f + y2 * (0.16666667f + y2 * (0.041666668f + y2 * (0.0083333338f + y2 * 0.0013888889f)))));
          const float em = (y2 > -0.25f) ? poly : (1.f - av * av);
          const float bv = __builtin_amdgcn_sqrtf(fmaxf(em, 0.f)) * (ig * xl);
          R1[tt * 64 + j] = av;
          R2[tt * 64 + j] = bv;
        }
    }
  }
  __syncthreads();
  {
    const int j = tid & 63, seg = tid >> 6;
    float h = 0.f, Ac = 1.f;
#pragma unroll 4
    for (int s = 0; s < 32; ++s) {
      const int tt = seg * 32 + s;
      const float a = R1[tt * 64 + j], bb = R2[tt * 64 + j];
      h = a * h + bb;
      Ac *= a;
      R2[tt * 64 + j] = h;
      R1[tt * 64 + j] = Ac;
    }
    R3[seg * 64 + j] = h;
    R3[256 + seg * 64 + j] = Ac;
    __syncthreads();
    float cin = 0.f, Ain = 1.f;
    for (int s2 = 0; s2 < seg; ++s2) {
      cin = R3[256 + s2 * 64 + j] * cin + R3[s2 * 64 + j];
      Ain *= R3[256 + s2 * 64 + j];
    }
    float* hloc = (float*)(ws + OFF_HLOC);
    float* cumA = (float*)(ws + OFF_CUMA);
#pragma unroll 4
    for (int s = 0; s < 32; ++s) {
      const int tt = seg * 32 + s;
      const float hl = R2[tt * 64 + j] + R1[tt * 64 + j] * cin;
      const float Al = R1[tt * 64 + j] * Ain;
      hloc[(size_t)(t0 + tt) * 1024 + ch0 + j] = hl;
      cumA[(size_t)(t0 + tt) * 1024 + ch0 + j] = Al;
    }
  }
  __syncthreads();
}

__device__ void ssd_local_unit(const Params& p, unsigned char* smem, int unit) {
  const int tid = threadIdx.x & 255, lane = tid & 63, wid = tid >> 6, l15 = lane & 15, q4 = lane >> 4;
  const int hh = unit & 15, c = (unit >> 4) & 15, b = unit >> 8, g = hh >> 3;
  const int t0 = b * 2048 + c * 128, ts0 = c * 128;
  unsigned char* ws = p.ws;
  const bf16_t* proj = (const bf16_t*)(ws + OFF_PROJ);
  unsigned char* Bm = smem;
  unsigned char* XT = smem + 32768;
  unsigned char* Pw = smem + 49152 + wid * 4096;
  float* dts = (float*)(smem + 65536);
  float* acs = dts + 128;
  float* adt = acs + 128;
  if (tid < 128) {
    const float raw = bf2f(proj[(size_t)(t0 + tid) * LDP + 4608 + hh]);
    const float dtv = softplus_(raw + p.ssd_dt_bias[hh]);
    dts[tid] = dtv;
    adt[tid] = -__expf(p.ssd_a_log[hh]) * dtv;
  }
  __syncthreads();
  if (tid < 128) {
    float s = 0.f;
    for (int k = 0; k <= tid; ++k) s += adt[k];
    acs[tid] = s;
    ((float*)(ws + OFF_ACS))[(size_t)(t0 + tid) * 16 + hh] = s;
  }
  {
    const bf16_t* bact = (const bf16_t*)(ws + OFF_BACT);
    const int chunk = tid & 15;
#pragma unroll
    for (int i = 0; i < 8; ++i) {
      const int tt = (tid >> 4) + 16 * i;
      *(u32x4*)(Bm + sw256(tt, chunk)) = *(const u32x4*)(bact + (size_t)(t0 + tt) * 256 + g * 128 + chunk * 8);
    }
  }
  __syncthreads();
  const bf16_t* xact = (const bf16_t*)(ws + OFF_XACT);
  {
    const int pp = tid & 63;
    const int ch = hh * 64 + pp;
#pragma unroll
    for (int i = 0; i < 4; ++i) {
      const int chunk = (tid >> 6) * 4 + i;
      const int tt0 = chunk * 8;
      float o[8];
#pragma unroll
      for (int e = 0; e < 8; ++e) o[e] = bf2f(xact[(size_t)(t0 + tt0 + e) * 1024 + ch]) * dts[tt0 + e];
      u32x4 r = {pk2(o[0], o[1]), pk2(o[2], o[3]), pk2(o[4], o[5]), pk2(o[6], o[7])};
      *(u32x4*)(XT + sw256(pp, chunk)) = r;
    }
  }
  __syncthreads();
  bf16_t* ypart = (bf16_t*)(ws + OFF_YPART);
  const float Dh = p.ssd_d[hh];
#pragma unroll 1
  for (int mt = 0; mt < 2; ++mt) {
    const int M = wid * 2 + mt;
    const int lrow = M * 16 + l15;
    bf16x8 cf[4];
#pragma unroll
    for (int ks = 0; ks < 4; ++ks) cf[ks] = cfrag(p, proj, t0 + lrow, ts0 + lrow, g, ks * 32 + q4 * 8);
    const float acl = acs[lrow];
    const int ntmax = M | 1;
#pragma unroll 2
    for (int nt = 0; nt <= ntmax; ++nt) {
      f32x4 a4 = (f32x4){0, 0, 0, 0};
      if (nt <= M) {
#pragma unroll
        for (int ks = 0; ks < 4; ++ks) {
          bf16x8 bfr = *(const bf16x8*)(Bm + sw256(nt * 16 + l15, ks * 4 + q4));
          a4 = mfma16(bfr, cf[ks], a4);
        }
      }
      float pv[4];
#pragma unroll
      for (int r = 0; r < 4; ++r) {
        const int s = nt * 16 + q4 * 4 + r;
        pv[r] = (s <= lrow) ? a4[r] * __expf(acl - acs[s]) : 0.f;
      }
      u32x2 o = {pk2(pv[0], pv[1]), pk2(pv[2], pv[3])};
      const int chunk = nt * 2 + (q4 >> 1);
      *(u32x2*)(Pw + sw256(l15, chunk) + (q4 & 1) * 8) = o;
    }
    f32x4 ya[4];
#pragma unroll
    for (int pt = 0; pt < 4; ++pt) ya[pt] = (f32x4){0, 0, 0, 0};
    const int ksmax = M >> 1;
#pragma unroll 1
    for (int ks = 0; ks <= ksmax; ++ks) {
      bf16x8 pf = *(const bf16x8*)(Pw + sw256(l15, ks * 4 + q4));
#pragma unroll
      for (int pt = 0; pt < 4; ++pt) {
        bf16x8 xf = *(const bf16x8*)(XT + sw256(pt * 16 + l15, ks * 4 + q4));
        ya[pt] = mfma16(xf, pf, ya[pt]);
      }
    }
#pragma unroll
    for (int pt = 0; pt < 4; ++pt) {
      const int pc = pt * 16 + q4 * 4;
      const int ch = hh * 64 + pc;
      const u32x2 xv = *(const u32x2*)(xact + (size_t)(t0 + lrow) * 1024 + ch);
      float y0 = ya[pt][0] + Dh * bflo(xv[0]), y1 = ya[pt][1] + Dh * bfhi(xv[0]);
      float y2 = ya[pt][2] + Dh * bflo(xv[1]), y3 = ya[pt][3] + Dh * bfhi(xv[1]);
      u32x2 o = {pk2(y0, y1), pk2(y2, y3)};
      *(u32x2*)(ypart + (size_t)(t0 + lrow) * 1024 + ch) = o;
    }
  }
  {
    f32x4 sa[2][4];
#pragma unroll
    for (int i = 0; i < 2; ++i)
#pragma unroll
      for (int j = 0; j < 4; ++j) sa[i][j] = (f32x4){0, 0, 0, 0};
    const float aend = acs[127];
#pragma unroll 2
    for (int ks = 0; ks < 4; ++ks) {
      float dec[8];
#pragma unroll
      for (int e = 0; e < 8; ++e) dec[e] = __expf(aend - acs[ks * 32 + q4 * 8 + e]);
      bf16x8 bd[2];
#pragma unroll
      for (int ni = 0; ni < 2; ++ni) {
        const int n = wid * 32 + ni * 16 + l15;
        float v[8];
#pragma unroll
        for (int e = 0; e < 8; ++e) {
          const int l = ks * 32 + q4 * 8 + e;
          const bf16_t raw = *(const bf16_t*)(Bm + sw256(l, n >> 3) + (n & 7) * 2);
          v[e] = bf2f(raw) * dec[e];
        }
        u32x4 r = {pk2(v[0], v[1]), pk2(v[2], v[3]), pk2(v[4], v[5]), pk2(v[6], v[7])};
        bd[ni] = as_frag(r);
      }
#pragma unroll
      for (int pt = 0; pt < 4; ++pt) {
        bf16x8 xf = *(const bf16x8*)(XT + sw256(pt * 16 + l15, ks * 4 + q4));
#pragma unroll
        for (int ni = 0; ni < 2; ++ni) sa[ni][pt] = mfma16(bd[ni], xf, sa[ni][pt]);
      }
    }
    float* St = (float*)(ws + OFF_ST) + (size_t)((b * 16 + c) * 16 + hh) * 8192;
#pragma unroll
    for (int ni = 0; ni < 2; ++ni)
#pragma unroll
      for (int pt = 0; pt < 4; ++pt) {
        const int pr = pt * 16 + l15, n = wid * 32 + ni * 16 + q4 * 4;
        *(f32x4*)(St + pr * 128 + n) = sa[ni][pt];
      }
  }
  __syncthreads();
}

__device__ void phase_carry(const Params& p) {
  unsigned char* ws = p.ws;
  const int gt = blockIdx.x * NTHR + threadIdx.x, ng = gridDim.x * NTHR;
  const float* hloc = (const float*)(ws + OFF_HLOC);
  const float* cumA = (const float*)(ws + OFF_CUMA);
  float* lcarry = (float*)(ws + OFF_LCARRY);
  for (int i = gt; i < 8192; i += ng) {
    const int b = i >> 10, ch = i & 1023;
    float ca[16], hl[16];
#pragma unroll
    for (int c = 0; c < 16; ++c) {
      const size_t tl = (size_t)(b * 2048 + c * 128 + 127) * 1024 + ch;
      ca[c] = cumA[tl];
      hl[c] = hloc[tl];
    }
    float carry = 0.f;
#pragma unroll
    for (int c = 0; c < 16; ++c) {
      lcarry[(size_t)(b * 16 + c) * 1024 + ch] = carry;
      carry = ca[c] * carry + hl[c];
    }
  }
  const float* acsG = (const float*)(ws + OFF_ACS);
  float* St = (float*)(ws + OFF_ST);
  for (int i = gt; i < 128 * 2048; i += ng) {
    const int bh = i >> 11, e4 = i & 2047, b = bh >> 4, hh = bh & 15;
    f32x4 tmp[16];
    float Ad[16];
#pragma unroll
    for (int c = 0; c < 16; ++c) {
      Ad[c] = __expf(acsG[(size_t)(b * 2048 + c * 128 + 127) * 16 + hh]);
      tmp[c] = *(const f32x4*)(St + (size_t)((b * 16 + c) * 16 + hh) * 8192 + e4 * 4);
    }
    f32x4 s = (f32x4){0, 0, 0, 0};
#pragma unroll
    for (int c = 0; c < 16; ++c) {
      u32x2 o = {pk2(s[0], s[1]), pk2(s[2], s[3])};
      *(u32x2*)(sinb_ptr(ws, b, c, hh) + e4 * 4) = o;
      s = s * Ad[c] + tmp[c];
    }
  }
}

__device__ void ssd_final_unit(const Params& p, int unit) {
  const int tid = threadIdx.x & 255, lane = tid & 63, wid = tid >> 6, l15 = lane & 15, q4 = lane >> 4;
  const int hh = unit & 15, c = (unit >> 4) & 15, b = unit >> 8, g = hh >> 3;
  const int t0 = b * 2048 + c * 128, ts0 = c * 128;
  unsigned char* ws = p.ws;
  const bf16_t* proj = (const bf16_t*)(ws + OFF_PROJ);
  const bf16_t* Sin = sinb_ptr(ws, b, c, hh);
  const bf16_t* ypart = (const bf16_t*)(ws + OFF_YPART);
  const float* acsG = (const float*)(ws + OFF_ACS);
  bf16_t* A2 = (bf16_t*)(ws + OFF_XB);
  float* ssq = (float*)(ws + OFF_SSQ);
#pragma unroll 1
  for (int mt = 0; mt < 2; ++mt) {
    const int lrow = (wid * 2 + mt) * 16 + l15;
    f32x4 ya[4];
#pragma unroll
    for (int pt = 0; pt < 4; ++pt) ya[pt] = (f32x4){0, 0, 0, 0};
    if (c > 0) {
#pragma unroll
      for (int ks = 0; ks < 4; ++ks) {
        bf16x8 cf = cfrag(p, proj, t0 + lrow, ts0 + lrow, g, ks * 32 + q4 * 8);
#pragma unroll
        for (int pt = 0; pt < 4; ++pt) {
          const u32x4 r = *(const u32x4*)(Sin + (pt * 16 + l15) * 128 + ks * 32 + q4 * 8);
          ya[pt] = mfma16(as_frag(r), cf, ya[pt]);
        }
      }
    }
    const size_t t = (size_t)(t0 + lrow);
    const float ea = __expf(acsG[t * 16 + hh]);
    float ss = 0.f;
#pragma unroll
    for (int pt = 0; pt < 4; ++pt) {
      const int ch = hh * 64 + pt * 16 + q4 * 4;
      u32x2 yp = *(const u32x2*)(ypart + t * 1024 + ch);
      u32x2 zz = *(const u32x2*)(proj + t * LDP + 2048 + ch);
      float y[4] = {bflo(yp[0]) + ea * ya[pt][0], bfhi(yp[0]) + ea * ya[pt][1], bflo(yp[1]) + ea * ya[pt][2],
                    bfhi(yp[1]) + ea * ya[pt][3]};
      float z[4] = {bflo(zz[0]), bfhi(zz[0]), bflo(zz[1]), bfhi(zz[1])};
#pragma unroll
      for (int r = 0; r < 4; ++r) { y[r] = y[r] * silu_(z[r]); ss += y[r] * y[r]; }
      u32x2 o = {pk2(y[0], y[1]), pk2(y[2], y[3])};
      *(u32x2*)(A2 + t * DM + 1024 + ch) = o;
    }
    ss += __shfl_xor(ss, 16);
    ss += __shfl_xor(ss, 32);
    if (q4 == 0) ssq[t * 16 + hh] = ss;
  }
}

__device__ void phase_mix_final(const Params& p) {
  unsigned char* ws = p.ws;
  const bf16_t* proj = (const bf16_t*)(ws + OFF_PROJ);
  const f32x4* hloc = (const f32x4*)(ws + OFF_HLOC);
  const f32x4* cumA = (const f32x4*)(ws + OFF_CUMA);
  const float* lcarry = (const float*)(ws + OFF_LCARRY);
  bf16_t* A2 = (bf16_t*)(ws + OFF_XB);
  for (int u = blockIdx.x * 2 + (threadIdx.x >> 8); u < 2048; u += gridDim.x * 2) ssd_final_unit(p, u);
#pragma unroll 4
  for (int i = blockIdx.x * NTHR + threadIdx.x; i < T_TOK * 256; i += gridDim.x * NTHR) {
    const int t = i >> 8, ch = (i & 255) * 4;
    f32x4 h = hloc[i], ca = cumA[i];
    f32x4 cr = *(const f32x4*)(lcarry + (size_t)(t >> 7) * 1024 + ch);
    u32x2 gg = *(const u32x2*)(proj + (size_t)t * LDP + 1024 + ch);
    float y0 = (h[0] + ca[0] * cr[0]) * gelu_(bflo(gg[0]));
    float y1 = (h[1] + ca[1] * cr[1]) * gelu_(bfhi(gg[0]));
    float y2 = (h[2] + ca[2] * cr[2]) * gelu_(bflo(gg[1]));
    float y3 = (h[3] + ca[3] * cr[3]) * gelu_(bfhi(gg[1]));
    u32x2 o = {pk2(y0, y1), pk2(y2, y3)};
    *(u32x2*)(A2 + (size_t)t * DM + ch) = o;
  }
}

__device__ void convert_uv(const Params& p, int part, int nparts) {
  unsigned char* ws = p.ws;
  const int lane = threadIdx.x & 63, wid = threadIdx.x >> 6;
  unsigned char* tb = ws + OFF_XB;
  float* scales = (float*)(ws + OFF_SCALES);
  for (int row = blockIdx.x * 8 + wid + part * (int)gridDim.x * 8; row < 32768; row += nparts * (int)gridDim.x * 8) {
    const bool isv = row >= 16384;
    const int e = row & 16383;
    const float* src = (isv ? p.peer_v : p.peer_u) + (size_t)e * DM + lane * 32;
    float vals[32];
    float ss = 0.f;
#pragma unroll
    for (int q = 0; q < 8; ++q) {
      f32x4 t = *(const f32x4*)(src + q * 4);
      if (!isv) t *= *(const f32x4*)(p.norm_ffn_w + lane * 32 + q * 4);
#pragma unroll
      for (int k = 0; k < 4; ++k) {
        vals[q * 4 + k] = t[k];
        ss += t[k] * t[k];
      }
    }
    ss = wave_sum(ss);
    const float rms = sqrtf(ss * (1.f / 2048.f));
    const float sc = rms * (2.6f / 7.f);
    const float inv = sc > 0.f ? 1.f / sc : 0.f;
    u32x4 o;
#pragma unroll
    for (int m = 0; m < 4; ++m) {
      unsigned w = 0;
#pragma unroll
      for (int j = 0; j < 4; ++j) {
        const float lo = fminf(fmaxf(rintf(vals[m * 8 + j] * inv), -7.f), 7.f);
        const float hi = fminf(fmaxf(rintf(vals[m * 8 + 4 + j] * inv), -7.f), 7.f);
        const unsigned bl = isv ? (unsigned)((int)lo + 8) : ((unsigned)(int)lo & 0xfu);
        const unsigned bh = isv ? (unsigned)((int)hi + 8) : ((unsigned)(int)hi & 0xfu);
        w |= (bl | (bh << 4)) << (8 * j);
      }
      o[m] = w;
    }
    *(u32x4*)(tb + (size_t)row * 1024 + lane * 16) = o;
    if (lane == 0) scales[row] = sc;
  }
}

__device__ const unsigned char cand_tab[64] = {
    0x00, 0x01, 0x02, 0x03, 0x04, 0x05, 0x06, 0x07, 0x08, 0x09, 0x0a, 0x0b, 0x0c, 0x0d, 0x0e, 0x0f,
    0x10, 0x11, 0x12, 0x13, 0x14, 0x15, 0x16, 0x17,
    0x20, 0x21, 0x22, 0x23, 0x24,
    0x30, 0x31, 0x32, 0x33,
    0x40, 0x41, 0x42,
    0x50, 0x51, 0x60, 0x61, 0x70, 0x71,
    0x80, 0x90, 0xa0, 0xb0, 0xc0, 0xd0, 0xe0, 0xf0,
    0xff, 0xff, 0xff, 0xff, 0xff, 0xff, 0xff, 0xff, 0xff, 0xff, 0xff, 0xff, 0xff, 0xff};

__device__ __forceinline__ unsigned ord_key(float f) {
  unsigned u = __float_as_uint(f);
  return u ^ ((u >> 31) ? 0xffffffffu : 0x80000000u);
}
__device__ __forceinline__ float ord_dec(unsigned k) {
  unsigned u = (k >> 31) ? (k ^ 0x80000000u) : ~k;
  return __uint_as_float(u);
}

__device__ void topk_unit(const Params& p, unsigned char* smem, int unit) {
  const int tid = threadIdx.x & 255, lane = tid & 63, wid = tid >> 6, l15 = lane & 15, q4 = lane >> 4;
  const int h = unit & 7, tile = unit >> 3;
  const int tok0 = tile * 64 + wid * 16;
  unsigned char* ws = p.ws;
  const bf16_t* qg = (const bf16_t*)(ws + OFF_Q);
  const bf16_t* kb = (const bf16_t*)(ws + OFF_KEYSB);
  unsigned* S = (unsigned*)(smem + wid * 16640);
  float* tops = (float*)(smem + 4 * 16640 + wid * 256);
  int* topi = (int*)(tops + 32);
  unsigned* Ms = (unsigned*)(smem + 67584 + wid * 768);
#pragma unroll
  for (int k = 0; k < 2; ++k) {
    f32x4 sc[8];
#pragma unroll
    for (int i = 0; i < 8; ++i) sc[i] = (f32x4){0, 0, 0, 0};
#pragma unroll
    for (int ks = 0; ks < 4; ++ks) {
      bf16x8 qf = as_frag(*(const u32x4*)(qg + (size_t)(tok0 + l15) * DM + h * 256 + k * 128 + ks * 32 + q4 * 8));
#pragma unroll
      for (int nt = 0; nt < 8; ++nt) {
        bf16x8 kf = as_frag(*(const u32x4*)(kb + (size_t)((h * 2 + k) * 128 + nt * 16 + l15) * 128 + ks * 32 + q4 * 8));
        sc[nt] = mfma16(kf, qf, sc[nt]);
      }
    }
#pragma unroll
    for (int nt = 0; nt < 8; ++nt) {
      const int n = nt * 16 + q4 * 4;
      u32x4 kk;
#pragma unroll
      for (int r = 0; r < 4; ++r) kk[r] = (ord_key(sc[nt][r]) & ~127u) | (unsigned)(127 - (n + r));
      *(u32x4*)(S + l15 * 260 + k * 128 + n) = kk;
    }
  }
  const unsigned ct = cand_tab[lane];
  const int ca = ct >> 4, cbb = ct & 15;
  int* idxo = (int*)(ws + OFF_IDX);
  float* go = (float*)(ws + OFF_G);
  for (int tk = 0; tk < 16; ++tk) {
    const unsigned* row = S + tk * 260;
    unsigned ka[2], kb[2], mxk[2];
#pragma unroll
    for (int hf = 0; hf < 2; ++hf) {
      ka[hf] = row[hf * 128 + lane];
      kb[hf] = row[hf * 128 + 64 + lane];
      mxk[hf] = ka[hf] > kb[hf] ? ka[hf] : kb[hf];
      Ms[hf * 96 + lane] = mxk[hf];
    }
    int cnt[2][4];
#pragma unroll
    for (int hf = 0; hf < 2; ++hf)
#pragma unroll
      for (int e = 0; e < 4; ++e) cnt[hf][e] = 0;
#pragma unroll
    for (int j = 0; j < 16; ++j)
#pragma unroll
      for (int hf = 0; hf < 2; ++hf) {
        u32x4 x = *(const u32x4*)(Ms + hf * 96 + j * 4);
#pragma unroll
        for (int e = 0; e < 4; ++e) cnt[hf][e] += (x[e] > mxk[hf]) ? 1 : 0;
      }
    bool ca_[2], cb_[2];
    int pa[2], pb[2], ncand[2];
    const unsigned long long lt = (1ull << lane) - 1ull;
#pragma unroll
    for (int hf = 0; hf < 2; ++hf) {
      const int c_ = cnt[hf][0] + cnt[hf][1] + cnt[hf][2] + cnt[hf][3];
      const unsigned long long bm = __ballot(c_ == 15);
      const int srcT = __ffsll((long long)bm) - 1;
      const unsigned T0 = (unsigned)__shfl((int)mxk[hf], srcT);
      ca_[hf] = ka[hf] >= T0;
      cb_[hf] = kb[hf] >= T0;
      const unsigned long long ba = __ballot(ca_[hf]), bb = __ballot(cb_[hf]);
      const int na = __popcll(ba);
      pa[hf] = __popcll(ba & lt);
      pb[hf] = na + __popcll(bb & lt);
      ncand[hf] = na + __popcll(bb);
    }
#pragma unroll
    for (int hf = 0; hf < 2; ++hf) {
      unsigned* Cs = Ms + hf * 96 + 64;
      if (lane < 32) Cs[lane] = 0u;
      if (ca_[hf]) Cs[pa[hf]] = ka[hf];
      if (cb_[hf]) Cs[pb[hf]] = kb[hf];
    }
    unsigned my[2];
    int rk2[2][4];
#pragma unroll
    for (int hf = 0; hf < 2; ++hf) {
      my[hf] = Ms[hf * 96 + 64 + (lane & 31)];
#pragma unroll
      for (int e = 0; e < 4; ++e) rk2[hf][e] = 0;
    }
#pragma unroll
    for (int j = 0; j < 8; ++j)
#pragma unroll
      for (int hf = 0; hf < 2; ++hf) {
        u32x4 x = *(const u32x4*)(Ms + hf * 96 + 64 + j * 4);
#pragma unroll
        for (int e = 0; e < 4; ++e) rk2[hf][e] += (x[e] > my[hf]) ? 1 : 0;
      }
#pragma unroll
    for (int hf = 0; hf < 2; ++hf) {
      const int r_ = rk2[hf][0] + rk2[hf][1] + rk2[hf][2] + rk2[hf][3];
      if (lane < ncand[hf] && r_ < 16) {
        tops[hf * 16 + r_] = ord_dec(my[hf] & ~127u);
        topi[hf * 16 + r_] = 127 - (int)(my[hf] & 127u);
      }
    }
    float cs = 0.f;
    unsigned ck = 0u;
    if (lane < 50) {
      cs = tops[ca] + tops[16 + cbb];
      ck = (ord_key(cs) & ~255u) | (unsigned)(255 - (ca * 16 + cbb));
    }
    int rkA = 0, rkB = 0;
#pragma unroll
    for (int j = 0; j < 50; j += 2) {
      const unsigned oj = (unsigned)__builtin_amdgcn_readlane((int)ck, j);
      const unsigned oj2 = (unsigned)__builtin_amdgcn_readlane((int)ck, j + 1);
      rkA += (oj > ck) ? 1 : 0;
      rkB += (oj2 > ck) ? 1 : 0;
    }
    const int rk = rkA + rkB;
    const float mx = tops[0] + tops[16];
    const bool sel = (lane < 50) && (rk < 16);
    const float ev = sel ? __expf(cs - mx) : 0.f;
    const float sum = wave_sum(ev);
    if (sel) {
      const size_t o = (size_t)(tok0 + tk) * 128 + h * 16 + rk;
      idxo[o] = topi[ca] * 128 + topi[16 + cbb];
      go[o] = ev * __builtin_amdgcn_rcpf(sum);
    }
  }
}

__device__ __forceinline__ float ub0(unsigned w) { return (float)(w & 0xffu); }
__device__ __forceinline__ float ub1(unsigned w) { return (float)((w >> 8) & 0xffu); }
__device__ __forceinline__ float ub2(unsigned w) { return (float)((w >> 16) & 0xffu); }
__device__ __forceinline__ float ub3(unsigned w) { return (float)(w >> 24); }

#define OFF_XQ OFF_YPART
#define OFF_WBUF OFF_ST
__device__ void phase_gather_u(const Params& p) {
  const int tid = threadIdx.x, lane = tid & 63, wid = tid >> 6;
  unsigned char* ws = p.ws;
  const unsigned char* ub = ws + OFF_XB;
  const int* idxg = (const int*)(ws + OFF_IDX);
  u32x4* xq = (u32x4*)(ws + OFF_XQ);
  int* wbuf = (int*)(ws + OFF_WBUF);
  float* sxa = (float*)(ws + OFF_WBUF + 8 * MIB);
  const bool b5 = (lane & 32) != 0, b4 = (lane & 16) != 0, b3 = (lane & 8) != 0;
  const int srcl = ((lane & 1) << 3) | (((lane >> 1) & 1) << 4) | (((lane >> 2) & 1) << 5);
  const int tbase = blockIdx.x * 8 + wid, tstride = gridDim.x * 8;
  for (int t = tbase; t < T_TOK; t += tstride) {
    const float* orow = p.out + (size_t)t * DM + lane * 32;
    float xr[32];
    float amax = 0.f;
#pragma unroll
    for (int q = 0; q < 8; ++q) {
      f32x4 v = *(const f32x4*)(orow + q * 4);
#pragma unroll
      for (int k = 0; k < 4; ++k) { xr[q * 4 + k] = v[k]; amax = fmaxf(amax, fabsf(v[k])); }
    }
#pragma unroll
    for (int o = 32; o > 0; o >>= 1) amax = fmaxf(amax, __shfl_xor(amax, o));
    const float inv = amax > 0.f ? 119.f / amax : 0.f;
    u32x4 ph, pl;
#pragma unroll
    for (int m = 0; m < 4; ++m) {
      unsigned wh = 0, wl = 0;
#pragma unroll
      for (int j = 0; j < 4; ++j) {
        const int a_ = __float2int_rn(xr[m * 8 + j] * inv), b_ = __float2int_rn(xr[m * 8 + 4 + j] * inv);
        const int ah = (a_ + 8) >> 4, bh = (b_ + 8) >> 4;
        const int al = a_ - 16 * ah, bl = b_ - 16 * bh;
        wh |= (((unsigned)ah & 0xfu) | (((unsigned)bh & 0xfu) << 4)) << (8 * j);
        wl |= (((unsigned)al & 0xfu) | (((unsigned)bl & 0xfu) << 4)) << (8 * j);
      }
      ph[m] = wh;
      pl[m] = wl;
    }
    xq[((size_t)t * 64 + lane) * 2] = ph;
    xq[((size_t)t * 64 + lane) * 2 + 1] = pl;
    if (lane == 0) sxa[t] = amax * (1.f / 119.f);
  }
  asm volatile("s_waitcnt vmcnt(0)" ::: "memory");
#pragma unroll 1
  for (int r = 0; r < 4; ++r) {
#pragma unroll 1
    for (int t = tbase; t < T_TOK; t += tstride) {
      const u32x4 ph = xq[((size_t)t * 64 + lane) * 2], pl = xq[((size_t)t * 64 + lane) * 2 + 1];
      const int idA = idxg[(size_t)t * 128 + lane], idB = idxg[(size_t)t * 128 + 64 + lane];
      unsigned long long m0 = __ballot((idA >> 12) == r), m1 = __ballot((idB >> 12) == r);
      while (m0 | m1) {
        int jk[16];
        u32x4 rw[16];
        const int nvalid = min((int)(__popcll(m0) + __popcll(m1)), 16);
        int jfirst, efirst;
        if (m0) { jfirst = __builtin_amdgcn_readfirstlane(__ffsll((long long)m0) - 1); efirst = __builtin_amdgcn_readlane(idA, jfirst); }
        else { const int j1 = __builtin_amdgcn_readfirstlane(__ffsll((long long)m1) - 1); efirst = __builtin_amdgcn_readlane(idB, j1); jfirst = 64 + j1; }
#pragma unroll
        for (int k = 0; k < 16; ++k) {
          int j = jfirst, e = efirst;
          if (m0) { const int jj = __builtin_amdgcn_readfirstlane(__ffsll((long long)m0) - 1); m0 &= m0 - 1ull; j = jj; e = __builtin_amdgcn_readlane(idA, jj); }
          else if (m1) { const int jj = __builtin_amdgcn_readfirstlane(__ffsll((long long)m1) - 1); m1 &= m1 - 1ull; j = 64 + jj; e = __builtin_amdgcn_readlane(idB, jj); }
          jk[k] = j;
          rw[k] = *(const u32x4*)(ub + (size_t)e * 1024 + lane * 16);
        }
#pragma unroll
        for (int bt = 0; bt < 2; ++bt) {
          int dv[8];
#pragma unroll
          for (int k = 0; k < 8; ++k) {
            int dh = 0, dl = 0;
#pragma unroll
            for (int q = 0; q < 4; ++q) {
              dh = __builtin_amdgcn_sdot8((int)rw[bt * 8 + k][q], (int)ph[q], dh, false);
              dl = __builtin_amdgcn_sdot8((int)rw[bt * 8 + k][q], (int)pl[q], dl, false);
            }
            dv[k] = 16 * dh + dl;
          }
          int a4[4], a2[2];
#pragma unroll
          for (int k = 0; k < 4; ++k) {
            const int mine = b5 ? dv[k + 4] : dv[k], oth = b5 ? dv[k] : dv[k + 4];
            a4[k] = mine + __shfl_xor(oth, 32);
          }
#pragma unroll
          for (int k = 0; k < 2; ++k) {
            const int mine = b4 ? a4[k + 2] : a4[k], oth = b4 ? a4[k] : a4[k + 2];
            a2[k] = mine + __shfl_xor(oth, 16);
          }
          int c1;
          {
            const int mine = b3 ? a2[1] : a2[0], oth = b3 ? a2[0] : a2[1];
            c1 = mine + __shfl_xor(oth, 8);
          }
          c1 += __shfl_xor(c1, 4);
          c1 += __shfl_xor(c1, 2);
          c1 += __shfl_xor(c1, 1);
          const int val = __shfl(c1, srcl);
          int jsel = jk[bt * 8];
#pragma unroll
          for (int k = 1; k < 8; ++k) jsel = (lane == k) ? jk[bt * 8 + k] : jsel;
          if (lane < 8 && lane < nvalid - bt * 8) wbuf[(size_t)t * 128 + jsel] = val;
        }
      }
    }
  }
  asm volatile("s_waitcnt vmcnt(0)" ::: "memory");
}

#define GROWS 8
#ifndef USE_SDOT4
#define USE_SDOT4 1
#endif
typedef float f32x2 __attribute__((ext_vector_type(2)));
__device__ void phase_gather(const Params& p) {
  const int tid = threadIdx.x, lane = tid & 63, wid = tid >> 6;
  unsigned char* ws = p.ws;
  const unsigned char* ub = ws + OFF_XB;
  const unsigned char* vb = ws + OFF_XB + 16 * MIB;
  const float* scales = (const float*)(ws + OFF_SCALES);
  const int* idxg = (const int*)(ws + OFF_IDX);
  const float* gg = (const float*)(ws + OFF_G);
  const float* ssq2 = (const float*)(ws + OFF_SSQ2);
  const bool b5 = (lane & 32) != 0, b4 = (lane & 16) != 0, b3 = (lane & 8) != 0;
  const int srcl = ((lane & 1) << 3) | (((lane >> 1) & 1) << 4) | (((lane >> 2) & 1) << 5);
  for (int t = blockIdx.x * 8 + wid; t < T_TOK; t += gridDim.x * 8) {
    const int id0 = idxg[(size_t)t * 128 + lane], id1 = idxg[(size_t)t * 128 + 64 + lane];
    const float g0 = gg[(size_t)t * 128 + lane], g1 = gg[(size_t)t * 128 + 64 + lane];
    const float su0 = scales[id0], su1 = scales[id1], sv0 = scales[16384 + id0], sv1 = scales[16384 + id1];
    float* orow = p.out + (size_t)t * DM + lane * 32;
    const float sx = ((const float*)(ws + OFF_WBUF + 8 * MIB))[t];
    float sq = (lane < 32) ? ssq2[(size_t)t * 32 + lane] : 0.f;
    sq = wave_sum(sq);
    const float rs2 = rsqrtf(sq * (1.f / 2048.f) + EPSV);
    const int* wbuf = (const int*)(ws + OFF_WBUF);
    const int d0 = wbuf[(size_t)t * 128 + lane], d1 = wbuf[(size_t)t * 128 + 64 + lane];
    const float w0 = gelu_((float)d0 * (su0 * sx * rs2)) * g0 * sv0;
    const float w1 = gelu_((float)d1 * (su1 * sx * rs2)) * g1 * sv1;
    float wmax = fmaxf(fabsf(w0), fabsf(w1));
#pragma unroll
    for (int o = 32; o > 0; o >>= 1) wmax = fmaxf(wmax, __shfl_xor(wmax, o));
    const float sw = wmax * (1.f / 127.f);
    const float winv = wmax > 0.f ? 127.f / wmax : 0.f;
    const int q0 = __float2int_rn(w0 * winv), q1 = __float2int_rn(w1 * winv);
    int wsumq = q0 + q1;
#pragma unroll
    for (int o = 32; o > 0; o >>= 1) wsumq += __shfl_xor(wsumq, o);
    int pk0 = (int)(((unsigned)q0 & 0xffu) << (8 * (lane & 3))), pk1 = (int)(((unsigned)q1 & 0xffu) << (8 * (lane & 3)));
    pk0 |= __shfl_xor(pk0, 1); pk0 |= __shfl_xor(pk0, 2);
    pk1 |= __shfl_xor(pk1, 1); pk1 |= __shfl_xor(pk1, 2);
    int acc[32];
#pragma unroll
    for (int i = 0; i < 32; ++i) acc[i] = 0;
#pragma unroll 1
    for (int half = 0; half < 2; ++half) {
      const int idv = half ? id1 : id0;
      const int pkv = half ? pk1 : pk0;
      u32x4 rr[3][GROWS];
#pragma unroll
      for (int k = 0; k < GROWS; ++k) {
        const int e = __builtin_amdgcn_readlane(idv, k);
        rr[0][k] = *(const u32x4*)(vb + (size_t)e * 1024 + lane * 16);
        const int e2 = __builtin_amdgcn_readlane(idv, GROWS + k);
        rr[1][k] = *(const u32x4*)(vb + (size_t)e2 * 1024 + lane * 16);
      }
#pragma unroll
      for (int gi = 0; gi < 64 / GROWS; ++gi) {
        const int j0 = gi * GROWS;
        if (gi + 2 < 64 / GROWS) {
#pragma unroll
          for (int k = 0; k < GROWS; ++k) {
            const int e = __builtin_amdgcn_readlane(idv, j0 + 2 * GROWS + k);
            rr[(gi + 2) % 3][k] = *(const u32x4*)(vb + (size_t)e * 1024 + lane * 16);
          }
        }
#pragma unroll
        for (int sub = 0; sub < GROWS / 4; ++sub) {
          const int W4 = __builtin_amdgcn_readlane(pkv, j0 + 4 * sub);
#pragma unroll
          for (int m = 0; m < 4; ++m) {
            unsigned lo[4], hi[4];
#pragma unroll
            for (int k = 0; k < 4; ++k) {
              const unsigned w = rr[gi % 3][sub * 4 + k][m];
              lo[k] = w & 0x0f0f0f0fu;
              hi[k] = (w >> 4) & 0x0f0f0f0fu;
            }
            {
              const unsigned p01l = __builtin_amdgcn_perm(lo[1], lo[0], 0x05010400u), p01h = __builtin_amdgcn_perm(lo[1], lo[0], 0x07030602u);
              const unsigned p23l = __builtin_amdgcn_perm(lo[3], lo[2], 0x05010400u), p23h = __builtin_amdgcn_perm(lo[3], lo[2], 0x07030602u);
              acc[m * 8 + 0] = __builtin_amdgcn_sdot4((int)__builtin_amdgcn_perm(p23l, p01l, 0x05040100u), W4, acc[m * 8 + 0], false);
              acc[m * 8 + 1] = __builtin_amdgcn_sdot4((int)__builtin_amdgcn_perm(p23l, p01l, 0x07060302u), W4, acc[m * 8 + 1], false);
              acc[m * 8 + 2] = __builtin_amdgcn_sdot4((int)__builtin_amdgcn_perm(p23h, p01h, 0x05040100u), W4, acc[m * 8 + 2], false);
              acc[m * 8 + 3] = __builtin_amdgcn_sdot4((int)__builtin_amdgcn_perm(p23h, p01h, 0x07060302u), W4, acc[m * 8 + 3], false);
            }
            {
              const unsigned p01l = __builtin_amdgcn_perm(hi[1], hi[0], 0x05010400u), p01h = __builtin_amdgcn_perm(hi[1], hi[0], 0x07030602u);
              const unsigned p23l = __builtin_amdgcn_perm(hi[3], hi[2], 0x05010400u), p23h = __builtin_amdgcn_perm(hi[3], hi[2], 0x07030602u);
              acc[m * 8 + 4] = __builtin_amdgcn_sdot4((int)__builtin_amdgcn_perm(p23l, p01l, 0x05040100u), W4, acc[m * 8 + 4], false);
              acc[m * 8 + 5] = __builtin_amdgcn_sdot4((int)__builtin_amdgcn_perm(p23l, p01l, 0x07060302u), W4, acc[m * 8 + 5], false);
              acc[m * 8 + 6] = __builtin_amdgcn_sdot4((int)__builtin_amdgcn_perm(p23h, p01h, 0x05040100u), W4, acc[m * 8 + 6], false);
              acc[m * 8 + 7] = __builtin_amdgcn_sdot4((int)__builtin_amdgcn_perm(p23h, p01h, 0x07060302u), W4, acc[m * 8 + 7], false);
            }
          }
        }
      }
    }
    float val[32];
    float ss = 0.f;
    const int off8 = 8 * wsumq;
#pragma unroll
    for (int q = 0; q < 8; ++q) {
      f32x4 v = *(const f32x4*)(orow + q * 4);
#pragma unroll
      for (int k = 0; k < 4; ++k) {
        val[q * 4 + k] = sw * (float)(acc[q * 4 + k] - off8) + v[k];
        ss += val[q * 4 + k] * val[q * 4 + k];
      }
    }
    ss = wave_sum(ss);
    const float rs3 = rsqrtf(ss * (1.f / 2048.f) + EPSV);
#pragma unroll
    for (int q = 0; q < 8; ++q) {
      f32x4 wf = *(const f32x4*)(p.norm_final_w + lane * 32 + q * 4);
      f32x4 o = {val[q * 4 + 0] * rs3 * wf[0], val[q * 4 + 1] * rs3 * wf[1], val[q * 4 + 2] * rs3 * wf[2],
                 val[q * 4 + 3] * rs3 * wf[3]};
      *(f32x4*)(orow + q * 4) = o;
    }
  }
}

#define XB_TMO      128
#define XB_XCNT(j)  (256  + 64 * (j))
#define XB_XSUB(j)  (1280 + 64 * (j))
#define XB_XGEN(j)  (2304 + 64 * (j))
#define XB_TOP      3328
#define XB_TOPGEN   3392
#define XCD_BAR_WORDS 3456
#define XB_SPIN_CAP (1u << 18)
#define XLAS __attribute__((address_space(3)))
__device__ __forceinline__ unsigned xb_ld(unsigned* p) { return __hip_atomic_load(p, __ATOMIC_RELAXED, __HIP_MEMORY_SCOPE_AGENT); }
__device__ __forceinline__ unsigned xb_add(unsigned* p, unsigned v) { return __hip_atomic_fetch_add(p, v, __ATOMIC_RELAXED, __HIP_MEMORY_SCOPE_AGENT); }
__device__ __forceinline__ unsigned xb_xcc_id() { return (unsigned)__builtin_amdgcn_s_getreg((3 << 11) | 20) & 0xFu; }
#define XB_SPIN(cond, bar) do { unsigned _sp = 0; while (cond) { __builtin_amdgcn_s_sleep(1); \
    if ((++_sp & 255u) == 0u) { if (xb_ld(&(bar)[XB_TMO])) break; if (_sp > XB_SPIN_CAP) { atomicAdd(&(bar)[XB_TMO], 1u); break; } } } } while (0)
struct XcdBarrier { unsigned* bar; unsigned x; volatile XLAS unsigned* st; };
__device__ __forceinline__ XcdBarrier xcd_barrier_post(unsigned* bar, volatile XLAS unsigned* st) {
  XcdBarrier b; b.bar = bar; b.x = xb_xcc_id(); b.st = st;
  if (threadIdx.x == 0) (void)xb_add(&bar[XB_XCNT(b.x)], 1u);
  return b;
}
__device__ __forceinline__ void xcd_barrier_complete(unsigned* bar, unsigned x, unsigned& nloc, unsigned& nx) {
  const unsigned G = gridDim.x * gridDim.y * gridDim.z;
  unsigned sum, cnt, mine, sp = 0u;
  for (;;) {
    sum = 0u; cnt = 0u; mine = 0u;
#pragma unroll
    for (unsigned j = 0; j < 16; ++j) { const unsigned c = xb_ld(&bar[XB_XCNT(j)]); sum += c; cnt += (c > 0u) ? 1u : 0u; mine = (j == x) ? c : mine; }
    if (sum == G) break;
    __builtin_amdgcn_s_sleep(1);
    if ((++sp & 255u) == 0u) { if (xb_ld(&bar[XB_TMO])) break; if (sp > XB_SPIN_CAP) { atomicAdd(&bar[XB_TMO], 1u); break; } }
  }
  nloc = mine > 0u ? mine : 1u; nx = cnt > 0u ? cnt : 1u;
}
__device__ __forceinline__ void xcd_barrier(const XcdBarrier& b) {
  asm volatile("s_waitcnt vmcnt(0)" ::: "memory");
  __syncthreads();
  if (threadIdx.x == 0) {
    unsigned* bar = b.bar;
    __builtin_amdgcn_s_waitcnt(0);
    unsigned nloc = b.st[0], nx = b.st[1];
    if (nloc == 0u) { xcd_barrier_complete(bar, b.x, nloc, nx); b.st[0] = nloc; b.st[1] = nx; }
    const unsigned old = xb_add(&bar[XB_XSUB(b.x)], 1u);
    const unsigned gen = old / nloc;
    if (old + 1u == (gen + 1u) * nloc) {
      __builtin_amdgcn_fence(__ATOMIC_RELEASE, "agent");
      asm volatile("s_waitcnt vmcnt(0)" ::: "memory");
      const unsigned og = xb_add(&bar[XB_TOP], 1u);
      const unsigned tg = og / nx;
      if (og + 1u == (tg + 1u) * nx) xb_add(&bar[XB_TOPGEN], 1u);
      else XB_SPIN(xb_ld(&bar[XB_TOPGEN]) == tg, bar);
      __builtin_amdgcn_fence(__ATOMIC_ACQUIRE, "agent");
      xb_add(&bar[XB_XGEN(b.x)], 1u);
      asm volatile("s_waitcnt vmcnt(0)" ::: "memory");
    } else {
      XB_SPIN(xb_ld(&bar[XB_XGEN(b.x)]) == gen, bar);
      __builtin_amdgcn_fence(__ATOMIC_ACQUIRE, "agent");
      asm volatile("s_waitcnt vmcnt(0)" ::: "memory");
    }
  }
  __syncthreads();
}

__global__ void __launch_bounds__(NTHR, 2) fwd_kernel(Params p) {
  __shared__ __attribute__((aligned(16))) unsigned char smem[SMEM_BYTES];
  __shared__ uint4 xb_words;
  cg::grid_group grid = cg::this_grid();
  unsigned char* ws = p.ws;
  if (threadIdx.x == 0) xb_words = make_uint4(0u, 0u, 0u, 0u);
  __syncthreads();
  XcdBarrier xb = xcd_barrier_post((unsigned*)(ws + OFF_BAR), (volatile XLAS unsigned*)&xb_words);
  const int hb = threadIdx.x >> 8;
  unsigned char* hsm = smem + hb * SMEM_HALF;
#define PHASE_ON(n) (p.phase_lo <= (n) && (n) <= p.phase_hi)
#define PHASE_SYNC(n) if (p.coop && PHASE_ON(n) && (n) < p.phase_hi) { if (p.coop == 2) grid.sync(); else xcd_barrier(xb); }
  if (PHASE_ON(0)) phase_prep(p, smem);
  PHASE_SYNC(0)
  if (PHASE_ON(1)) {
    pg8::Gemm g{(const bf16_t*)(ws + OFF_XB), (const bf16_t*)(ws + OFF_WINT), T_TOK, NPAD1, 2048};
    pg8::SimpleOrder S; S.init(T_TOK, NPAD1, gridDim.x, blockIdx.x);
    pg8::Epi1 E{(const float*)(ws + OFF_RS1), (bf16_t*)(ws + OFF_PROJ)};
    pg8::gemm_phase<pg8::Epi1, pg8::SimpleOrder, 0>((PG8_LAS unsigned char*)smem, g, S, E);
  }
  PHASE_SYNC(1)
  if (PHASE_ON(2)) {
    {
      const int u_step = gridDim.x * 2;
      const int nk = (int)blockIdx.x * 2 < 2048 ? (2048 - (int)blockIdx.x * 2 + u_step - 1) / u_step : 0;
      if (nk == 0) conv_prepass(p, 0, 1);
      int kk = 0;
      for (int u0 = blockIdx.x * 2; u0 < 2048; u0 += u_step, ++kk) {
        lru_local_unit(p, hsm, u0 + hb);
        conv_prepass(p, kk, nk);
      }
    }
    if (p.coop) xcd_barrier(xb);
    for (int u0 = blockIdx.x * 2; u0 < 2048; u0 += gridDim.x * 2) ssd_local_unit(p, hsm, u0 + hb);
  }
  PHASE_SYNC(2)
  if (PHASE_ON(3)) phase_carry(p);
  PHASE_SYNC(3)
  if (PHASE_ON(4)) phase_mix_final(p);
  PHASE_SYNC(4)
  if (PHASE_ON(5)) {
    pg8::Gemm g{(const bf16_t*)(ws + OFF_XB), (const bf16_t*)(ws + OFF_WOUTT), T_TOK, 2048, 2048};
    pg8::SimpleOrder S; S.init(T_TOK, 2048, gridDim.x, blockIdx.x);
    pg8::Epi2 E{p.x, p.out, (bf16_t*)(ws + OFF_X1B), (float*)(ws + OFF_SSQ2), (const float*)(ws + OFF_SSQ)};
    pg8::gemm_phase<pg8::Epi2, pg8::SimpleOrder, 16>((PG8_LAS unsigned char*)smem, g, S, E);
  }
  PHASE_SYNC(5)
  if (PHASE_ON(6)) {
    pg8::Gemm g{(const bf16_t*)(ws + OFF_X1B), (const bf16_t*)(ws + OFF_WQT), T_TOK, 2048, 2048};
    pg8::SimpleOrder S; S.init(T_TOK, 2048, gridDim.x, blockIdx.x);
    pg8::Epi3 E{(const float*)(ws + OFF_SSQ2), (bf16_t*)(ws + OFF_Q)};
    pg8::gemm_phase<pg8::Epi3, pg8::SimpleOrder, 0>((PG8_LAS unsigned char*)smem, g, S, E);
  }
  PHASE_SYNC(6)
  if (PHASE_ON(7)) {
    const int u_first = blockIdx.x * 2 + hb, u_step = gridDim.x * 2;
    const int nk = u_first < 2048 ? (2048 - u_first + u_step - 1) / u_step : 0;
    if (nk == 0) convert_uv(p, 0, 1);
    int kk = 0;
    for (int u = u_first; u < 2048; u += u_step, ++kk) {
      topk_unit(p, hsm, u);
      convert_uv(p, kk, nk);
    }
  }
  PHASE_SYNC(7)
  if (PHASE_ON(8)) { phase_gather_u(p); phase_gather(p); }
}

extern "C" void kernel_launch(void* const* d_in, const int* in_sizes, int n_in, void* d_out, int out_size,
                              void* d_ws, size_t ws_size, hipStream_t stream) {
  Params p{};
  const float** fp = (const float**)&p;
  for (int i = 0; i < 23; ++i) fp[i] = (const float*)d_in[i];
  p.out = (float*)d_out;
  p.ws = (unsigned char*)d_ws;
  static int grid_blocks = 0;
  if (!grid_blocks) {
    int dev = 0, cus = 0, per_cu = 0;
    hipGetDevice(&dev);
    hipDeviceGetAttribute(&cus, hipDeviceAttributeMultiprocessorCount, dev);
    hipOccupancyMaxActiveBlocksPerMultiprocessor(&per_cu, fwd_kernel, NTHR, 0);
    if (per_cu < 1) per_cu = 1;
    if (per_cu > 1) per_cu = 1;
    grid_blocks = cus * per_cu;
  }
#if SINGLE_LAUNCH
  p.phase_lo = 0; p.phase_hi = 8; p.coop = 1;
  hipMemsetAsync((unsigned char*)d_ws + OFF_BAR, 0, XCD_BAR_WORDS * sizeof(unsigned), stream);
  void* args[] = {&p};
  hipError_t e = hipLaunchCooperativeKernel((void*)fwd_kernel, dim3(grid_blocks), dim3(NTHR), args, 0, stream);
  if (e != hipSuccess) fprintf(stderr, "cooperative launch failed: %s (grid %d)\n", hipGetErrorString(e), grid_blocks);
#else
  for (int ph = 0; ph <= 8; ++ph) {
    p.phase_lo = ph; p.phase_hi = ph; p.coop = 0;
    hipLaunchKernelGGL(fwd_kernel, dim3(grid_blocks), dim3(NTHR), 0, stream, p);
  }
#endif
}
```
